# Optimizing an MI355X kernel written in HIP

```python
import math
import jax, jax.numpy as jnp
from jax import lax
import numpy as np

D_MODEL = 4096
BATCH = 2
SEQ = 4096
DEPTH = 2

F32 = jnp.float32
EPS = 1e-6
HEAD_DIM = 128
MIX_WIDTH = D_MODEL
N_GROUPS = 4
GROUP_WIDTH = MIX_WIDTH // N_GROUPS
GROUP_HEADS = GROUP_WIDTH // HEAD_DIM

RET_HEADS = GROUP_HEADS
RET_CHUNK = 128
ROPE_BASE = 10000.0
MOBA_HEADS = GROUP_HEADS
MOBA_BLOCK = 256
MOBA_TOPK = 3
MOBA_QCHUNK = 32
LRU_WIDTH = GROUP_WIDTH
LRU_BLOCKS = GROUP_HEADS
LRU_BLOCK_W = LRU_WIDTH // LRU_BLOCKS
CONV_WIDTH = 4
LRU_C = 8.0
NSA_HEADS = GROUP_HEADS
NSA_KV_HEADS = 2
NSA_KV_WIDTH = NSA_KV_HEADS * HEAD_DIM
NSA_BRANCHES = 3
CMP_LEN = 32
CMP_STRIDE = 16
CMP_HIDDEN = 256
SEL_BLOCK = 64
SEL_TOPN = 16
WIN = 512
WIN_QBLOCK = 128
NSA_QCHUNK = 64
D_FF = ((8 * D_MODEL + 3 * 256 - 1) // (3 * 256)) * 256

IN_WIDTHS = ((GROUP_WIDTH,) * 4
             + (GROUP_WIDTH,) * 3
             + (LRU_WIDTH,) * 2
             + (GROUP_WIDTH,)
             + (NSA_KV_WIDTH,) * 6
             + (NSA_HEADS * NSA_BRANCHES,))
IN_WIDTH = sum(IN_WIDTHS)
SPLIT_POINTS = tuple(sum(IN_WIDTHS[:i]) for i in range(1, len(IN_WIDTHS)))

kernel_name = 'hybrid_parallel_heads_trunk'


def rmsnorm(x, w):
    xf = x.astype(F32)
    y = xf * lax.rsqrt(jnp.mean(xf * xf, axis=-1, keepdims=True) + EPS) * w.astype(F32)
    return y.astype(x.dtype)


def masked_softmax(scores, mask):
    s = jnp.where(mask, scores.astype(F32), -jnp.inf)
    m = jnp.max(s, axis=-1, keepdims=True)
    m = jnp.where(jnp.isfinite(m), m, 0.0)
    e = jnp.where(mask, jnp.exp(s - m), 0.0)
    return e / jnp.maximum(jnp.sum(e, axis=-1, keepdims=True), 1e-30)


def to_chunks(t, axis, size):
    n = t.shape[axis] // size
    t = t.reshape(t.shape[:axis] + (n, size) + t.shape[axis + 1:])
    return jnp.moveaxis(t, axis, 0)


def from_chunks(t, axis):
    t = jnp.moveaxis(t, 0, axis)
    return t.reshape(t.shape[:axis] + (t.shape[axis] * t.shape[axis + 1],) + t.shape[axis + 2:])


def rope(x, pos):
    half = x.shape[-1] // 2
    inv = ROPE_BASE ** (-jnp.arange(half, dtype=F32) / half)
    ang = pos.astype(F32)[:, None] * inv[None, :]
    cos = jnp.cos(ang)[None, :, None, :]
    sin = jnp.sin(ang)[None, :, None, :]
    x1, x2 = x[..., :half], x[..., half:]
    return jnp.concatenate([x1 * cos - x2 * sin, x1 * sin + x2 * cos], axis=-1)


def retention(q, k, v, g, gain):
    B_, S_, H, d = q.shape
    pos = jnp.arange(S_)
    q = rope(q.astype(F32), pos)
    k = rope(k.astype(F32), pos) * (d ** -0.5)
    v = v.astype(F32)
    C = RET_CHUNK
    N = S_ // C
    log_gamma = jnp.log1p(-jnp.exp2(-5.0 - jnp.arange(H, dtype=F32)))
    qc = q.reshape(B_, N, C, H, d)
    kc = k.reshape(B_, N, C, H, d)
    vc = v.reshape(B_, N, C, H, d)
    pc = jnp.arange(C, dtype=F32)
    diff = pc[:, None] - pc[None, :]
    decay_intra = jnp.where(diff >= 0, jnp.exp(log_gamma[:, None, None] * jnp.maximum(diff, 0.0)), 0.0)
    scores = jnp.einsum('bnihd,bnjhd->bnhij', qc, kc) * decay_intra
    y_intra = jnp.einsum('bnhij,bnjhd->bnihd', scores, vc)
    decay_to_end = jnp.exp(log_gamma[:, None] * (C - 1.0 - pc)[None, :])
    kv_chunk = jnp.einsum('bnjhd,hj,bnjhe->bnhde', kc, decay_to_end, vc)
    decay_chunk = jnp.exp(log_gamma * C)[None, :, None, None]

    def step(state, kv_n):
        return decay_chunk * state + kv_n, state

    _, state_prev = lax.scan(step, jnp.zeros((B_, H, d, d), F32), jnp.moveaxis(kv_chunk, 1, 0))
    state_prev = jnp.moveaxis(state_prev, 0, 1)
    decay_from_start = jnp.exp(log_gamma[:, None] * (pc + 1.0)[None, :])
    y_cross = jnp.einsum('bnihd,bnhde,hi->bnihe', qc, state_prev, decay_from_start)
    y = (y_intra + y_cross).reshape(B_, S_, H, d)
    y = y - jnp.mean(y, axis=-1, keepdims=True)
    y = y * lax.rsqrt(jnp.mean(y * y, axis=-1, keepdims=True) + EPS)
    y = y.reshape(B_, S_, H * d) * gain.astype(F32)
    return (jax.nn.silu(g.astype(F32)) * y).astype(g.dtype)


def moba_attention(q, k, v):
    B_, S_, H, d = q.shape
    scale = d ** -0.5
    BLK = MOBA_BLOCK
    QC = MOBA_QCHUNK
    NB = -(-S_ // BLK)
    pad = NB * BLK - S_
    qt = q.transpose(0, 2, 1, 3)
    kp = jnp.pad(k.transpose(0, 2, 1, 3), ((0, 0), (0, 0), (0, pad), (0, 0)))
    vp = jnp.pad(v.transpose(0, 2, 1, 3), ((0, 0), (0, 0), (0, pad), (0, 0)))
    kb = kp.reshape(B_, H, NB, BLK, d)
    vb = vp.reshape(B_, H, NB, BLK, d)
    k_mean = jnp.mean(kb.astype(F32), axis=3)
    qblk = jnp.arange(S_) // BLK
    gate = jnp.einsum('bhsd,bhnd->bhsn', qt.astype(F32), k_mean)
    past = jnp.arange(NB)[None, :] < qblk[:, None]
    gate = jnp.where(past, gate, -jnp.inf)
    topk = min(MOBA_TOPK, NB)
    _, sel = lax.top_k(gate, topk)
    sel_valid = sel < qblk[None, None, :, None]
    bi = jnp.arange(B_)[:, None, None, None]
    hi = jnp.arange(H)[None, :, None, None]
    M = topk * BLK

    def one_chunk(args):
        c, q_c, sel_c, val_c = args
        t_c = c * QC + jnp.arange(QC)
        k_sel = kb[bi, hi, sel_c].reshape(B_, H, QC, M, d)
        v_sel = vb[bi, hi, sel_c].reshape(B_, H, QC, M, d)
        own = (c * QC) // BLK * BLK
        k_own = lax.dynamic_slice_in_dim(kp, own, BLK, axis=2)
        v_own = lax.dynamic_slice_in_dim(vp, own, BLK, axis=2)
        s_sel = jnp.einsum('bhqd,bhqmd->bhqm', q_c, k_sel)
        s_own = jnp.einsum('bhqd,bhld->bhql', q_c, k_own)
        m_sel = jnp.broadcast_to(val_c[..., None], (B_, H, QC, topk, BLK)).reshape(B_, H, QC, M)
        m_own = jnp.broadcast_to(((own + jnp.arange(BLK))[None, :] <= t_c[:, None])[None, None], (B_, H, QC, BLK))
        p = masked_softmax(jnp.concatenate([s_sel, s_own], axis=-1) * scale,
                           jnp.concatenate([m_sel, m_own], axis=-1)).astype(v.dtype)
        return (jnp.einsum('bhqm,bhqmd->bhqd', p[..., :M], v_sel)
                + jnp.einsum('bhql,bhld->bhqd', p[..., M:], v_own))

    n_ch = S_ // QC
    out = lax.map(one_chunk, (jnp.arange(n_ch), to_chunks(qt, 2, QC), to_chunks(sel, 2, QC), to_chunks(sel_valid, 2, QC)))
    out = from_chunks(out, 2)
    return out.transpose(0, 2, 1, 3).reshape(B_, S_, H * d)


def rg_lru_block(xb, gb, conv_w, conv_b, wa, ba, wx, bx, lam):
    B_, S_, R = xb.shape
    xp = jnp.pad(xb, ((0, 0), (CONV_WIDTH - 1, 0), (0, 0)))
    xc = conv_b
    for tap in range(CONV_WIDTH):
        xc = xc + xp[:, tap:tap + S_] * conv_w[tap]
    xg = xc.reshape(B_, S_, LRU_BLOCKS, LRU_BLOCK_W)
    r = jax.nn.sigmoid((jnp.einsum('bsgi,gij->bsgj', xg, wa).reshape(B_, S_, R) + ba).astype(F32))
    i = jax.nn.sigmoid((jnp.einsum('bsgi,gij->bsgj', xg, wx).reshape(B_, S_, R) + bx).astype(F32))
    log_a = -LRU_C * r * jax.nn.softplus(-lam.astype(F32))
    a = jnp.exp(log_a)
    u = jnp.sqrt(jnp.maximum(-jnp.expm1(2.0 * log_a), 0.0)) * (i * xc.astype(F32))
    _, h = lax.associative_scan(lambda e1, e2: (e1[0] * e2[0], e2[0] * e1[1] + e2[1]), (a, u), axis=1)
    return (h * jax.nn.gelu(gb.astype(F32))).astype(xb.dtype)


def nsa_attention(q, k_cmp, v_cmp, k_sel, v_sel, k_win, v_win, gate_logits,
                  pos_k, w1_k, w2_k, pos_v, w1_v, w2_v):
    B_, S_, H, d = q.shape
    KVH = k_cmp.shape[2]
    G = H // KVH
    scale = d ** -0.5
    t = jnp.arange(S_)
    qg = q.reshape(B_, S_, KVH, G, d).transpose(0, 2, 3, 1, 4)

    NC = (S_ - CMP_LEN) // CMP_STRIDE + 1
    starts = jnp.arange(NC) * CMP_STRIDE
    cidx = starts[:, None] + jnp.arange(CMP_LEN)[None, :]

    def compress(x, pos, w1, w2):
        blk = x[:, cidx] + pos[None, None, :, None, :]
        flat = blk.transpose(0, 3, 1, 2, 4).reshape(B_, KVH, NC, CMP_LEN * d)
        return jax.nn.gelu(flat @ w1) @ w2

    kc = compress(k_cmp, pos_k, w1_k, w2_k)
    vc = compress(v_cmp, pos_v, w1_v, w2_v)
    s_cmp = jnp.einsum('bkgsd,bknd->bkgsn', qg, kc) * scale
    m_cmp = (starts + CMP_LEN - 1)[None, :] <= t[:, None]
    p_cmp = masked_softmax(s_cmp, m_cmp)
    o_cmp = jnp.einsum('bkgsn,bknd->bkgsd', p_cmp.astype(vc.dtype), vc).astype(F32)

    NSEL = S_ // SEL_BLOCK
    sel_start = jnp.arange(NSEL) * SEL_BLOCK
    overlap = ((starts[:, None] < sel_start[None, :] + SEL_BLOCK)
               & (starts[:, None] + CMP_LEN > sel_start[None, :])).astype(F32)
    imp = jnp.einsum('bkgsn,nj->bksj', p_cmp, overlap)
    qsb = t // SEL_BLOCK
    j = jnp.arange(NSEL)[None, :]
    forced = (j == 0) | (j == qsb[:, None]) | (j == qsb[:, None] - 1)
    allowed = j <= qsb[:, None]
    imp = jnp.where(forced, jnp.inf, jnp.where(allowed, imp, -jnp.inf))
    topn = min(SEL_TOPN, NSEL)
    _, sel = lax.top_k(imp, topn)
    kb = k_sel.transpose(0, 2, 1, 3).reshape(B_, KVH, NSEL, SEL_BLOCK, d)
    vb = v_sel.transpose(0, 2, 1, 3).reshape(B_, KVH, NSEL, SEL_BLOCK, d)
    bi = jnp.arange(B_)[:, None, None, None]
    hi = jnp.arange(KVH)[None, :, None, None]
    QC = NSA_QCHUNK
    M = topn * SEL_BLOCK

    def sel_chunk(args):
        c, q_c, sel_c = args
        t_c = c * QC + jnp.arange(QC)
        kk = kb[bi, hi, sel_c].reshape(B_, KVH, QC, M, d)
        vv = vb[bi, hi, sel_c].reshape(B_, KVH, QC, M, d)
        s = jnp.einsum('bkgqd,bkqmd->bkgqm', q_c, kk) * scale
        kpos = (sel_c[..., None] * SEL_BLOCK + jnp.arange(SEL_BLOCK)).reshape(B_, KVH, QC, M)
        mask = (kpos <= t_c[None, None, :, None])[:, :, None]
        p = masked_softmax(s, mask).astype(vv.dtype)
        return jnp.einsum('bkgqm,bkqmd->bkgqd', p, vv)

    n_ch = S_ // QC
    o_sel = lax.map(sel_chunk, (jnp.arange(n_ch), to_chunks(qg, 3, QC), to_chunks(sel, 2, QC)))
    o_sel = from_chunks(o_sel, 3).astype(F32)

    NQB = S_ // WIN_QBLOCK
    NPB = WIN // WIN_QBLOCK

    def window_blocks(x):
        xp = jnp.pad(x.transpose(0, 2, 1, 3), ((0, 0), (0, 0), (WIN, 0), (0, 0)))
        xp = xp.reshape(B_, KVH, NPB + NQB, WIN_QBLOCK, d)
        return jnp.concatenate([xp[:, :, o:o + NQB] for o in range(NPB + 1)], axis=3)

    kw = window_blocks(k_win)
    vw = window_blocks(v_win)
    qw = qg.reshape(B_, KVH, G, NQB, WIN_QBLOCK, d)
    s_win = jnp.einsum('bkgnqd,bknmd->bkgnqm', qw, kw) * scale
    tq = jnp.arange(S_).reshape(NQB, WIN_QBLOCK)
    kpos = (jnp.arange(NQB) * WIN_QBLOCK - WIN)[:, None] + jnp.arange((NPB + 1) * WIN_QBLOCK)[None, :]
    dist = tq[:, :, None] - kpos[:, None, :]
    m_win = (kpos[:, None, :] >= 0) & (dist >= 0) & (dist < WIN)
    p_win = masked_softmax(s_win, m_win).astype(vw.dtype)
    o_win = jnp.einsum('bkgnqm,bknmd->bkgnqd', p_win, vw).reshape(B_, KVH, G, S_, d).astype(F32)

    gates = jax.nn.sigmoid(gate_logits.astype(F32)).reshape(B_, S_, KVH, G, NSA_BRANCHES).transpose(0, 2, 3, 1, 4)
    o = gates[..., 0:1] * o_cmp + gates[..., 1:2] * o_sel + gates[..., 2:3] * o_win
    return o.transpose(0, 3, 1, 2, 4).reshape(B_, S_, H * d).astype(q.dtype)


def split_heads(t, n_heads):
    return t.reshape(t.shape[0], t.shape[1], n_heads, HEAD_DIM)


def hybrid_layer(x, norm_mix, w_in, w_out, ret_norm, lru_conv_w, lru_conv_b, lru_wa, lru_ba, lru_wx, lru_bx,
                 lru_lambda, cmp_pos_k, cmp_w1_k, cmp_w2_k, cmp_pos_v, cmp_w1_v, cmp_w2_v,
                 norm_ffn, w_gate, w_up, w_down):
    B_, S_, _ = x.shape
    h = rmsnorm(x, norm_mix)
    proj = jnp.einsum('bsd,de->bse', h, w_in)
    (rq, rk, rv, rg, mq, mk, mv, lx, lg, nq, nkc, nvc, nks, nvs, nkw, nvw, ngate) = jnp.split(proj, SPLIT_POINTS, axis=-1)
    y_ret = retention(split_heads(rq, RET_HEADS), split_heads(rk, RET_HEADS), split_heads(rv, RET_HEADS), rg, ret_norm)
    y_moba = moba_attention(split_heads(mq, MOBA_HEADS), split_heads(mk, MOBA_HEADS), split_heads(mv, MOBA_HEADS))
    y_lru = rg_lru_block(lx, lg, lru_conv_w, lru_conv_b, lru_wa, lru_ba, lru_wx, lru_bx, lru_lambda)
    y_nsa = nsa_attention(split_heads(nq, NSA_HEADS),
                          split_heads(nkc, NSA_KV_HEADS), split_heads(nvc, NSA_KV_HEADS),
                          split_heads(nks, NSA_KV_HEADS), split_heads(nvs, NSA_KV_HEADS),
                          split_heads(nkw, NSA_KV_HEADS), split_heads(nvw, NSA_KV_HEADS),
                          ngate.reshape(B_, S_, NSA_HEADS, NSA_BRANCHES),
                          cmp_pos_k, cmp_w1_k, cmp_w2_k, cmp_pos_v, cmp_w1_v, cmp_w2_v)
    y = jnp.concatenate([y_ret, y_moba, y_lru, y_nsa], axis=-1)
    x = x + jnp.einsum('bse,ed->bsd', y, w_out)
    h = rmsnorm(x, norm_ffn)
    u = jax.nn.silu(h @ w_gate) * (h @ w_up)
    return x + u @ w_down


def setup_inputs(seed: int = 0) -> dict:
    key = jax.random.key(seed)
    ks = jax.random.split(key, 24)

    def nrm(k, shape, scale):
        return jax.random.normal(k, shape, F32) * scale

    D = D_MODEL
    a_c = jax.random.uniform(ks[11], (DEPTH, LRU_WIDTH), F32, 0.9, 0.999)
    a = a_c ** (1.0 / LRU_C)
    return {
        'x': nrm(ks[0], (BATCH, SEQ, D), 1.0),
        'norm_mix': 1.0 + nrm(ks[1], (DEPTH, D), 0.02),
        'w_in': nrm(ks[2], (DEPTH, D, IN_WIDTH), D ** -0.5),
        'w_out': nrm(ks[3], (DEPTH, MIX_WIDTH, D), MIX_WIDTH ** -0.5),
        'ret_norm': 1.0 + nrm(ks[4], (DEPTH, GROUP_WIDTH), 0.02),
        'lru_conv_w': nrm(ks[5], (DEPTH, CONV_WIDTH, LRU_WIDTH), CONV_WIDTH ** -0.5),
        'lru_conv_b': nrm(ks[6], (DEPTH, LRU_WIDTH), 0.01),
        'lru_wa': nrm(ks[7], (DEPTH, LRU_BLOCKS, LRU_BLOCK_W, LRU_BLOCK_W), LRU_BLOCK_W ** -0.5),
        'lru_ba': nrm(ks[8], (DEPTH, LRU_WIDTH), 0.01),
        'lru_wx': nrm(ks[9], (DEPTH, LRU_BLOCKS, LRU_BLOCK_W, LRU_BLOCK_W), LRU_BLOCK_W ** -0.5),
        'lru_bx': nrm(ks[10], (DEPTH, LRU_WIDTH), 0.01),
        'lru_lambda': jnp.log(a) - jnp.log1p(-a),
        'cmp_pos_k': nrm(ks[12], (DEPTH, CMP_LEN, HEAD_DIM), 0.02),
        'cmp_w1_k': nrm(ks[13], (DEPTH, CMP_LEN * HEAD_DIM, CMP_HIDDEN), (CMP_LEN * HEAD_DIM) ** -0.5),
        'cmp_w2_k': nrm(ks[14], (DEPTH, CMP_HIDDEN, HEAD_DIM), CMP_HIDDEN ** -0.5),
        'cmp_pos_v': nrm(ks[15], (DEPTH, CMP_LEN, HEAD_DIM), 0.02),
        'cmp_w1_v': nrm(ks[16], (DEPTH, CMP_LEN * HEAD_DIM, CMP_HIDDEN), (CMP_LEN * HEAD_DIM) ** -0.5),
        'cmp_w2_v': nrm(ks[17], (DEPTH, CMP_HIDDEN, HEAD_DIM), CMP_HIDDEN ** -0.5),
        'norm_ffn': 1.0 + nrm(ks[18], (DEPTH, D), 0.02),
        'w_gate': nrm(ks[19], (DEPTH, D, D_FF), D ** -0.5),
        'w_up': nrm(ks[20], (DEPTH, D, D_FF), D ** -0.5),
        'w_down': nrm(ks[21], (DEPTH, D_FF, D), D_FF ** -0.5),
        'norm_final': 1.0 + nrm(ks[22], (D,), 0.02),
    }


def reference(x, norm_mix, w_in, w_out, ret_norm, lru_conv_w, lru_conv_b, lru_wa, lru_ba, lru_wx, lru_bx,
              lru_lambda, cmp_pos_k, cmp_w1_k, cmp_w2_k, cmp_pos_v, cmp_w1_v, cmp_w2_v,
              norm_ffn, w_gate, w_up, w_down, norm_final):
    for l in range(DEPTH):
        x = hybrid_layer(x, norm_mix[l], w_in[l], w_out[l], ret_norm[l], lru_conv_w[l], lru_conv_b[l],
                         lru_wa[l], lru_ba[l], lru_wx[l], lru_bx[l], lru_lambda[l],
                         cmp_pos_k[l], cmp_w1_k[l], cmp_w2_k[l], cmp_pos_v[l], cmp_w1_v[l], cmp_w2_v[l],
                         norm_ffn[l], w_gate[l], w_up[l], w_down[l])
    return rmsnorm(x, norm_final)
```

```cpp
#include <hip/hip_runtime.h>
#include <cstdio>
#include <cstdint>

#ifndef GEMM_MFMA32
#define GEMM_MFMA32 0
#endif
#ifndef MK_LAUNCHES
#define MK_LAUNCHES 1
#endif

#define LAS __attribute__((address_space(3)))
#define GAS __attribute__((address_space(1)))
typedef unsigned short bf16_t;
typedef short bf16x8 __attribute__((ext_vector_type(8)));
typedef short s16x4 __attribute__((ext_vector_type(4)));
typedef float f32x2 __attribute__((ext_vector_type(2)));
typedef float f32x4 __attribute__((ext_vector_type(4)));
typedef float f32x16 __attribute__((ext_vector_type(16)));
typedef unsigned u32x2 __attribute__((ext_vector_type(2)));
typedef unsigned u32x4 __attribute__((ext_vector_type(4)));
typedef LAS unsigned char* ldsp;

namespace pg8 {
#define PG8_LAS __attribute__((address_space(3)))
constexpr int BM = 256, BK = 64, HALF = 128, HTB = HALF * BK * 2  , STAGE_BYTES = 8 * HTB, NXCD = 8, WGM = 8;

__host__ __device__ __forceinline__ int lds_byte(int r, int c) { const int st = (r >> 4) * 2 + (c >> 5), rr = r & 15, cc = c & 31, ob = rr * 64 + cc * 2; return st * 1024 + (ob ^ (((ob >> 9) & 1) << 5)); }
__host__ __device__ __forceinline__ void stage_rc(int b, int& R, int& C) { const int st = b / 1024, sb = b % 1024, swz = sb ^ (((sb >> 9) & 1) << 5); R = (st >> 1) * 16 + swz / 64; C = (st & 1) * 32 + (swz % 64) / 2; }
__host__ __device__ __forceinline__ int perm32(int rho) { const int n = rho >> 4, i = rho & 15; return 8 * (i >> 2) + 4 * n + (i & 3); }

__host__ __device__ __forceinline__ int perm32x(int rho) { return 16 * ((rho >> 2) & 1) + 4 * (rho >> 3) + (rho & 3); }
struct Unit { int pm, pn; };
struct Gemm { const bf16_t* A; const bf16_t* Bt; int M, N, K; };

struct StaticOrder {
    int nM, nN, nwg, G, c;
    __host__ __device__ void init(int M, int N, int G_, int c_) { nM = M / BM; nN = N / BM; nwg = nM * nN; G = G_; c = c_; }
    __host__ __device__ bool next(int i, Unit& u) const {
        const long L = (long)i * G + c; if (L >= nwg) return false;
        int wgid = (int)L; { const int q = nwg / NXCD, r = nwg % NXCD, xcd = wgid % NXCD, off = wgid / NXCD; wgid = (xcd < r ? xcd * (q + 1) : r * (q + 1) + (xcd - r) * q) + off; }
        const int nig = WGM * nN, gid = wgid / nig, fm = gid * WGM, gsz = (nM - fm) < WGM ? (nM - fm) : WGM;
        u.pm = fm + ((wgid % nig) % gsz); u.pn = (wgid % nig) / gsz; return true;
    }
    __device__ __forceinline__ void a_ready(const Unit&) const {}
    __device__ __forceinline__ void done(const Unit&) const {}
};

__device__ __forceinline__ unsigned cvt_pk_bf16(float lo, float hi) { unsigned r; asm volatile("v_cvt_pk_bf16_f32 %0, %1, %2" : "=v"(r) : "v"(lo), "v"(hi)); return r; }

constexpr float EPI_EPS = 1e-6f;
__device__ __forceinline__ void epi_bar() { asm volatile("s_waitcnt lgkmcnt(0)" ::: "memory"); __builtin_amdgcn_s_barrier(); asm volatile("" ::: "memory"); }
__device__ __forceinline__ void epi_rstd_table(const float* ssq, int fm, PG8_LAS float* RS, int t) {
    f32x4 v[4][4];
#pragma unroll
    for (int q = 0; q < 4; ++q) { const f32x4* p = (const f32x4*)(ssq + (size_t)(fm * BM + t + 512 * q) * 16); v[q][0] = p[0]; v[q][1] = p[1]; v[q][2] = p[2]; v[q][3] = p[3]; }
    asm volatile("" :: "v"(v[0][0]), "v"(v[0][1]), "v"(v[0][2]), "v"(v[0][3]), "v"(v[1][0]), "v"(v[1][1]), "v"(v[1][2]), "v"(v[1][3]),
                    "v"(v[2][0]), "v"(v[2][1]), "v"(v[2][2]), "v"(v[2][3]), "v"(v[3][0]), "v"(v[3][1]), "v"(v[3][2]), "v"(v[3][3]) : "memory");
#pragma unroll
    for (int q = 0; q < 4; ++q) { const int r = t + 512 * q; const f32x4 a = v[q][0], b = v[q][1], c = v[q][2], d = v[q][3];
        const float sm = ((a[0] + a[1]) + (a[2] + a[3])) + ((b[0] + b[1]) + (b[2] + b[3])) + ((c[0] + c[1]) + (c[2] + c[3])) + ((d[0] + d[1]) + (d[2] + d[3]));
        RS[r] = 1.0f / sqrtf(sm * (1.0f / 4096.0f) + EPI_EPS); }
    epi_bar();
}
#if GEMM_MFMA32
struct EpiBf16N {
    static constexpr bool PERM = true, AFTER_DRAIN = false;
    bf16_t* O; int ldc; int fm; PG8_LAS unsigned char* xl;
    __device__ __forceinline__ void operator()(const f32x16 (&acc)[2][2][2], const Unit& u, int wr, int wc, int fr, int fq) const {
        const PG8_LAS float* RS = (const PG8_LAS float*)xl + (u.pm - fm) * BM;
        const int row0 = u.pm * BM + wr * 64 + fr, col0 = u.pn * BM + wc * 32 + 16 * fq;
#pragma unroll
        for (int ai = 0; ai < 2; ++ai)
#pragma unroll
            for (int mt = 0; mt < 2; ++mt) { bf16_t* rowp = O + (size_t)(row0 + ai * HALF + mt * 32) * ldc + col0; const float rs = RS[ai * HALF + wr * 64 + mt * 32 + fr];
#pragma unroll
                for (int bj = 0; bj < 2; ++bj) { const f32x16 v = acc[ai][bj][mt] * rs;
                    u32x4 w0, w1; w0.x = cvt_pk_bf16(v[0], v[1]); w0.y = cvt_pk_bf16(v[2], v[3]); w0.z = cvt_pk_bf16(v[4], v[5]); w0.w = cvt_pk_bf16(v[6], v[7]);
                    w1.x = cvt_pk_bf16(v[8], v[9]); w1.y = cvt_pk_bf16(v[10], v[11]); w1.z = cvt_pk_bf16(v[12], v[13]); w1.w = cvt_pk_bf16(v[14], v[15]);
                    *(u32x4*)(rowp + bj * HALF) = w0; *(u32x4*)(rowp + bj * HALF + 8) = w1; } }
    }
};
struct EpiSwiGLUN {
    static constexpr bool PERM = true, AFTER_DRAIN = false;
    bf16_t* O; int ldc; int fm; PG8_LAS unsigned char* xl;
    __device__ __forceinline__ void operator()(const f32x16 (&acc)[2][2][2], const Unit& u, int wr, int wc, int fr, int fq) const {
        const PG8_LAS float* RS = (const PG8_LAS float*)xl + (u.pm - fm) * BM;
        const int row0 = u.pm * BM + wr * 64 + fr, col0 = u.pn * HALF + wc * 32 + 16 * fq;
#pragma unroll
        for (int ai = 0; ai < 2; ++ai)
#pragma unroll
            for (int mt = 0; mt < 2; ++mt) { bf16_t* rowp = O + (size_t)(row0 + ai * HALF + mt * 32) * ldc + col0; const float rs = RS[ai * HALF + wr * 64 + mt * 32 + fr];
                float r[16];
#pragma unroll
                for (int j = 0; j < 16; ++j) { const float g = acc[ai][0][mt][j] * rs, up = acc[ai][1][mt][j] * rs; r[j] = g * __builtin_amdgcn_rcpf(1.0f + __expf(-g)) * up; }
                u32x4 w0, w1; w0.x = cvt_pk_bf16(r[0], r[1]); w0.y = cvt_pk_bf16(r[2], r[3]); w0.z = cvt_pk_bf16(r[4], r[5]); w0.w = cvt_pk_bf16(r[6], r[7]);
                w1.x = cvt_pk_bf16(r[8], r[9]); w1.y = cvt_pk_bf16(r[10], r[11]); w1.z = cvt_pk_bf16(r[12], r[13]); w1.w = cvt_pk_bf16(r[14], r[15]);
                *(u32x4*)rowp = w0; *(u32x4*)(rowp + 8) = w1; }
    }
};
struct EpiResidB {
    static constexpr bool PERM = true, AFTER_DRAIN = false;
    const bf16_t* res; bf16_t* X; int ldc; float* ssq_out; PG8_LAS unsigned char* xl;
    __device__ __forceinline__ void operator()(const f32x16 (&acc)[2][2][2], const Unit& u, int wr, int wc, int fr, int fq) const {
        PG8_LAS float* SSQL = (PG8_LAS float*)(xl + 8192);
        const int row0 = u.pm * BM + wr * 64 + fr, col0 = u.pn * BM + wc * 32 + 16 * fq;
#pragma unroll
        for (int ai = 0; ai < 2; ++ai) { u32x4 rw[2][2][2];
#pragma unroll
            for (int mt = 0; mt < 2; ++mt)
#pragma unroll
                for (int bj = 0; bj < 2; ++bj) { const bf16_t* rp = res + (size_t)(row0 + ai * HALF + mt * 32) * ldc + col0 + bj * HALF; rw[mt][bj][0] = *(const u32x4*)rp; rw[mt][bj][1] = *(const u32x4*)(rp + 8); }
#pragma unroll
            for (int mt = 0; mt < 2; ++mt) { float sq = 0.f;
#pragma unroll
                for (int bj = 0; bj < 2; ++bj) { const f32x16 a = acc[ai][bj][mt]; float v[16];
#pragma unroll
                    for (int h = 0; h < 2; ++h) { const u32x4 rr = rw[mt][bj][h];
                        v[8 * h + 0] = __uint_as_float(rr.x << 16) + a[8 * h + 0]; v[8 * h + 1] = __uint_as_float(rr.x & 0xffff0000u) + a[8 * h + 1];
                        v[8 * h + 2] = __uint_as_float(rr.y << 16) + a[8 * h + 2]; v[8 * h + 3] = __uint_as_float(rr.y & 0xffff0000u) + a[8 * h + 3];
                        v[8 * h + 4] = __uint_as_float(rr.z << 16) + a[8 * h + 4]; v[8 * h + 5] = __uint_as_float(rr.z & 0xffff0000u) + a[8 * h + 5];
                        v[8 * h + 6] = __uint_as_float(rr.w << 16) + a[8 * h + 6]; v[8 * h + 7] = __uint_as_float(rr.w & 0xffff0000u) + a[8 * h + 7]; }
#pragma unroll
                    for (int j = 0; j < 16; j += 4) sq += (v[j] * v[j] + v[j + 1] * v[j + 1]) + (v[j + 2] * v[j + 2] + v[j + 3] * v[j + 3]);
                    u32x4 w0, w1; w0.x = cvt_pk_bf16(v[0], v[1]); w0.y = cvt_pk_bf16(v[2], v[3]); w0.z = cvt_pk_bf16(v[4], v[5]); w0.w = cvt_pk_bf16(v[6], v[7]);
                    w1.x = cvt_pk_bf16(v[8], v[9]); w1.y = cvt_pk_bf16(v[10], v[11]); w1.z = cvt_pk_bf16(v[12], v[13]); w1.w = cvt_pk_bf16(v[14], v[15]);
                    bf16_t* xp = X + (size_t)(row0 + ai * HALF + mt * 32) * ldc + col0 + bj * HALF; *(u32x4*)xp = w0; *(u32x4*)(xp + 8) = w1; }
                sq += __shfl_xor(sq, 32);
                if (fq == 0) SSQL[(ai * HALF + wr * 64 + mt * 32 + fr) * 4 + wc] = sq; } }
        epi_bar();
        const int t = (wr * 4 + wc) * 64 + fq * 32 + fr;
        if (t < 256) { const f32x4 p = *(const PG8_LAS f32x4*)(SSQL + t * 4); ssq_out[(size_t)(u.pm * BM + t) * 16 + u.pn] = (p[0] + p[1]) + (p[2] + p[3]); }
    }
};
#else
struct EpiBf16N {
    static constexpr bool PERM = true, AFTER_DRAIN = false;
    bf16_t* O; int ldc; int fm; PG8_LAS unsigned char* xl;
    __device__ __forceinline__ void operator()(const f32x4 (&acc)[2][2][4][2], const Unit& u, int wr, int wc, int fr, int fq) const {
        const PG8_LAS float* RS = (const PG8_LAS float*)xl + (u.pm - fm) * BM;
        const int row0 = u.pm * BM + wr * 64 + fr, col0 = u.pn * BM + wc * 32 + 8 * fq;
#pragma unroll
        for (int ai = 0; ai < 2; ++ai)
#pragma unroll
            for (int m = 0; m < 4; ++m) { bf16_t* rowp = O + (size_t)(row0 + ai * HALF + m * 16) * ldc + col0; const float rs = RS[ai * HALF + wr * 64 + m * 16 + fr];
#pragma unroll
                for (int bj = 0; bj < 2; ++bj) { const f32x4 v0 = acc[ai][bj][m][0] * rs, v1 = acc[ai][bj][m][1] * rs;
                    u32x4 w; w.x = cvt_pk_bf16(v0[0], v0[1]); w.y = cvt_pk_bf16(v0[2], v0[3]); w.z = cvt_pk_bf16(v1[0], v1[1]); w.w = cvt_pk_bf16(v1[2], v1[3]);
                    *(u32x4*)(rowp + bj * HALF) = w; } }
    }
};
struct EpiSwiGLUN {
    static constexpr bool PERM = true, AFTER_DRAIN = false;
    bf16_t* O; int ldc; int fm; PG8_LAS unsigned char* xl;
    __device__ __forceinline__ void operator()(const f32x4 (&acc)[2][2][4][2], const Unit& u, int wr, int wc, int fr, int fq) const {
        const PG8_LAS float* RS = (const PG8_LAS float*)xl + (u.pm - fm) * BM;
        const int row0 = u.pm * BM + wr * 64 + fr, col0 = u.pn * HALF + wc * 32 + 8 * fq;
#pragma unroll
        for (int ai = 0; ai < 2; ++ai)
#pragma unroll
            for (int m = 0; m < 4; ++m) { bf16_t* rowp = O + (size_t)(row0 + ai * HALF + m * 16) * ldc + col0; const float rs = RS[ai * HALF + wr * 64 + m * 16 + fr];
                float r[8];
#pragma unroll
                for (int n = 0; n < 2; ++n)
#pragma unroll
                    for (int j = 0; j < 4; ++j) { const float g = acc[ai][0][m][n][j] * rs, up = acc[ai][1][m][n][j] * rs;
                        r[n * 4 + j] = g * __builtin_amdgcn_rcpf(1.0f + __expf(-g)) * up; }
                u32x4 w; w.x = cvt_pk_bf16(r[0], r[1]); w.y = cvt_pk_bf16(r[2], r[3]); w.z = cvt_pk_bf16(r[4], r[5]); w.w = cvt_pk_bf16(r[6], r[7]);
                *(u32x4*)rowp = w; }
    }
};
struct EpiResidB {
    static constexpr bool PERM = true, AFTER_DRAIN = false;
    const bf16_t* res; bf16_t* X; int ldc; float* ssq_out; PG8_LAS unsigned char* xl;
    __device__ __forceinline__ void operator()(const f32x4 (&acc)[2][2][4][2], const Unit& u, int wr, int wc, int fr, int fq) const {
        PG8_LAS float* SSQL = (PG8_LAS float*)(xl + 8192);
        const int row0 = u.pm * BM + wr * 64 + fr, col0 = u.pn * BM + wc * 32 + 8 * fq;
#pragma unroll
        for (int ai = 0; ai < 2; ++ai) { u32x4 rw[4][2];
#pragma unroll
            for (int m = 0; m < 4; ++m)
#pragma unroll
                for (int bj = 0; bj < 2; ++bj) rw[m][bj] = *(const u32x4*)(res + (size_t)(row0 + ai * HALF + m * 16) * ldc + col0 + bj * HALF);
#pragma unroll
            for (int m = 0; m < 4; ++m) { float sq = 0.f;
#pragma unroll
                for (int bj = 0; bj < 2; ++bj) { const u32x4 rr = rw[m][bj]; const f32x4 a0 = acc[ai][bj][m][0], a1 = acc[ai][bj][m][1];
                    float v[8];
                    v[0] = __uint_as_float(rr.x << 16) + a0[0]; v[1] = __uint_as_float(rr.x & 0xffff0000u) + a0[1]; v[2] = __uint_as_float(rr.y << 16) + a0[2]; v[3] = __uint_as_float(rr.y & 0xffff0000u) + a0[3];
                    v[4] = __uint_as_float(rr.z << 16) + a1[0]; v[5] = __uint_as_float(rr.z & 0xffff0000u) + a1[1]; v[6] = __uint_as_float(rr.w << 16) + a1[2]; v[7] = __uint_as_float(rr.w & 0xffff0000u) + a1[3];
                    sq += ((v[0] * v[0] + v[1] * v[1]) + (v[2] * v[2] + v[3] * v[3])) + ((v[4] * v[4] + v[5] * v[5]) + (v[6] * v[6] + v[7] * v[7]));
                    u32x4 w; w.x = cvt_pk_bf16(v[0], v[1]); w.y = cvt_pk_bf16(v[2], v[3]); w.z = cvt_pk_bf16(v[4], v[5]); w.w = cvt_pk_bf16(v[6], v[7]);
                    *(u32x4*)(X + (size_t)(row0 + ai * HALF + m * 16) * ldc + col0 + bj * HALF) = w; }
                sq += __shfl_xor(sq, 16); sq += __shfl_xor(sq, 32);
                if (fq == 0) SSQL[(ai * HALF + wr * 64 + m * 16 + fr) * 4 + wc] = sq; } }
        epi_bar();
        const int t = (wr * 4 + wc) * 64 + fq * 16 + fr;
        if (t < 256) { const f32x4 p = *(const PG8_LAS f32x4*)(SSQL + t * 4); ssq_out[(size_t)(u.pm * BM + t) * 16 + u.pn] = (p[0] + p[1]) + (p[2] + p[3]); }
    }
};
#endif
template <class Epi, class Sched, bool ALIGN_EPI = false, bool SP2 = false>
__device__ __forceinline__ void gemm_phase(PG8_LAS unsigned char* lds, const Gemm g, const Sched& S, const Epi& E) {
    int tid_ = threadIdx.x; asm volatile("" : "+v"(tid_));
#if GEMM_MFMA32
    const int tid = tid_, wid = __builtin_amdgcn_readfirstlane(tid >> 6), lane = tid & 63, wr = wid >> 2, wc = wid & 3, fr = lane & 31, fq = lane >> 5;
#else
    const int tid = tid_, wid = __builtin_amdgcn_readfirstlane(tid >> 6), lane = tid & 63, wr = wid >> 2, wc = wid & 3, fr = lane & 15, fq = lane >> 4;
#endif
    const int K = g.K, nt = K / BK;
    unsigned voffA[2], voffB[2];
#pragma unroll
    for (int i = 0; i < 2; ++i) { int R, C; stage_rc(tid * 16 + i * 8192, R, C); const int Rb = Epi::PERM ? ((R & ~31) + (GEMM_MFMA32 ? perm32x(R & 31) : perm32(R & 31))) : R;
        voffA[i] = (unsigned)(R * K + C) * 2u; voffB[i] = (unsigned)(Rb * K + C) * 2u; }
    const size_t kstep = (size_t)(BK * 2);
    const size_t hstep = (size_t)HALF * K * 2;
    const size_t tstep = 2 * hstep;
    const unsigned ldsw = (unsigned)wid * 1024u;
#if GEMM_MFMA32
    const int aE = lds_byte(wr * 64 + fr, fq * 8), aO = lds_byte(wr * 64 + fr, 16 + fq * 8), bE = lds_byte(wc * 32 + fr, fq * 8), bO = lds_byte(wc * 32 + fr, 16 + fq * 8);
#else
    const int aoff = lds_byte(wr * 64 + fr, fq * 8), boff = lds_byte(wc * 32 + fr, fq * 8);
#endif
#define PG8_SA(b, h) (((b) * 2 + (h)) * HTB)
#define PG8_SB(b, h) ((4 + (b) * 2 + (h)) * HTB)
#define PG8_STAGE(bufoff, gbase, voff) do { _Pragma("unroll") for (int _i = 0; _i < 2; ++_i) \
        __builtin_amdgcn_global_load_lds((const unsigned*)((const char*)(gbase) + (voff)[_i]), (PG8_LAS unsigned*)(lds + (bufoff) + ldsw + _i * 8192), 16, 0, 0); } while (0)
#if GEMM_MFMA32
#define PG8_LDA(dst, b, h) do { _Pragma("unroll") for (int m = 0; m < 2; ++m) _Pragma("unroll") for (int k = 0; k < 4; ++k) dst[m][k] = *(const PG8_LAS bf16x8*)(lds + PG8_SA(b, h) + ((k & 1) ? aO : aE) + (k >> 1) * 1024 + m * 4096); } while (0)
#define PG8_LDB(dst, b, h) do { _Pragma("unroll") for (int k = 0; k < 4; ++k) dst[k] = *(const PG8_LAS bf16x8*)(lds + PG8_SB(b, h) + ((k & 1) ? bO : bE) + (k >> 1) * 1024); } while (0)
#define PG8_MMA(ai, bj, At, Bt) do { __builtin_amdgcn_s_setprio(1); _Pragma("unroll") for (int k = 0; k < 4; ++k) _Pragma("unroll") for (int m = 0; m < 2; ++m) \
        acc[ai][bj][m] = __builtin_amdgcn_mfma_f32_32x32x16_bf16(Bt[k], At[m][k], acc[ai][bj][m], 0, 0, 0); __builtin_amdgcn_s_setprio(0); } while (0)
#define PG8_ZERO_ACC() do { _Pragma("unroll") for (int a = 0; a < 2; ++a) _Pragma("unroll") for (int b = 0; b < 2; ++b) _Pragma("unroll") for (int m = 0; m < 2; ++m) acc[a][b][m] = f32x16{}; } while (0)
#define PG8_MMA2(ai, At, Bx, By) do { __builtin_amdgcn_s_setprio(1); _Pragma("unroll") for (int k = 0; k < 4; ++k) _Pragma("unroll") for (int m = 0; m < 2; ++m) { \
        acc[ai][0][m] = __builtin_amdgcn_mfma_f32_32x32x16_bf16(Bx[k], At[m][k], acc[ai][0][m], 0, 0, 0); \
        acc[ai][1][m] = __builtin_amdgcn_mfma_f32_32x32x16_bf16(By[k], At[m][k], acc[ai][1][m], 0, 0, 0); } __builtin_amdgcn_s_setprio(0); } while (0)
#else
#define PG8_MMA2(ai, At, Bx, By) do { PG8_MMA(ai, 0, At, Bx); PG8_MMA(ai, 1, At, By); } while (0)
#define PG8_LDA(dst, b, h) do { _Pragma("unroll") for (int m = 0; m < 4; ++m) _Pragma("unroll") for (int k = 0; k < 2; ++k) dst[m][k] = *(const PG8_LAS bf16x8*)(lds + PG8_SA(b, h) + aoff + m * 2048 + k * 1024); } while (0)
#define PG8_LDB(dst, b, h) do { _Pragma("unroll") for (int n = 0; n < 2; ++n) _Pragma("unroll") for (int k = 0; k < 2; ++k) dst[n][k] = *(const PG8_LAS bf16x8*)(lds + PG8_SB(b, h) + boff + n * 2048 + k * 1024); } while (0)
#define PG8_MMA(ai, bj, At, Bt) do { __builtin_amdgcn_s_setprio(1); _Pragma("unroll") for (int m = 0; m < 4; ++m) _Pragma("unroll") for (int n = 0; n < 2; ++n) _Pragma("unroll") for (int k = 0; k < 2; ++k) \
        acc[ai][bj][m][n] = __builtin_amdgcn_mfma_f32_16x16x32_bf16(Bt[n][k], At[m][k], acc[ai][bj][m][n], 0, 0, 0); __builtin_amdgcn_s_setprio(0); } while (0)
#define PG8_ZERO_ACC() do { _Pragma("unroll") for (int a = 0; a < 2; ++a) _Pragma("unroll") for (int b = 0; b < 2; ++b) _Pragma("unroll") for (int m = 0; m < 4; ++m) _Pragma("unroll") for (int n = 0; n < 2; ++n) acc[a][b][m][n] = (f32x4){0.f, 0.f, 0.f, 0.f}; } while (0)
#endif
#define PG8_WAIT_V(n) asm volatile("s_waitcnt vmcnt(" #n ")" ::: "memory")
#define PG8_WAIT_L(n) asm volatile("s_waitcnt lgkmcnt(" #n ")" ::: "memory")
#define PG8_BAR __builtin_amdgcn_s_barrier()
#define PG8_SCHED __builtin_amdgcn_sched_barrier(0)
    Unit cur, nxt; int ui = 0;
    if (!S.next(0, cur)) return;
#if GEMM_MFMA32
    f32x16 acc[2][2][2]; bf16x8 At[2][4], B0[4], B1[4];
#else
    f32x4 acc[2][2][4][2]; bf16x8 At[4][2], B0[2][2], B1[2][2];
#endif
    PG8_ZERO_ACC();
    const char* cA = (const char*)g.A + (size_t)cur.pm * tstep; const char* cB = (const char*)g.Bt + (size_t)cur.pn * tstep;
    S.a_ready(cur);
    if constexpr (SP2) {
        PG8_STAGE(PG8_SB(0, 0), cB, voffB); PG8_STAGE(PG8_SB(0, 1), cB + hstep, voffB); PG8_STAGE(PG8_SA(0, 0), cA, voffA); PG8_STAGE(PG8_SA(0, 1), cA + hstep, voffA);
        if (wr == 1) PG8_BAR;
        PG8_WAIT_V(2); PG8_BAR;
        PG8_STAGE(PG8_SB(1, 0), cB + kstep, voffB); PG8_STAGE(PG8_SA(1, 0), cA + kstep, voffA); PG8_STAGE(PG8_SB(1, 1), cB + hstep + kstep, voffB);
        PG8_WAIT_V(6); PG8_BAR;
    } else {
        PG8_STAGE(PG8_SB(0, 0), cB, voffB); PG8_STAGE(PG8_SA(0, 0), cA, voffA); PG8_STAGE(PG8_SB(0, 1), cB + hstep, voffB); PG8_STAGE(PG8_SA(0, 1), cA + hstep, voffA);
        if (wr == 1) PG8_BAR;
        PG8_WAIT_V(4); PG8_BAR;
        PG8_STAGE(PG8_SB(1, 0), cB + kstep, voffB); PG8_STAGE(PG8_SA(1, 0), cA + kstep, voffA); PG8_STAGE(PG8_SB(1, 1), cB + hstep + kstep, voffB);
        PG8_WAIT_V(6); PG8_BAR;
    }
    for (;;) {
        const bool has_next = S.next(ui + 1, nxt);
        const char* nA = has_next ? (const char*)g.A + (size_t)nxt.pm * tstep : cA; const char* nB = has_next ? (const char*)g.Bt + (size_t)nxt.pn * tstep : cB;
        for (int t = 0; t < nt; t += 2) {
            const bool last = (t == nt - 2);
            const char* a1 = cA + (size_t)(t + 1) * kstep;
            const char* a2 = last ? nA : cA + (size_t)(t + 2) * kstep; const char* b2 = last ? nB : cB + (size_t)(t + 2) * kstep;
            const char* a3 = a2 + kstep; const char* b3 = b2 + kstep;
            if (last && has_next) S.a_ready(nxt);
            if constexpr (SP2) {
            PG8_LDB(B0, 0, 0); PG8_LDB(B1, 0, 1); PG8_SCHED; PG8_LDA(At, 0, 0); PG8_STAGE(PG8_SA(1, 1), a1 + hstep, voffA);
            PG8_WAIT_V(8); PG8_WAIT_L(0); PG8_BAR; PG8_MMA2(0, At, B0, B1); PG8_BAR; PG8_SCHED;
            PG8_LDA(At, 0, 1); PG8_STAGE(PG8_SB(0, 0), b2, voffB); PG8_STAGE(PG8_SB(0, 1), b2 + hstep, voffB); PG8_STAGE(PG8_SA(0, 0), a2, voffA);
            PG8_WAIT_V(8); PG8_WAIT_L(0); PG8_BAR; PG8_MMA2(1, At, B0, B1); PG8_BAR; PG8_SCHED;
            PG8_LDB(B0, 1, 0); PG8_LDB(B1, 1, 1); PG8_SCHED; PG8_LDA(At, 1, 0); PG8_STAGE(PG8_SA(0, 1), a2 + hstep, voffA);
            PG8_WAIT_V(8); PG8_WAIT_L(0); PG8_BAR; PG8_MMA2(0, At, B0, B1); PG8_BAR; PG8_SCHED;
            PG8_LDA(At, 1, 1); PG8_STAGE(PG8_SB(1, 0), b3, voffB); PG8_STAGE(PG8_SB(1, 1), b3 + hstep, voffB); PG8_STAGE(PG8_SA(1, 0), a3, voffA);
            PG8_WAIT_V(8); PG8_WAIT_L(0); PG8_BAR; PG8_MMA2(1, At, B0, B1); PG8_BAR; PG8_SCHED;
            } else {
            PG8_LDB(B0, 0, 0); PG8_SCHED; PG8_LDA(At, 0, 0); PG8_STAGE(PG8_SA(1, 1), a1 + hstep, voffA);
            PG8_WAIT_L(8); PG8_BAR; PG8_WAIT_L(0); PG8_MMA(0, 0, At, B0); PG8_BAR; PG8_SCHED;
            PG8_LDB(B1, 0, 1); PG8_STAGE(PG8_SB(0, 0), b2, voffB);
            PG8_BAR; PG8_WAIT_L(0); PG8_MMA(0, 1, At, B1); PG8_BAR;
            PG8_LDA(At, 0, 1); PG8_STAGE(PG8_SA(0, 0), a2, voffA);
            PG8_BAR; PG8_WAIT_L(0); PG8_MMA(1, 0, At, B0); PG8_BAR; PG8_SCHED;
            PG8_STAGE(PG8_SB(0, 1), b2 + hstep, voffB);
            PG8_WAIT_V(6); PG8_BAR; PG8_MMA(1, 1, At, B1); PG8_BAR;
            PG8_LDB(B0, 1, 0); PG8_SCHED; PG8_LDA(At, 1, 0); PG8_STAGE(PG8_SA(0, 1), a2 + hstep, voffA);
            PG8_WAIT_L(8); PG8_BAR; PG8_WAIT_L(0); PG8_MMA(0, 0, At, B0); PG8_BAR; PG8_SCHED;
            PG8_LDB(B1, 1, 1); PG8_STAGE(PG8_SB(1, 0), b3, voffB);
            PG8_BAR; PG8_WAIT_L(0); PG8_MMA(0, 1, At, B1); PG8_BAR;
            PG8_LDA(At, 1, 1); PG8_STAGE(PG8_SA(1, 0), a3, voffA);
            PG8_BAR; PG8_WAIT_L(0); PG8_MMA(1, 0, At, B0); PG8_BAR; PG8_SCHED;
            PG8_STAGE(PG8_SB(1, 1), b3 + hstep, voffB);
            PG8_WAIT_V(6); PG8_BAR; PG8_MMA(1, 1, At, B1); PG8_BAR;
            }
        }
        if constexpr (ALIGN_EPI) { if (wr == 0) PG8_BAR; }
        if constexpr (!Epi::AFTER_DRAIN) { E(acc, cur, wr, wc, fr, fq); S.done(cur); }
        if (!has_next) break;
        PG8_ZERO_ACC();
        cur = nxt; cA = nA; cB = nB; ++ui;
        if constexpr (ALIGN_EPI) { if (wr == 1) PG8_BAR; }
    }
    PG8_WAIT_V(0);
    if constexpr (!ALIGN_EPI) { if (wr == 0) PG8_BAR; }
    PG8_BAR;
    if constexpr (Epi::AFTER_DRAIN) { E.fused(acc, cur, wr, wc, fr, fq, lds, wid, lane); S.done(cur); }
#undef PG8_SA
#undef PG8_SB
#undef PG8_STAGE
#undef PG8_LDA
#undef PG8_LDB
#undef PG8_MMA
#undef PG8_MMA2
#undef PG8_ZERO_ACC
#undef PG8_WAIT_V
#undef PG8_WAIT_L
#undef PG8_BAR
#undef PG8_SCHED
}
}

#define XB_TMO      128
#define XB_XCNT(j)  (256  + 64 * (j))
#define XB_XSUB(j)  (1280 + 64 * (j))
#define XB_XGEN(j)  (2304 + 64 * (j))
#define XB_TOP      3328
#define XB_TOPGEN   3392
#define XCD_BAR_WORDS 3456
#define XB_SPIN_CAP (1u << 18)

__device__ __forceinline__ unsigned xb_ld(unsigned* p)              { return __hip_atomic_load(p, __ATOMIC_RELAXED, __HIP_MEMORY_SCOPE_AGENT); }
__device__ __forceinline__ unsigned xb_add(unsigned* p, unsigned v) { return __hip_atomic_fetch_add(p, v, __ATOMIC_RELAXED, __HIP_MEMORY_SCOPE_AGENT); }
__device__ __forceinline__ unsigned xb_xcc_id() { return (unsigned)__builtin_amdgcn_s_getreg((3 << 11) | 20) & 0xFu; }
#define XB_SPIN(cond, bar) do { unsigned _sp = 0; while (cond) { __builtin_amdgcn_s_sleep(1); \
    if ((++_sp & 255u) == 0u) { if (xb_ld(&(bar)[XB_TMO])) break; if (_sp > XB_SPIN_CAP) { atomicAdd(&(bar)[XB_TMO], 1u); break; } } } } while (0)

struct XcdBarrier {
    unsigned* bar; unsigned x;
    volatile LAS unsigned* st;
};

__device__ __forceinline__ XcdBarrier xcd_barrier_post(unsigned* bar, volatile LAS unsigned* st) {
    XcdBarrier b; b.bar = bar; b.x = xb_xcc_id(); b.st = st;
    if (threadIdx.x == 0) (void)xb_add(&bar[XB_XCNT(b.x)], 1u);
    return b;
}
__device__ __forceinline__ void xcd_barrier_complete(unsigned* bar, unsigned x, unsigned& nloc, unsigned& nx) {
    const unsigned G = gridDim.x * gridDim.y * gridDim.z;
    unsigned sum, cnt, mine, sp = 0u;
    for (;;) {
        sum = 0u; cnt = 0u; mine = 0u;
#pragma unroll
        for (unsigned j = 0; j < 16; ++j) { const unsigned c = xb_ld(&bar[XB_XCNT(j)]); sum += c; cnt += (c > 0u) ? 1u : 0u; mine = (j == x) ? c : mine; }
        if (sum == G) break;
        __builtin_amdgcn_s_sleep(1);
        if ((++sp & 255u) == 0u) { if (xb_ld(&bar[XB_TMO])) break; if (sp > XB_SPIN_CAP) { atomicAdd(&bar[XB_TMO], 1u); break; } }
    }
    nloc = mine > 0u ? mine : 1u; nx = cnt > 0u ? cnt : 1u;
}

__device__ __forceinline__ void xcd_barrier(const XcdBarrier& b) {
    asm volatile("s_waitcnt vmcnt(0)" ::: "memory");
    __syncthreads();
    if (threadIdx.x == 0) {
        unsigned* bar = b.bar;
        __builtin_amdgcn_s_waitcnt(0);
        unsigned nloc = b.st[0], nx = b.st[1];
        if (nloc == 0u) { xcd_barrier_complete(bar, b.x, nloc, nx); b.st[0] = nloc; b.st[1] = nx; }
        const unsigned old = xb_add(&bar[XB_XSUB(b.x)], 1u);
        const unsigned gen = old / nloc;
        if (old + 1u == (gen + 1u) * nloc) {
            __builtin_amdgcn_fence(__ATOMIC_RELEASE, "agent");
            asm volatile("s_waitcnt vmcnt(0)" ::: "memory");
            const unsigned og = xb_add(&bar[XB_TOP], 1u);
            const unsigned tg = og / nx;
            if (og + 1u == (tg + 1u) * nx) xb_add(&bar[XB_TOPGEN], 1u);
            else XB_SPIN(xb_ld(&bar[XB_TOPGEN]) == tg, bar);
            __builtin_amdgcn_fence(__ATOMIC_ACQUIRE, "agent");
            xb_add(&bar[XB_XGEN(b.x)], 1u);
            asm volatile("s_waitcnt vmcnt(0)" ::: "memory");
        } else {
            XB_SPIN(xb_ld(&bar[XB_XGEN(b.x)]) == gen, bar);
            __builtin_amdgcn_fence(__ATOMIC_ACQUIRE, "agent");
            asm volatile("s_waitcnt vmcnt(0)" ::: "memory");
        }
    }
    __syncthreads();
}


constexpr int NWAVES = 8, NTHR = 512;
constexpr int SEQ = 4096, DM = 4096, MTOK = 8192, NP = 12032, INW = 11800, DFF = 11008, NGU = 22016;
constexpr int C_RQ = 0, C_RK = 1024, C_RV = 2048, C_RG = 3072, C_MQ = 4096, C_MK = 5120, C_MV = 6144, C_LX = 7168, C_LG = 8192, C_NQ = 9216,
              C_NKC = 10240, C_NVC = 10496, C_NKS = 10752, C_NVS = 11008, C_NKW = 11264, C_NVW = 11520, C_NGATE = 11776;
constexpr float RMS_EPS = 1e-6f;

constexpr size_t MiB = 1u << 20;
constexpr size_t WS_CTL = 0, CTL_ZERO_BYTES = 1 * MiB;
constexpr size_t WS_ROPEC = 1 * MiB, WS_ROPES = 2 * MiB;
constexpr size_t WS_SMALL = 3 * MiB;
constexpr size_t SM_KMEAN = WS_SMALL;
constexpr size_t SM_LRUCA = WS_SMALL + 256 * 1024;
constexpr size_t SM_LRUCH = WS_SMALL + 512 * 1024;
constexpr size_t SM_CB1P  = WS_SMALL + 768 * 1024;
constexpr size_t SM_CW2T  = WS_SMALL + 1024 * 1024;
constexpr size_t SM_WAT   = WS_SMALL + 2 * MiB;
constexpr size_t SM_WXT   = WS_SMALL + 3 * MiB;
constexpr size_t SM_KC    = WS_SMALL + 4 * MiB;
constexpr size_t SM_VC    = WS_SMALL + 5 * MiB;
constexpr size_t SM_SSQA  = WS_SMALL + 6 * MiB;
constexpr size_t SM_SSQB  = WS_SMALL + 7 * MiB;
constexpr size_t WS_CW1T  = 11 * MiB;
constexpr size_t WS_WIN   = 19 * MiB;
constexpr size_t WS_WOUT  = WS_WIN + 188 * MiB;
constexpr size_t WS_WGU   = WS_WOUT + 64 * MiB;
constexpr size_t WS_WDN   = WS_WGU + 344 * MiB;
constexpr size_t WS_H     = WS_WDN + 172 * MiB;
constexpr size_t WS_PROJ  = WS_H + 64 * MiB;
constexpr size_t WS_Y     = WS_PROJ + 188 * MiB;
constexpr size_t WS_XS0   = WS_Y + 64 * MiB;
constexpr size_t WS_XS1   = WS_XS0 + 64 * MiB;
constexpr size_t WS_XS2   = WS_XS1 + 64 * MiB;
constexpr size_t WS_XB    = WS_XS0 + 128 * MiB;
constexpr size_t WS_U     = WS_XB + 128 * MiB;
constexpr size_t WS_RETKV = WS_U + 172 * MiB;
constexpr size_t WS_LRUH  = WS_RETKV + 32 * MiB;
constexpr size_t WS_LRUP  = WS_LRUH + 32 * MiB;
constexpr size_t WS_NSAACC = WS_LRUP + 32 * MiB;
constexpr size_t WS_END   = WS_NSAACC + 32 * MiB;
constexpr int CW_BAR = 4096;

constexpr int PH_BYTES = 147456;
constexpr int MISC_OFF = PH_BYTES;
constexpr int LDS_BYTES = PH_BYTES + 1024;

#define LDS_WAIT() asm volatile("s_waitcnt lgkmcnt(0)" ::: "memory")
#define VM_WAIT() asm volatile("s_waitcnt vmcnt(0)" ::: "memory")
__device__ __forceinline__ float bf2f(unsigned short b) { return __uint_as_float(((unsigned)b) << 16); }
__device__ __forceinline__ float bflo(unsigned w) { return __uint_as_float(w << 16); }
__device__ __forceinline__ float bfhi(unsigned w) { return __uint_as_float(w & 0xffff0000u); }
__device__ __forceinline__ unsigned f2bf(float f) { unsigned u = __float_as_uint(f); return (u + 0x7fffu + ((u >> 16) & 1u)) >> 16; }
__device__ __forceinline__ unsigned pk2(float lo, float hi) { return f2bf(lo) | (f2bf(hi) << 16); }
__device__ __forceinline__ unsigned cvtpk(float lo, float hi) { unsigned r; asm volatile("v_cvt_pk_bf16_f32 %0, %1, %2" : "=v"(r) : "v"(lo), "v"(hi)); return r; }
__device__ __forceinline__ float wave_sum(float v) {
#pragma unroll
    for (int o = 1; o < 64; o <<= 1) v += __shfl_xor(v, o);
    return v;
}
__device__ __forceinline__ float sigmoidf_(float x) { return __builtin_amdgcn_rcpf(1.0f + __expf(-x)); }
__device__ __forceinline__ float gelu_tanh(float x) { const float z = 0.7978845608028654f * (x + 0.044715f * x * x * x); const float e = __expf(2.0f * z); const float t = 1.0f - 2.0f * __builtin_amdgcn_rcpf(e + 1.0f); return 0.5f * x * (1.0f + t); }
__device__ __forceinline__ void unpack8(const u32x4 w, float (&f)[8]) { f[0] = bflo(w.x); f[1] = bfhi(w.x); f[2] = bflo(w.y); f[3] = bfhi(w.y); f[4] = bflo(w.z); f[5] = bfhi(w.z); f[6] = bflo(w.w); f[7] = bfhi(w.w); }

struct Frame {
    ldsp lds;
    int tid, lane, wave, G, bid;
    unsigned char* ws;
};
#define KAS __attribute__((address_space(4)))
#define OPQ_S(x) asm volatile("" : "+s"(x))
#define OPQ_V(x) asm volatile("" : "+v"(x))
__device__ __forceinline__ int otid() { int t = threadIdx.x; OPQ_V(t); return t; }
#define GAS __attribute__((address_space(1)))
__device__ __forceinline__ unsigned char* ows() { unsigned long long w = ((const unsigned long long KAS*)__builtin_amdgcn_kernarg_segment_ptr())[24]; OPQ_S(w);
    return (unsigned char*)(GAS unsigned char*)w; }
__device__ __forceinline__ const float* inp(int i) { return (const float*)(const GAS float*)((const unsigned long long KAS*)__builtin_amdgcn_kernarg_segment_ptr())[i]; }
__device__ __forceinline__ Frame mk_frame(ldsp lds) {
    Frame F; F.lds = lds; F.tid = otid(); F.lane = F.tid & 63; F.wave = __builtin_amdgcn_readfirstlane(F.tid >> 6); F.G = gridDim.x; F.bid = blockIdx.x;
    F.ws = ows(); return F;
}
#ifdef USE_NOINLINE
#define NOINL __attribute__((noinline))
#else
#define NOINL __forceinline__
#endif

__device__ __forceinline__ void tr_load(f32x4 (&v)[16], const float* __restrict__ W, int N, int k0, int n0, int lane) {
    const int rr = lane >> 4, c4 = (lane & 15) * 4; const bool ok = (n0 + c4) < N;
    const float* src = W + (size_t)(k0 + rr) * N + n0 + c4;
#pragma unroll
    for (int i = 0; i < 16; ++i) v[i] = ok ? *(const f32x4*)(src + (size_t)(4 * i) * N) : (f32x4){0.f, 0.f, 0.f, 0.f};
}
__device__ __forceinline__ void tr_emit(const f32x4 (&v)[16], int K, bf16_t* __restrict__ WT, int k0, int drow0, LAS float* scr, int lane, const float* __restrict__ kscale) {
    const int rr = lane >> 4, c4 = (lane & 15) * 4;
#pragma unroll
    for (int i = 0; i < 16; ++i) { const float kq = kscale ? kscale[k0 + rr + 4 * i] : 1.0f;
        LAS float* d = scr + (rr + 4 * i) * 65 + c4; d[0] = v[i].x * kq; d[1] = v[i].y * kq; d[2] = v[i].z * kq; d[3] = v[i].w * kq; }
    LDS_WAIT(); asm volatile("" ::: "memory");
    const int c = lane & 7;
#pragma unroll
    for (int j = 0; j < 8; ++j) { const int nn = (lane >> 3) + 8 * j; const LAS float* s = scr + (8 * c) * 65 + nn;
        u32x4 o; o.x = cvtpk(s[0 * 65], s[1 * 65]); o.y = cvtpk(s[2 * 65], s[3 * 65]); o.z = cvtpk(s[4 * 65], s[5 * 65]); o.w = cvtpk(s[6 * 65], s[7 * 65]);
        *(u32x4*)(WT + (size_t)(drow0 + nn) * K + k0 + 8 * c) = o; }
    LDS_WAIT(); asm volatile("" ::: "memory");
}
struct TrDesc { const float* W; bf16_t* WT; const float* ks; int K, N, nnb, mode; };
__device__ __forceinline__ void tr_matrix_rt(const float* W, int K, int N, int nnb, bf16_t* WT, LAS float* scr, int gw, int NGW, int lane, const float* kscale, int MODE, int it_lo = 0, int it_hi = 0x7fffffff) {
    const int nkb = K / 64, tot = nkb * nnb; const int hi_ = it_hi < tot ? it_hi : tot;
    int it = it_lo + gw; if (it >= hi_) return;
#define TR_GEO(it_) const int kb_ = (it_) / nnb, n0_ = ((it_) - kb_ * nnb) * 64; \
        const int dr_ = (MODE == 0) ? n0_ : ((n0_ >> 7) * 256 + (n0_ & 127) + (MODE == 2 ? 128 : 0))
    f32x4 va[16], vb[16];
    { TR_GEO(it); tr_load(va, W, N, kb_ * 64, n0_, lane); }
    for (;;) {
        if (it + NGW < hi_) { TR_GEO(it + NGW); tr_load(vb, W, N, kb_ * 64, n0_, lane); }
        { TR_GEO(it); tr_emit(va, K, WT, kb_ * 64, dr_, scr, lane, kscale); }
        it += NGW; if (it >= hi_) break;
        if (it + NGW < hi_) { TR_GEO(it + NGW); tr_load(va, W, N, kb_ * 64, n0_, lane); }
        { TR_GEO(it); tr_emit(vb, K, WT, kb_ * 64, dr_, scr, lane, kscale); }
        it += NGW; if (it >= hi_) break;
    }
#undef TR_GEO
}
__device__ __forceinline__ TrDesc deferred_desc(unsigned char* ws, int j) {
    const int l = j >= 4 ? 1 : 0, k = j >= 4 ? j - 4 : j + 1;
    TrDesc d;
    if (k == 0) { d.W = inp(2) + (size_t)l * DM * INW; d.WT = (bf16_t*)(ws + WS_WIN) + (size_t)l * NP * DM; d.ks = inp(1) + (size_t)l * DM; d.K = DM; d.N = INW; d.nnb = NP / 64; d.mode = 0; }
    else if (k == 1) { d.W = inp(3) + (size_t)l * DM * DM; d.WT = (bf16_t*)(ws + WS_WOUT) + (size_t)l * DM * DM; d.ks = nullptr; d.K = DM; d.N = DM; d.nnb = DM / 64; d.mode = 0; }
    else if (k == 2) { d.W = inp(19) + (size_t)l * DM * DFF; d.WT = (bf16_t*)(ws + WS_WGU) + (size_t)l * NGU * DM; d.ks = inp(18) + (size_t)l * DM; d.K = DM; d.N = DFF; d.nnb = DFF / 64; d.mode = 1; }
    else if (k == 3) { d.W = inp(20) + (size_t)l * DM * DFF; d.WT = (bf16_t*)(ws + WS_WGU) + (size_t)l * NGU * DM; d.ks = inp(18) + (size_t)l * DM; d.K = DM; d.N = DFF; d.nnb = DFF / 64; d.mode = 2; }
    else { d.W = inp(21) + (size_t)l * DFF * DM; d.WT = (bf16_t*)(ws + WS_WDN) + (size_t)l * DM * DFF; d.ks = nullptr; d.K = DFF; d.N = DM; d.nnb = DM / 64; d.mode = 0; }
    return d;
}
__device__ __forceinline__ void convert_deferred(unsigned char* ws, LAS float* scr, int w, int NW, int lane, int j_lo = 0, int j_hi = 9) {
#pragma unroll 1
    for (int j = j_lo; j < j_hi; ++j) { const TrDesc d = deferred_desc(ws, j); tr_matrix_rt(d.W, d.K, d.N, d.nnb, d.WT, scr, w, NW, lane, d.ks, d.mode); }
}
constexpr bool SPLIT_GU0 = false;
constexpr int GU0_WGS = 192;
constexpr bool SPLIT_INPROJ0 = false;
constexpr int GEMM0_WGS = 192;
__device__ NOINL void deferred_phase(ldsp lds_, int first_wg, int j_lo, int j_hi) {
    Frame F = mk_frame(lds_);
    LAS float* scr = (LAS float*)(F.lds + F.wave * 16640);
    convert_deferred(F.ws, scr, (F.bid - first_wg) * NWAVES + F.wave, (F.G - first_wg) * NWAVES, F.lane, j_lo, j_hi);
}
__device__ NOINL void p0_prologue(ldsp lds_) {
    Frame F = mk_frame(lds_);
    LAS float* scr = (LAS float*)(F.lds + F.wave * 16640);
    const int gw = F.bid * NWAVES + F.wave, NGW = F.G * NWAVES, lane = F.lane;
    unsigned char* ws = F.ws;
#pragma unroll 1
    for (int j = 0; j < 41; ++j) {
        TrDesc d; int rot = 0;
        if (j == 0) { d.W = inp(2); d.WT = (bf16_t*)(ws + WS_WIN); d.ks = inp(1); d.K = DM; d.N = INW; d.nnb = NP / 64; }
        else if (j <= 4) { const int q = j - 1, l = q >> 1, wh = q & 1;
            d.W = inp(wh ? 16 : 13) + (size_t)l * 4096 * 256; d.WT = (bf16_t*)(ws + WS_CW1T) + (size_t)(l * 2 + wh) * 256 * 4096; d.ks = nullptr; d.K = 4096; d.N = 256; d.nnb = 4; rot = 512 * j; }
        else if (j <= 8) { const int q = j - 5, l = q >> 1, wh = q & 1;
            d.W = inp(wh ? 17 : 14) + (size_t)l * 256 * 128; d.WT = (bf16_t*)(ws + SM_CW2T) + (size_t)(l * 2 + wh) * 128 * 256; d.ks = nullptr; d.K = 256; d.N = 128; d.nnb = 2; rot = 1536 + 16 * j; }
        else { const int q = j - 9, wx = q & 1, lg = q >> 1;
            d.W = inp(wx ? 9 : 7) + (size_t)lg * 128 * 128; d.WT = (bf16_t*)(ws + (wx ? SM_WXT : SM_WAT)) + (size_t)lg * 128 * 128; d.ks = nullptr; d.K = 128; d.N = 128; d.nnb = 2; rot = 1600 + 8 * q; }
        tr_matrix_rt(d.W, d.K, d.N, d.nnb, d.WT, scr, (gw + rot) % NGW, NGW, lane, d.ks, 0);
    }
    if (F.G != 256) convert_deferred(ws, scr, gw, NGW, lane);
    else if (SPLIT_GU0) convert_deferred(ws, scr, gw, NGW, lane, 0, 4);
    else if (!SPLIT_INPROJ0) convert_deferred(ws, scr, gw, NGW, lane);
    {   const float* x = inp(0); bf16_t* xs = (bf16_t*)(ws + WS_XS0); float* ssq = (float*)(ws + SM_SSQA);
        for (int m = gw; m < MTOK; m += NGW) {
            const f32x4* xr = (const f32x4*)(x + (size_t)m * DM) + lane; u32x2* o = (u32x2*)(xs + (size_t)m * DM) + lane;
            f32x4 v[16];
#pragma unroll
            for (int j = 0; j < 16; ++j) v[j] = xr[64 * j];
            float mine = 0.f;
#pragma unroll
            for (int j = 0; j < 16; ++j) { const float sj = wave_sum((v[j].x * v[j].x + v[j].y * v[j].y) + (v[j].z * v[j].z + v[j].w * v[j].w)); mine = (lane == j) ? sj : mine;
                u32x2 pk; pk.x = cvtpk(v[j].x, v[j].y); pk.y = cvtpk(v[j].z, v[j].w); o[64 * j] = pk; }
            if (lane < 16) ssq[(size_t)m * 16 + lane] = mine; } }
    for (int idx = (F.bid * NTHR + F.tid); idx < SEQ * 64; idx += F.G * NTHR) {
        const int t = idx >> 6, i = idx & 63;
        const float inv = powf(10000.0f, -(float)i * (1.0f / 64.0f));
        const float ang = (float)t * inv;
        double rev = (double)ang * 0.15915494309189535; rev -= rint(rev);
        ((float*)(ws + WS_ROPEC))[idx] = __builtin_amdgcn_cosf((float)rev);
        ((float*)(ws + WS_ROPES))[idx] = __builtin_amdgcn_sinf((float)rev);
    }
    for (int it = (gw + 1800) % NGW; it < 2 * 2 * 32; it += NGW) {
        const int s = it & 31, which = (it >> 5) & 1, l = it >> 6;
        const float* pos = inp(which ? 15 : 12) + (size_t)l * 4096 + s * 128;
        const float* w1 = inp(which ? 16 : 13) + (size_t)l * 4096 * 256 + (size_t)s * 128 * 256;
        float a0 = 0.f, a1 = 0.f, a2 = 0.f, a3 = 0.f;
#pragma unroll 1
        for (int k0 = 0; k0 < 128; k0 += 16) { float pp[16], w0[16], w1v[16], w2[16], w3[16];
#pragma unroll
            for (int x = 0; x < 16; ++x) { const float* wr = w1 + (k0 + x) * 256 + lane; pp[x] = pos[k0 + x]; w0[x] = wr[0]; w1v[x] = wr[64]; w2[x] = wr[128]; w3[x] = wr[192]; }
#pragma unroll
            for (int x = 0; x < 16; ++x) { a0 += pp[x] * w0[x]; a1 += pp[x] * w1v[x]; a2 += pp[x] * w2[x]; a3 += pp[x] * w3[x]; } }
        float* o = (float*)(ws + SM_CB1P) + (size_t)it * 256 + lane;
        o[0] = a0; o[64] = a1; o[128] = a2; o[192] = a3;
    }
}

__device__ NOINL void final_norm_phase(ldsp lds_, const bf16_t* __restrict__ xs, const float* __restrict__ ssq, const float* __restrict__ w, float* __restrict__ outp) {
    Frame F = mk_frame(lds_);
    const int gw = F.bid * NWAVES + F.wave, NGW = F.G * NWAVES, lane = F.lane;
    for (int m = gw; m < MTOK; m += NGW) {
        const float part = ssq[(size_t)m * 16 + (lane & 15)];
        const float rstd = 1.0f / sqrtf(wave_sum(part) * (0.25f / DM) + RMS_EPS);
        const u32x2* xr = (const u32x2*)(xs + (size_t)m * DM) + lane; const f32x4* wr = (const f32x4*)w + lane; f32x4* o = (f32x4*)(outp + (size_t)m * DM) + lane;
        u32x2 v[16];
#pragma unroll
        for (int j = 0; j < 16; ++j) v[j] = xr[64 * j];
#pragma unroll
        for (int j = 0; j < 16; ++j) { const f32x4 ww = wr[64 * j]; f32x4 y; y.x = bflo(v[j].x) * rstd * ww.x; y.y = bfhi(v[j].x) * rstd * ww.y; y.z = bflo(v[j].y) * rstd * ww.z; y.w = bfhi(v[j].y) * rstd * ww.w; o[64 * j] = y; }
    }
}

template <int NT, int KSTEPS>
__device__ __forceinline__ void strip_mma(f32x4 (&acc)[NT], const LAS unsigned char* A, int arow0, int apitch, const LAS unsigned char* Bt, int bpitch, int lane) {
    const int fr = lane & 15, fq = lane >> 4;
#pragma unroll
    for (int ks = 0; ks < KSTEPS; ++ks) {
        const bf16x8 a = *(const LAS bf16x8*)(A + (arow0 + fr) * apitch + (ks * 32 + fq * 8) * 2);
#pragma unroll
        for (int nt = 0; nt < NT; ++nt) {
            const bf16x8 b = *(const LAS bf16x8*)(Bt + (nt * 16 + fr) * bpitch + (ks * 32 + fq * 8) * 2);
            acc[nt] = __builtin_amdgcn_mfma_f32_16x16x32_bf16(a, b, acc[nt], 0, 0, 0);
        }
    }
}
constexpr int P272 = 272;

__device__ __forceinline__ float ret_log_gamma(int h) { return log1pf(-exp2f(-5.0f - (float)h)); }

__device__ __forceinline__ void rope8(const u32x4 w1, const u32x4 w2, const float* __restrict__ cs, const float* __restrict__ sn, float (&r1)[8], float (&r2)[8]) {
    float a[8], b[8]; unpack8(w1, a); unpack8(w2, b);
    const f32x4 c0 = *(const f32x4*)cs, c1 = *(const f32x4*)(cs + 4), s0 = *(const f32x4*)sn, s1 = *(const f32x4*)(sn + 4);
    const float c[8] = {c0.x, c0.y, c0.z, c0.w, c1.x, c1.y, c1.z, c1.w}, s[8] = {s0.x, s0.y, s0.z, s0.w, s1.x, s1.y, s1.z, s1.w};
#pragma unroll
    for (int x = 0; x < 8; ++x) { r1[x] = a[x] * c[x] - b[x] * s[x]; r2[x] = a[x] * s[x] + b[x] * c[x]; }
}

__device__ NOINL void ret_kv_unit(ldsp lds_, int unit) {
    Frame F = mk_frame(lds_);
    const int h = unit & 7, n = (unit >> 3) & 31, b = unit >> 8;
    const bf16_t* proj = (const bf16_t*)(F.ws + WS_PROJ);
    const float* ropec = (const float*)(F.ws + WS_ROPEC); const float* ropes = (const float*)(F.ws + WS_ROPES);
    ldsp vT = F.lds, kT = F.lds + 128 * P272;
    const int tid = F.tid, lane = F.lane, wave = F.wave;
    const size_t row0 = (size_t)b * SEQ + (size_t)n * 128;
    const float lg = ret_log_gamma(h);
    const int c0v = (tid & 15) * 8, c0k = (tid & 7) * 8;
    u32x4 vw[4], kw[2][2]; f32x4 tc[2][2], ts[2][2];
#pragma unroll
    for (int ps = 0; ps < 4; ++ps) { const int j = (tid >> 4) + 32 * ps; vw[ps] = *(const u32x4*)(proj + (row0 + j) * NP + C_RV + h * 128 + c0v); }
#pragma unroll
    for (int ps = 0; ps < 2; ++ps) { const int j = (tid >> 3) + 64 * ps; const int t = n * 128 + j;
        const bf16_t* kr = proj + (row0 + j) * NP + C_RK + h * 128 + c0k;
        kw[ps][0] = *(const u32x4*)kr; kw[ps][1] = *(const u32x4*)(kr + 64);
        tc[ps][0] = *(const f32x4*)(ropec + t * 64 + c0k); tc[ps][1] = *(const f32x4*)(ropec + t * 64 + c0k + 4); ts[ps][0] = *(const f32x4*)(ropes + t * 64 + c0k); ts[ps][1] = *(const f32x4*)(ropes + t * 64 + c0k + 4); }
    asm volatile("" :: "v"(vw[0]), "v"(vw[1]), "v"(vw[2]), "v"(vw[3]), "v"(kw[0][0]), "v"(kw[0][1]), "v"(kw[1][0]), "v"(kw[1][1]),
                    "v"(tc[0][0]), "v"(tc[0][1]), "v"(tc[1][0]), "v"(tc[1][1]), "v"(ts[0][0]), "v"(ts[0][1]), "v"(ts[1][0]), "v"(ts[1][1]) : "memory");
    asm volatile("" : "+v"(vw[0]), "+v"(vw[1]), "+v"(vw[2]), "+v"(vw[3]), "+v"(kw[0][0]), "+v"(kw[0][1]), "+v"(kw[1][0]), "+v"(kw[1][1]));
    asm volatile("" : "+v"(tc[0][0]), "+v"(tc[0][1]), "+v"(tc[1][0]), "+v"(tc[1][1]), "+v"(ts[0][0]), "+v"(ts[0][1]), "+v"(ts[1][0]), "+v"(ts[1][1]));
#pragma unroll
    for (int ps = 0; ps < 4; ++ps) { const int j = (tid >> 4) + 32 * ps; const int c0 = c0v;
        const unsigned ww[4] = {vw[ps].x, vw[ps].y, vw[ps].z, vw[ps].w};
#pragma unroll
        for (int x = 0; x < 8; ++x) *(LAS unsigned short*)(vT + (c0 + x) * P272 + j * 2) = (unsigned short)((x & 1) ? (ww[x >> 1] >> 16) : (ww[x >> 1] & 0xffffu)); }
#pragma unroll
    for (int ps = 0; ps < 2; ++ps) { const int j = (tid >> 3) + 64 * ps; const int c0 = c0k;
        const float cc[8] = {tc[ps][0].x, tc[ps][0].y, tc[ps][0].z, tc[ps][0].w, tc[ps][1].x, tc[ps][1].y, tc[ps][1].z, tc[ps][1].w}, sn[8] = {ts[ps][0].x, ts[ps][0].y, ts[ps][0].z, ts[ps][0].w, ts[ps][1].x, ts[ps][1].y, ts[ps][1].z, ts[ps][1].w};
        float a[8], bb[8], r1[8], r2[8]; unpack8(kw[ps][0], a); unpack8(kw[ps][1], bb);
#pragma unroll
        for (int x = 0; x < 8; ++x) { r1[x] = a[x] * cc[x] - bb[x] * sn[x]; r2[x] = a[x] * sn[x] + bb[x] * cc[x]; }
        const float sc = 0.08838834764831845f * __expf(lg * (float)(127 - j));
#pragma unroll
        for (int x = 0; x < 8; ++x) { *(LAS unsigned short*)(kT + (c0 + x) * P272 + j * 2) = (unsigned short)f2bf(r1[x] * sc);
                                      *(LAS unsigned short*)(kT + (c0 + 64 + x) * P272 + j * 2) = (unsigned short)f2bf(r2[x] * sc); } }
    __syncthreads();
    f32x4 acc[8];
#pragma unroll
    for (int i = 0; i < 8; ++i) acc[i] = (f32x4){0.f, 0.f, 0.f, 0.f};
    strip_mma<8, 4>(acc, vT, wave * 16, P272, kT, P272, lane);
    float* kv = (float*)(F.ws + WS_RETKV) + (size_t)unit * 16384;
    const int fr = lane & 15, fq = lane >> 4;
#pragma unroll
    for (int nt = 0; nt < 8; ++nt)
#pragma unroll
        for (int j = 0; j < 4; ++j) kv[(wave * 16 + 4 * fq + j) * 128 + nt * 16 + fr] = acc[nt][j];
    __syncthreads();
}

__device__ NOINL void moba_kmean_unit(ldsp lds_, int unit) {
    Frame F = mk_frame(lds_);
    const int blk = unit & 15, h = (unit >> 4) & 7, b = unit >> 7;
    const bf16_t* proj = (const bf16_t*)(F.ws + WS_PROJ);
    LAS float* part = (LAS float*)F.lds;
    const int tid = F.tid, d0 = (tid & 15) * 8, p = tid >> 4;
    float s[8] = {0, 0, 0, 0, 0, 0, 0, 0};
#pragma unroll
    for (int kk = 0; kk < 8; ++kk) { const size_t row = (size_t)b * SEQ + blk * 256 + p * 8 + kk;
        float f[8]; unpack8(*(const u32x4*)(proj + row * NP + C_MK + h * 128 + d0), f);
#pragma unroll
        for (int x = 0; x < 8; ++x) s[x] += f[x]; }
#pragma unroll
    for (int x = 0; x < 8; ++x) part[p * 128 + d0 + x] = s[x];
    __syncthreads();
    if (tid < 128) { float a = 0.f;
#pragma unroll 8
        for (int q = 0; q < 32; ++q) a += part[q * 128 + tid];
        ((float*)(F.ws + SM_KMEAN))[(size_t)unit * 128 + tid] = a * (1.0f / 256.0f); }
    __syncthreads();
}

constexpr int CP2 = 528;
constexpr int CMP_B = 64 * CP2, CMP_STG2 = CMP_B + 32 * CP2;
__device__ NOINL void nsa_cmp1_unit(ldsp lds_, int layer, int unit) {
    Frame F = mk_frame(lds_);
    const int nq = unit & 3, rg = (unit >> 2) & 7, kvh = (unit >> 5) & 1, b = (unit >> 6) & 1, which = unit >> 7;
    const bf16_t* proj = (const bf16_t*)(F.ws + WS_PROJ);
    const bf16_t* w1t = (const bf16_t*)(F.ws + WS_CW1T) + (size_t)(layer * 2 + which) * 256 * 4096 + (size_t)(nq * 64) * 4096;
    const float* cb1p = (const float*)(F.ws + SM_CB1P) + (size_t)(layer * 2 + which) * 32 * 256 + nq * 64;
    ldsp stg = F.lds;
    LAS float* biasL = (LAS float*)(F.lds + 2 * CMP_STG2);
    const int tid = F.tid, lane = F.lane, wave = F.wave;
    if (tid < 64) { float a = 0.f; float bv[32];
#pragma unroll
        for (int s = 0; s < 32; ++s) bv[s] = cb1p[s * 256 + tid];
#pragma unroll
        for (int s = 0; s < 32; ++s) a += bv[s];
        biasL[tid] = a; }
    const int kc = (tid & 31) * 8, r0 = tid >> 5;
    const bf16_t* bsrc = w1t + (size_t)r0 * 4096 + kc;
    const bf16_t* asrc[2];
#pragma unroll
    for (int i = 0; i < 2; ++i) { int ncr = rg * 32 + r0 + 16 * i; ncr = ncr > 254 ? 254 : ncr;
        asrc[i] = proj + ((size_t)b * SEQ + 16 * ncr + (kc >> 7)) * NP + (which ? C_NVC : C_NKC) + kvh * 128 + (kc & 127); }
    const int dstb = r0 * CP2 + kc * 2;
    bf16x8 sbA[4], saA[2], sbB[4], saB[2];
#define C_LOAD(SB, SA, s_) do { _Pragma("unroll") for (int i = 0; i < 4; ++i) SB[i] = *(const bf16x8*)(bsrc + (size_t)i * 16 * 4096 + (s_) * 256); \
        _Pragma("unroll") for (int i = 0; i < 2; ++i) SA[i] = *(const bf16x8*)(asrc[i] + (size_t)(2 * (s_)) * NP); } while (0)
#define C_WRITE(SB, SA, bf) do { ldsp d_ = stg + (bf) * CMP_STG2; _Pragma("unroll") for (int i = 0; i < 4; ++i) *(LAS bf16x8*)(d_ + dstb + i * 16 * CP2) = SB[i]; \
        _Pragma("unroll") for (int i = 0; i < 2; ++i) *(LAS bf16x8*)(d_ + CMP_B + dstb + i * 16 * CP2) = SA[i]; } while (0)
#define C_MMA(bf) do { ldsp cur = stg + (bf) * CMP_STG2; strip_mma<1, 8>(acc, cur + CMP_B, (wave >> 2) * 16, CP2, cur + ((wave & 3) * 16) * CP2, CP2, lane); } while (0)
    f32x4 acc[1] = {(f32x4){0.f, 0.f, 0.f, 0.f}};
    C_LOAD(sbA, saA, 0); C_LOAD(sbB, saB, 1);
    C_WRITE(sbA, saA, 0); __syncthreads();
#pragma unroll 1
    for (int s = 0; s < 16; s += 2) {
        if (s + 2 < 16) C_LOAD(sbA, saA, s + 2);
        C_MMA(0);
        C_WRITE(sbB, saB, 1); __syncthreads();
        if (s + 3 < 16) C_LOAD(sbB, saB, s + 3);
        C_MMA(1);
        if (s + 2 < 16) C_WRITE(sbA, saA, 0);
        __syncthreads();
    }
#undef C_LOAD
#undef C_WRITE
#undef C_MMA
    const int fr = lane & 15, fq = lane >> 4;
    bf16_t* hidg = (bf16_t*)(F.ws + WS_H) + (size_t)(((which * 2 + b) * 2 + kvh) * 256 + rg * 32) * 256 + nq * 64;
    {   const int col = (wave & 3) * 16 + fr; const float bv = biasL[col];
#pragma unroll
        for (int j = 0; j < 4; ++j) { const int row = (wave >> 2) * 16 + 4 * fq + j; hidg[(size_t)row * 256 + col] = (bf16_t)f2bf(gelu_tanh(acc[0][j] + bv)); } }
    __syncthreads();
}
__device__ NOINL void nsa_cmp2_unit(ldsp lds_, int layer, int unit) {
    Frame F = mk_frame(lds_);
    const int rg = unit & 7, kvh = (unit >> 3) & 1, b = (unit >> 4) & 1, which = unit >> 5;
    const bf16_t* w2t = (const bf16_t*)(F.ws + SM_CW2T) + (size_t)(layer * 2 + which) * 128 * 256;
    const bf16_t* hidg = (const bf16_t*)(F.ws + WS_H) + (size_t)(((which * 2 + b) * 2 + kvh) * 256 + rg * 32) * 256;
    ldsp hid = F.lds;
    const int tid = F.tid, lane = F.lane, wave = F.wave, fr = lane & 15, fq = lane >> 4;
    bf16x8 bw[8];
    {   u32x4 hw[2];
#pragma unroll
        for (int i = 0; i < 2; ++i) { const int c = tid + 512 * i; hw[i] = *(const u32x4*)(hidg + (size_t)(c >> 5) * 256 + (c & 31) * 8); }
#pragma unroll
        for (int ks = 0; ks < 8; ++ks) bw[ks] = *(const bf16x8*)(w2t + (size_t)(wave * 16 + fr) * 256 + ks * 32 + fq * 8);
        __builtin_amdgcn_sched_barrier(0);
        asm volatile("" : "+v"(hw[0]), "+v"(hw[1]), "+v"(bw[0]), "+v"(bw[1]), "+v"(bw[2]), "+v"(bw[3]), "+v"(bw[4]), "+v"(bw[5]), "+v"(bw[6]), "+v"(bw[7]));
#pragma unroll
        for (int i = 0; i < 2; ++i) { const int c = tid + 512 * i; *(LAS u32x4*)(hid + (c >> 5) * 528 + (c & 31) * 16) = hw[i]; } }
    __syncthreads();
    f32x4 a2[2] = {(f32x4){0.f, 0.f, 0.f, 0.f}, (f32x4){0.f, 0.f, 0.f, 0.f}};
#pragma unroll
    for (int ks = 0; ks < 8; ++ks) {
        const bf16x8 bb = bw[ks];
#pragma unroll
        for (int s = 0; s < 2; ++s) { const bf16x8 a = *(const LAS bf16x8*)(hid + (s * 16 + fr) * 528 + (ks * 32 + fq * 8) * 2);
            a2[s] = __builtin_amdgcn_mfma_f32_16x16x32_bf16(a, bb, a2[s], 0, 0, 0); }
    }
    bf16_t* outp = (bf16_t*)(F.ws + (which ? SM_VC : SM_KC)) + (size_t)((b * 2 + kvh) * 256 + rg * 32) * 128;
#pragma unroll
    for (int s = 0; s < 2; ++s)
#pragma unroll
        for (int j = 0; j < 4; ++j) { const int row = s * 16 + 4 * fq + j; const bool valid = (rg * 32 + row) < 255;
            outp[row * 128 + wave * 16 + fr] = valid ? (bf16_t)f2bf(a2[s][j]) : (bf16_t)0; }
    __syncthreads();
}

__device__ NOINL void lru_local_unit(ldsp lds_, int layer, int unit) {
    Frame F = mk_frame(lds_);
    const int g = unit & 7, tc = (unit >> 3) & 31, b = unit >> 8;
    const bf16_t* proj = (const bf16_t*)(F.ws + WS_PROJ);
    const float* convw = inp(5) + (size_t)layer * 4 * 1024 + g * 128;
    const float* convb = inp(6) + (size_t)layer * 1024 + g * 128;
    const float* ba = inp(8) + (size_t)layer * 1024 + g * 128;
    const float* bx = inp(10) + (size_t)layer * 1024 + g * 128;
    const float* lam = inp(11) + (size_t)layer * 1024 + g * 128;
    const bf16_t* wat = (const bf16_t*)(F.ws + SM_WAT) + (size_t)(layer * 8 + g) * 16384;
    const bf16_t* wxt = (const bf16_t*)(F.ws + SM_WXT) + (size_t)(layer * 8 + g) * 16384;
    ldsp LX = F.lds;
    ldsp XCB = F.lds + 132 * P272;
    ldsp WA = XCB + 128 * P272, WX = WA + 128 * P272;
    LAS float* AL = (LAS float*)F.lds;
    LAS float* UL = (LAS float*)(F.lds + 65536);
    LAS float* PRM = (LAS float*)(F.lds + 140352);
    const int tid = F.tid, lane = F.lane, wave = F.wave;
    const int t0 = tc * 128;
    {   float pv[2]; u32x4 lxw[5], waw[4], wxw[4];
#pragma unroll
        for (int q = 0; q < 2; ++q) { const int i = tid + 512 * q, k = i >> 7, c = i & 127;
            const float* src = (k < 4) ? (convw + k * 1024) : (k == 4) ? convb : (k == 5) ? ba : (k == 6) ? bx : lam;
            pv[q] = src[c]; }
#pragma unroll
        for (int q = 0; q < 5; ++q) { const int i = tid + 512 * q, r = i >> 4, c0 = (i & 15) * 8; const int t = t0 - 3 + r;
            lxw[q] = (u32x4){0u, 0u, 0u, 0u}; if (i < 131 * 16 && t >= 0) lxw[q] = *(const u32x4*)(proj + ((size_t)b * SEQ + t) * NP + C_LX + g * 128 + c0); }
#pragma unroll
        for (int q = 0; q < 4; ++q) { const int i = tid + 512 * q; waw[q] = *(const u32x4*)(wat + i * 8); wxw[q] = *(const u32x4*)(wxt + i * 8); }
#pragma unroll
        for (int q = 0; q < 2; ++q) { const int i = tid + 512 * q; PRM[i] = (i >= 896) ? log1pf(__expf(-pv[q])) : pv[q]; }
#pragma unroll
        for (int q = 0; q < 5; ++q) { const int i = tid + 512 * q, r = i >> 4, c0 = (i & 15) * 8; if (i < 132 * 16) *(LAS u32x4*)(LX + r * P272 + c0 * 2) = lxw[q]; }
#pragma unroll
        for (int q = 0; q < 4; ++q) { const int i = tid + 512 * q, r = i >> 4, c0 = (i & 15) * 8;
            *(LAS u32x4*)(WA + r * P272 + c0 * 2) = waw[q]; *(LAS u32x4*)(WX + r * P272 + c0 * 2) = wxw[q]; }
    }
    __syncthreads();
    {   const int t = tid >> 2, cb0 = (tid & 3) * 32;
#pragma unroll 4
        for (int c = cb0; c < cb0 + 32; c += 2) { float y0 = PRM[512 + c], y1 = PRM[512 + c + 1];
#pragma unroll
            for (int tap = 0; tap < 4; ++tap) { const unsigned w = *(const LAS unsigned*)(LX + (t + tap) * P272 + c * 2);
                y0 += bflo(w) * PRM[tap * 128 + c]; y1 += bfhi(w) * PRM[tap * 128 + c + 1]; }
            *(LAS unsigned*)(XCB + t * P272 + c * 2) = pk2(y0, y1); } }
    __syncthreads();
    f32x4 accR[8], accI[8];
#pragma unroll
    for (int i = 0; i < 8; ++i) { accR[i] = (f32x4){0.f, 0.f, 0.f, 0.f}; accI[i] = (f32x4){0.f, 0.f, 0.f, 0.f}; }
    strip_mma<8, 4>(accR, XCB, wave * 16, P272, WA, P272, lane);
    strip_mma<8, 4>(accI, XCB, wave * 16, P272, WX, P272, lane);
    const int fr = lane & 15, fq = lane >> 4;
    float av[8][4], uv[8][4];
#pragma unroll
    for (int nt = 0; nt < 8; ++nt) { const int c = nt * 16 + fr;
        const float cw0 = PRM[c], cw1 = PRM[128 + c], cw2 = PRM[256 + c], cw3 = PRM[384 + c], cb = PRM[512 + c];
        const float bav = PRM[640 + c], bxv = PRM[768 + c], spl = PRM[896 + c];
#pragma unroll
        for (int j = 0; j < 4; ++j) { const int t = wave * 16 + 4 * fq + j;
            const float xc = cb + bf2f(*(const LAS unsigned short*)(LX + (t + 0) * P272 + c * 2)) * cw0 + bf2f(*(const LAS unsigned short*)(LX + (t + 1) * P272 + c * 2)) * cw1
                                + bf2f(*(const LAS unsigned short*)(LX + (t + 2) * P272 + c * 2)) * cw2 + bf2f(*(const LAS unsigned short*)(LX + (t + 3) * P272 + c * 2)) * cw3;
            const float r = sigmoidf_(accR[nt][j] + bav), ig = sigmoidf_(accI[nt][j] + bxv);
            const float la = -8.0f * r * spl; const float a = __expf(la);
            const float x2 = 2.0f * la;
            const float om = (x2 > -0.02f) ? -x2 * (1.0f + x2 * (0.5f + x2 * 0.16666667f)) : 1.0f - __expf(x2);
            av[nt][j] = a; uv[nt][j] = __builtin_amdgcn_sqrtf(fmaxf(om, 0.0f)) * (ig * xc); } }
    __syncthreads();
#pragma unroll
    for (int nt = 0; nt < 8; ++nt)
#pragma unroll
        for (int j = 0; j < 4; ++j) { const int t = wave * 16 + 4 * fq + j, c = nt * 16 + fr; AL[t * 128 + c] = av[nt][j]; UL[t * 128 + c] = uv[nt][j]; }
    __syncthreads();
    if (tid < 128) { float hh = 0.f, P = 1.f; const size_t base = ((size_t)b * SEQ + t0) * 1024 + g * 128 + tid;
        float* Hp = (float*)(F.ws + WS_LRUH) + base; float* Pp = (float*)(F.ws + WS_LRUP) + base;
#pragma unroll 4
        for (int t = 0; t < 128; ++t) { const float a = AL[t * 128 + tid]; P *= a; hh = a * hh + UL[t * 128 + tid]; Hp[(size_t)t * 1024] = hh; Pp[(size_t)t * 1024] = P; }
        ((float*)(F.ws + SM_LRUCA))[(size_t)(b * 32 + tc) * 1024 + g * 128 + tid] = P;
        ((float*)(F.ws + SM_LRUCH))[(size_t)(b * 32 + tc) * 1024 + g * 128 + tid] = hh; }
    __syncthreads();
}

__device__ __forceinline__ void s1_phase(ldsp lds, int layer) {
    int G = gridDim.x, bid = blockIdx.x; OPQ_S(G); OPQ_S(bid);
#ifndef S1_DUP
#define S1_DUP 0
#endif
#define S1REP(b) _Pragma("unroll 1") for (int r1_ = 0; r1_ < 1 + ((S1_DUP >> (b)) & 1); ++r1_)
    S1REP(0) for (int u = bid; u < 512; u += G) ret_kv_unit(lds, u);
    S1REP(1) for (int u = bid; u < 512; u += G) lru_local_unit(lds, layer, u);
    S1REP(2) for (int u = bid; u < 256; u += G) moba_kmean_unit(lds, u);
    S1REP(3) for (int u = bid; u < 256; u += G) nsa_cmp1_unit(lds, layer, u);
}

__device__ NOINL void ret_scan_phase(ldsp lds_) {
    Frame F = mk_frame(lds_);
    for (int gid = F.bid * NTHR + F.tid; gid < 16 * 8192; gid += F.G * NTHR) {
        const int bh = gid >> 13, idx2 = gid & 8191, b = bh >> 3, h = bh & 7;
        f32x2* base = (f32x2*)((float*)(F.ws + WS_RETKV) + (size_t)((b * 32) * 8 + h) * 16384) + idx2;
        const float dc = __expf(ret_log_gamma(h) * 128.0f);
        f32x2 v[32];
#pragma unroll
        for (int n = 0; n < 32; ++n) v[n] = base[(size_t)n * 8 * 8192];
        f32x2 st = {0.f, 0.f};
#pragma unroll
        for (int n = 0; n < 32; ++n) { base[(size_t)n * 8 * 8192] = st; st = st * dc + v[n]; }
    }
}

__device__ NOINL void ret_out_unit(ldsp lds_, int layer, int unit) {
    Frame F = mk_frame(lds_);
    const int h = unit & 7, n = (unit >> 3) & 31, b = unit >> 8;
    const bf16_t* proj = (const bf16_t*)(F.ws + WS_PROJ);
    const float* ropec = (const float*)(F.ws + WS_ROPEC); const float* ropes = (const float*)(F.ws + WS_ROPES);
    const float* gain = inp(4) + (size_t)layer * 1024 + h * 128;
    ldsp Q = F.lds, Kt = F.lds + 128 * P272, vT = F.lds + 2 * 128 * P272, ST = F.lds + 3 * 128 * P272;
    const int tid = F.tid, lane = F.lane, wave = F.wave;
    const size_t row0 = (size_t)b * SEQ + (size_t)n * 128;
    const float lg = ret_log_gamma(h);
    const f32x4* kvp = (const f32x4*)((const float*)(F.ws + WS_RETKV) + (size_t)unit * 16384) + tid;
    f32x4 st[8]; u32x4 qw[2][2], kw[2][2], vw[4]; f32x4 tc[2][2], ts[2][2];
    const int c0q = (tid & 7) * 8, c0v = (tid & 15) * 8;
#pragma unroll
    for (int k = 0; k < 8; ++k) st[k] = kvp[512 * k];
#pragma unroll
    for (int ps = 0; ps < 2; ++ps) { const int j = (tid >> 3) + 64 * ps; const int t = n * 128 + j;
        const bf16_t* qrw = proj + (row0 + j) * NP + C_RQ + h * 128 + c0q; const bf16_t* krw = proj + (row0 + j) * NP + C_RK + h * 128 + c0q;
        qw[ps][0] = *(const u32x4*)qrw; qw[ps][1] = *(const u32x4*)(qrw + 64); kw[ps][0] = *(const u32x4*)krw; kw[ps][1] = *(const u32x4*)(krw + 64);
        tc[ps][0] = *(const f32x4*)(ropec + t * 64 + c0q); tc[ps][1] = *(const f32x4*)(ropec + t * 64 + c0q + 4); ts[ps][0] = *(const f32x4*)(ropes + t * 64 + c0q); ts[ps][1] = *(const f32x4*)(ropes + t * 64 + c0q + 4); }
#pragma unroll
    for (int ps = 0; ps < 4; ++ps) { const int j = (tid >> 4) + 32 * ps; vw[ps] = *(const u32x4*)(proj + (row0 + j) * NP + C_RV + h * 128 + c0v); }
    asm volatile("" :: "v"(st[0]), "v"(st[1]), "v"(st[2]), "v"(st[3]), "v"(st[4]), "v"(st[5]), "v"(st[6]), "v"(st[7]), "v"(qw[0][0]), "v"(qw[0][1]), "v"(qw[1][0]), "v"(qw[1][1]),
                    "v"(kw[0][0]), "v"(kw[0][1]), "v"(kw[1][0]), "v"(kw[1][1]), "v"(tc[0][0]), "v"(tc[0][1]), "v"(tc[1][0]), "v"(tc[1][1]), "v"(ts[0][0]), "v"(ts[0][1]), "v"(ts[1][0]), "v"(ts[1][1]),
                    "v"(vw[0]), "v"(vw[1]), "v"(vw[2]), "v"(vw[3]) : "memory");
    asm volatile("" : "+v"(st[0]), "+v"(st[1]), "+v"(st[2]), "+v"(st[3]), "+v"(st[4]), "+v"(st[5]), "+v"(st[6]), "+v"(st[7]));
    asm volatile("" : "+v"(qw[0][0]), "+v"(qw[0][1]), "+v"(qw[1][0]), "+v"(qw[1][1]), "+v"(kw[0][0]), "+v"(kw[0][1]), "+v"(kw[1][0]), "+v"(kw[1][1]));
    asm volatile("" : "+v"(tc[0][0]), "+v"(tc[0][1]), "+v"(tc[1][0]), "+v"(tc[1][1]), "+v"(ts[0][0]), "+v"(ts[0][1]), "+v"(ts[1][0]), "+v"(ts[1][1]));
    asm volatile("" : "+v"(vw[0]), "+v"(vw[1]), "+v"(vw[2]), "+v"(vw[3]));
#pragma unroll
    for (int k = 0; k < 8; ++k) { const int idx = (tid + 512 * k) * 4; const int e = idx >> 7, d = idx & 127;
        u32x2 w; w.x = pk2(st[k].x, st[k].y); w.y = pk2(st[k].z, st[k].w); *(LAS u32x2*)(ST + e * P272 + d * 2) = w; }
#pragma unroll
    for (int ps = 0; ps < 2; ++ps) { const int j = (tid >> 3) + 64 * ps; const int c0 = c0q;
        const float cc[8] = {tc[ps][0].x, tc[ps][0].y, tc[ps][0].z, tc[ps][0].w, tc[ps][1].x, tc[ps][1].y, tc[ps][1].z, tc[ps][1].w}, sn[8] = {ts[ps][0].x, ts[ps][0].y, ts[ps][0].z, ts[ps][0].w, ts[ps][1].x, ts[ps][1].y, ts[ps][1].z, ts[ps][1].w};
        float a[8], bb[8], r1[8], r2[8]; u32x4 w;
        unpack8(qw[ps][0], a); unpack8(qw[ps][1], bb);
#pragma unroll
        for (int x = 0; x < 8; ++x) { r1[x] = a[x] * cc[x] - bb[x] * sn[x]; r2[x] = a[x] * sn[x] + bb[x] * cc[x]; }
        w.x = pk2(r1[0], r1[1]); w.y = pk2(r1[2], r1[3]); w.z = pk2(r1[4], r1[5]); w.w = pk2(r1[6], r1[7]); *(LAS u32x4*)(Q + j * P272 + c0 * 2) = w;
        w.x = pk2(r2[0], r2[1]); w.y = pk2(r2[2], r2[3]); w.z = pk2(r2[4], r2[5]); w.w = pk2(r2[6], r2[7]); *(LAS u32x4*)(Q + j * P272 + (c0 + 64) * 2) = w;
        unpack8(kw[ps][0], a); unpack8(kw[ps][1], bb);
#pragma unroll
        for (int x = 0; x < 8; ++x) { r1[x] = a[x] * cc[x] - bb[x] * sn[x]; r2[x] = a[x] * sn[x] + bb[x] * cc[x]; }
        const float sc = 0.08838834764831845f;
        w.x = pk2(r1[0] * sc, r1[1] * sc); w.y = pk2(r1[2] * sc, r1[3] * sc); w.z = pk2(r1[4] * sc, r1[5] * sc); w.w = pk2(r1[6] * sc, r1[7] * sc); *(LAS u32x4*)(Kt + j * P272 + c0 * 2) = w;
        w.x = pk2(r2[0] * sc, r2[1] * sc); w.y = pk2(r2[2] * sc, r2[3] * sc); w.z = pk2(r2[4] * sc, r2[5] * sc); w.w = pk2(r2[6] * sc, r2[7] * sc); *(LAS u32x4*)(Kt + j * P272 + (c0 + 64) * 2) = w; }
#pragma unroll
    for (int ps = 0; ps < 4; ++ps) { const int j = (tid >> 4) + 32 * ps; const int c0 = c0v;
        const unsigned ww[4] = {vw[ps].x, vw[ps].y, vw[ps].z, vw[ps].w};
#pragma unroll
        for (int x = 0; x < 8; ++x) *(LAS unsigned short*)(vT + (c0 + x) * P272 + j * 2) = (unsigned short)((x & 1) ? (ww[x >> 1] >> 16) : (ww[x >> 1] & 0xffffu)); }
    __syncthreads();
    const int fr = lane & 15, fq = lane >> 4;
    f32x4 accC[8], accS[8];
#pragma unroll
    for (int i = 0; i < 8; ++i) { accC[i] = (f32x4){0.f, 0.f, 0.f, 0.f}; accS[i] = (f32x4){0.f, 0.f, 0.f, 0.f}; }
    strip_mma<8, 4>(accC, Q, wave * 16, P272, ST, P272, lane);
    strip_mma<8, 4>(accS, Q, wave * 16, P272, Kt, P272, lane);
    __syncthreads();
#pragma unroll
    for (int nt = 0; nt < 8; ++nt)
#pragma unroll
        for (int j = 0; j < 4; ++j) { const int i = wave * 16 + 4 * fq + j, jj = nt * 16 + fr;
            const float v = (i >= jj) ? accS[nt][j] * __expf(lg * (float)(i - jj)) : 0.0f;
            *(LAS unsigned short*)(Q + i * P272 + jj * 2) = (unsigned short)f2bf(v); }
    __syncthreads();
#pragma unroll
    for (int i = 0; i < 8; ++i) accS[i] = (f32x4){0.f, 0.f, 0.f, 0.f};
    float gvv[4][8], gn[8]; unsigned graw[4][8];
#pragma unroll
    for (int nt = 0; nt < 8; ++nt) gn[nt] = gain[nt * 16 + fr];
#pragma unroll
    for (int j = 0; j < 4; ++j) { const bf16_t* grow = proj + (row0 + wave * 16 + 4 * fq + j) * NP + C_RG + h * 128;
#pragma unroll
        for (int nt = 0; nt < 8; ++nt) graw[j][nt] = grow[nt * 16 + fr]; }
    __builtin_amdgcn_sched_barrier(0);
    strip_mma<8, 4>(accS, Q, wave * 16, P272, vT, P272, lane);
    __builtin_amdgcn_sched_barrier(0);
#pragma unroll
    for (int j = 0; j < 4; ++j) asm volatile("" : "+v"(graw[j][0]), "+v"(graw[j][1]), "+v"(graw[j][2]), "+v"(graw[j][3]), "+v"(graw[j][4]), "+v"(graw[j][5]), "+v"(graw[j][6]), "+v"(graw[j][7]));
    asm volatile("" : "+v"(gn[0]), "+v"(gn[1]), "+v"(gn[2]), "+v"(gn[3]), "+v"(gn[4]), "+v"(gn[5]), "+v"(gn[6]), "+v"(gn[7]));
#pragma unroll
    for (int j = 0; j < 4; ++j)
#pragma unroll
        for (int nt = 0; nt < 8; ++nt) gvv[j][nt] = bf2f((unsigned short)graw[j][nt]);
#pragma unroll
    for (int j = 0; j < 4; ++j) { const int i = wave * 16 + 4 * fq + j;
        const float dfs = __expf(lg * (float)(i + 1));
        float y[8]; float s = 0.f;
#pragma unroll
        for (int nt = 0; nt < 8; ++nt) { y[nt] = accS[nt][j] + dfs * accC[nt][j]; s += y[nt]; }
        s += __shfl_xor(s, 1); s += __shfl_xor(s, 2); s += __shfl_xor(s, 4); s += __shfl_xor(s, 8);
        const float mean = s * (1.0f / 128.0f); float q2 = 0.f;
#pragma unroll
        for (int nt = 0; nt < 8; ++nt) { y[nt] -= mean; q2 += y[nt] * y[nt]; }
        q2 += __shfl_xor(q2, 1); q2 += __shfl_xor(q2, 2); q2 += __shfl_xor(q2, 4); q2 += __shfl_xor(q2, 8);
        const float rstd = 1.0f / sqrtf(q2 * (1.0f / 128.0f) + RMS_EPS);
        bf16_t* yrow = (bf16_t*)(F.ws + WS_Y) + (row0 + i) * DM + 0 + h * 128;
#pragma unroll
        for (int nt = 0; nt < 8; ++nt) { const int e = nt * 16 + fr; const float gv = gvv[j][nt];
            yrow[e] = (bf16_t)f2bf(gv * sigmoidf_(gv) * (y[nt] * rstd * gn[nt])); } }
    __syncthreads();
}

__device__ NOINL void lru_out_unit(ldsp lds_, int unit) {
    Frame F = mk_frame(lds_);
    const int ch = unit & 1, tc = (unit >> 1) & 31, b = unit >> 6;
    const bf16_t* proj = (const bf16_t*)(F.ws + WS_PROJ);
    LAS float* HIN = (LAS float*)F.lds;
    {   const int c = ch * 512 + F.tid;
        const float* CA = (const float*)(F.ws + SM_LRUCA) + (size_t)b * 32 * 1024 + c; const float* CH = (const float*)(F.ws + SM_LRUCH) + (size_t)b * 32 * 1024 + c;
        float H = 0.f; float ca[32], chv[32];
#pragma unroll
        for (int k = 0; k < 32; ++k) { ca[k] = CA[k * 1024]; chv[k] = CH[k * 1024]; }
#pragma unroll
        for (int k = 0; k < 32; ++k) H = (k < tc) ? ca[k] * H + chv[k] : H;
        HIN[F.tid] = H; }
    __syncthreads();
    const int cg = (F.tid & 127) * 4, tsub = F.tid >> 7; const int c0 = ch * 512 + cg;
    const f32x4 Hin = *(const LAS f32x4*)(HIN + cg);
    const size_t r0 = (size_t)b * SEQ + tc * 128 + tsub;
    const float* Hp = (const float*)(F.ws + WS_LRUH) + r0 * 1024 + c0; const float* Pp = (const float*)(F.ws + WS_LRUP) + r0 * 1024 + c0;
    const bf16_t* gp = proj + r0 * NP + C_LG + c0; bf16_t* yp = (bf16_t*)(F.ws + WS_Y) + r0 * DM + 2048 + c0;
#pragma unroll 1
    for (int i0 = 0; i0 < 32; i0 += 8) { f32x4 hv[8], pv[8]; u32x2 gv[8];
#pragma unroll
        for (int x = 0; x < 8; ++x) { const size_t t = (size_t)(i0 + x) * 4; hv[x] = *(const f32x4*)(Hp + t * 1024); pv[x] = *(const f32x4*)(Pp + t * 1024); gv[x] = *(const u32x2*)(gp + t * NP); }
#pragma unroll
        for (int x = 0; x < 8; ++x) { const size_t t = (size_t)(i0 + x) * 4; const f32x4 h = hv[x] + pv[x] * Hin;
            u32x2 w; w.x = cvtpk(h.x * gelu_tanh(bflo(gv[x].x)), h.y * gelu_tanh(bfhi(gv[x].x))); w.y = cvtpk(h.z * gelu_tanh(bflo(gv[x].y)), h.w * gelu_tanh(bfhi(gv[x].y)));
            *(u32x2*)(yp + t * DM) = w; } }
    __syncthreads();
}

constexpr int SHM_T = 16384;
#define KSWZ(row, colB) ((row) * 256 + ((colB) ^ (((row) & 7) << 4)))
__device__ __forceinline__ int v_st(int k, int c) { const int kk = (k & ~0xC) | ((k & 4) << 1) | ((k & 8) >> 1); return ((kk >> 3) * 4 + (c >> 5)) * 512 + ((kk & 7) * 32 + (c & 31)) * 2; }
__device__ __forceinline__ int v_rd_base(int lane) { return ((lane & 3) << 3) | (((lane >> 2) & 3) << 6) | (((lane >> 4) & 1) << 5) | (((lane >> 5) & 1) << 8); }
constexpr int v_rd_off(int d0, int ks, int half) { return d0 * 512 + ks * 4096 + half * 2048; }
__device__ __forceinline__ int crow(int r, int hi) { return (r & 3) + 8 * (r >> 2) + 4 * hi; }
__device__ __forceinline__ float half_max(float v) { auto rr = __builtin_amdgcn_permlane32_swap(__float_as_uint(v), __float_as_uint(v), false, false); return fmaxf(__uint_as_float(rr[0]), __uint_as_float(rr[1])); }
__device__ __forceinline__ float half_sum(float v) { auto rr = __builtin_amdgcn_permlane32_swap(__float_as_uint(v), __float_as_uint(v), false, false); return __uint_as_float(rr[0]) + __uint_as_float(rr[1]); }
__device__ __forceinline__ float half_other(float v) { auto rr = __builtin_amdgcn_permlane32_swap(__float_as_uint(v), __float_as_uint(v), false, false); const float a = __uint_as_float(rr[0]), b = __uint_as_float(rr[1]); return (__lane_id() & 32) ? a : b; }

__device__ __forceinline__ void qkt(f32x16& p0, f32x16& p1, const LAS unsigned char* K_lds, int r32, int hi, const bf16x8 (&qr)[8]) {
    p0 = f32x16{}; p1 = f32x16{};
    const LAS unsigned char* kb[4];
#pragma unroll
    for (int dd = 0; dd < 4; ++dd) kb[dd] = K_lds + KSWZ(r32, (dd * 16 + hi * 8) * 2);
#pragma unroll
    for (int d0 = 0; d0 < 8; ++d0) { const LAS unsigned char* a = kb[d0 & 3] + (d0 >> 2) * 128;
        const bf16x8 b0 = *(const LAS bf16x8*)a;
        const bf16x8 b1 = *(const LAS bf16x8*)(a + 32 * 256);
        p0 = __builtin_amdgcn_mfma_f32_32x32x16_bf16(b0, qr[d0], p0, 0, 0, 0);
        p1 = __builtin_amdgcn_mfma_f32_32x32x16_bf16(b1, qr[d0], p1, 0, 0, 0);
        if (d0 & 1) __builtin_amdgcn_sched_barrier(0); }
}
__device__ __forceinline__ void pv_tile(f32x16 (&o)[4], int vb0, bf16x8 pa0, bf16x8 pa1, bf16x8 pa2, bf16x8 pa3) {
#define TRRD(dst, off) asm volatile("ds_read_b64_tr_b16 %0, %1 offset:%2" : "=&v"(dst) : "v"(vb0), "i"(off) : "memory")
#define PV_D0(d0) do { s16x4 l0, l1, l2, l3, h0, h1, h2, h3; constexpr int b_ = v_rd_off(d0, 0, 0); \
        TRRD(l0, b_); TRRD(h0, b_ + 2048); TRRD(l1, b_ + 4096); TRRD(h1, b_ + 6144); TRRD(l2, b_ + 8192); TRRD(h2, b_ + 10240); TRRD(l3, b_ + 12288); TRRD(h3, b_ + 14336); \
        asm volatile("s_waitcnt lgkmcnt(0)" ::: "memory"); __builtin_amdgcn_sched_barrier(0);   \
        o[d0] = __builtin_amdgcn_mfma_f32_32x32x16_bf16(pa0, (bf16x8){l0[0], l0[1], l0[2], l0[3], h0[0], h0[1], h0[2], h0[3]}, o[d0], 0, 0, 0);   \
        o[d0] = __builtin_amdgcn_mfma_f32_32x32x16_bf16(pa1, (bf16x8){l1[0], l1[1], l1[2], l1[3], h1[0], h1[1], h1[2], h1[3]}, o[d0], 0, 0, 0);   \
        o[d0] = __builtin_amdgcn_mfma_f32_32x32x16_bf16(pa2, (bf16x8){l2[0], l2[1], l2[2], l2[3], h2[0], h2[1], h2[2], h2[3]}, o[d0], 0, 0, 0);   \
        o[d0] = __builtin_amdgcn_mfma_f32_32x32x16_bf16(pa3, (bf16x8){l3[0], l3[1], l3[2], l3[3], h3[0], h3[1], h3[2], h3[3]}, o[d0], 0, 0, 0); } while (0)
    PV_D0(0); PV_D0(1); PV_D0(2); PV_D0(3);
#undef PV_D0
#undef TRRD
}
#define PK4(P, B_, OUT) do { unsigned a0_ = cvtpk(P[B_+0], P[B_+1]), a1_ = cvtpk(P[B_+2], P[B_+3]);                          \
        unsigned b0_ = cvtpk(P[B_+4], P[B_+5]), b1_ = cvtpk(P[B_+6], P[B_+7]);                                             \
        auto r0_ = __builtin_amdgcn_permlane32_swap(a0_, b0_, false, false); auto r1_ = __builtin_amdgcn_permlane32_swap(a1_, b1_, false, false); \
        u32x4 w_ = {r0_[0], r1_[0], r0_[1], r1_[1]}; OUT = __builtin_bit_cast(bf16x8, w_); } while (0)

__device__ __forceinline__ void glds16(const void* gsrc, unsigned lds_dst) { unsigned keep;
    asm volatile("s_mov_b32 %0, m0\n\ts_mov_b32 m0, %2\n\ts_nop 0\n\tglobal_load_lds_dwordx4 %1, off\n\ts_mov_b32 m0, %0" : "=&s"(keep) : "v"(gsrc), "s"(lds_dst) : "memory"); }
enum { AM_MOBA = 0, AM_SEL = 1, AM_WIN = 2, AM_CSTAT = 3, AM_COUT = 4 };
constexpr float ATT_C2 = 1.4426950408889634f * 0.08838834764831845f;
constexpr int ATT_BIG = 1 << 24;
constexpr float ATT_DEFER = 6.0f;

struct AttnIO {
    const bf16_t* Kg; const bf16_t* Vg; int pitch;
    int t_lo, t_hi;
    int q;
    int own;
    unsigned mlo, mhi;
};

template <int MODE, int NB>
__device__ __forceinline__ void attn_pass(ldsp lds, LAS float* wsc, const bf16x8 (&qr)[8], const AttnIO& io, f32x16 (&o)[4], float& m_reg, float& l_reg, float inv_l, LAS float* imp) {
    const int tid = otid(), lane = tid & 63, r32 = lane & 31, hi = lane >> 5;
    ldsp V_lds = lds; ldsp K_lds = lds + NB * SHM_T;
    const int vbase = (int)(unsigned)(uintptr_t)V_lds + v_rd_base(lane);
    constexpr int DEPTH = NB - 1;
    constexpr bool NEEDV = (MODE != AM_CSTAT);
    float carry = 0.f;
    const int wv = __builtin_amdgcn_readfirstlane(tid >> 6);
    size_t ksrc[2], vsrc[2];
#pragma unroll
    for (int i = 0; i < 2; ++i) { const int ch = wv * 2 + i;
        const int kr = ch * 4 + (lane >> 4), kc = (lane & 15) ^ (kr & 7);
        ksrc[i] = (size_t)kr * io.pitch + kc * 8;
        const int sub = ch * 2 + (lane >> 5), kk = (sub >> 2) * 8 + ((lane & 31) >> 2), vk = (kk & ~0xC) | ((kk & 4) << 1) | ((kk & 8) >> 1), vc = (sub & 3) * 32 + (lane & 3) * 8;
        vsrc[i] = (size_t)vk * io.pitch + vc; }
#define A_DMA(T, bf) do { const size_t t0_ = (size_t)((T) * 64) * io.pitch; \
        _Pragma("unroll") for (int i = 0; i < 2; ++i) { \
            glds16((const void*)(io.Kg + t0_ + ksrc[i]), (unsigned)(uintptr_t)(K_lds + (bf) * SHM_T + (wv * 2 + i) * 1024)); \
            if (NEEDV) glds16((const void*)(io.Vg + t0_ + vsrc[i]), (unsigned)(uintptr_t)(V_lds + (bf) * SHM_T + (wv * 2 + i) * 1024)); } } while (0)
#define A_STEP(T) do { \
        const int T_ = (T); const int bsel = (T_ - io.t_lo) & (NB - 1); const int vb0 = vbase + bsel * SHM_T; \
        if (T_ + DEPTH < io.t_hi) A_DMA(T_ + DEPTH, (T_ + DEPTH - io.t_lo) & (NB - 1)); \
        f32x16 p0, p1; qkt(p0, p1, K_lds + bsel * SHM_T, r32, hi, qr); \
        __builtin_amdgcn_sched_barrier(0); \
        int dq; unsigned W = 0x7fffffffu; \
        if (MODE == AM_MOBA) { const int blk = T_ >> 2; dq = (blk == io.own) ? (io.q - T_ * 64) : (((io.mlo >> blk) & 1u) ? ATT_BIG : -1); } \
        else if (MODE == AM_SEL) { const unsigned bit = (T_ < 32) ? ((io.mlo >> T_) & 1u) : ((io.mhi >> (T_ - 32)) & 1u); dq = (T_ == io.own) ? (io.q - T_ * 64) : (bit ? ATT_BIG : -1); } \
        else if (MODE == AM_WIN) { dq = io.q - T_ * 64; W = 512u; } \
        else { dq = io.q - T_ * 64; } \
        dq -= 4 * hi; \
        { const float NEG = -__builtin_inff(); \
          _Pragma("unroll") for (int r = 0; r < 16; ++r) { const int c = (r & 3) + 8 * (r >> 2); \
              if ((unsigned)(dq - c) >= W) p0[r] = NEG; if ((unsigned)(dq - c - 32) >= W) p1[r] = NEG; } } \
        if (MODE == AM_COUT) { \
            const float mL = -m_reg * ATT_C2; \
            _Pragma("unroll") for (int r = 0; r < 16; ++r) { p0[r] = __builtin_amdgcn_exp2f(fmaf(p0[r], ATT_C2, mL)) * inv_l; p1[r] = __builtin_amdgcn_exp2f(fmaf(p1[r], ATT_C2, mL)) * inv_l; } \
              \
            { float prev = carry; \
              _Pragma("unroll") for (int g = 0; g < 8; ++g) { \
                  const float s4 = (g < 4) ? ((p0[4 * (g & 3)] + p0[4 * (g & 3) + 1]) + (p0[4 * (g & 3) + 2] + p0[4 * (g & 3) + 3])) : ((p1[4 * (g & 3)] + p1[4 * (g & 3) + 1]) + (p1[4 * (g & 3) + 2] + p1[4 * (g & 3) + 3])); \
                  const float sp = (g < 4) ? p0[4 * (g & 3) + 3] : p1[4 * (g & 3) + 3]; \
                  const float osp = half_other(sp); \
                  imp[16 * T_ + 2 * g + hi] = s4 + (hi ? osp : prev); prev = osp; } \
              carry = prev; } \
            bf16x8 pa0, pa1, pa2, pa3; PK4(p0, 0, pa0); PK4(p0, 8, pa1); PK4(p1, 0, pa2); PK4(p1, 8, pa3); \
            pv_tile(o, vb0, pa0, pa1, pa2, pa3); \
        } else { \
            float pmax = p0[0]; \
            _Pragma("unroll") for (int r = 1; r < 16; ++r) pmax = fmaxf(pmax, p0[r]); \
            _Pragma("unroll") for (int r = 0; r < 16; ++r) pmax = fmaxf(pmax, p1[r]); \
            pmax = half_max(pmax); \
            const float mn = fmaxf(m_reg, pmax); const float alpha = __builtin_amdgcn_exp2f((m_reg - mn) * ATT_C2); m_reg = mn; \
            const float mL = -mn * ATT_C2; float ps = 0.f; \
            _Pragma("unroll") for (int r = 0; r < 16; ++r) { p0[r] = __builtin_amdgcn_exp2f(fmaf(p0[r], ATT_C2, mL)); p1[r] = __builtin_amdgcn_exp2f(fmaf(p1[r], ATT_C2, mL)); ps += p0[r] + p1[r]; } \
            ps = half_sum(ps); l_reg = l_reg * alpha + ps; \
            if (NEEDV) { \
                if (__any(alpha < 1.0f)) { if (hi == 0) wsc[r32] = alpha; LDS_WAIT(); \
                    _Pragma("unroll") for (int r = 0; r < 16; ++r) { const float al = wsc[crow(r, hi)]; o[0][r] *= al; o[1][r] *= al; o[2][r] *= al; o[3][r] *= al; } } \
                bf16x8 pa0, pa1, pa2, pa3; PK4(p0, 0, pa0); PK4(p0, 8, pa1); PK4(p1, 0, pa2); PK4(p1, 8, pa3); \
                    pv_tile(o, vb0, pa0, pa1, pa2, pa3); } \
        } \
          \
        { const int ahead = io.t_hi - 2 - T_; \
          if (DEPTH >= 3 && ahead >= 2) asm volatile("s_waitcnt vmcnt(%0)" :: "n"(2 * PER) : "memory"); \
          else if (DEPTH >= 2 && ahead >= 1) asm volatile("s_waitcnt vmcnt(%0)" :: "n"(PER) : "memory"); \
          else asm volatile("s_waitcnt vmcnt(0)" ::: "memory"); } \
        asm volatile("s_waitcnt lgkmcnt(0)" ::: "memory"); __builtin_amdgcn_s_barrier(); asm volatile("" ::: "memory"); } while (0)

    constexpr int PER = NEEDV ? 4 : 2;
#pragma unroll
    for (int d0 = 0; d0 < 8; ++d0) asm volatile("" :: "v"(qr[d0]));
    asm volatile("" :: "v"(io.mlo), "v"(io.mhi), "v"(io.q));
#pragma unroll
    for (int d = 0; d < DEPTH; ++d) if (io.t_lo + d < io.t_hi) A_DMA(io.t_lo + d, d);
    {   const int ahead = io.t_hi - 1 - io.t_lo;
        if (DEPTH >= 3 && ahead >= 2) asm volatile("s_waitcnt vmcnt(%0)" :: "n"(2 * PER) : "memory");
        else if (DEPTH >= 2 && ahead >= 1) asm volatile("s_waitcnt vmcnt(%0)" :: "n"(PER) : "memory");
        else asm volatile("s_waitcnt vmcnt(0)" ::: "memory"); }
    asm volatile("s_waitcnt lgkmcnt(0)" ::: "memory"); __builtin_amdgcn_s_barrier(); asm volatile("" ::: "memory");
#pragma unroll 1
    for (int T = io.t_lo; T < io.t_hi; ++T) A_STEP(T);
#undef A_DMA
#undef A_STEP
}

template <int MODE>
__device__ __forceinline__ void attn_pass_pipe(ldsp lds, LAS float* wsc, const bf16x8 (&qr)[8], const AttnIO& io, f32x16 (&o)[4], float& m_reg, float& l_reg) {
    constexpr int NB = 4, PER = 4;
    const int tid = otid(), lane = tid & 63, r32 = lane & 31, hi = lane >> 5;
    ldsp V_lds = lds; ldsp K_lds = lds + NB * SHM_T;
    const int vbase = (int)(unsigned)(uintptr_t)V_lds + v_rd_base(lane);
    const int wv = __builtin_amdgcn_readfirstlane(tid >> 6);
    const int q0 = __builtin_amdgcn_readfirstlane(io.q - r32);
    size_t ksrc[2], vsrc[2];
#pragma unroll
    for (int i = 0; i < 2; ++i) { const int ch = wv * 2 + i;
        const int kr = ch * 4 + (lane >> 4), kc = (lane & 15) ^ (kr & 7);
        ksrc[i] = (size_t)kr * io.pitch + kc * 8;
        const int sub = ch * 2 + (lane >> 5), kk = (sub >> 2) * 8 + ((lane & 31) >> 2), vk = (kk & ~0xC) | ((kk & 4) << 1) | ((kk & 8) >> 1), vc = (sub & 3) * 32 + (lane & 3) * 8;
        vsrc[i] = (size_t)vk * io.pitch + vc; }
#define P_DMA(T, bf) do { const size_t t0_ = (size_t)((T) * 64) * io.pitch; \
        _Pragma("unroll") for (int i = 0; i < 2; ++i) { \
            glds16((const void*)(io.Kg + t0_ + ksrc[i]), (unsigned)(uintptr_t)(K_lds + (bf) * SHM_T + (wv * 2 + i) * 1024)); \
            glds16((const void*)(io.Vg + t0_ + vsrc[i]), (unsigned)(uintptr_t)(V_lds + (bf) * SHM_T + (wv * 2 + i) * 1024)); } } while (0)
#define P_STEP(C0, C1, N0, N1, T) do { \
        const int T_ = (T); const int vb0 = vbase + ((T_ - io.t_lo) & 3) * SHM_T; \
        if (T_ + 3 < io.t_hi) P_DMA(T_ + 3, (T_ + 3 - io.t_lo) & 3); \
        if (T_ + 1 < io.t_hi) qkt(N0, N1, K_lds + ((T_ + 1 - io.t_lo) & 3) * SHM_T, r32, hi, qr); \
        __builtin_amdgcn_sched_barrier(0); \
        bool on = true, edge; int dq = io.q - T_ * 64 - 4 * hi; unsigned W = 0x7fffffffu; \
        if (MODE == AM_MOBA) { const int blk = T_ >> 2; edge = (blk == io.own); on = edge || ((io.mlo >> blk) & 1u); } \
        else if (MODE == AM_SEL) { const unsigned bit = (T_ < 32) ? ((io.mlo >> T_) & 1u) : ((io.mhi >> (T_ - 32)) & 1u); edge = (T_ == io.own); on = edge || bit; } \
        else { W = 512u; edge = !((T_ * 64 + 63 <= q0) && (q0 + 31 - T_ * 64 < 512)); } \
        if (edge) { const float NEG = -__builtin_inff(); \
          _Pragma("unroll") for (int r = 0; r < 16; ++r) { const int c = (r & 3) + 8 * (r >> 2); \
              if ((unsigned)(dq - c) >= W) C0[r] = NEG; if ((unsigned)(dq - c - 32) >= W) C1[r] = NEG; } } \
        float mx[8]; \
        _Pragma("unroll") for (int r = 0; r < 8; ++r) mx[r] = fmaxf(fmaxf(C0[2 * r], C0[2 * r + 1]), fmaxf(C1[2 * r], C1[2 * r + 1])); \
        float pmax = fmaxf(fmaxf(fmaxf(mx[0], mx[1]), fmaxf(mx[2], mx[3])), fmaxf(fmaxf(mx[4], mx[5]), fmaxf(mx[6], mx[7]))); \
        pmax = on ? pmax : -__builtin_inff(); \
        pmax = half_max(pmax); \
        const float mn = fmaxf(m_reg, pmax); const float alpha = __builtin_amdgcn_exp2f((m_reg - mn) * ATT_C2); m_reg = mn; \
        const float mL = on ? -mn * ATT_C2 : -__builtin_inff(); float ps0 = 0.f, ps1 = 0.f; \
        _Pragma("unroll") for (int r = 0; r < 16; ++r) { C0[r] = __builtin_amdgcn_exp2f(fmaf(C0[r], ATT_C2, mL)); C1[r] = __builtin_amdgcn_exp2f(fmaf(C1[r], ATT_C2, mL)); ps0 += C0[r]; ps1 += C1[r]; } \
        const float ps = half_sum(ps0 + ps1); l_reg = l_reg * alpha + ps; \
        if (__any(alpha < 1.0f)) { if (hi == 0) wsc[r32] = alpha; LDS_WAIT(); \
            _Pragma("unroll") for (int r = 0; r < 16; ++r) { const float al = wsc[crow(r, hi)]; o[0][r] *= al; o[1][r] *= al; o[2][r] *= al; o[3][r] *= al; } } \
        { bf16x8 pa0, pa1, pa2, pa3; PK4(C0, 0, pa0); PK4(C0, 8, pa1); PK4(C1, 0, pa2); PK4(C1, 8, pa3); \
          pv_tile(o, vb0, pa0, pa1, pa2, pa3); } \
          \
        if (T_ + 3 < io.t_hi) asm volatile("s_waitcnt vmcnt(%0)" :: "n"(PER) : "memory"); else asm volatile("s_waitcnt vmcnt(0)" ::: "memory"); \
        asm volatile("s_waitcnt lgkmcnt(0)" ::: "memory"); __builtin_amdgcn_s_barrier(); asm volatile("" ::: "memory"); } while (0)

#pragma unroll
    for (int d0 = 0; d0 < 8; ++d0) asm volatile("" :: "v"(qr[d0]));
    asm volatile("" :: "v"(io.mlo), "v"(io.mhi), "v"(io.q));
#pragma unroll
    for (int d = 0; d < 3; ++d) if (io.t_lo + d < io.t_hi) P_DMA(io.t_lo + d, d);
    if (io.t_lo + 2 < io.t_hi) asm volatile("s_waitcnt vmcnt(%0)" :: "n"(PER) : "memory"); else asm volatile("s_waitcnt vmcnt(0)" ::: "memory");
    asm volatile("s_waitcnt lgkmcnt(0)" ::: "memory"); __builtin_amdgcn_s_barrier(); asm volatile("" ::: "memory");
    f32x16 pA0, pA1, pB0, pB1;
    qkt(pA0, pA1, K_lds, r32, hi, qr);
#pragma unroll 1
    for (int T = io.t_lo; T < io.t_hi; T += 2) {
        P_STEP(pA0, pA1, pB0, pB1, T);
        if (T + 1 < io.t_hi) P_STEP(pB0, pB1, pA0, pA1, T + 1);
    }
#undef P_DMA
#undef P_STEP
}

template <int MODE>
__device__ __forceinline__ void attn_pass_pipe2(ldsp lds, LAS float* wsc, const bf16x8 (&qr)[8], const AttnIO& io, f32x16 (&o)[4], float& m_reg, float& l_reg) {
    constexpr int NB = 4;
    const int tid = otid(), lane = tid & 63, r32 = lane & 31, hi = lane >> 5;
    ldsp V_lds = lds; ldsp K_lds = lds + NB * SHM_T;
    const int vbase = (int)(unsigned)(uintptr_t)V_lds + v_rd_base(lane);
    const int wv = __builtin_amdgcn_readfirstlane(tid >> 6);
    const bool lead = wv < 4;
    const int q0 = __builtin_amdgcn_readfirstlane(io.q - r32);
    size_t ksrc[2], vsrc[2];
#pragma unroll
    for (int i = 0; i < 2; ++i) { const int ch = wv * 2 + i;
        const int kr = ch * 4 + (lane >> 4), kc = (lane & 15) ^ (kr & 7);
        ksrc[i] = (size_t)kr * io.pitch + kc * 8;
        const int sub = ch * 2 + (lane >> 5), kk = (sub >> 2) * 8 + ((lane & 31) >> 2), vk = (kk & ~0xC) | ((kk & 4) << 1) | ((kk & 8) >> 1), vc = (sub & 3) * 32 + (lane & 3) * 8;
        vsrc[i] = (size_t)vk * io.pitch + vc; }
#define Q_DMAK(T) do { const size_t t0_ = (size_t)((T) * 64) * io.pitch; const int bf_ = ((T) - io.t_lo) & 3; \
        _Pragma("unroll") for (int i = 0; i < 2; ++i) glds16((const void*)(io.Kg + t0_ + ksrc[i]), (unsigned)(uintptr_t)(K_lds + bf_ * SHM_T + (wv * 2 + i) * 1024)); } while (0)
#define Q_DMAV(T) do { const size_t t0_ = (size_t)((T) * 64) * io.pitch; const int bf_ = ((T) - io.t_lo) & 3; \
        _Pragma("unroll") for (int i = 0; i < 2; ++i) glds16((const void*)(io.Vg + t0_ + vsrc[i]), (unsigned)(uintptr_t)(V_lds + bf_ * SHM_T + (wv * 2 + i) * 1024)); } while (0)
#define Q_QKT(N0, N1, T_) do { if ((T_) + 1 < io.t_hi) qkt(N0, N1, K_lds + (((T_) + 1 - io.t_lo) & 3) * SHM_T, r32, hi, qr); __builtin_amdgcn_sched_barrier(0); } while (0)
#define Q_PV(TT) do { pv_tile(o, vbase + (((TT) - io.t_lo) & 3) * SHM_T, pa0, pa1, pa2, pa3); __builtin_amdgcn_sched_barrier(0); } while (0)
#define Q_SOFTMAX(C0, C1, T_) do { \
        bool on = true, edge; int dq = io.q - (T_) * 64 - 4 * hi; unsigned W = 0x7fffffffu; \
        if (MODE == AM_MOBA) { const int blk = (T_) >> 2; edge = (blk == io.own); on = edge || ((io.mlo >> blk) & 1u); } \
        else if (MODE == AM_SEL) { const unsigned bit = ((T_) < 32) ? ((io.mlo >> (T_)) & 1u) : ((io.mhi >> ((T_) - 32)) & 1u); edge = ((T_) == io.own); on = edge || bit; } \
        else { W = 512u; edge = !(((T_) * 64 + 63 <= q0) && (q0 + 31 - (T_) * 64 < 512)); } \
        if (edge) { const float NEG = -__builtin_inff(); \
          _Pragma("unroll") for (int r = 0; r < 16; ++r) { const int c = (r & 3) + 8 * (r >> 2); \
              if ((unsigned)(dq - c) >= W) C0[r] = NEG; if ((unsigned)(dq - c - 32) >= W) C1[r] = NEG; } } \
        float mx[8]; \
        _Pragma("unroll") for (int r = 0; r < 8; ++r) mx[r] = fmaxf(fmaxf(C0[2 * r], C0[2 * r + 1]), fmaxf(C1[2 * r], C1[2 * r + 1])); \
        float pmax = fmaxf(fmaxf(fmaxf(mx[0], mx[1]), fmaxf(mx[2], mx[3])), fmaxf(fmaxf(mx[4], mx[5]), fmaxf(mx[6], mx[7]))); \
        pmax = on ? pmax : -__builtin_inff(); \
        pmax = half_max(pmax); \
          \
        const bool upd = __any((pmax - m_reg) * ATT_C2 > ATT_DEFER); float alpha = 1.0f; \
        if (upd) { const float mn = fmaxf(m_reg, pmax); alpha = __builtin_amdgcn_exp2f((m_reg - mn) * ATT_C2); m_reg = mn; } \
        const float mL = on ? -m_reg * ATT_C2 : -__builtin_inff(); float ps0 = 0.f, ps1 = 0.f; \
        _Pragma("unroll") for (int r = 0; r < 16; ++r) { C0[r] = __builtin_amdgcn_exp2f(fmaf(C0[r], ATT_C2, mL)); C1[r] = __builtin_amdgcn_exp2f(fmaf(C1[r], ATT_C2, mL)); ps0 += C0[r]; ps1 += C1[r]; } \
        const float ps = half_sum(ps0 + ps1); l_reg = l_reg * alpha + ps; \
        if (upd) { if (hi == 0) wsc[r32] = alpha; LDS_WAIT(); \
            _Pragma("unroll") for (int r = 0; r < 16; ++r) { const float al = wsc[crow(r, hi)]; o[0][r] *= al; o[1][r] *= al; o[2][r] *= al; o[3][r] *= al; } } \
        PK4(C0, 0, pa0); PK4(C0, 8, pa1); PK4(C1, 0, pa2); PK4(C1, 8, pa3); __builtin_amdgcn_sched_barrier(0); } while (0)
#define Q_STEP(C0, C1, N0, N1, T) do { \
        const int T_ = (T); \
        if (T_ + 3 < io.t_hi) Q_DMAK(T_ + 3); \
        if (T_ + 2 < io.t_hi) Q_DMAV(T_ + 2); \
        if (!lead && T_ > io.t_lo) Q_PV(T_ - 1); \
        Q_QKT(N0, N1, T_); Q_SOFTMAX(C0, C1, T_); \
        if (lead) Q_PV(T_); \
          \
        { const int nk = (T_ + 3 < io.t_hi) ? 2 : 0, nv = (T_ + 2 < io.t_hi) ? 2 : 0; \
          if (nk + nv == 4) asm volatile("s_waitcnt vmcnt(4)" ::: "memory"); else if (nk + nv == 2) asm volatile("s_waitcnt vmcnt(2)" ::: "memory"); else asm volatile("s_waitcnt vmcnt(0)" ::: "memory"); } \
        asm volatile("s_waitcnt lgkmcnt(0)" ::: "memory"); __builtin_amdgcn_s_barrier(); asm volatile("" ::: "memory"); } while (0)

#pragma unroll
    for (int d0 = 0; d0 < 8; ++d0) asm volatile("" :: "v"(qr[d0]));
    asm volatile("" :: "v"(io.mlo), "v"(io.mhi), "v"(io.q));
    Q_DMAK(io.t_lo); Q_DMAV(io.t_lo);
    if (io.t_lo + 1 < io.t_hi) { Q_DMAK(io.t_lo + 1); Q_DMAV(io.t_lo + 1); }
    if (io.t_lo + 2 < io.t_hi) Q_DMAK(io.t_lo + 2);
    { const int young = ((io.t_lo + 1 < io.t_hi) ? 2 : 0) + ((io.t_lo + 2 < io.t_hi) ? 2 : 0);
      if (young == 4) asm volatile("s_waitcnt vmcnt(4)" ::: "memory"); else if (young == 2) asm volatile("s_waitcnt vmcnt(2)" ::: "memory"); else asm volatile("s_waitcnt vmcnt(0)" ::: "memory"); }
    asm volatile("s_waitcnt lgkmcnt(0)" ::: "memory"); __builtin_amdgcn_s_barrier(); asm volatile("" ::: "memory");
    f32x16 pA0, pA1, pB0, pB1; bf16x8 pa0, pa1, pa2, pa3;
    pa0 = pa1 = pa2 = pa3 = (bf16x8){0, 0, 0, 0, 0, 0, 0, 0};
    qkt(pA0, pA1, K_lds, r32, hi, qr);
#pragma unroll 1
    for (int T = io.t_lo; T < io.t_hi; T += 2) {
        Q_STEP(pA0, pA1, pB0, pB1, T);
        if (T + 1 < io.t_hi) Q_STEP(pB0, pB1, pA0, pA1, T + 1);
    }
    if (!lead) Q_PV(io.t_hi - 1);
#undef Q_DMAK
#undef Q_DMAV
#undef Q_QKT
#undef Q_PV
#undef Q_SOFTMAX
#undef Q_STEP
}

__device__ __forceinline__ void load_q(bf16x8 (&qr)[8], const bf16_t* qrow, int hi) {
#pragma unroll
    for (int d0 = 0; d0 < 8; ++d0) qr[d0] = *(const bf16x8*)(qrow + d0 * 16 + hi * 8);
}


__device__ __forceinline__ void store_o_bf16(const f32x16 (&o)[4], const LAS float* wsc, bf16_t* dst, size_t pitch, int r32, int hi) {
#pragma unroll
    for (int r = 0; r < 16; ++r) { const int row = crow(r, hi); const float sc = wsc[row];
#pragma unroll
        for (int d0 = 0; d0 < 4; ++d0) { const float v = o[d0][r] * sc; const float vn = __shfl_xor(v, 1);
            if ((r32 & 1) == 0) *(unsigned*)(dst + (size_t)row * pitch + d0 * 32 + r32) = cvtpk(v, vn); } }
}

constexpr int MB_Q = 0, MB_KM = 69632, MB_GT = 77824, MB_SELM = 131072, MB_WSC = 132096;
__device__ __forceinline__ void moba_gate(ldsp lds, unsigned char* ws, int unit) {
    const int qb = unit & 15, h = (unit >> 4) & 7, b = unit >> 7;
    const bf16_t* proj = (const bf16_t*)(ws + WS_PROJ);
    const int tid = otid();
    LAS float* KM = (LAS float*)(lds + MB_KM);
    LAS float* GT = (LAS float*)(lds + MB_GT);
    LAS unsigned* SELM = (LAS unsigned*)(lds + MB_SELM);
    const size_t row0 = (size_t)b * SEQ + (size_t)qb * 256;
    const float* km = (const float*)(ws + SM_KMEAN) + (size_t)((b * 8 + h) * 16) * 128;
    {   u32x4 qw[8]; float kw[4];
#pragma unroll
        for (int i = 0; i < 8; ++i) { const int c = tid + 512 * i; qw[i] = *(const u32x4*)(proj + (row0 + (c >> 4)) * NP + C_MQ + h * 128 + (c & 15) * 8); }
#pragma unroll
        for (int i = 0; i < 4; ++i) kw[i] = km[tid + 512 * i];
#pragma unroll
        for (int i = 0; i < 8; ++i) { const int c = tid + 512 * i; *(LAS u32x4*)(lds + MB_Q + (c >> 4) * P272 + (c & 15) * 16) = qw[i]; }
#pragma unroll
        for (int i = 0; i < 4; ++i) KM[tid + 512 * i] = kw[i]; }
    __syncthreads();
    const int ql = tid >> 1, n0 = (tid & 1) * 8;
    float acc[8] = {0, 0, 0, 0, 0, 0, 0, 0};
    if (n0 < qb) {
#pragma unroll 2
        for (int i = 0; i < 16; ++i) { float qf[8]; unpack8(*(const LAS u32x4*)(lds + MB_Q + ql * P272 + i * 16), qf); const int d = 8 * i;
#pragma unroll
            for (int n = 0; n < 8; ++n) { const f32x4 k0 = *(const LAS f32x4*)(KM + (n0 + n) * 128 + d), k1 = *(const LAS f32x4*)(KM + (n0 + n) * 128 + d + 4);
                acc[n] += (qf[0] * k0.x + qf[1] * k0.y) + (qf[2] * k0.z + qf[3] * k0.w) + (qf[4] * k1.x + qf[5] * k1.y) + (qf[6] * k1.z + qf[7] * k1.w); } } }
#pragma unroll
    for (int n = 0; n < 8; ++n) GT[ql * 16 + n0 + n] = acc[n];
    __syncthreads();
    if (tid < 256) { unsigned m = 0u;
        if (qb <= 3) m = (1u << qb) - 1u;
        else { float g[16];
#pragma unroll
            for (int n = 0; n < 16; ++n) g[n] = (n < qb) ? GT[tid * 16 + n] : -__builtin_inff();
#pragma unroll
            for (int pick = 0; pick < 3; ++pick) { float best = -__builtin_inff(); int bi = 0;
#pragma unroll
                for (int n = 0; n < 16; ++n) { const bool tk = g[n] > best; best = tk ? g[n] : best; bi = tk ? n : bi; }
                m |= 1u << bi;
#pragma unroll
                for (int n = 0; n < 16; ++n) g[n] = (n == bi) ? -__builtin_inff() : g[n]; } }
        SELM[tid] = m; }
    __syncthreads();
}
__device__ NOINL void moba_unit(ldsp lds, int unit) {
    unsigned char* ws = ows();
    moba_gate(lds, ws, unit);
    f32x16 o[4] = {}; float m_reg = -1e30f, l_reg = 0.f;
    {   const int qb = unit & 15, h = (unit >> 4) & 7, b = unit >> 7;
        const bf16_t* proj = (const bf16_t*)(ws + WS_PROJ);
        const int tid = otid(), lane = tid & 63, wave = __builtin_amdgcn_readfirstlane(tid >> 6), r32 = lane & 31, hi = lane >> 5;
        const size_t row0 = (size_t)b * SEQ + (size_t)qb * 256;
        bf16x8 qr[8]; load_q(qr, proj + (row0 + wave * 32 + r32) * NP + C_MQ + h * 128, hi);
        AttnIO io; io.Kg = proj + (size_t)b * SEQ * NP + C_MK + h * 128; io.Vg = proj + (size_t)b * SEQ * NP + C_MV + h * 128; io.pitch = NP;
        io.t_lo = 0; io.t_hi = 4 * qb + 4; io.q = qb * 256 + wave * 32 + r32; io.own = qb; io.mlo = ((LAS unsigned*)(lds + MB_SELM))[wave * 32 + r32]; io.mhi = 0u;
        attn_pass_pipe2<AM_MOBA>(lds, (LAS float*)(lds + MB_WSC) + wave * 64, qr, io, o, m_reg, l_reg);
    }
    {   int u2 = unit; OPQ_S(u2); const int tz = otid();
        const int qb = u2 & 15, h = (u2 >> 4) & 7, b = u2 >> 7;
        const int lane = tz & 63, wave = __builtin_amdgcn_readfirstlane(tz >> 6), r32 = lane & 31, hi = lane >> 5;
        LAS float* wsc = (LAS float*)(lds + MB_WSC) + wave * 64;
        const size_t row0 = (size_t)b * SEQ + (size_t)qb * 256;
        if (hi == 0) wsc[r32] = 1.0f / l_reg;
        LDS_WAIT();
        store_o_bf16(o, wsc, (bf16_t*)(ws + WS_Y) + (row0 + wave * 32) * DM + 1024 + h * 128, DM, r32, hi);
    }
    __syncthreads();
}

constexpr int NS_IMP = 65536, NS_SELM = 131072, NS_GATE = 131584, NS_WSC = 135680;
struct NsaIdx { int qt, kvh, b, lane, wave, r32, hi, hl, qh, hh, qloc, qpos; size_t row0; };
__device__ __forceinline__ NsaIdx nsa_idx(int unit, int tid) {
    NsaIdx x; x.qt = unit & 63; x.kvh = (unit >> 6) & 1; x.b = unit >> 7; x.lane = tid & 63; x.wave = __builtin_amdgcn_readfirstlane(tid >> 6); x.r32 = x.lane & 31; x.hi = x.lane >> 5;
    x.hl = x.wave >> 1; x.qh = x.wave & 1; x.hh = x.kvh * 4 + x.hl; x.qloc = x.qh * 32 + x.r32; x.qpos = x.qt * 64 + x.qloc; x.row0 = (size_t)x.b * SEQ + (size_t)x.qt * 64; return x;
}
__device__ NOINL void nsa_cmp_branch(ldsp lds, int unit) {
    unsigned char* ws = ows();
    f32x16 o[4]; float m_reg = -1e30f, l_reg = 0.f;
#pragma unroll
    for (int d = 0; d < 4; ++d) o[d] = f32x16{};
    {   const NsaIdx x = nsa_idx(unit, otid());
        const bf16_t* proj = (const bf16_t*)(ws + WS_PROJ);
        LAS float* GATEL = (LAS float*)(lds + NS_GATE);
        if (x.hi == 0) {
#pragma unroll
            for (int br = 0; br < 3; ++br) GATEL[(x.wave * 32 + x.r32) * 4 + br] = sigmoidf_(bf2f(proj[(x.row0 + x.qloc) * NP + C_NGATE + x.hh * 3 + br])); }
        bf16x8 qr[8]; load_q(qr, proj + (x.row0 + x.qloc) * NP + C_NQ + x.hh * 128, x.hi);
        AttnIO io; io.pitch = 128; io.own = 0; io.mlo = 0u; io.mhi = 0u;
        io.Kg = (const bf16_t*)(ws + SM_KC) + (size_t)(x.b * 2 + x.kvh) * 256 * 128; io.Vg = (const bf16_t*)(ws + SM_VC) + (size_t)(x.b * 2 + x.kvh) * 256 * 128;
        io.t_lo = 0; io.t_hi = ((4 * x.qt + 2) >> 6) + 1; io.q = (x.qpos >= 31) ? ((x.qpos - 31) >> 4) : -1;
        LAS float* wsc = (LAS float*)(lds + NS_WSC) + x.wave * 64;
        attn_pass<AM_CSTAT, 2>(lds, wsc, qr, io, o, m_reg, l_reg, 0.f, nullptr);
        const float inv_l = (l_reg > 0.f) ? 1.0f / l_reg : 0.f;
        attn_pass<AM_COUT, 2>(lds, wsc, qr, io, o, m_reg, l_reg, inv_l, (LAS float*)(lds + NS_IMP) + (x.hl * 64 + x.qloc) * 64);
    }
    {   int u2 = unit; OPQ_S(u2); const int tz = otid();
        const NsaIdx x = nsa_idx(u2, tz);
        const LAS float* GATEL = (const LAS float*)(lds + NS_GATE);
        float* accp = (float*)(ws + WS_NSAACC) + (x.row0 + x.qh * 32) * 1024 + x.hh * 128;
        LDS_WAIT();
#pragma unroll
        for (int r = 0; r < 16; ++r) { const int row = crow(r, x.hi); const float g0 = GATEL[(x.wave * 32 + row) * 4 + 0];
#pragma unroll
            for (int d0 = 0; d0 < 4; ++d0) accp[(size_t)row * 1024 + d0 * 32 + x.r32] = g0 * o[d0][r]; }
    }
    __syncthreads();
    {   int u2 = unit; OPQ_S(u2); const int tid = otid();
        const int qt = u2 & 63;
        LAS float* IMP = (LAS float*)(lds + NS_IMP); LAS unsigned* SELM = (LAS unsigned*)(lds + NS_SELM);
        const int q = tid >> 3, jg = tid & 7;
        float v[8];
#pragma unroll
        for (int xx = 0; xx < 8; ++xx) { const int j = jg * 8 + xx; v[xx] = (IMP[(0 * 64 + q) * 64 + j] + IMP[(1 * 64 + q) * 64 + j]) + (IMP[(2 * 64 + q) * 64 + j] + IMP[(3 * 64 + q) * 64 + j]);
            if (j > qt) v[xx] = -__builtin_inff();
            if (j == 0 || j == qt || j == qt - 1) v[xx] = __builtin_inff(); }
        __syncthreads();
#pragma unroll
        for (int xx = 0; xx < 8; ++xx) IMP[q * 64 + jg * 8 + xx] = v[xx];
        __syncthreads();
        int rank[8] = {0, 0, 0, 0, 0, 0, 0, 0};
        for (int j2 = 0; j2 < 64; ++j2) { const float w = IMP[q * 64 + j2];
#pragma unroll
            for (int xx = 0; xx < 8; ++xx) { const int j = jg * 8 + xx; rank[xx] += (w > v[xx] || (w == v[xx] && j2 < j)) ? 1 : 0; } }
        unsigned bits = 0u;
#pragma unroll
        for (int xx = 0; xx < 8; ++xx) bits |= (rank[xx] < 16) ? (1u << xx) : 0u;
        unsigned lo = (jg < 4) ? (bits << (8 * jg)) : 0u, hiw = (jg >= 4) ? (bits << (8 * (jg - 4))) : 0u;
        lo |= __shfl_xor(lo, 1); lo |= __shfl_xor(lo, 2); lo |= __shfl_xor(lo, 4);
        hiw |= __shfl_xor(hiw, 1); hiw |= __shfl_xor(hiw, 2); hiw |= __shfl_xor(hiw, 4);
        if (jg == 0) { SELM[q * 2] = lo; SELM[q * 2 + 1] = hiw; }
        __syncthreads();
    }
}
template <int BR>
__device__ NOINL void nsa_attn_branch(ldsp lds, int unit) {
    unsigned char* ws = ows();
    f32x16 o[4]; float m_reg = -1e30f, l_reg = 0.f;
#pragma unroll
    for (int d = 0; d < 4; ++d) o[d] = f32x16{};
    {   const NsaIdx x = nsa_idx(unit, otid());
        const bf16_t* proj = (const bf16_t*)(ws + WS_PROJ);
        bf16x8 qr[8]; load_q(qr, proj + (x.row0 + x.qloc) * NP + C_NQ + x.hh * 128, x.hi);
        AttnIO io; io.pitch = NP; io.q = x.qpos; io.t_hi = x.qt + 1;
        const LAS unsigned* SELM = (const LAS unsigned*)(lds + NS_SELM);
        LAS float* wsc = (LAS float*)(lds + NS_WSC) + x.wave * 64;
        if (BR == 1) { io.Kg = proj + (size_t)x.b * SEQ * NP + C_NKS + x.kvh * 128; io.Vg = proj + (size_t)x.b * SEQ * NP + C_NVS + x.kvh * 128;
            io.t_lo = 0; io.own = x.qt; io.mlo = SELM[x.qloc * 2]; io.mhi = SELM[x.qloc * 2 + 1];
            attn_pass_pipe2<AM_SEL>(lds, wsc, qr, io, o, m_reg, l_reg); }
        else { io.Kg = proj + (size_t)x.b * SEQ * NP + C_NKW + x.kvh * 128; io.Vg = proj + (size_t)x.b * SEQ * NP + C_NVW + x.kvh * 128;
            io.t_lo = (x.qt >= 8) ? x.qt - 8 : 0; io.own = 0; io.mlo = 0u; io.mhi = 0u;
#ifndef PROBE_WINREP
#define PROBE_WINREP 1
#endif
            int nrep = PROBE_WINREP; OPQ_S(nrep);
#pragma unroll 1
            for (int rp = 0; rp < nrep; ++rp) {
#pragma unroll
                for (int d = 0; d < 4; ++d) o[d] = f32x16{};
                m_reg = -1e30f; l_reg = 0.f;
                attn_pass_pipe2<AM_WIN>(lds, wsc, qr, io, o, m_reg, l_reg); } }
    }
    {   int u2 = unit; OPQ_S(u2); const int tz = otid();
        const NsaIdx x = nsa_idx(u2, tz);
        const LAS float* GATEL = (const LAS float*)(lds + NS_GATE);
        LAS float* wsc = (LAS float*)(lds + NS_WSC) + x.wave * 64;
        float* accp = (float*)(ws + WS_NSAACC) + (x.row0 + x.qh * 32) * 1024 + x.hh * 128;
        if (x.hi == 0) wsc[32 + x.r32] = GATEL[(x.wave * 32 + x.r32) * 4 + BR] / l_reg;
        LDS_WAIT();
        if (BR == 1) {
            float pv[4][16];
#pragma unroll
            for (int d0 = 0; d0 < 4; ++d0)
#pragma unroll
                for (int r = 0; r < 16; ++r) pv[d0][r] = accp[(size_t)crow(r, x.hi) * 1024 + d0 * 32 + x.r32];
            asm volatile("" ::: "memory");
#pragma unroll
            for (int d0 = 0; d0 < 4; ++d0)
#pragma unroll
                for (int r = 0; r < 16; ++r) { const int row = crow(r, x.hi); accp[(size_t)row * 1024 + d0 * 32 + x.r32] = pv[d0][r] + wsc[32 + row] * o[d0][r]; } }
        else { bf16_t* yp = (bf16_t*)(ws + WS_Y) + (x.row0 + x.qh * 32) * DM + 3072 + x.hh * 128;
            float pv[4][16];
#pragma unroll
            for (int d0 = 0; d0 < 4; ++d0)
#pragma unroll
                for (int r = 0; r < 16; ++r) pv[d0][r] = accp[(size_t)crow(r, x.hi) * 1024 + d0 * 32 + x.r32];
            asm volatile("" ::: "memory");
#pragma unroll
            for (int d0 = 0; d0 < 4; ++d0)
#pragma unroll
                for (int r = 0; r < 16; ++r) { const int row = crow(r, x.hi); const float v = pv[d0][r] + wsc[32 + row] * o[d0][r]; const float vn = __shfl_xor(v, 1);
                    if ((x.r32 & 1) == 0) *(unsigned*)(yp + (size_t)row * DM + d0 * 32 + x.r32) = cvtpk(v, vn); } }
    }
    __syncthreads();
}

__device__ __forceinline__ void s3_phase(ldsp lds, int layer) {
    int G = gridDim.x, bid = blockIdx.x; OPQ_S(G); OPQ_S(bid);
#ifndef S3_MASK
#define S3_MASK 0x3f
#endif
#ifndef S3_DUP
#define S3_DUP 0
#endif
#define S3REP(b) _Pragma("unroll 1") for (int r3_ = 0; r3_ < 1 + ((S3_DUP >> (b)) & 1); ++r3_)
    for (int u = bid; u < 256; u += G) {
        const int x = u & 7, slot = u >> 3, qbm = slot & 15;
        const int mu = (G == 256) ? ((2 * x + (slot >> 4)) * 16 + qbm) : u;
        if (S3_MASK & 1) S3REP(0) moba_unit(lds, mu); }
    for (int u = bid; u < 256; u += G) {
        int nu;
        if (G == 256) { const int x = u & 7, slot = u >> 3, qbm = slot & 15, r = 2 * (x & 1) + (slot >> 4); nu = (x >> 1) * 64 + (63 - 4 * qbm - r); }
        else { const int qbm = u & 15, bh = u >> 4; nu = (bh >> 2) * 64 + (63 - 4 * qbm - (bh & 3)); }
        if (S3_MASK & 2) S3REP(1) nsa_cmp_branch(lds, nu); if (S3_MASK & 4) S3REP(2) nsa_attn_branch<1>(lds, nu); if (S3_MASK & 8) S3REP(3) nsa_attn_branch<2>(lds, nu); }
    if (S3_MASK & 16) S3REP(4) for (int u = bid; u < 512; u += G) ret_out_unit(lds, layer, u);
    if (S3_MASK & 32) S3REP(5) for (int u = bid; u < 128; u += G) lru_out_unit(lds, u);
}

constexpr int N_PHASES = 16;
struct Args { const float* in[23]; float* out; unsigned char* ws; int ph_lo, ph_hi, li, pad; };
template <class Epi>
__device__ NOINL void gemm_call(ldsp lds, const bf16_t* A, const bf16_t* Bt, int N, int K, Epi E) {
    pg8::Gemm g{A, Bt, MTOK, N, K}; pg8::StaticOrder S; S.init(MTOK, N, (int)gridDim.x, (int)blockIdx.x);
    pg8::gemm_phase<Epi, pg8::StaticOrder, true, true>(lds, g, S, E);
}
template <class Epi>
__device__ NOINL void gemm_call_norm(ldsp lds, const bf16_t* A, const bf16_t* Bt, int N, int K, const float* ssq, Epi E, int Gg) {
    pg8::Gemm g{A, Bt, MTOK, N, K}; pg8::StaticOrder S; S.init(MTOK, N, Gg, (int)blockIdx.x);
    pg8::Unit u0; if (!S.next(0, u0)) return;
    E.fm = (u0.pm >> 3) << 3;
    pg8::epi_rstd_table(ssq, E.fm, (LAS float*)E.xl, otid());
    pg8::gemm_phase<Epi, pg8::StaticOrder, false, true>(lds, g, S, E);
}
__global__ void __launch_bounds__(NTHR, 2) trunk_fwd(Args args) {
    extern __shared__ __attribute__((aligned(16))) unsigned char lds_raw[];
    const ldsp lds = (ldsp)lds_raw;
    volatile LAS unsigned* MISC = (volatile LAS unsigned*)(lds + MISC_OFF);
    if (threadIdx.x < 64) MISC[threadIdx.x] = 0u;
    __syncthreads();
    const int lo = args.ph_lo, hi = args.ph_hi;
    unsigned char* ws = args.ws;
    XcdBarrier bar; bar.bar = (unsigned*)(ws + WS_CTL) + CW_BAR + args.li * XCD_BAR_WORDS; bar.x = 0; bar.st = nullptr;
    if (hi - lo > 1) bar = xcd_barrier_post((unsigned*)(ws + WS_CTL) + CW_BAR + args.li * XCD_BAR_WORDS, MISC + 8);
#ifndef PH_MASK
#define PH_MASK 0xfff
#endif
#define IN(k) (lo <= (k) && (k) < hi)
#define ON(b) ((PH_MASK >> (b)) & 1)
#ifndef PROBE_DUP
#define PROBE_DUP 0
#endif
#define REP(b) _Pragma("unroll 1") for (int rep_ = 0; rep_ < 1 + ((PROBE_DUP >> (b)) & 1); ++rep_)
#define SEAM(k) do { if (IN(k) && IN((k) + 1)) xcd_barrier(bar); } while (0)

    if (ON(0) && IN(0)) REP(0) p0_prologue(lds);
    SEAM(0);
    const ldsp xl = lds + 131072;
#pragma unroll
    for (int layer = 0; layer < 2; ++layer) {
        const int pb = 1 + 7 * layer;
        bf16_t* x_in = (bf16_t*)(ws + (layer == 0 ? WS_XS0 : WS_XS2)); bf16_t* x_mid = (bf16_t*)(ws + WS_XS1); bf16_t* x_out = (bf16_t*)(ws + (layer == 0 ? WS_XS2 : WS_XS0));
        float* ssqa = (float*)(ws + SM_SSQA); float* ssqb = (float*)(ws + SM_SSQB);
        if (ON(5) && IN(pb + 0)) {
            const bool split = (SPLIT_INPROJ0 && layer == 0 && gridDim.x == 256);
            if (split && (int)blockIdx.x >= GEMM0_WGS) deferred_phase(lds, GEMM0_WGS, 0, 9);
            else REP(5) gemm_call_norm(lds, x_in, (const bf16_t*)(ws + WS_WIN) + (size_t)layer * NP * DM, NP, DM, ssqa, pg8::EpiBf16N{(bf16_t*)(ws + WS_PROJ), NP, 0, xl}, split ? GEMM0_WGS : (int)gridDim.x);
        }
        SEAM(pb + 0);
        if (ON(3) && IN(pb + 1)) REP(3) s1_phase(lds, layer);
        SEAM(pb + 1);
        if (ON(3) && IN(pb + 2)) { ret_scan_phase(lds); for (int u = (int)gridDim.x - 1 - (int)blockIdx.x; u < 64; u += (int)gridDim.x) nsa_cmp2_unit(lds, layer, u); }
        SEAM(pb + 2);
        if (ON(4) && IN(pb + 3)) REP(4) s3_phase(lds, layer);
        SEAM(pb + 3);
        if (ON(6) && IN(pb + 4)) REP(6) gemm_call(lds, (const bf16_t*)(ws + WS_Y), (const bf16_t*)(ws + WS_WOUT) + (size_t)layer * DM * DM, DM, DM, pg8::EpiResidB{x_in, x_mid, DM, ssqb, xl});
        SEAM(pb + 4);
        if (ON(7) && IN(pb + 5)) {
            const bool split = (SPLIT_GU0 && layer == 0 && gridDim.x == 256);
            if (split && (int)blockIdx.x >= GU0_WGS) deferred_phase(lds, GU0_WGS, 4, 9);
            else REP(7) gemm_call_norm(lds, x_mid, (const bf16_t*)(ws + WS_WGU) + (size_t)layer * NGU * DM, NGU, DM, ssqb, pg8::EpiSwiGLUN{(bf16_t*)(ws + WS_U), DFF, 0, xl}, split ? GU0_WGS : (int)gridDim.x);
        }
        SEAM(pb + 5);
        if (ON(8) && IN(pb + 6)) REP(8) gemm_call(lds, (const bf16_t*)(ws + WS_U), (const bf16_t*)(ws + WS_WDN) + (size_t)layer * DM * DFF, DM, DFF, pg8::EpiResidB{x_mid, x_out, DM, ssqa, xl});
        SEAM(pb + 6);
    }
    if (ON(1) && IN(15)) final_norm_phase(lds, (const bf16_t*)(ws + WS_XS0), (const float*)(ws + SM_SSQA), inp(22), args.out);
#undef IN
#undef SEAM
}

extern "C" void kernel_launch(void* const* d_in, const int* in_sizes, int n_in, void* d_out, int out_size, void* d_ws, size_t ws_size, hipStream_t stream) {
    static int grid = 0;
    if (grid == 0) {
        if (n_in != 23 || in_sizes[0] != MTOK * DM || out_size != MTOK * DM || ws_size < WS_END) {
            fprintf(stderr, "kernel_launch: unexpected shapes (n_in %d, in0 %d, out %d, ws %zu < %zu); nothing launched\n", n_in, n_in > 0 ? in_sizes[0] : -1, out_size, ws_size, (size_t)WS_END); grid = -1; return; }
        int dev = 0, cus = 0, per_cu = 0;
        if (hipGetDevice(&dev) != hipSuccess || hipDeviceGetAttribute(&cus, hipDeviceAttributeMultiprocessorCount, dev) != hipSuccess) { fprintf(stderr, "kernel_launch: device query failed\n"); grid = -1; return; }
        if (hipFuncSetAttribute((const void*)trunk_fwd, hipFuncAttributeMaxDynamicSharedMemorySize, LDS_BYTES) != hipSuccess) { fprintf(stderr, "kernel_launch: hipFuncSetAttribute(%d B LDS) failed\n", LDS_BYTES); grid = -1; return; }
        if (hipOccupancyMaxActiveBlocksPerMultiprocessor(&per_cu, (const void*)trunk_fwd, NTHR, LDS_BYTES) != hipSuccess || per_cu < 1)
            fprintf(stderr, "kernel_launch: note: occupancy query reports %d workgroups per CU\n", per_cu);
        (void)hipGetLastError();
        grid = cus;
    }
    if (grid < 0) return;
    if (hipMemsetAsync((char*)d_ws + WS_CTL, 0, CTL_ZERO_BYTES, stream) != hipSuccess) { fprintf(stderr, "kernel_launch: memset failed\n"); return; }
    Args a{};
    for (int i = 0; i < 23; ++i) a.in[i] = (const float*)d_in[i];
    a.out = (float*)d_out; a.ws = (unsigned char*)d_ws; a.pad = 0;
#if MK_LAUNCHES == 1
    a.ph_lo = 0; a.ph_hi = N_PHASES; a.li = 0;
    hipLaunchKernelGGL(trunk_fwd, dim3(grid), dim3(NTHR), LDS_BYTES, stream, a);
#else
    for (int k = 0; k < N_PHASES; ++k) { a.ph_lo = k; a.ph_hi = k + 1; a.li = k;
        hipLaunchKernelGGL(trunk_fwd, dim3(grid), dim3(NTHR), LDS_BYTES, stream, a); }
#endif
    const hipError_t le = hipPeekAtLastError();
    if (le != hipSuccess) fprintf(stderr, "kernel_launch: launch failed: %s (grid %d)\n", hipGetErrorName(le), grid);
}
```

```cpp
#include <hip/hip_runtime.h>
#include <cstdio>
#include <cstdint>

#ifndef GEMM_MFMA32
#define GEMM_MFMA32 0
#endif
#ifndef MK_LAUNCHES
#define MK_LAUNCHES 1
#endif

#define LAS __attribute__((address_space(3)))
#define GAS __attribute__((address_space(1)))
typedef unsigned short bf16_t;
typedef short bf16x8 __attribute__((ext_vector_type(8)));
typedef short s16x4 __attribute__((ext_vector_type(4)));
typedef float f32x2 __attribute__((ext_vector_type(2)));
typedef float f32x4 __attribute__((ext_vector_type(4)));
typedef float f32x16 __attribute__((ext_vector_type(16)));
typedef unsigned u32x2 __attribute__((ext_vector_type(2)));
typedef unsigned u32x4 __attribute__((ext_vector_type(4)));
typedef LAS unsigned char* ldsp;

namespace pg8 {
#define PG8_LAS __attribute__((address_space(3)))
constexpr int BM = 256, BK = 64, HALF = 128, HTB = HALF * BK * 2  , STAGE_BYTES = 8 * HTB, NXCD = 8, WGM = 8;

__host__ __device__ __forceinline__ int lds_byte(int r, int c) { const int st = (r >> 4) * 2 + (c >> 5), rr = r & 15, cc = c & 31, ob = rr * 64 + cc * 2; return st * 1024 + (ob ^ (((ob >> 9) & 1) << 5)); }
__host__ __device__ __forceinline__ void stage_rc(int b, int& R, int& C) { const int st = b / 1024, sb = b % 1024, swz = sb ^ (((sb >> 9) & 1) << 5); R = (st >> 1) * 16 + swz / 64; C = (st & 1) * 32 + (swz % 64) / 2; }
__host__ __device__ __forceinline__ int perm32(int rho) { const int n = rho >> 4, i = rho & 15; return 8 * (i >> 2) + 4 * n + (i & 3); }

__host__ __device__ __forceinline__ int perm32x(int rho) { return 16 * ((rho >> 2) & 1) + 4 * (rho >> 3) + (rho & 3); }
struct Unit { int pm, pn; };
struct Gemm { const bf16_t* A; const bf16_t* Bt; int M, N, K; };

struct StaticOrder {
    int nM, nN, nwg, G, c;
    __host__ __device__ void init(int M, int N, int G_, int c_) { nM = M / BM; nN = N / BM; nwg = nM * nN; G = G_; c = c_; }
    __host__ __device__ bool next(int i, Unit& u) const {
        const long L = (long)i * G + c; if (L >= nwg) return false;
        int wgid = (int)L; { const int q = nwg / NXCD, r = nwg % NXCD, xcd = wgid % NXCD, off = wgid / NXCD; wgid = (xcd < r ? xcd * (q + 1) : r * (q + 1) + (xcd - r) * q) + off; }
        const int nig = WGM * nN, gid = wgid / nig, fm = gid * WGM, gsz = (nM - fm) < WGM ? (nM - fm) : WGM;
        u.pm = fm + ((wgid % nig) % gsz); u.pn = (wgid % nig) / gsz; return true;
    }
    __device__ __forceinline__ void a_ready(const Unit&) const {}
    __device__ __forceinline__ void done(const Unit&) const {}
};

__device__ __forceinline__ unsigned cvt_pk_bf16(float lo, float hi) { unsigned r; asm volatile("v_cvt_pk_bf16_f32 %0, %1, %2" : "=v"(r) : "v"(lo), "v"(hi)); return r; }

constexpr float EPI_EPS = 1e-6f;
__device__ __forceinline__ void epi_bar() { asm volatile("s_waitcnt lgkmcnt(0)" ::: "memory"); __builtin_amdgcn_s_barrier(); asm volatile("" ::: "memory"); }
__device__ __forceinline__ void epi_rstd_table(const float* ssq, int fm, PG8_LAS float* RS, int t) {
    f32x4 v[4][4];
#pragma unroll
    for (int q = 0; q < 4; ++q) { const f32x4* p = (const f32x4*)(ssq + (size_t)(fm * BM + t + 512 * q) * 16); v[q][0] = p[0]; v[q][1] = p[1]; v[q][2] = p[2]; v[q][3] = p[3]; }
    asm volatile("" :: "v"(v[0][0]), "v"(v[0][1]), "v"(v[0][2]), "v"(v[0][3]), "v"(v[1][0]), "v"(v[1][1]), "v"(v[1][2]), "v"(v[1][3]),
                    "v"(v[2][0]), "v"(v[2][1]), "v"(v[2][2]), "v"(v[2][3]), "v"(v[3][0]), "v"(v[3][1]), "v"(v[3][2]), "v"(v[3][3]) : "memory");
#pragma unroll
    for (int q = 0; q < 4; ++q) { const int r = t + 512 * q; const f32x4 a = v[q][0], b = v[q][1], c = v[q][2], d = v[q][3];
        const float sm = ((a[0] + a[1]) + (a[2] + a[3])) + ((b[0] + b[1]) + (b[2] + b[3])) + ((c[0] + c[1]) + (c[2] + c[3])) + ((d[0] + d[1]) + (d[2] + d[3]));
        RS[r] = 1.0f / sqrtf(sm * (1.0f / 4096.0f) + EPI_EPS); }
    epi_bar();
}
#if GEMM_MFMA32
struct EpiBf16N {
    static constexpr bool PERM = true, AFTER_DRAIN = false;
    bf16_t* O; int ldc; int fm; PG8_LAS unsigned char* xl;
    __device__ __forceinline__ void operator()(const f32x16 (&acc)[2][2][2], const Unit& u, int wr, int wc, int fr, int fq) const {
        const PG8_LAS float* RS = (const PG8_LAS float*)xl + (u.pm - fm) * BM;
        const int row0 = u.pm * BM + wr * 64 + fr, col0 = u.pn * BM + wc * 32 + 16 * fq;
#pragma unroll
        for (int ai = 0; ai < 2; ++ai)
#pragma unroll
            for (int mt = 0; mt < 2; ++mt) { bf16_t* rowp = O + (size_t)(row0 + ai * HALF + mt * 32) * ldc + col0; const float rs = RS[ai * HALF + wr * 64 + mt * 32 + fr];
#pragma unroll
                for (int bj = 0; bj < 2; ++bj) { const f32x16 v = acc[ai][bj][mt] * rs;
                    u32x4 w0, w1; w0.x = cvt_pk_bf16(v[0], v[1]); w0.y = cvt_pk_bf16(v[2], v[3]); w0.z = cvt_pk_bf16(v[4], v[5]); w0.w = cvt_pk_bf16(v[6], v[7]);
                    w1.x = cvt_pk_bf16(v[8], v[9]); w1.y = cvt_pk_bf16(v[10], v[11]); w1.z = cvt_pk_bf16(v[12], v[13]); w1.w = cvt_pk_bf16(v[14], v[15]);
                    *(u32x4*)(rowp + bj * HALF) = w0; *(u32x4*)(rowp + bj * HALF + 8) = w1; } }
    }
};
struct EpiSwiGLUN {
    static constexpr bool PERM = true, AFTER_DRAIN = false;
    bf16_t* O; int ldc; int fm; PG8_LAS unsigned char* xl;
    __device__ __forceinline__ void operator()(const f32x16 (&acc)[2][2][2], const Unit& u, int wr, int wc, int fr, int fq) const {
        const PG8_LAS float* RS = (const PG8_LAS float*)xl + (u.pm - fm) * BM;
        const int row0 = u.pm * BM + wr * 64 + fr, col0 = u.pn * HALF + wc * 32 + 16 * fq;
#pragma unroll
        for (int ai = 0; ai < 2; ++ai)
#pragma unroll
            for (int mt = 0; mt < 2; ++mt) { bf16_t* rowp = O + (size_t)(row0 + ai * HALF + mt * 32) * ldc + col0; const float rs = RS[ai * HALF + wr * 64 + mt * 32 + fr];
                float r[16];
#pragma unroll
                for (int j = 0; j < 16; ++j) { const float g = acc[ai][0][mt][j] * rs, up = acc[ai][1][mt][j] * rs; r[j] = g * __builtin_amdgcn_rcpf(1.0f + __expf(-g)) * up; }
                u32x4 w0, w1; w0.x = cvt_pk_bf16(r[0], r[1]); w0.y = cvt_pk_bf16(r[2], r[3]); w0.z = cvt_pk_bf16(r[4], r[5]); w0.w = cvt_pk_bf16(r[6], r[7]);
                w1.x = cvt_pk_bf16(r[8], r[9]); w1.y = cvt_pk_bf16(r[10], r[11]); w1.z = cvt_pk_bf16(r[12], r[13]); w1.w = cvt_pk_bf16(r[14], r[15]);
                *(u32x4*)rowp = w0; *(u32x4*)(rowp + 8) = w1; }
    }
};
struct EpiResidB {
    static constexpr bool PERM = true, AFTER_DRAIN = false;
    const bf16_t* res; bf16_t* X; int ldc; float* ssq_out; PG8_LAS unsigned char* xl;
    __device__ __forceinline__ void operator()(const f32x16 (&acc)[2][2][2], const Unit& u, int wr, int wc, int fr, int fq) const {
        PG8_LAS float* SSQL = (PG8_LAS float*)(xl + 8192);
        const int row0 = u.pm * BM + wr * 64 + fr, col0 = u.pn * BM + wc * 32 + 16 * fq;
#pragma unroll
        for (int ai = 0; ai < 2; ++ai) { u32x4 rw[2][2][2];
#pragma unroll
            for (int mt = 0; mt < 2; ++mt)
#pragma unroll
                for (int bj = 0; bj < 2; ++bj) { const bf16_t* rp = res + (size_t)(row0 + ai * HALF + mt * 32) * ldc + col0 + bj * HALF; rw[mt][bj][0] = *(const u32x4*)rp; rw[mt][bj][1] = *(const u32x4*)(rp + 8); }
#pragma unroll
            for (int mt = 0; mt < 2; ++mt) { float sq = 0.f;
#pragma unroll
                for (int bj = 0; bj < 2; ++bj) { const f32x16 a = acc[ai][bj][mt]; float v[16];
#pragma unroll
                    for (int h = 0; h < 2; ++h) { const u32x4 rr = rw[mt][bj][h];
                        v[8 * h + 0] = __uint_as_float(rr.x << 16) + a[8 * h + 0]; v[8 * h + 1] = __uint_as_float(rr.x & 0xffff0000u) + a[8 * h + 1];
                        v[8 * h + 2] = __uint_as_float(rr.y << 16) + a[8 * h + 2]; v[8 * h + 3] = __uint_as_float(rr.y & 0xffff0000u) + a[8 * h + 3];
                        v[8 * h + 4] = __uint_as_float(rr.z << 16) + a[8 * h + 4]; v[8 * h + 5] = __uint_as_float(rr.z & 0xffff0000u) + a[8 * h + 5];
                        v[8 * h + 6] = __uint_as_float(rr.w << 16) + a[8 * h + 6]; v[8 * h + 7] = __uint_as_float(rr.w & 0xffff0000u) + a[8 * h + 7]; }
#pragma unroll
                    for (int j = 0; j < 16; j += 4) sq += (v[j] * v[j] + v[j + 1] * v[j + 1]) + (v[j + 2] * v[j + 2] + v[j + 3] * v[j + 3]);
                    u32x4 w0, w1; w0.x = cvt_pk_bf16(v[0], v[1]); w0.y = cvt_pk_bf16(v[2], v[3]); w0.z = cvt_pk_bf16(v[4], v[5]); w0.w = cvt_pk_bf16(v[6], v[7]);
                    w1.x = cvt_pk_bf16(v[8], v[9]); w1.y = cvt_pk_bf16(v[10], v[11]); w1.z = cvt_pk_bf16(v[12], v[13]); w1.w = cvt_pk_bf16(v[14], v[15]);
                    bf16_t* xp = X + (size_t)(row0 + ai * HALF + mt * 32) * ldc + col0 + bj * HALF; *(u32x4*)xp = w0; *(u32x4*)(xp + 8) = w1; }
                sq += __shfl_xor(sq, 32);
                if (fq == 0) SSQL[(ai * HALF + wr * 64 + mt * 32 + fr) * 4 + wc] = sq; } }
        epi_bar();
        const int t = (wr * 4 + wc) * 64 + fq * 32 + fr;
        if (t < 256) { const f32x4 p = *(const PG8_LAS f32x4*)(SSQL + t * 4); ssq_out[(size_t)(u.pm * BM + t) * 16 + u.pn] = (p[0] + p[1]) + (p[2] + p[3]); }
    }
};
#else
struct EpiBf16N {
    static constexpr bool PERM = true, AFTER_DRAIN = false;
    bf16_t* O; int ldc; int fm; PG8_LAS unsigned char* xl;
    __device__ __forceinline__ void operator()(const f32x4 (&acc)[2][2][4][2], const Unit& u, int wr, int wc, int fr, int fq) const {
        const PG8_LAS float* RS = (const PG8_LAS float*)xl + (u.pm - fm) * BM;
        const int row0 = u.pm * BM + wr * 64 + fr, col0 = u.pn * BM + wc * 32 + 8 * fq;
#pragma unroll
        for (int ai = 0; ai < 2; ++ai)
#pragma unroll
            for (int m = 0; m < 4; ++m) { bf16_t* rowp = O + (size_t)(row0 + ai * HALF + m * 16) * ldc + col0; const float rs = RS[ai * HALF + wr * 64 + m * 16 + fr];
#pragma unroll
                for (int bj = 0; bj < 2; ++bj) { const f32x4 v0 = acc[ai][bj][m][0] * rs, v1 = acc[ai][bj][m][1] * rs;
                    u32x4 w; w.x = cvt_pk_bf16(v0[0], v0[1]); w.y = cvt_pk_bf16(v0[2], v0[3]); w.z = cvt_pk_bf16(v1[0], v1[1]); w.w = cvt_pk_bf16(v1[2], v1[3]);
                    *(u32x4*)(rowp + bj * HALF) = w; } }
    }
};
struct EpiSwiGLUN {
    static constexpr bool PERM = true, AFTER_DRAIN = false;
    bf16_t* O; int ldc; int fm; PG8_LAS unsigned char* xl;
    __device__ __forceinline__ void operator()(const f32x4 (&acc)[2][2][4][2], const Unit& u, int wr, int wc, int fr, int fq) const {
        const PG8_LAS float* RS = (const PG8_LAS float*)xl + (u.pm - fm) * BM;
        const int row0 = u.pm * BM + wr * 64 + fr, col0 = u.pn * HALF + wc * 32 + 8 * fq;
#pragma unroll
        for (int ai = 0; ai < 2; ++ai)
#pragma unroll
            for (int m = 0; m < 4; ++m) { bf16_t* rowp = O + (size_t)(row0 + ai * HALF + m * 16) * ldc + col0; const float rs = RS[ai * HALF + wr * 64 + m * 16 + fr];
                float r[8];
#pragma unroll
                for (int n = 0; n < 2; ++n)
#pragma unroll
                    for (int j = 0; j < 4; ++j) { const float g = acc[ai][0][m][n][j] * rs, up = acc[ai][1][m][n][j] * rs;
                        r[n * 4 + j] = g * __builtin_amdgcn_rcpf(1.0f + __expf(-g)) * up; }
                u32x4 w; w.x = cvt_pk_bf16(r[0], r[1]); w.y = cvt_pk_bf16(r[2], r[3]); w.z = cvt_pk_bf16(r[4], r[5]); w.w = cvt_pk_bf16(r[6], r[7]);
                *(u32x4*)rowp = w; }
    }
};
struct EpiResidB {
    static constexpr bool PERM = true, AFTER_DRAIN = false;
    const bf16_t* res; bf16_t* X; int ldc; float* ssq_out; PG8_LAS unsigned char* xl;
    __device__ __forceinline__ void operator()(const f32x4 (&acc)[2][2][4][2], const Unit& u, int wr, int wc, int fr, int fq) const {
        PG8_LAS float* SSQL = (PG8_LAS float*)(xl + 8192);
        const int row0 = u.pm * BM + wr * 64 + fr, col0 = u.pn * BM + wc * 32 + 8 * fq;
#pragma unroll
        for (int ai = 0; ai < 2; ++ai) { u32x4 rw[4][2];
#pragma unroll
            for (int m = 0; m < 4; ++m)
#pragma unroll
                for (int bj = 0; bj < 2; ++bj) rw[m][bj] = *(const u32x4*)(res + (size_t)(row0 + ai * HALF + m * 16) * ldc + col0 + bj * HALF);
#pragma unroll
            for (int m = 0; m < 4; ++m) { float sq = 0.f;
#pragma unroll
                for (int bj = 0; bj < 2; ++bj) { const u32x4 rr = rw[m][bj]; const f32x4 a0 = acc[ai][bj][m][0], a1 = acc[ai][bj][m][1];
                    float v[8];
                    v[0] = __uint_as_float(rr.x << 16) + a0[0]; v[1] = __uint_as_float(rr.x & 0xffff0000u) + a0[1]; v[2] = __uint_as_float(rr.y << 16) + a0[2]; v[3] = __uint_as_float(rr.y & 0xffff0000u) + a0[3];
                    v[4] = __uint_as_float(rr.z << 16) + a1[0]; v[5] = __uint_as_float(rr.z & 0xffff0000u) + a1[1]; v[6] = __uint_as_float(rr.w << 16) + a1[2]; v[7] = __uint_as_float(rr.w & 0xffff0000u) + a1[3];
                    sq += ((v[0] * v[0] + v[1] * v[1]) + (v[2] * v[2] + v[3] * v[3])) + ((v[4] * v[4] + v[5] * v[5]) + (v[6] * v[6] + v[7] * v[7]));
                    u32x4 w; w.x = cvt_pk_bf16(v[0], v[1]); w.y = cvt_pk_bf16(v[2], v[3]); w.z = cvt_pk_bf16(v[4], v[5]); w.w = cvt_pk_bf16(v[6], v[7]);
                    *(u32x4*)(X + (size_t)(row0 + ai * HALF + m * 16) * ldc + col0 + bj * HALF) = w; }
                sq += __shfl_xor(sq, 16); sq += __shfl_xor(sq, 32);
                if (fq == 0) SSQL[(ai * HALF + wr * 64 + m * 16 + fr) * 4 + wc] = sq; } }
        epi_bar();
        const int t = (wr * 4 + wc) * 64 + fq * 16 + fr;
        if (t < 256) { const f32x4 p = *(const PG8_LAS f32x4*)(SSQL + t * 4); ssq_out[(size_t)(u.pm * BM + t) * 16 + u.pn] = (p[0] + p[1]) + (p[2] + p[3]); }
    }
};
#endif
template <class Epi, class Sched, bool ALIGN_EPI = false, bool SP2 = false>
__device__ __forceinline__ void gemm_phase(PG8_LAS unsigned char* lds, const Gemm g, const Sched& S, const Epi& E) {
    int tid_ = threadIdx.x; asm volatile("" : "+v"(tid_));
#if GEMM_MFMA32
    const int tid = tid_, wid = __builtin_amdgcn_readfirstlane(tid >> 6), lane = tid & 63, wr = wid >> 2, wc = wid & 3, fr = lane & 31, fq = lane >> 5;
#else
    const int tid = tid_, wid = __builtin_amdgcn_readfirstlane(tid >> 6), lane = tid & 63, wr = wid >> 2, wc = wid & 3, fr = lane & 15, fq = lane >> 4;
#endif
    const int K = g.K, nt = K / BK;
    unsigned voffA[2], voffB[2];
#pragma unroll
    for (int i = 0; i < 2; ++i) { int R, C; stage_rc(tid * 16 + i * 8192, R, C); const int Rb = Epi::PERM ? ((R & ~31) + (GEMM_MFMA32 ? perm32x(R & 31) : perm32(R & 31))) : R;
        voffA[i] = (unsigned)(R * K + C) * 2u; voffB[i] = (unsigned)(Rb * K + C) * 2u; }
    const size_t kstep = (size_t)(BK * 2);
    const size_t hstep = (size_t)HALF * K * 2;
    const size_t tstep = 2 * hstep;
    const unsigned ldsw = (unsigned)wid * 1024u;
#if GEMM_MFMA32
    const int aE = lds_byte(wr * 64 + fr, fq * 8), aO = lds_byte(wr * 64 + fr, 16 + fq * 8), bE = lds_byte(wc * 32 + fr, fq * 8), bO = lds_byte(wc * 32 + fr, 16 + fq * 8);
#else
    const int aoff = lds_byte(wr * 64 + fr, fq * 8), boff = lds_byte(wc * 32 + fr, fq * 8);
#endif
#define PG8_SA(b, h) (((b) * 2 + (h)) * HTB)
#define PG8_SB(b, h) ((4 + (b) * 2 + (h)) * HTB)
#define PG8_STAGE(bufoff, gbase, voff) do { _Pragma("unroll") for (int _i = 0; _i < 2; ++_i) \
        __builtin_amdgcn_global_load_lds((const unsigned*)((const char*)(gbase) + (voff)[_i]), (PG8_LAS unsigned*)(lds + (bufoff) + ldsw + _i * 8192), 16, 0, 0); } while (0)
#if GEMM_MFMA32
#define PG8_LDA(dst, b, h) do { _Pragma("unroll") for (int m = 0; m < 2; ++m) _Pragma("unroll") for (int k = 0; k < 4; ++k) dst[m][k] = *(const PG8_LAS bf16x8*)(lds + PG8_SA(b, h) + ((k & 1) ? aO : aE) + (k >> 1) * 1024 + m * 4096); } while (0)
#define PG8_LDB(dst, b, h) do { _Pragma("unroll") for (int k = 0; k < 4; ++k) dst[k] = *(const PG8_LAS bf16x8*)(lds + PG8_SB(b, h) + ((k & 1) ? bO : bE) + (k >> 1) * 1024); } while (0)
#define PG8_MMA(ai, bj, At, Bt) do { __builtin_amdgcn_s_setprio(1); _Pragma("unroll") for (int k = 0; k < 4; ++k) _Pragma("unroll") for (int m = 0; m < 2; ++m) \
        acc[ai][bj][m] = __builtin_amdgcn_mfma_f32_32x32x16_bf16(Bt[k], At[m][k], acc[ai][bj][m], 0, 0, 0); __builtin_amdgcn_s_setprio(0); } while (0)
#define PG8_ZERO_ACC() do { _Pragma("unroll") for (int a = 0; a < 2; ++a) _Pragma("unroll") for (int b = 0; b < 2; ++b) _Pragma("unroll") for (int m = 0; m < 2; ++m) acc[a][b][m] = f32x16{}; } while (0)
#define PG8_MMA2(ai, At, Bx, By) do { __builtin_amdgcn_s_setprio(1); _Pragma("unroll") for (int k = 0; k < 4; ++k) _Pragma("unroll") for (int m = 0; m < 2; ++m) { \
        acc[ai][0][m] = __builtin_amdgcn_mfma_f32_32x32x16_bf16(Bx[k], At[m][k], acc[ai][0][m], 0, 0, 0); \
        acc[ai][1][m] = __builtin_amdgcn_mfma_f32_32x32x16_bf16(By[k], At[m][k], acc[ai][1][m], 0, 0, 0); } __builtin_amdgcn_s_setprio(0); } while (0)
#else
#define PG8_MMA2(ai, At, Bx, By) do { PG8_MMA(ai, 0, At, Bx); PG8_MMA(ai, 1, At, By); } while (0)
#define PG8_LDA(dst, b, h) do { _Pragma("unroll") for (int m = 0; m < 4; ++m) _Pragma("unroll") for (int k = 0; k < 2; ++k) dst[m][k] = *(const PG8_LAS bf16x8*)(lds + PG8_SA(b, h) + aoff + m * 2048 + k * 1024); } while (0)
#define PG8_LDB(dst, b, h) do { _Pragma("unroll") for (int n = 0; n < 2; ++n) _Pragma("unroll") for (int k = 0; k < 2; ++k) dst[n][k] = *(const PG8_LAS bf16x8*)(lds + PG8_SB(b, h) + boff + n * 2048 + k * 1024); } while (0)
#define PG8_MMA(ai, bj, At, Bt) do { __builtin_amdgcn_s_setprio(1); _Pragma("unroll") for (int m = 0; m < 4; ++m) _Pragma("unroll") for (int n = 0; n < 2; ++n) _Pragma("unroll") for (int k = 0; k < 2; ++k) \
        acc[ai][bj][m][n] = __builtin_amdgcn_mfma_f32_16x16x32_bf16(Bt[n][k], At[m][k], acc[ai][bj][m][n], 0, 0, 0); __builtin_amdgcn_s_setprio(0); } while (0)
#define PG8_ZERO_ACC() do { _Pragma("unroll") for (int a = 0; a < 2; ++a) _Pragma("unroll") for (int b = 0; b < 2; ++b) _Pragma("unroll") for (int m = 0; m < 4; ++m) _Pragma("unroll") for (int n = 0; n < 2; ++n) acc[a][b][m][n] = (f32x4){0.f, 0.f, 0.f, 0.f}; } while (0)
#endif
#define PG8_WAIT_V(n) asm volatile("s_waitcnt vmcnt(" #n ")" ::: "memory")
#define PG8_WAIT_L(n) asm volatile("s_waitcnt lgkmcnt(" #n ")" ::: "memory")
#define PG8_BAR __builtin_amdgcn_s_barrier()
#define PG8_SCHED __builtin_amdgcn_sched_barrier(0)
    Unit cur, nxt; int ui = 0;
    if (!S.next(0, cur)) return;
#if GEMM_MFMA32
    f32x16 acc[2][2][2]; bf16x8 At[2][4], B0[4], B1[4];
#else
    f32x4 acc[2][2][4][2]; bf16x8 At[4][2], B0[2][2], B1[2][2];
#endif
    PG8_ZERO_ACC();
    const char* cA = (const char*)g.A + (size_t)cur.pm * tstep; const char* cB = (const char*)g.Bt + (size_t)cur.pn * tstep;
    S.a_ready(cur);
    if constexpr (SP2) {
        PG8_STAGE(PG8_SB(0, 0), cB, voffB); PG8_STAGE(PG8_SB(0, 1), cB + hstep, voffB); PG8_STAGE(PG8_SA(0, 0), cA, voffA); PG8_STAGE(PG8_SA(0, 1), cA + hstep, voffA);
        if (wr == 1) PG8_BAR;
        PG8_WAIT_V(2); PG8_BAR;
        PG8_STAGE(PG8_SB(1, 0), cB + kstep, voffB); PG8_STAGE(PG8_SA(1, 0), cA + kstep, voffA); PG8_STAGE(PG8_SB(1, 1), cB + hstep + kstep, voffB);
        PG8_WAIT_V(6); PG8_BAR;
    } else {
        PG8_STAGE(PG8_SB(0, 0), cB, voffB); PG8_STAGE(PG8_SA(0, 0), cA, voffA); PG8_STAGE(PG8_SB(0, 1), cB + hstep, voffB); PG8_STAGE(PG8_SA(0, 1), cA + hstep, voffA);
        if (wr == 1) PG8_BAR;
        PG8_WAIT_V(4); PG8_BAR;
        PG8_STAGE(PG8_SB(1, 0), cB + kstep, voffB); PG8_STAGE(PG8_SA(1, 0), cA + kstep, voffA); PG8_STAGE(PG8_SB(1, 1), cB + hstep + kstep, voffB);
        PG8_WAIT_V(6); PG8_BAR;
    }
    for (;;) {
        const bool has_next = S.next(ui + 1, nxt);
        const char* nA = has_next ? (const char*)g.A + (size_t)nxt.pm * tstep : cA; const char* nB = has_next ? (const char*)g.Bt + (size_t)nxt.pn * tstep : cB;
        for (int t = 0; t < nt; t += 2) {
            const bool last = (t == nt - 2);
            const char* a1 = cA + (size_t)(t + 1) * kstep;
            const char* a2 = last ? nA : cA + (size_t)(t + 2) * kstep; const char* b2 = last ? nB : cB + (size_t)(t + 2) * kstep;
            const char* a3 = a2 + kstep; const char* b3 = b2 + kstep;
            if (last && has_next) S.a_ready(nxt);
            if constexpr (SP2) {
            PG8_LDB(B0, 0, 0); PG8_LDB(B1, 0, 1); PG8_SCHED; PG8_LDA(At, 0, 0); PG8_STAGE(PG8_SA(1, 1), a1 + hstep, voffA);
            PG8_WAIT_V(8); PG8_WAIT_L(0); PG8_BAR; PG8_MMA2(0, At, B0, B1); PG8_BAR; PG8_SCHED;
            PG8_LDA(At, 0, 1); PG8_STAGE(PG8_SB(0, 0), b2, voffB); PG8_STAGE(PG8_SB(0, 1), b2 + hstep, voffB); PG8_STAGE(PG8_SA(0, 0), a2, voffA);
            PG8_WAIT_V(8); PG8_WAIT_L(0); PG8_BAR; PG8_MMA2(1, At, B0, B1); PG8_BAR; PG8_SCHED;
            PG8_LDB(B0, 1, 0); PG8_LDB(B1, 1, 1); PG8_SCHED; PG8_LDA(At, 1, 0); PG8_STAGE(PG8_SA(0, 1), a2 + hstep, voffA);
            PG8_WAIT_V(8); PG8_WAIT_L(0); PG8_BAR; PG8_MMA2(0, At, B0, B1); PG8_BAR; PG8_SCHED;
            PG8_LDA(At, 1, 1); PG8_STAGE(PG8_SB(1, 0), b3, voffB); PG8_STAGE(PG8_SB(1, 1), b3 + hstep, voffB); PG8_STAGE(PG8_SA(1, 0), a3, voffA);
            PG8_WAIT_V(8); PG8_WAIT_L(0); PG8_BAR; PG8_MMA2(1, At, B0, B1); PG8_BAR; PG8_SCHED;
            } else {
            PG8_LDB(B0, 0, 0); PG8_SCHED; PG8_LDA(At, 0, 0); PG8_STAGE(PG8_SA(1, 1), a1 + hstep, voffA);
            PG8_WAIT_L(8); PG8_BAR; PG8_WAIT_L(0); PG8_MMA(0, 0, At, B0); PG8_BAR; PG8_SCHED;
            PG8_LDB(B1, 0, 1); PG8_STAGE(PG8_SB(0, 0), b2, voffB);
            PG8_BAR; PG8_WAIT_L(0); PG8_MMA(0, 1, At, B1); PG8_BAR;
            PG8_LDA(At, 0, 1); PG8_STAGE(PG8_SA(0, 0), a2, voffA);
            PG8_BAR; PG8_WAIT_L(0); PG8_MMA(1, 0, At, B0); PG8_BAR; PG8_SCHED;
            PG8_STAGE(PG8_SB(0, 1), b2 + hstep, voffB);
            PG8_WAIT_V(6); PG8_BAR; PG8_MMA(1, 1, At, B1); PG8_BAR;
            PG8_LDB(B0, 1, 0); PG8_SCHED; PG8_LDA(At, 1, 0); PG8_STAGE(PG8_SA(0, 1), a2 + hstep, voffA);
            PG8_WAIT_L(8); PG8_BAR; PG8_WAIT_L(0); PG8_MMA(0, 0, At, B0); PG8_BAR; PG8_SCHED;
            PG8_LDB(B1, 1, 1); PG8_STAGE(PG8_SB(1, 0), b3, voffB);
            PG8_BAR; PG8_WAIT_L(0); PG8_MMA(0, 1, At, B1); PG8_BAR;
            PG8_LDA(At, 1, 1); PG8_STAGE(PG8_SA(1, 0), a3, voffA);
            PG8_BAR; PG8_WAIT_L(0); PG8_MMA(1, 0, At, B0); PG8_BAR; PG8_SCHED;
            PG8_STAGE(PG8_SB(1, 1), b3 + hstep, voffB);
            PG8_WAIT_V(6); PG8_BAR; PG8_MMA(1, 1, At, B1); PG8_BAR;
            }
        }
        if constexpr (ALIGN_EPI) { if (wr == 0) PG8_BAR; }
        if constexpr (!Epi::AFTER_DRAIN) { E(acc, cur, wr, wc, fr, fq); S.done(cur); }
        if (!has_next) break;
        PG8_ZERO_ACC();
        cur = nxt; cA = nA; cB = nB; ++ui;
        if constexpr (ALIGN_EPI) { if (wr == 1) PG8_BAR; }
    }
    PG8_WAIT_V(0);
    if constexpr (!ALIGN_EPI) { if (wr == 0) PG8_BAR; }
    PG8_BAR;
    if constexpr (Epi::AFTER_DRAIN) { E.fused(acc, cur, wr, wc, fr, fq, lds, wid, lane); S.done(cur); }
#undef PG8_SA
#undef PG8_SB
#undef PG8_STAGE
#undef PG8_LDA
#undef PG8_LDB
#undef PG8_MMA
#undef PG8_MMA2
#undef PG8_ZERO_ACC
#undef PG8_WAIT_V
#undef PG8_WAIT_L
#undef PG8_BAR
#undef PG8_SCHED
}
}

#define XB_TMO      128
#define XB_XCNT(j)  (256  + 64 * (j))
#define XB_XSUB(j)  (1280 + 64 * (j))
#define XB_XGEN(j)  (2304 + 64 * (j))
#define XB_TOP      3328
#define XB_TOPGEN   3392
#define XCD_BAR_WORDS 3456
#define XB_SPIN_CAP (1u << 18)

__device__ __forceinline__ unsigned xb_ld(unsigned* p)              { return __hip_atomic_load(p, __ATOMIC_RELAXED, __HIP_MEMORY_SCOPE_AGENT); }
__device__ __forceinline__ unsigned xb_add(unsigned* p, unsigned v) { return __hip_atomic_fetch_add(p, v, __ATOMIC_RELAXED, __HIP_MEMORY_SCOPE_AGENT); }
__device__ __forceinline__ unsigned xb_xcc_id() { return (unsigned)__builtin_amdgcn_s_getreg((3 << 11) | 20) & 0xFu; }
#define XB_SPIN(cond, bar) do { unsigned _sp = 0; while (cond) { __builtin_amdgcn_s_sleep(1); \
    if ((++_sp & 255u) == 0u) { if (xb_ld(&(bar)[XB_TMO])) break; if (_sp > XB_SPIN_CAP) { atomicAdd(&(bar)[XB_TMO], 1u); break; } } } } while (0)

struct XcdBarrier {
    unsigned* bar; unsigned x;
    volatile LAS unsigned* st;
};

__device__ __forceinline__ XcdBarrier xcd_barrier_post(unsigned* bar, volatile LAS unsigned* st) {
    XcdBarrier b; b.bar = bar; b.x = xb_xcc_id(); b.st = st;
    if (threadIdx.x == 0) (void)xb_add(&bar[XB_XCNT(b.x)], 1u);
    return b;
}
__device__ __forceinline__ void xcd_barrier_complete(unsigned* bar, unsigned x, unsigned& nloc, unsigned& nx) {
    const unsigned G = gridDim.x * gridDim.y * gridDim.z;
    unsigned sum, cnt, mine, sp = 0u;
    for (;;) {
        sum = 0u; cnt = 0u; mine = 0u;
#pragma unroll
        for (unsigned j = 0; j < 16; ++j) { const unsigned c = xb_ld(&bar[XB_XCNT(j)]); sum += c; cnt += (c > 0u) ? 1u : 0u; mine = (j == x) ? c : mine; }
        if (sum == G) break;
        __builtin_amdgcn_s_sleep(1);
        if ((++sp & 255u) == 0u) { if (xb_ld(&bar[XB_TMO])) break; if (sp > XB_SPIN_CAP) { atomicAdd(&bar[XB_TMO], 1u); break; } }
    }
    nloc = mine > 0u ? mine : 1u; nx = cnt > 0u ? cnt : 1u;
}

__device__ __forceinline__ void xcd_barrier(const XcdBarrier& b) {
    asm volatile("s_waitcnt vmcnt(0)" ::: "memory");
    __syncthreads();
    if (threadIdx.x == 0) {
        unsigned* bar = b.bar;
        __builtin_amdgcn_s_waitcnt(0);
        unsigned nloc = b.st[0], nx = b.st[1];
        if (nloc == 0u) { xcd_barrier_complete(bar, b.x, nloc, nx); b.st[0] = nloc; b.st[1] = nx; }
        const unsigned old = xb_add(&bar[XB_XSUB(b.x)], 1u);
        const unsigned gen = old / nloc;
        if (old + 1u == (gen + 1u) * nloc) {
            __builtin_amdgcn_fence(__ATOMIC_RELEASE, "agent");
            asm volatile("s_waitcnt vmcnt(0)" ::: "memory");
            const unsigned og = xb_add(&bar[XB_TOP], 1u);
            const unsigned tg = og / nx;
            if (og + 1u == (tg + 1u) * nx) xb_add(&bar[XB_TOPGEN], 1u);
            else XB_SPIN(xb_ld(&bar[XB_TOPGEN]) == tg, bar);
            __builtin_amdgcn_fence(__ATOMIC_ACQUIRE, "agent");
            xb_add(&bar[XB_XGEN(b.x)], 1u);
            asm volatile("s_waitcnt vmcnt(0)" ::: "memory");
        } else {
            XB_SPIN(xb_ld(&bar[XB_XGEN(b.x)]) == gen, bar);
            __builtin_amdgcn_fence(__ATOMIC_ACQUIRE, "agent");
            asm volatile("s_waitcnt vmcnt(0)" ::: "memory");
        }
    }
    __syncthreads();
}


constexpr int NWAVES = 8, NTHR = 512;
constexpr int SEQ = 4096, DM = 4096, MTOK = 8192, NP = 12032, INW = 11800, DFF = 11008, NGU = 22016;
constexpr int C_RQ = 0, C_RK = 1024, C_RV = 2048, C_RG = 3072, C_MQ = 4096, C_MK = 5120, C_MV = 6144, C_LX = 7168, C_LG = 8192, C_NQ = 9216,
              C_NKC = 10240, C_NVC = 10496, C_NKS = 10752, C_NVS = 11008, C_NKW = 11264, C_NVW = 11520, C_NGATE = 11776;
constexpr float RMS_EPS = 1e-6f;

constexpr size_t MiB = 1u << 20;
constexpr size_t WS_CTL = 0, CTL_ZERO_BYTES = 1 * MiB;
constexpr size_t WS_ROPEC = 1 * MiB, WS_ROPES = 2 * MiB;
constexpr size_t WS_SMALL = 3 * MiB;
constexpr size_t SM_KMEAN = WS_SMALL;
constexpr size_t SM_LRUCA = WS_SMALL + 256 * 1024;
constexpr size_t SM_LRUCH = WS_SMALL + 512 * 1024;
constexpr size_t SM_CB1P  = WS_SMALL + 768 * 1024;
constexpr size_t SM_CW2T  = WS_SMALL + 1024 * 1024;
constexpr size_t SM_WAT   = WS_SMALL + 2 * MiB;
constexpr size_t SM_WXT   = WS_SMALL + 3 * MiB;
constexpr size_t SM_KC    = WS_SMALL + 4 * MiB;
constexpr size_t SM_VC    = WS_SMALL + 5 * MiB;
constexpr size_t SM_SSQA  = WS_SMALL + 6 * MiB;
constexpr size_t SM_SSQB  = WS_SMALL + 7 * MiB;
constexpr size_t WS_CW1T  = 11 * MiB;
constexpr size_t WS_WIN   = 19 * MiB;
constexpr size_t WS_WOUT  = WS_WIN + 188 * MiB;
constexpr size_t WS_WGU   = WS_WOUT + 64 * MiB;
constexpr size_t WS_WDN   = WS_WGU + 344 * MiB;
constexpr size_t WS_H     = WS_WDN + 172 * MiB;
constexpr size_t WS_PROJ  = WS_H + 64 * MiB;
constexpr size_t WS_Y     = WS_PROJ + 188 * MiB;
constexpr size_t WS_XS0   = WS_Y + 64 * MiB;
constexpr size_t WS_XS1   = WS_XS0 + 64 * MiB;
constexpr size_t WS_XS2   = WS_XS1 + 64 * MiB;
constexpr size_t WS_XB    = WS_XS0 + 128 * MiB;
constexpr size_t WS_U     = WS_XB + 128 * MiB;
constexpr size_t WS_RETKV = WS_U + 172 * MiB;
constexpr size_t WS_LRUH  = WS_RETKV + 32 * MiB;
constexpr size_t WS_LRUP  = WS_LRUH + 32 * MiB;
constexpr size_t WS_NSAACC = WS_LRUP + 32 * MiB;
constexpr size_t WS_END   = WS_NSAACC + 32 * MiB;
constexpr int CW_BAR = 4096;

constexpr int PH_BYTES = 147456;
constexpr int MISC_OFF = PH_BYTES;
constexpr int LDS_BYTES = PH_BYTES + 1024;

#define LDS_WAIT() asm volatile("s_waitcnt lgkmcnt(0)" ::: "memory")
#define VM_WAIT() asm volatile("s_waitcnt vmcnt(0)" ::: "memory")
__device__ __forceinline__ float bf2f(unsigned short b) { return __uint_as_float(((unsigned)b) << 16); }
__device__ __forceinline__ float bflo(unsigned w) { return __uint_as_float(w << 16); }
__device__ __forceinline__ float bfhi(unsigned w) { return __uint_as_float(w & 0xffff0000u); }
__device__ __forceinline__ unsigned f2bf(float f) { unsigned u = __float_as_uint(f); return (u + 0x7fffu + ((u >> 16) & 1u)) >> 16; }
__device__ __forceinline__ unsigned pk2(float lo, float hi) { return f2bf(lo) | (f2bf(hi) << 16); }
__device__ __forceinline__ unsigned cvtpk(float lo, float hi) { unsigned r; asm volatile("v_cvt_pk_bf16_f32 %0, %1, %2" : "=v"(r) : "v"(lo), "v"(hi)); return r; }
__device__ __forceinline__ float wave_sum(float v) {
#pragma unroll
    for (int o = 1; o < 64; o <<= 1) v += __shfl_xor(v, o);
    return v;
}
__device__ __forceinline__ float sigmoidf_(float x) { return __builtin_amdgcn_rcpf(1.0f + __expf(-x)); }
__device__ __forceinline__ float gelu_tanh(float x) { const float z = 0.7978845608028654f * (x + 0.044715f * x * x * x); const float e = __expf(2.0f * z); const float t = 1.0f - 2.0f * __builtin_amdgcn_rcpf(e + 1.0f); return 0.5f * x * (1.0f + t); }
__device__ __forceinline__ void unpack8(const u32x4 w, float (&f)[8]) { f[0] = bflo(w.x); f[1] = bfhi(w.x); f[2] = bflo(w.y); f[3] = bfhi(w.y); f[4] = bflo(w.z); f[5] = bfhi(w.z); f[6] = bflo(w.w); f[7] = bfhi(w.w); }

struct Frame {
    ldsp lds;
    int tid, lane, wave, G, bid;
    unsigned char* ws;
};
#define KAS __attribute__((address_space(4)))
#define OPQ_S(x) asm volatile("" : "+s"(x))
#define OPQ_V(x) asm volatile("" : "+v"(x))
__device__ __forceinline__ int otid() { int t = threadIdx.x; OPQ_V(t); return t; }
#define GAS __attribute__((address_space(1)))
__device__ __forceinline__ unsigned char* ows() { unsigned long long w = ((const unsigned long long KAS*)__builtin_amdgcn_kernarg_segment_ptr())[24]; OPQ_S(w);
    return (unsigned char*)(GAS unsigned char*)w; }
__device__ __forceinline__ const float* inp(int i) { return (const float*)(const GAS float*)((const unsigned long long KAS*)__builtin_amdgcn_kernarg_segment_ptr())[i]; }
__device__ __forceinline__ Frame mk_frame(ldsp lds) {
    Frame F; F.lds = lds; F.tid = otid(); F.lane = F.tid & 63; F.wave = __builtin_amdgcn_readfirstlane(F.tid >> 6); F.G = gridDim.x; F.bid = blockIdx.x;
    F.ws = ows(); return F;
}
#ifdef USE_NOINLINE
#define NOINL __attribute__((noinline))
#else
#define NOINL __forceinline__
#endif

__device__ __forceinline__ void tr_load(f32x4 (&v)[16], const float* __restrict__ W, int N, int k0, int n0, int lane) {
    const int rr = lane >> 4, c4 = (lane & 15) * 4; const bool ok = (n0 + c4) < N;
    const float* src = W + (size_t)(k0 + rr) * N + n0 + c4;
#pragma unroll
    for (int i = 0; i < 16; ++i) v[i] = ok ? *(const f32x4*)(src + (size_t)(4 * i) * N) : (f32x4){0.f, 0.f, 0.f, 0.f};
}
__device__ __forceinline__ void tr_emit(const f32x4 (&v)[16], int K, bf16_t* __restrict__ WT, int k0, int drow0, LAS float* scr, int lane, const float* __restrict__ kscale) {
    const int rr = lane >> 4, c4 = (lane & 15) * 4;
#pragma unroll
    for (int i = 0; i < 16; ++i) { const float kq = kscale ? kscale[k0 + rr + 4 * i] : 1.0f;
        LAS float* d = scr + (rr + 4 * i) * 65 + c4; d[0] = v[i].x * kq; d[1] = v[i].y * kq; d[2] = v[i].z * kq; d[3] = v[i].w * kq; }
    LDS_WAIT(); asm volatile("" ::: "memory");
    const int c = lane & 7;
#pragma unroll
    for (int j = 0; j < 8; ++j) { const int nn = (lane >> 3) + 8 * j; const LAS float* s = scr + (8 * c) * 65 + nn;
        u32x4 o; o.x = cvtpk(s[0 * 65], s[1 * 65]); o.y = cvtpk(s[2 * 65], s[3 * 65]); o.z = cvtpk(s[4 * 65], s[5 * 65]); o.w = cvtpk(s[6 * 65], s[7 * 65]);
        *(u32x4*)(WT + (size_t)(drow0 + nn) * K + k0 + 8 * c) = o; }
    LDS_WAIT(); asm volatile("" ::: "memory");
}
struct TrDesc { const float* W; bf16_t* WT; const float* ks; int K, N, nnb, mode; };
__device__ __forceinline__ void tr_matrix_rt(const float* W, int K, int N, int nnb, bf16_t* WT, LAS float* scr, int gw, int NGW, int lane, const float* kscale, int MODE, int it_lo = 0, int it_hi = 0x7fffffff) {
    const int nkb = K / 64, tot = nkb * nnb; const int hi_ = it_hi < tot ? it_hi : tot;
    int it = it_lo + gw; if (it >= hi_) return;
#define TR_GEO(it_) const int kb_ = (it_) / nnb, n0_ = ((it_) - kb_ * nnb) * 64; \
        const int dr_ = (MODE == 0) ? n0_ : ((n0_ >> 7) * 256 + (n0_ & 127) + (MODE == 2 ? 128 : 0))
    f32x4 va[16], vb[16];
    { TR_GEO(it); tr_load(va, W, N, kb_ * 64, n0_, lane); }
    for (;;) {
        if (it + NGW < hi_) { TR_GEO(it + NGW); tr_load(vb, W, N, kb_ * 64, n0_, lane); }
        { TR_GEO(it); tr_emit(va, K, WT, kb_ * 64, dr_, scr, lane, kscale); }
        it += NGW; if (it >= hi_) break;
        if (it + NGW < hi_) { TR_GEO(it + NGW); tr_load(va, W, N, kb_ * 64, n0_, lane); }
        { TR_GEO(it); tr_emit(vb, K, WT, kb_ * 64, dr_, scr, lane, kscale); }
        it += NGW; if (it >= hi_) break;
    }
#undef TR_GEO
}
__device__ __forceinline__ TrDesc deferred_desc(unsigned char* ws, int j) {
    const int l = j >= 4 ? 1 : 0, k = j >= 4 ? j - 4 : j + 1;
    TrDesc d;
    if (k == 0) { d.W = inp(2) + (size_t)l * DM * INW; d.WT = (bf16_t*)(ws + WS_WIN) + (size_t)l * NP * DM; d.ks = inp(1) + (size_t)l * DM; d.K = DM; d.N = INW; d.nnb = NP / 64; d.mode = 0; }
    else if (k == 1) { d.W = inp(3) + (size_t)l * DM * DM; d.WT = (bf16_t*)(ws + WS_WOUT) + (size_t)l * DM * DM; d.ks = nullptr; d.K = DM; d.N = DM; d.nnb = DM / 64; d.mode = 0; }
    else if (k == 2) { d.W = inp(19) + (size_t)l * DM * DFF; d.WT = (bf16_t*)(ws + WS_WGU) + (size_t)l * NGU * DM; d.ks = inp(18) + (size_t)l * DM; d.K = DM; d.N = DFF; d.nnb = DFF / 64; d.mode = 1; }
    else if (k == 3) { d.W = inp(20) + (size_t)l * DM * DFF; d.WT = (bf16_t*)(ws + WS_WGU) + (size_t)l * NGU * DM; d.ks = inp(18) + (size_t)l * DM; d.K = DM; d.N = DFF; d.nnb = DFF / 64; d.mode = 2; }
    else { d.W = inp(21) + (size_t)l * DFF * DM; d.WT = (bf16_t*)(ws + WS_WDN) + (size_t)l * DM * DFF; d.ks = nullptr; d.K = DFF; d.N = DM; d.nnb = DM / 64; d.mode = 0; }
    return d;
}
__device__ __forceinline__ void convert_deferred(unsigned char* ws, LAS float* scr, int w, int NW, int lane, int j_lo = 0, int j_hi = 9) {
#pragma unroll 1
    for (int j = j_lo; j < j_hi; ++j) { const TrDesc d = deferred_desc(ws, j); tr_matrix_rt(d.W, d.K, d.N, d.nnb, d.WT, scr, w, NW, lane, d.ks, d.mode); }
}
constexpr bool SPLIT_GU0 = false;
constexpr int GU0_WGS = 192;
constexpr bool SPLIT_INPROJ0 = false;
constexpr int GEMM0_WGS = 192;
__device__ NOINL void deferred_phase(ldsp lds_, int first_wg, int j_lo, int j_hi) {
    Frame F = mk_frame(lds_);
    LAS float* scr = (LAS float*)(F.lds + F.wave * 16640);
    convert_deferred(F.ws, scr, (F.bid - first_wg) * NWAVES + F.wave, (F.G - first_wg) * NWAVES, F.lane, j_lo, j_hi);
}
__device__ NOINL void p0_prologue(ldsp lds_) {
    Frame F = mk_frame(lds_);
    LAS float* scr = (LAS float*)(F.lds + F.wave * 16640);
    const int gw = F.bid * NWAVES + F.wave, NGW = F.G * NWAVES, lane = F.lane;
    unsigned char* ws = F.ws;
#pragma unroll 1
    for (int j = 0; j < 41; ++j) {
        TrDesc d; int rot = 0;
        if (j == 0) { d.W = inp(2); d.WT = (bf16_t*)(ws + WS_WIN); d.ks = inp(1); d.K = DM; d.N = INW; d.nnb = NP / 64; }
        else if (j <= 4) { const int q = j - 1, l = q >> 1, wh = q & 1;
            d.W = inp(wh ? 16 : 13) + (size_t)l * 4096 * 256; d.WT = (bf16_t*)(ws + WS_CW1T) + (size_t)(l * 2 + wh) * 256 * 4096; d.ks = nullptr; d.K = 4096; d.N = 256; d.nnb = 4; rot = 512 * j; }
        else if (j <= 8) { const int q = j - 5, l = q >> 1, wh = q & 1;
            d.W = inp(wh ? 17 : 14) + (size_t)l * 256 * 128; d.WT = (bf16_t*)(ws + SM_CW2T) + (size_t)(l * 2 + wh) * 128 * 256; d.ks = nullptr; d.K = 256; d.N = 128; d.nnb = 2; rot = 1536 + 16 * j; }
        else { const int q = j - 9, wx = q & 1, lg = q >> 1;
            d.W = inp(wx ? 9 : 7) + (size_t)lg * 128 * 128; d.WT = (bf16_t*)(ws + (wx ? SM_WXT : SM_WAT)) + (size_t)lg * 128 * 128; d.ks = nullptr; d.K = 128; d.N = 128; d.nnb = 2; rot = 1600 + 8 * q; }
        tr_matrix_rt(d.W, d.K, d.N, d.nnb, d.WT, scr, (gw + rot) % NGW, NGW, lane, d.ks, 0);
    }
    if (F.G != 256) convert_deferred(ws, scr, gw, NGW, lane);
    else if (SPLIT_GU0) convert_deferred(ws, scr, gw, NGW, lane, 0, 4);
    else if (!SPLIT_INPROJ0) convert_deferred(ws, scr, gw, NGW, lane);
    {   const float* x = inp(0); bf16_t* xs = (bf16_t*)(ws + WS_XS0); float* ssq = (float*)(ws + SM_SSQA);
        for (int m = gw; m < MTOK; m += NGW) {
            const f32x4* xr = (const f32x4*)(x + (size_t)m * DM) + lane; u32x2* o = (u32x2*)(xs + (size_t)m * DM) + lane;
            f32x4 v[16];
#pragma unroll
            for (int j = 0; j < 16; ++j) v[j] = xr[64 * j];
            float mine = 0.f;
#pragma unroll
            for (int j = 0; j < 16; ++j) { const float sj = wave_sum((v[j].x * v[j].x + v[j].y * v[j].y) + (v[j].z * v[j].z + v[j].w * v[j].w)); mine = (lane == j) ? sj : mine;
                u32x2 pk; pk.x = cvtpk(v[j].x, v[j].y); pk.y = cvtpk(v[j].z, v[j].w); o[64 * j] = pk; }
            if (lane < 16) ssq[(size_t)m * 16 + lane] = mine; } }
    for (int idx = (F.bid * NTHR + F.tid); idx < SEQ * 64; idx += F.G * NTHR) {
        const int t = idx >> 6, i = idx & 63;
        const float inv = powf(10000.0f, -(float)i * (1.0f / 64.0f));
        const float ang = (float)t * inv;
        double rev = (double)ang * 0.15915494309189535; rev -= rint(rev);
        ((float*)(ws + WS_ROPEC))[idx] = __builtin_amdgcn_cosf((float)rev);
        ((float*)(ws + WS_ROPES))[idx] = __builtin_amdgcn_sinf((float)rev);
    }
    for (int it = (gw + 1800) % NGW; it < 2 * 2 * 32; it += NGW) {
        const int s = it & 31, which = (it >> 5) & 1, l = it >> 6;
        const float* pos = inp(which ? 15 : 12) + (size_t)l * 4096 + s * 128;
        const float* w1 = inp(which ? 16 : 13) + (size_t)l * 4096 * 256 + (size_t)s * 128 * 256;
        float a0 = 0.f, a1 = 0.f, a2 = 0.f, a3 = 0.f;
#pragma unroll 1
        for (int k0 = 0; k0 < 128; k0 += 16) { float pp[16], w0[16], w1v[16], w2[16], w3[16];
#pragma unroll
            for (int x = 0; x < 16; ++x) { const float* wr = w1 + (k0 + x) * 256 + lane; pp[x] = pos[k0 + x]; w0[x] = wr[0]; w1v[x] = wr[64]; w2[x] = wr[128]; w3[x] = wr[192]; }
#pragma unroll
            for (int x = 0; x < 16; ++x) { a0 += pp[x] * w0[x]; a1 += pp[x] * w1v[x]; a2 += pp[x] * w2[x]; a3 += pp[x] * w3[x]; } }
        float* o = (float*)(ws + SM_CB1P) + (size_t)it * 256 + lane;
        o[0] = a0; o[64] = a1; o[128] = a2; o[192] = a3;
    }
}

__device__ NOINL void final_norm_phase(ldsp lds_, const bf16_t* __restrict__ xs, const float* __restrict__ ssq, const float* __restrict__ w, float* __restrict__ outp) {
    Frame F = mk_frame(lds_);
    const int gw = F.bid * NWAVES + F.wave, NGW = F.G * NWAVES, lane = F.lane;
    for (int m = gw; m < MTOK; m += NGW) {
        const float part = ssq[(size_t)m * 16 + (lane & 15)];
        const float rstd = 1.0f / sqrtf(wave_sum(part) * (0.25f / DM) + RMS_EPS);
        const u32x2* xr = (const u32x2*)(xs + (size_t)m * DM) + lane; const f32x4* wr = (const f32x4*)w + lane; f32x4* o = (f32x4*)(outp + (size_t)m * DM) + lane;
        u32x2 v[16];
#pragma unroll
        for (int j = 0; j < 16; ++j) v[j] = xr[64 * j];
#pragma unroll
        for (int j = 0; j < 16; ++j) { const f32x4 ww = wr[64 * j]; f32x4 y; y.x = bflo(v[j].x) * rstd * ww.x; y.y = bfhi(v[j].x) * rstd * ww.y; y.z = bflo(v[j].y) * rstd * ww.z; y.w = bfhi(v[j].y) * rstd * ww.w; o[64 * j] = y; }
    }
}

template <int NT, int KSTEPS>
__device__ __forceinline__ void strip_mma(f32x4 (&acc)[NT], const LAS unsigned char* A, int arow0, int apitch, const LAS unsigned char* Bt, int bpitch, int lane) {
    const int fr = lane & 15, fq = lane >> 4;
#pragma unroll
    for (int ks = 0; ks < KSTEPS; ++ks) {
        const bf16x8 a = *(const LAS bf16x8*)(A + (arow0 + fr) * apitch + (ks * 32 + fq * 8) * 2);
#pragma unroll
        for (int nt = 0; nt < NT; ++nt) {
            const bf16x8 b = *(const LAS bf16x8*)(Bt + (nt * 16 + fr) * bpitch + (ks * 32 + fq * 8) * 2);
            acc[nt] = __builtin_amdgcn_mfma_f32_16x16x32_bf16(a, b, acc[nt], 0, 0, 0);
        }
    }
}
constexpr int P272 = 272;

__device__ __forceinline__ float ret_log_gamma(int h) { return log1pf(-exp2f(-5.0f - (float)h)); }

__device__ __forceinline__ void rope8(const u32x4 w1, const u32x4 w2, const float* __restrict__ cs, const float* __restrict__ sn, float (&r1)[8], float (&r2)[8]) {
    float a[8], b[8]; unpack8(w1, a); unpack8(w2, b);
    const f32x4 c0 = *(const f32x4*)cs, c1 = *(const f32x4*)(cs + 4), s0 = *(const f32x4*)sn, s1 = *(const f32x4*)(sn + 4);
    const float c[8] = {c0.x, c0.y, c0.z, c0.w, c1.x, c1.y, c1.z, c1.w}, s[8] = {s0.x, s0.y, s0.z, s0.w, s1.x, s1.y, s1.z, s1.w};
#pragma unroll
    for (int x = 0; x < 8; ++x) { r1[x] = a[x] * c[x] - b[x] * s[x]; r2[x] = a[x] * s[x] + b[x] * c[x]; }
}

__device__ NOINL void ret_kv_unit(ldsp lds_, int unit) {
    Frame F = mk_frame(lds_);
    const int h = unit & 7, n = (unit >> 3) & 31, b = unit >> 8;
    const bf16_t* proj = (const bf16_t*)(F.ws + WS_PROJ);
    const float* ropec = (const float*)(F.ws + WS_ROPEC); const float* ropes = (const float*)(F.ws + WS_ROPES);
    ldsp vT = F.lds, kT = F.lds + 128 * P272;
    const int tid = F.tid, lane = F.lane, wave = F.wave;
    const size_t row0 = (size_t)b * SEQ + (size_t)n * 128;
    const float lg = ret_log_gamma(h);
    const int c0v = (tid & 15) * 8, c0k = (tid & 7) * 8;
    u32x4 vw[4], kw[2][2]; f32x4 tc[2][2], ts[2][2];
#pragma unroll
    for (int ps = 0; ps < 4; ++ps) { const int j = (tid >> 4) + 32 * ps; vw[ps] = *(const u32x4*)(proj + (row0 + j) * NP + C_RV + h * 128 + c0v); }
#pragma unroll
    for (int ps = 0; ps < 2; ++ps) { const int j = (tid >> 3) + 64 * ps; const int t = n * 128 + j;
        const bf16_t* kr = proj + (row0 + j) * NP + C_RK + h * 128 + c0k;
        kw[ps][0] = *(const u32x4*)kr; kw[ps][1] = *(const u32x4*)(kr + 64);
        tc[ps][0] = *(const f32x4*)(ropec + t * 64 + c0k); tc[ps][1] = *(const f32x4*)(ropec + t * 64 + c0k + 4); ts[ps][0] = *(const f32x4*)(ropes + t * 64 + c0k); ts[ps][1] = *(const f32x4*)(ropes + t * 64 + c0k + 4); }
    asm volatile("" :: "v"(vw[0]), "v"(vw[1]), "v"(vw[2]), "v"(vw[3]), "v"(kw[0][0]), "v"(kw[0][1]), "v"(kw[1][0]), "v"(kw[1][1]),
                    "v"(tc[0][0]), "v"(tc[0][1]), "v"(tc[1][0]), "v"(tc[1][1]), "v"(ts[0][0]), "v"(ts[0][1]), "v"(ts[1][0]), "v"(ts[1][1]) : "memory");
    asm volatile("" : "+v"(vw[0]), "+v"(vw[1]), "+v"(vw[2]), "+v"(vw[3]), "+v"(kw[0][0]), "+v"(kw[0][1]), "+v"(kw[1][0]), "+v"(kw[1][1]));
    asm volatile("" : "+v"(tc[0][0]), "+v"(tc[0][1]), "+v"(tc[1][0]), "+v"(tc[1][1]), "+v"(ts[0][0]), "+v"(ts[0][1]), "+v"(ts[1][0]), "+v"(ts[1][1]));
#pragma unroll
    for (int ps = 0; ps < 4; ++ps) { const int j = (tid >> 4) + 32 * ps; const int c0 = c0v;
        const unsigned ww[4] = {vw[ps].x, vw[ps].y, vw[ps].z, vw[ps].w};
#pragma unroll
        for (int x = 0; x < 8; ++x) *(LAS unsigned short*)(vT + (c0 + x) * P272 + j * 2) = (unsigned short)((x & 1) ? (ww[x >> 1] >> 16) : (ww[x >> 1] & 0xffffu)); }
#pragma unroll
    for (int ps = 0; ps < 2; ++ps) { const int j = (tid >> 3) + 64 * ps; const int c0 = c0k;
        const float cc[8] = {tc[ps][0].x, tc[ps][0].y, tc[ps][0].z, tc[ps][0].w, tc[ps][1].x, tc[ps][1].y, tc[ps][1].z, tc[ps][1].w}, sn[8] = {ts[ps][0].x, ts[ps][0].y, ts[ps][0].z, ts[ps][0].w, ts[ps][1].x, ts[ps][1].y, ts[ps][1].z, ts[ps][1].w};
        float a[8], bb[8], r1[8], r2[8]; unpack8(kw[ps][0], a); unpack8(kw[ps][1], bb);
#pragma unroll
        for (int x = 0; x < 8; ++x) { r1[x] = a[x] * cc[x] - bb[x] * sn[x]; r2[x] = a[x] * sn[x] + bb[x] * cc[x]; }
        const float sc = 0.08838834764831845f * __expf(lg * (float)(127 - j));
#pragma unroll
        for (int x = 0; x < 8; ++x) { *(LAS unsigned short*)(kT + (c0 + x) * P272 + j * 2) = (unsigned short)f2bf(r1[x] * sc);
                                      *(LAS unsigned short*)(kT + (c0 + 64 + x) * P272 + j * 2) = (unsigned short)f2bf(r2[x] * sc); } }
    __syncthreads();
    f32x4 acc[8];
#pragma unroll
    for (int i = 0; i < 8; ++i) acc[i] = (f32x4){0.f, 0.f, 0.f, 0.f};
    strip_mma<8, 4>(acc, vT, wave * 16, P272, kT, P272, lane);
    float* kv = (float*)(F.ws + WS_RETKV) + (size_t)unit * 16384;
    const int fr = lane & 15, fq = lane >> 4;
#pragma unroll
    for (int nt = 0; nt < 8; ++nt)
#pragma unroll
        for (int j = 0; j < 4; ++j) kv[(wave * 16 + 4 * fq + j) * 128 + nt * 16 + fr] = acc[nt][j];
    __syncthreads();
}

__device__ NOINL void moba_kmean_unit(ldsp lds_, int unit) {
    Frame F = mk_frame(lds_);
    const int blk = unit & 15, h = (unit >> 4) & 7, b = unit >> 7;
    const bf16_t* proj = (const bf16_t*)(F.ws + WS_PROJ);
    LAS float* part = (LAS float*)F.lds;
    const int tid = F.tid, d0 = (tid & 15) * 8, p = tid >> 4;
    float s[8] = {0, 0, 0, 0, 0, 0, 0, 0};
#pragma unroll
    for (int kk = 0; kk < 8; ++kk) { const size_t row = (size_t)b * SEQ + blk * 256 + p * 8 + kk;
        float f[8]; unpack8(*(const u32x4*)(proj + row * NP + C_MK + h * 128 + d0), f);
#pragma unroll
        for (int x = 0; x < 8; ++x) s[x] += f[x]; }
#pragma unroll
    for (int x = 0; x < 8; ++x) part[p * 128 + d0 + x] = s[x];
    __syncthreads();
    if (tid < 128) { float a = 0.f;
#pragma unroll 8
        for (int q = 0; q < 32; ++q) a += part[q * 128 + tid];
        ((float*)(F.ws + SM_KMEAN))[(size_t)unit * 128 + tid] = a * (1.0f / 256.0f); }
    __syncthreads();
}

constexpr int CP2 = 528;
constexpr int CMP_B = 64 * CP2, CMP_STG2 = CMP_B + 32 * CP2;
__device__ NOINL void nsa_cmp1_unit(ldsp lds_, int layer, int unit) {
    Frame F = mk_frame(lds_);
    const int nq = unit & 3, rg = (unit >> 2) & 7, kvh = (unit >> 5) & 1, b = (unit >> 6) & 1, which = unit >> 7;
    const bf16_t* proj = (const bf16_t*)(F.ws + WS_PROJ);
    const bf16_t* w1t = (const bf16_t*)(F.ws + WS_CW1T) + (size_t)(layer * 2 + which) * 256 * 4096 + (size_t)(nq * 64) * 4096;
    const float* cb1p = (const float*)(F.ws + SM_CB1P) + (size_t)(layer * 2 + which) * 32 * 256 + nq * 64;
    ldsp stg = F.lds;
    LAS float* biasL = (LAS float*)(F.lds + 2 * CMP_STG2);
    const int tid = F.tid, lane = F.lane, wave = F.wave;
    if (tid < 64) { float a = 0.f; float bv[32];
#pragma unroll
        for (int s = 0; s < 32; ++s) bv[s] = cb1p[s * 256 + tid];
#pragma unroll
        for (int s = 0; s < 32; ++s) a += bv[s];
        biasL[tid] = a; }
    const int kc = (tid & 31) * 8, r0 = tid >> 5;
    const bf16_t* bsrc = w1t + (size_t)r0 * 4096 + kc;
    const bf16_t* asrc[2];
#pragma unroll
    for (int i = 0; i < 2; ++i) { int ncr = rg * 32 + r0 + 16 * i; ncr = ncr > 254 ? 254 : ncr;
        asrc[i] = proj + ((size_t)b * SEQ + 16 * ncr + (kc >> 7)) * NP + (which ? C_NVC : C_NKC) + kvh * 128 + (kc & 127); }
    const int dstb = r0 * CP2 + kc * 2;
    bf16x8 sbA[4], saA[2], sbB[4], saB[2];
#define C_LOAD(SB, SA, s_) do { _Pragma("unroll") for (int i = 0; i < 4; ++i) SB[i] = *(const bf16x8*)(bsrc + (size_t)i * 16 * 4096 + (s_) * 256); \
        _Pragma("unroll") for (int i = 0; i < 2; ++i) SA[i] = *(const bf16x8*)(asrc[i] + (size_t)(2 * (s_)) * NP); } while (0)
#define C_WRITE(SB, SA, bf) do { ldsp d_ = stg + (bf) * CMP_STG2; _Pragma("unroll") for (int i = 0; i < 4; ++i) *(LAS bf16x8*)(d_ + dstb + i * 16 * CP2) = SB[i]; \
        _Pragma("unroll") for (int i = 0; i < 2; ++i) *(LAS bf16x8*)(d_ + CMP_B + dstb + i * 16 * CP2) = SA[i]; } while (0)
#define C_MMA(bf) do { ldsp cur = stg + (bf) * CMP_STG2; strip_mma<1, 8>(acc, cur + CMP_B, (wave >> 2) * 16, CP2, cur + ((wave & 3) * 16) * CP2, CP2, lane); } while (0)
    f32x4 acc[1] = {(f32x4){0.f, 0.f, 0.f, 0.f}};
    C_LOAD(sbA, saA, 0); C_LOAD(sbB, saB, 1);
    C_WRITE(sbA, saA, 0); __syncthreads();
#pragma unroll 1
    for (int s = 0; s < 16; s += 2) {
        if (s + 2 < 16) C_LOAD(sbA, saA, s + 2);
        C_MMA(0);
        C_WRITE(sbB, saB, 1); __syncthreads();
        if (s + 3 < 16) C_LOAD(sbB, saB, s + 3);
        C_MMA(1);
        if (s + 2 < 16) C_WRITE(sbA, saA, 0);
        __syncthreads();
    }
#undef C_LOAD
#undef C_WRITE
#undef C_MMA
    const int fr = lane & 15, fq = lane >> 4;
    bf16_t* hidg = (bf16_t*)(F.ws + WS_H) + (size_t)(((which * 2 + b) * 2 + kvh) * 256 + rg * 32) * 256 + nq * 64;
    {   const int col = (wave & 3) * 16 + fr; const float bv = biasL[col];
#pragma unroll
        for (int j = 0; j < 4; ++j) { const int row = (wave >> 2) * 16 + 4 * fq + j; hidg[(size_t)row * 256 + col] = (bf16_t)f2bf(gelu_tanh(acc[0][j] + bv)); } }
    __syncthreads();
}
__device__ NOINL void nsa_cmp2_unit(ldsp lds_, int layer, int unit) {
    Frame F = mk_frame(lds_);
    const int rg = unit & 7, kvh = (unit >> 3) & 1, b = (unit >> 4) & 1, which = unit >> 5;
    const bf16_t* w2t = (const bf16_t*)(F.ws + SM_CW2T) + (size_t)(layer * 2 + which) * 128 * 256;
    const bf16_t* hidg = (const bf16_t*)(F.ws + WS_H) + (size_t)(((which * 2 + b) * 2 + kvh) * 256 + rg * 32) * 256;
    ldsp hid = F.lds;
    const int tid = F.tid, lane = F.lane, wave = F.wave, fr = lane & 15, fq = lane >> 4;
    bf16x8 bw[8];
    {   u32x4 hw[2];
#pragma unroll
        for (int i = 0; i < 2; ++i) { const int c = tid + 512 * i; hw[i] = *(const u32x4*)(hidg + (size_t)(c >> 5) * 256 + (c & 31) * 8); }
#pragma unroll
        for (int ks = 0; ks < 8; ++ks) bw[ks] = *(const bf16x8*)(w2t + (size_t)(wave * 16 + fr) * 256 + ks * 32 + fq * 8);
        __builtin_amdgcn_sched_barrier(0);
        asm volatile("" : "+v"(hw[0]), "+v"(hw[1]), "+v"(bw[0]), "+v"(bw[1]), "+v"(bw[2]), "+v"(bw[3]), "+v"(bw[4]), "+v"(bw[5]), "+v"(bw[6]), "+v"(bw[7]));
#pragma unroll
        for (int i = 0; i < 2; ++i) { const int c = tid + 512 * i; *(LAS u32x4*)(hid + (c >> 5) * 528 + (c & 31) * 16) = hw[i]; } }
    __syncthreads();
    f32x4 a2[2] = {(f32x4){0.f, 0.f, 0.f, 0.f}, (f32x4){0.f, 0.f, 0.f, 0.f}};
#pragma unroll
    for (int ks = 0; ks < 8; ++ks) {
        const bf16x8 bb = bw[ks];
#pragma unroll
        for (int s = 0; s < 2; ++s) { const bf16x8 a = *(const LAS bf16x8*)(hid + (s * 16 + fr) * 528 + (ks * 32 + fq * 8) * 2);
            a2[s] = __builtin_amdgcn_mfma_f32_16x16x32_bf16(a, bb, a2[s], 0, 0, 0); }
    }
    bf16_t* outp = (bf16_t*)(F.ws + (which ? SM_VC : SM_KC)) + (size_t)((b * 2 + kvh) * 256 + rg * 32) * 128;
#pragma unroll
    for (int s = 0; s < 2; ++s)
#pragma unroll
        for (int j = 0; j < 4; ++j) { const int row = s * 16 + 4 * fq + j; const bool valid = (rg * 32 + row) < 255;
            outp[row * 128 + wave * 16 + fr] = valid ? (bf16_t)f2bf(a2[s][j]) : (bf16_t)0; }
    __syncthreads();
}

__device__ NOINL void lru_local_unit(ldsp lds_, int layer, int unit) {
    Frame F = mk_frame(lds_);
    const int g = unit & 7, tc = (unit >> 3) & 31, b = unit >> 8;
    const bf16_t* proj = (const bf16_t*)(F.ws + WS_PROJ);
    const float* convw = inp(5) + (size_t)layer * 4 * 1024 + g * 128;
    const float* convb = inp(6) + (size_t)layer * 1024 + g * 128;
    const float* ba = inp(8) + (size_t)layer * 1024 + g * 128;
    const float* bx = inp(10) + (size_t)layer * 1024 + g * 128;
    const float* lam = inp(11) + (size_t)layer * 1024 + g * 128;
    const bf16_t* wat = (const bf16_t*)(F.ws + SM_WAT) + (size_t)(layer * 8 + g) * 16384;
    const bf16_t* wxt = (const bf16_t*)(F.ws + SM_WXT) + (size_t)(layer * 8 + g) * 16384;
    ldsp LX = F.lds;
    ldsp XCB = F.lds + 132 * P272;
    ldsp WA = XCB + 128 * P272, WX = WA + 128 * P272;
    LAS float* AL = (LAS float*)F.lds;
    LAS float* UL = (LAS float*)(F.lds + 65536);
    LAS float* PRM = (LAS float*)(F.lds + 140352);
    const int tid = F.tid, lane = F.lane, wave = F.wave;
    const int t0 = tc * 128;
    {   float pv[2]; u32x4 lxw[5], waw[4], wxw[4];
#pragma unroll
        for (int q = 0; q < 2; ++q) { const int i = tid + 512 * q, k = i >> 7, c = i & 127;
            const float* src = (k < 4) ? (convw + k * 1024) : (k == 4) ? convb : (k == 5) ? ba : (k == 6) ? bx : lam;
            pv[q] = src[c]; }
#pragma unroll
        for (int q = 0; q < 5; ++q) { const int i = tid + 512 * q, r = i >> 4, c0 = (i & 15) * 8; const int t = t0 - 3 + r;
            lxw[q] = (u32x4){0u, 0u, 0u, 0u}; if (i < 131 * 16 && t >= 0) lxw[q] = *(const u32x4*)(proj + ((size_t)b * SEQ + t) * NP + C_LX + g * 128 + c0); }
#pragma unroll
        for (int q = 0; q < 4; ++q) { const int i = tid + 512 * q; waw[q] = *(const u32x4*)(wat + i * 8); wxw[q] = *(const u32x4*)(wxt + i * 8); }
#pragma unroll
        for (int q = 0; q < 2; ++q) { const int i = tid + 512 * q; PRM[i] = (i >= 896) ? log1pf(__expf(-pv[q])) : pv[q]; }
#pragma unroll
        for (int q = 0; q < 5; ++q) { const int i = tid + 512 * q, r = i >> 4, c0 = (i & 15) * 8; if (i < 132 * 16) *(LAS u32x4*)(LX + r * P272 + c0 * 2) = lxw[q]; }
#pragma unroll
        for (int q = 0; q < 4; ++q) { const int i = tid + 512 * q, r = i >> 4, c0 = (i & 15) * 8;
            *(LAS u32x4*)(WA + r * P272 + c0 * 2) = waw[q]; *(LAS u32x4*)(WX + r * P272 + c0 * 2) = wxw[q]; }
    }
    __syncthreads();
    {   const int t = tid >> 2, cb0 = (tid & 3) * 32;
#pragma unroll 4
        for (int c = cb0; c < cb0 + 32; c += 2) { float y0 = PRM[512 + c], y1 = PRM[512 + c + 1];
#pragma unroll
            for (int tap = 0; tap < 4; ++tap) { const unsigned w = *(const LAS unsigned*)(LX + (t + tap) * P272 + c * 2);
                y0 += bflo(w) * PRM[tap * 128 + c]; y1 += bfhi(w) * PRM[tap * 128 + c + 1]; }
            *(LAS unsigned*)(XCB + t * P272 + c * 2) = pk2(y0, y1); } }
    __syncthreads();
    f32x4 accR[8], accI[8];
#pragma unroll
    for (int i = 0; i < 8; ++i) { accR[i] = (f32x4){0.f, 0.f, 0.f, 0.f}; accI[i] = (f32x4){0.f, 0.f, 0.f, 0.f}; }
    strip_mma<8, 4>(accR, XCB, wave * 16, P272, WA, P272, lane);
    strip_mma<8, 4>(accI, XCB, wave * 16, P272, WX, P272, lane);
    const int fr = lane & 15, fq = lane >> 4;
    float av[8][4], uv[8][4];
#pragma unroll
    for (int nt = 0; nt < 8; ++nt) { const int c = nt * 16 + fr;
        const float cw0 = PRM[c], cw1 = PRM[128 + c], cw2 = PRM[256 + c], cw3 = PRM[384 + c], cb = PRM[512 + c];
        const float bav = PRM[640 + c], bxv = PRM[768 + c], spl = PRM[896 + c];
#pragma unroll
        for (int j = 0; j < 4; ++j) { const int t = wave * 16 + 4 * fq + j;
            const float xc = cb + bf2f(*(const LAS unsigned short*)(LX + (t + 0) * P272 + c * 2)) * cw0 + bf2f(*(const LAS unsigned short*)(LX + (t + 1) * P272 + c * 2)) * cw1
                                + bf2f(*(const LAS unsigned short*)(LX + (t + 2) * P272 + c * 2)) * cw2 + bf2f(*(const LAS unsigned short*)(LX + (t + 3) * P272 + c * 2)) * cw3;
            const float r = sigmoidf_(accR[nt][j] + bav), ig = sigmoidf_(accI[nt][j] + bxv);
            const float la = -8.0f * r * spl; const float a = __expf(la);
            const float x2 = 2.0f * la;
            const float om = (x2 > -0.02f) ? -x2 * (1.0f + x2 * (0.5f + x2 * 0.16666667f)) : 1.0f - __expf(x2);
            av[nt][j] = a; uv[nt][j] = __builtin_amdgcn_sqrtf(fmaxf(om, 0.0f)) * (ig * xc); } }
    __syncthreads();
#pragma unroll
    for (int nt = 0; nt < 8; ++nt)
#pragma unroll
        for (int j = 0; j < 4; ++j) { const int t = wave * 16 + 4 * fq + j, c = nt * 16 + fr; AL[t * 128 + c] = av[nt][j]; UL[t * 128 + c] = uv[nt][j]; }
    __syncthreads();
    if (tid < 128) { float hh = 0.f, P = 1.f; const size_t base = ((size_t)b * SEQ + t0) * 1024 + g * 128 + tid;
        float* Hp = (float*)(F.ws + WS_LRUH) + base; float* Pp = (float*)(F.ws + WS_LRUP) + base;
#pragma unroll 4
        for (int t = 0; t < 128; ++t) { const float a = AL[t * 128 + tid]; P *= a; hh = a * hh + UL[t * 128 + tid]; Hp[(size_t)t * 1024] = hh; Pp[(size_t)t * 1024] = P; }
        ((float*)(F.ws + SM_LRUCA))[(size_t)(b * 32 + tc) * 1024 + g * 128 + tid] = P;
        ((float*)(F.ws + SM_LRUCH))[(size_t)(b * 32 + tc) * 1024 + g * 128 + tid] = hh; }
    __syncthreads();
}

__device__ __forceinline__ void s1_phase(ldsp lds, int layer) {
    int G = gridDim.x, bid = blockIdx.x; OPQ_S(G); OPQ_S(bid);
#ifndef S1_DUP
#define S1_DUP 0
#endif
#define S1REP(b) _Pragma("unroll 1") for (int r1_ = 0; r1_ < 1 + ((S1_DUP >> (b)) & 1); ++r1_)
    S1REP(0) for (int u = bid; u < 512; u += G) ret_kv_unit(lds, u);
    S1REP(1) for (int u = bid; u < 512; u += G) lru_local_unit(lds, layer, u);
    S1REP(2) for (int u = bid; u < 256; u += G) moba_kmean_unit(lds, u);
    S1REP(3) for (int u = bid; u < 256; u += G) nsa_cmp1_unit(lds, layer, u);
}

__device__ NOINL void ret_scan_phase(ldsp lds_) {
    Frame F = mk_frame(lds_);
    for (int gid = F.bid * NTHR + F.tid; gid < 16 * 8192; gid += F.G * NTHR) {
        const int bh = gid >> 13, idx2 = gid & 8191, b = bh >> 3, h = bh & 7;
        f32x2* base = (f32x2*)((float*)(F.ws + WS_RETKV) + (size_t)((b * 32) * 8 + h) * 16384) + idx2;
        const float dc = __expf(ret_log_gamma(h) * 128.0f);
        f32x2 v[32];
#pragma unroll
        for (int n = 0; n < 32; ++n) v[n] = base[(size_t)n * 8 * 8192];
        f32x2 st = {0.f, 0.f};
#pragma unroll
        for (int n = 0; n < 32; ++n) { base[(size_t)n * 8 * 8192] = st; st = st * dc + v[n]; }
    }
}

__device__ NOINL void ret_out_unit(ldsp lds_, int layer, int unit) {
    Frame F = mk_frame(lds_);
    const int h = unit & 7, n = (unit >> 3) & 31, b = unit >> 8;
    const bf16_t* proj = (const bf16_t*)(F.ws + WS_PROJ);
    const float* ropec = (const float*)(F.ws + WS_ROPEC); const float* ropes = (const float*)(F.ws + WS_ROPES);
    const float* gain = inp(4) + (size_t)layer * 1024 + h * 128;
    ldsp Q = F.lds, Kt = F.lds + 128 * P272, vT = F.lds + 2 * 128 * P272, ST = F.lds + 3 * 128 * P272;
    const int tid = F.tid, lane = F.lane, wave = F.wave;
    const size_t row0 = (size_t)b * SEQ + (size_t)n * 128;
    const float lg = ret_log_gamma(h);
    const f32x4* kvp = (const f32x4*)((const float*)(F.ws + WS_RETKV) + (size_t)unit * 16384) + tid;
    f32x4 st[8]; u32x4 qw[2][2], kw[2][2], vw[4]; f32x4 tc[2][2], ts[2][2];
    const int c0q = (tid & 7) * 8, c0v = (tid & 15) * 8;
#pragma unroll
    for (int k = 0; k < 8; ++k) st[k] = kvp[512 * k];
#pragma unroll
    for (int ps = 0; ps < 2; ++ps) { const int j = (tid >> 3) + 64 * ps; const int t = n * 128 + j;
        const bf16_t* qrw = proj + (row0 + j) * NP + C_RQ + h * 128 + c0q; const bf16_t* krw = proj + (row0 + j) * NP + C_RK + h * 128 + c0q;
        qw[ps][0] = *(const u32x4*)qrw; qw[ps][1] = *(const u32x4*)(qrw + 64); kw[ps][0] = *(const u32x4*)krw; kw[ps][1] = *(const u32x4*)(krw + 64);
        tc[ps][0] = *(const f32x4*)(ropec + t * 64 + c0q); tc[ps][1] = *(const f32x4*)(ropec + t * 64 + c0q + 4); ts[ps][0] = *(const f32x4*)(ropes + t * 64 + c0q); ts[ps][1] = *(const f32x4*)(ropes + t * 64 + c0q + 4); }
#pragma unroll
    for (int ps = 0; ps < 4; ++ps) { const int j = (tid >> 4) + 32 * ps; vw[ps] = *(const u32x4*)(proj + (row0 + j) * NP + C_RV + h * 128 + c0v); }
    asm volatile("" :: "v"(st[0]), "v"(st[1]), "v"(st[2]), "v"(st[3]), "v"(st[4]), "v"(st[5]), "v"(st[6]), "v"(st[7]), "v"(qw[0][0]), "v"(qw[0][1]), "v"(qw[1][0]), "v"(qw[1][1]),
                    "v"(kw[0][0]), "v"(kw[0][1]), "v"(kw[1][0]), "v"(kw[1][1]), "v"(tc[0][0]), "v"(tc[0][1]), "v"(tc[1][0]), "v"(tc[1][1]), "v"(ts[0][0]), "v"(ts[0][1]), "v"(ts[1][0]), "v"(ts[1][1]),
                    "v"(vw[0]), "v"(vw[1]), "v"(vw[2]), "v"(vw[3]) : "memory");
    asm volatile("" : "+v"(st[0]), "+v"(st[1]), "+v"(st[2]), "+v"(st[3]), "+v"(st[4]), "+v"(st[5]), "+v"(st[6]), "+v"(st[7]));
    asm volatile("" : "+v"(qw[0][0]), "+v"(qw[0][1]), "+v"(qw[1][0]), "+v"(qw[1][1]), "+v"(kw[0][0]), "+v"(kw[0][1]), "+v"(kw[1][0]), "+v"(kw[1][1]));
    asm volatile("" : "+v"(tc[0][0]), "+v"(tc[0][1]), "+v"(tc[1][0]), "+v"(tc[1][1]), "+v"(ts[0][0]), "+v"(ts[0][1]), "+v"(ts[1][0]), "+v"(ts[1][1]));
    asm volatile("" : "+v"(vw[0]), "+v"(vw[1]), "+v"(vw[2]), "+v"(vw[3]));
#pragma unroll
    for (int k = 0; k < 8; ++k) { const int idx = (tid + 512 * k) * 4; const int e = idx >> 7, d = idx & 127;
        u32x2 w; w.x = pk2(st[k].x, st[k].y); w.y = pk2(st[k].z, st[k].w); *(LAS u32x2*)(ST + e * P272 + d * 2) = w; }
#pragma unroll
    for (int ps = 0; ps < 2; ++ps) { const int j = (tid >> 3) + 64 * ps; const int c0 = c0q;
        const float cc[8] = {tc[ps][0].x, tc[ps][0].y, tc[ps][0].z, tc[ps][0].w, tc[ps][1].x, tc[ps][1].y, tc[ps][1].z, tc[ps][1].w}, sn[8] = {ts[ps][0].x, ts[ps][0].y, ts[ps][0].z, ts[ps][0].w, ts[ps][1].x, ts[ps][1].y, ts[ps][1].z, ts[ps][1].w};
        float a[8], bb[8], r1[8], r2[8]; u32x4 w;
        unpack8(qw[ps][0], a); unpack8(qw[ps][1], bb);
#pragma unroll
        for (int x = 0; x < 8; ++x) { r1[x] = a[x] * cc[x] - bb[x] * sn[x]; r2[x] = a[x] * sn[x] + bb[x] * cc[x]; }
        w.x = pk2(r1[0], r1[1]); w.y = pk2(r1[2], r1[3]); w.z = pk2(r1[4], r1[5]); w.w = pk2(r1[6], r1[7]); *(LAS u32x4*)(Q + j * P272 + c0 * 2) = w;
        w.x = pk2(r2[0], r2[1]); w.y = pk2(r2[2], r2[3]); w.z = pk2(r2[4], r2[5]); w.w = pk2(r2[6], r2[7]); *(LAS u32x4*)(Q + j * P272 + (c0 + 64) * 2) = w;
        unpack8(kw[ps][0], a); unpack8(kw[ps][1], bb);
#pragma unroll
        for (int x = 0; x < 8; ++x) { r1[x] = a[x] * cc[x] - bb[x] * sn[x]; r2[x] = a[x] * sn[x] + bb[x] * cc[x]; }
        const float sc = 0.08838834764831845f;
        w.x = pk2(r1[0] * sc, r1[1] * sc); w.y = pk2(r1[2] * sc, r1[3] * sc); w.z = pk2(r1[4] * sc, r1[5] * sc); w.w = pk2(r1[6] * sc, r1[7] * sc); *(LAS u32x4*)(Kt + j * P272 + c0 * 2) = w;
        w.x = pk2(r2[0] * sc, r2[1] * sc); w.y = pk2(r2[2] * sc, r2[3] * sc); w.z = pk2(r2[4] * sc, r2[5] * sc); w.w = pk2(r2[6] * sc, r2[7] * sc); *(LAS u32x4*)(Kt + j * P272 + (c0 + 64) * 2) = w; }
#pragma unroll
    for (int ps = 0; ps < 4; ++ps) { const int j = (tid >> 4) + 32 * ps; const int c0 = c0v;
        const unsigned ww[4] = {vw[ps].x, vw[ps].y, vw[ps].z, vw[ps].w};
#pragma unroll
        for (int x = 0; x < 8; ++x) *(LAS unsigned short*)(vT + (c0 + x) * P272 + j * 2) = (unsigned short)((x & 1) ? (ww[x >> 1] >> 16) : (ww[x >> 1] & 0xffffu)); }
    __syncthreads();
    const int fr = lane & 15, fq = lane >> 4;
    f32x4 accC[8], accS[8];
#pragma unroll
    for (int i = 0; i < 8; ++i) { accC[i] = (f32x4){0.f, 0.f, 0.f, 0.f}; accS[i] = (f32x4){0.f, 0.f, 0.f, 0.f}; }
    strip_mma<8, 4>(accC, Q, wave * 16, P272, ST, P272, lane);
    strip_mma<8, 4>(accS, Q, wave * 16, P272, Kt, P272, lane);
    __syncthreads();
#pragma unroll
    for (int nt = 0; nt < 8; ++nt)
#pragma unroll
        for (int j = 0; j < 4; ++j) { const int i = wave * 16 + 4 * fq + j, jj = nt * 16 + fr;
            const float v = (i >= jj) ? accS[nt][j] * __expf(lg * (float)(i - jj)) : 0.0f;
            *(LAS unsigned short*)(Q + i * P272 + jj * 2) = (unsigned short)f2bf(v); }
    __syncthreads();
#pragma unroll
    for (int i = 0; i < 8; ++i) accS[i] = (f32x4){0.f, 0.f, 0.f, 0.f};
    float gvv[4][8], gn[8]; unsigned graw[4][8];
#pragma unroll
    for (int nt = 0; nt < 8; ++nt) gn[nt] = gain[nt * 16 + fr];
#pragma unroll
    for (int j = 0; j < 4; ++j) { const bf16_t* grow = proj + (row0 + wave * 16 + 4 * fq + j) * NP + C_RG + h * 128;
#pragma unroll
        for (int nt = 0; nt < 8; ++nt) graw[j][nt] = grow[nt * 16 + fr]; }
    __builtin_amdgcn_sched_barrier(0);
    strip_mma<8, 4>(accS, Q, wave * 16, P272, vT, P272, lane);
    __builtin_amdgcn_sched_barrier(0);
#pragma unroll
    for (int j = 0; j < 4; ++j) asm volatile("" : "+v"(graw[j][0]), "+v"(graw[j][1]), "+v"(graw[j][2]), "+v"(graw[j][3]), "+v"(graw[j][4]), "+v"(graw[j][5]), "+v"(graw[j][6]), "+v"(graw[j][7]));
    asm volatile("" : "+v"(gn[0]), "+v"(gn[1]), "+v"(gn[2]), "+v"(gn[3]), "+v"(gn[4]), "+v"(gn[5]), "+v"(gn[6]), "+v"(gn[7]));
#pragma unroll
    for (int j = 0; j < 4; ++j)
#pragma unroll
        for (int nt = 0; nt < 8; ++nt) gvv[j][nt] = bf2f((unsigned short)graw[j][nt]);
#pragma unroll
    for (int j = 0; j < 4; ++j) { const int i = wave * 16 + 4 * fq + j;
        const float dfs = __expf(lg * (float)(i + 1));
        float y[8]; float s = 0.f;
#pragma unroll
        for (int nt = 0; nt < 8; ++nt) { y[nt] = accS[nt][j] + dfs * accC[nt][j]; s += y[nt]; }
        s += __shfl_xor(s, 1); s += __shfl_xor(s, 2); s += __shfl_xor(s, 4); s += __shfl_xor(s, 8);
        const float mean = s * (1.0f / 128.0f); float q2 = 0.f;
#pragma unroll
        for (int nt = 0; nt < 8; ++nt) { y[nt] -= mean; q2 += y[nt] * y[nt]; }
        q2 += __shfl_xor(q2, 1); q2 += __shfl_xor(q2, 2); q2 += __shfl_xor(q2, 4); q2 += __shfl_xor(q2, 8);
        const float rstd = 1.0f / sqrtf(q2 * (1.0f / 128.0f) + RMS_EPS);
        bf16_t* yrow = (bf16_t*)(F.ws + WS_Y) + (row0 + i) * DM + 0 + h * 128;
#pragma unroll
        for (int nt = 0; nt < 8; ++nt) { const int e = nt * 16 + fr; const float gv = gvv[j][nt];
            yrow[e] = (bf16_t)f2bf(gv * sigmoidf_(gv) * (y[nt] * rstd * gn[nt])); } }
    __syncthreads();
}

__device__ NOINL void lru_out_unit(ldsp lds_, int unit) {
    Frame F = mk_frame(lds_);
    const int ch = unit & 1, tc = (unit >> 1) & 31, b = unit >> 6;
    const bf16_t* proj = (const bf16_t*)(F.ws + WS_PROJ);
    LAS float* HIN = (LAS float*)F.lds;
    {   const int c = ch * 512 + F.tid;
        const float* CA = (const float*)(F.ws + SM_LRUCA) + (size_t)b * 32 * 1024 + c; const float* CH = (const float*)(F.ws + SM_LRUCH) + (size_t)b * 32 * 1024 + c;
        float H = 0.f; float ca[32], chv[32];
#pragma unroll
        for (int k = 0; k < 32; ++k) { ca[k] = CA[k * 1024]; chv[k] = CH[k * 1024]; }
#pragma unroll
        for (int k = 0; k < 32; ++k) H = (k < tc) ? ca[k] * H + chv[k] : H;
        HIN[F.tid] = H; }
    __syncthreads();
    const int cg = (F.tid & 127) * 4, tsub = F.tid >> 7; const int c0 = ch * 512 + cg;
    const f32x4 Hin = *(const LAS f32x4*)(HIN + cg);
    const size_t r0 = (size_t)b * SEQ + tc * 128 + tsub;
    const float* Hp = (const float*)(F.ws + WS_LRUH) + r0 * 1024 + c0; const float* Pp = (const float*)(F.ws + WS_LRUP) + r0 * 1024 + c0;
    const bf16_t* gp = proj + r0 * NP + C_LG + c0; bf16_t* yp = (bf16_t*)(F.ws + WS_Y) + r0 * DM + 2048 + c0;
#pragma unroll 1
    for (int i0 = 0; i0 < 32; i0 += 8) { f32x4 hv[8], pv[8]; u32x2 gv[8];
#pragma unroll
        for (int x = 0; x < 8; ++x) { const size_t t = (size_t)(i0 + x) * 4; hv[x] = *(const f32x4*)(Hp + t * 1024); pv[x] = *(const f32x4*)(Pp + t * 1024); gv[x] = *(const u32x2*)(gp + t * NP); }
#pragma unroll
        for (int x = 0; x < 8; ++x) { const size_t t = (size_t)(i0 + x) * 4; const f32x4 h = hv[x] + pv[x] * Hin;
            u32x2 w; w.x = cvtpk(h.x * gelu_tanh(bflo(gv[x].x)), h.y * gelu_tanh(bfhi(gv[x].x))); w.y = cvtpk(h.z * gelu_tanh(bflo(gv[x].y)), h.w * gelu_tanh(bfhi(gv[x].y)));
            *(u32x2*)(yp + t * DM) = w; } }
    __syncthreads();
}

constexpr int SHM_T = 16384;
#define KSWZ(row, colB) ((row) * 256 + ((colB) ^ (((row) & 7) << 4)))
__device__ __forceinline__ int v_st(int k, int c) { const int kk = (k & ~0xC) | ((k & 4) << 1) | ((k & 8) >> 1); return ((kk >> 3) * 4 + (c >> 5)) * 512 + ((kk & 7) * 32 + (c & 31)) * 2; }
__device__ __forceinline__ int v_rd_base(int lane) { return ((lane & 3) << 3) | (((lane >> 2) & 3) << 6) | (((lane >> 4) & 1) << 5) | (((lane >> 5) & 1) << 8); }
constexpr int v_rd_off(int d0, int ks, int half) { return d0 * 512 + ks * 4096 + half * 2048; }
__device__ __forceinline__ int crow(int r, int hi) { return (r & 3) + 8 * (r >> 2) + 4 * hi; }
__device__ __forceinline__ float half_max(float v) { auto rr = __builtin_amdgcn_permlane32_swap(__float_as_uint(v), __float_as_uint(v), false, false); return fmaxf(__uint_as_float(rr[0]), __uint_as_float(rr[1])); }
__device__ __forceinline__ float half_sum(float v) { auto rr = __builtin_amdgcn_permlane32_swap(__float_as_uint(v), __float_as_uint(v), false, false); return __uint_as_float(rr[0]) + __uint_as_float(rr[1]); }
__device__ __forceinline__ float half_other(float v) { auto rr = __builtin_amdgcn_permlane32_swap(__float_as_uint(v), __float_as_uint(v), false, false); const float a = __uint_as_float(rr[0]), b = __uint_as_float(rr[1]); return (__lane_id() & 32) ? a : b; }

__device__ __forceinline__ void qkt(f32x16& p0, f32x16& p1, const LAS unsigned char* K_lds, int r32, int hi, const bf16x8 (&qr)[8]) {
    p0 = f32x16{}; p1 = f32x16{};
    const LAS unsigned char* kb[4];
#pragma unroll
    for (int dd = 0; dd < 4; ++dd) kb[dd] = K_lds + KSWZ(r32, (dd * 16 + hi * 8) * 2);
#pragma unroll
    for (int d0 = 0; d0 < 8; ++d0) { const LAS unsigned char* a = kb[d0 & 3] + (d0 >> 2) * 128;
        const bf16x8 b0 = *(const LAS bf16x8*)a;
        const bf16x8 b1 = *(const LAS bf16x8*)(a + 32 * 256);
        p0 = __builtin_amdgcn_mfma_f32_32x32x16_bf16(b0, qr[d0], p0, 0, 0, 0);
        p1 = __builtin_amdgcn_mfma_f32_32x32x16_bf16(b1, qr[d0], p1, 0, 0, 0);
        if (d0 & 1) __builtin_amdgcn_sched_barrier(0); }
}
__device__ __forceinline__ void pv_tile(f32x16 (&o)[4], int vb0, bf16x8 pa0, bf16x8 pa1, bf16x8 pa2, bf16x8 pa3) {
#define TRRD(dst, off) asm volatile("ds_read_b64_tr_b16 %0, %1 offset:%2" : "=&v"(dst) : "v"(vb0), "i"(off) : "memory")
#define PV_D0(d0) do { s16x4 l0, l1, l2, l3, h0, h1, h2, h3; constexpr int b_ = v_rd_off(d0, 0, 0); \
        TRRD(l0, b_); TRRD(h0, b_ + 2048); TRRD(l1, b_ + 4096); TRRD(h1, b_ + 6144); TRRD(l2, b_ + 8192); TRRD(h2, b_ + 10240); TRRD(l3, b_ + 12288); TRRD(h3, b_ + 14336); \
        asm volatile("s_waitcnt lgkmcnt(0)" ::: "memory"); __builtin_amdgcn_sched_barrier(0);   \
        o[d0] = __builtin_amdgcn_mfma_f32_32x32x16_bf16(pa0, (bf16x8){l0[0], l0[1], l0[2], l0[3], h0[0], h0[1], h0[2], h0[3]}, o[d0], 0, 0, 0);   \
        o[d0] = __builtin_amdgcn_mfma_f32_32x32x16_bf16(pa1, (bf16x8){l1[0], l1[1], l1[2], l1[3], h1[0], h1[1], h1[2], h1[3]}, o[d0], 0, 0, 0);   \
        o[d0] = __builtin_amdgcn_mfma_f32_32x32x16_bf16(pa2, (bf16x8){l2[0], l2[1], l2[2], l2[3], h2[0], h2[1], h2[2], h2[3]}, o[d0], 0, 0, 0);   \
        o[d0] = __builtin_amdgcn_mfma_f32_32x32x16_bf16(pa3, (bf16x8){l3[0], l3[1], l3[2], l3[3], h3[0], h3[1], h3[2], h3[3]}, o[d0], 0, 0, 0); } while (0)
    PV_D0(0); PV_D0(1); PV_D0(2); PV_D0(3);
#undef PV_D0
#undef TRRD
}
#define PK4(P, B_, OUT) do { unsigned a0_ = cvtpk(P[B_+0], P[B_+1]), a1_ = cvtpk(P[B_+2], P[B_+3]);                          \
        unsigned b0_ = cvtpk(P[B_+4], P[B_+5]), b1_ = cvtpk(P[B_+6], P[B_+7]);                                             \
        auto r0_ = __builtin_amdgcn_permlane32_swap(a0_, b0_, false, false); auto r1_ = __builtin_amdgcn_permlane32_swap(a1_, b1_, false, false); \
        u32x4 w_ = {r0_[0], r1_[0], r0_[1], r1_[1]}; OUT = __builtin_bit_cast(bf16x8, w_); } while (0)

__device__ __forceinline__ void glds16(const void* gsrc, unsigned lds_dst) { unsigned keep;
    asm volatile("s_mov_b32 %0, m0\n\ts_mov_b32 m0, %2\n\ts_nop 0\n\tglobal_load_lds_dwordx4 %1, off\n\ts_mov_b32 m0, %0" : "=&s"(keep) : "v"(gsrc), "s"(lds_dst) : "memory"); }
enum { AM_MOBA = 0, AM_SEL = 1, AM_WIN = 2, AM_CSTAT = 3, AM_COUT = 4 };
constexpr float ATT_C2 = 1.4426950408889634f * 0.08838834764831845f;
constexpr int ATT_BIG = 1 << 24;
constexpr float ATT_DEFER = 6.0f;

struct AttnIO {
    const bf16_t* Kg; const bf16_t* Vg; int pitch;
    int t_lo, t_hi;
    int q;
    int own;
    unsigned mlo, mhi;
};

template <int MODE, int NB>
__device__ __forceinline__ void attn_pass(ldsp lds, LAS float* wsc, const bf16x8 (&qr)[8], const AttnIO& io, f32x16 (&o)[4], float& m_reg, float& l_reg, float inv_l, LAS float* imp) {
    const int tid = otid(), lane = tid & 63, r32 = lane & 31, hi = lane >> 5;
    ldsp V_lds = lds; ldsp K_lds = lds + NB * SHM_T;
    const int vbase = (int)(unsigned)(uintptr_t)V_lds + v_rd_base(lane);
    constexpr int DEPTH = NB - 1;
    constexpr bool NEEDV = (MODE != AM_CSTAT);
    float carry = 0.f;
    const int wv = __builtin_amdgcn_readfirstlane(tid >> 6);
    size_t ksrc[2], vsrc[2];
#pragma unroll
    for (int i = 0; i < 2; ++i) { const int ch = wv * 2 + i;
        const int kr = ch * 4 + (lane >> 4), kc = (lane & 15) ^ (kr & 7);
        ksrc[i] = (size_t)kr * io.pitch + kc * 8;
        const int sub = ch * 2 + (lane >> 5), kk = (sub >> 2) * 8 + ((lane & 31) >> 2), vk = (kk & ~0xC) | ((kk & 4) << 1) | ((kk & 8) >> 1), vc = (sub & 3) * 32 + (lane & 3) * 8;
        vsrc[i] = (size_t)vk * io.pitch + vc; }
#define A_DMA(T, bf) do { const size_t t0_ = (size_t)((T) * 64) * io.pitch; \
        _Pragma("unroll") for (int i = 0; i < 2; ++i) { \
            glds16((const void*)(io.Kg + t0_ + ksrc[i]), (unsigned)(uintptr_t)(K_lds + (bf) * SHM_T + (wv * 2 + i) * 1024)); \
            if (NEEDV) glds16((const void*)(io.Vg + t0_ + vsrc[i]), (unsigned)(uintptr_t)(V_lds + (bf) * SHM_T + (wv * 2 + i) * 1024)); } } while (0)
#define A_STEP(T) do { \
        const int T_ = (T); const int bsel = (T_ - io.t_lo) & (NB - 1); const int vb0 = vbase + bsel * SHM_T; \
        if (T_ + DEPTH < io.t_hi) A_DMA(T_ + DEPTH, (T_ + DEPTH - io.t_lo) & (NB - 1)); \
        f32x16 p0, p1; qkt(p0, p1, K_lds + bsel * SHM_T, r32, hi, qr); \
        __builtin_amdgcn_sched_barrier(0); \
        int dq; unsigned W = 0x7fffffffu; \
        if (MODE == AM_MOBA) { const int blk = T_ >> 2; dq = (blk == io.own) ? (io.q - T_ * 64) : (((io.mlo >> blk) & 1u) ? ATT_BIG : -1); } \
        else if (MODE == AM_SEL) { const unsigned bit = (T_ < 32) ? ((io.mlo >> T_) & 1u) : ((io.mhi >> (T_ - 32)) & 1u); dq = (T_ == io.own) ? (io.q - T_ * 64) : (bit ? ATT_BIG : -1); } \
        else if (MODE == AM_WIN) { dq = io.q - T_ * 64; W = 512u; } \
        else { dq = io.q - T_ * 64; } \
        dq -= 4 * hi; \
        { const float NEG = -__builtin_inff(); \
          _Pragma("unroll") for (int r = 0; r < 16; ++r) { const int c = (r & 3) + 8 * (r >> 2); \
              if ((unsigned)(dq - c) >= W) p0[r] = NEG; if ((unsigned)(dq - c - 32) >= W) p1[r] = NEG; } } \
        if (MODE == AM_COUT) { \
            const float mL = -m_reg * ATT_C2; \
            _Pragma("unroll") for (int r = 0; r < 16; ++r) { p0[r] = __builtin_amdgcn_exp2f(fmaf(p0[r], ATT_C2, mL)) * inv_l; p1[r] = __builtin_amdgcn_exp2f(fmaf(p1[r], ATT_C2, mL)) * inv_l; } \
              \
            { float prev = carry; \
              _Pragma("unroll") for (int g = 0; g < 8; ++g) { \
                  const float s4 = (g < 4) ? ((p0[4 * (g & 3)] + p0[4 * (g & 3) + 1]) + (p0[4 * (g & 3) + 2] + p0[4 * (g & 3) + 3])) : ((p1[4 * (g & 3)] + p1[4 * (g & 3) + 1]) + (p1[4 * (g & 3) + 2] + p1[4 * (g & 3) + 3])); \
                  const float sp = (g < 4) ? p0[4 * (g & 3) + 3] : p1[4 * (g & 3) + 3]; \
                  const float osp = half_other(sp); \
                  imp[16 * T_ + 2 * g + hi] = s4 + (hi ? osp : prev); prev = osp; } \
              carry = prev; } \
            bf16x8 pa0, pa1, pa2, pa3; PK4(p0, 0, pa0); PK4(p0, 8, pa1); PK4(p1, 0, pa2); PK4(p1, 8, pa3); \
            pv_tile(o, vb0, pa0, pa1, pa2, pa3); \
        } else { \
            float pmax = p0[0]; \
            _Pragma("unroll") for (int r = 1; r < 16; ++r) pmax = fmaxf(pmax, p0[r]); \
            _Pragma("unroll") for (int r = 0; r < 16; ++r) pmax = fmaxf(pmax, p1[r]); \
            pmax = half_max(pmax); \
            const float mn = fmaxf(m_reg, pmax); const float alpha = __builtin_amdgcn_exp2f((m_reg - mn) * ATT_C2); m_reg = mn; \
            const float mL = -mn * ATT_C2; float ps = 0.f; \
            _Pragma("unroll") for (int r = 0; r < 16; ++r) { p0[r] = __builtin_amdgcn_exp2f(fmaf(p0[r], ATT_C2, mL)); p1[r] = __builtin_amdgcn_exp2f(fmaf(p1[r], ATT_C2, mL)); ps += p0[r] + p1[r]; } \
            ps = half_sum(ps); l_reg = l_reg * alpha + ps; \
            if (NEEDV) { \
                if (__any(alpha < 1.0f)) { if (hi == 0) wsc[r32] = alpha; LDS_WAIT(); \
                    _Pragma("unroll") for (int r = 0; r < 16; ++r) { const float al = wsc[crow(r, hi)]; o[0][r] *= al; o[1][r] *= al; o[2][r] *= al; o[3][r] *= al; } } \
                bf16x8 pa0, pa1, pa2, pa3; PK4(p0, 0, pa0); PK4(p0, 8, pa1); PK4(p1, 0, pa2); PK4(p1, 8, pa3); \
                    pv_tile(o, vb0, pa0, pa1, pa2, pa3); } \
        } \
          \
        { const int ahead = io.t_hi - 2 - T_; \
          if (DEPTH >= 3 && ahead >= 2) asm volatile("s_waitcnt vmcnt(%0)" :: "n"(2 * PER) : "memory"); \
          else if (DEPTH >= 2 && ahead >= 1) asm volatile("s_waitcnt vmcnt(%0)" :: "n"(PER) : "memory"); \
          else asm volatile("s_waitcnt vmcnt(0)" ::: "memory"); } \
        asm volatile("s_waitcnt lgkmcnt(0)" ::: "memory"); __builtin_amdgcn_s_barrier(); asm volatile("" ::: "memory"); } while (0)

    constexpr int PER = NEEDV ? 4 : 2;
#pragma unroll
    for (int d0 = 0; d0 < 8; ++d0) asm volatile("" :: "v"(qr[d0]));
    asm volatile("" :: "v"(io.mlo), "v"(io.mhi), "v"(io.q));
#pragma unroll
    for (int d = 0; d < DEPTH; ++d) if (io.t_lo + d < io.t_hi) A_DMA(io.t_lo + d, d);
    {   const int ahead = io.t_hi - 1 - io.t_lo;
        if (DEPTH >= 3 && ahead >= 2) asm volatile("s_waitcnt vmcnt(%0)" :: "n"(2 * PER) : "memory");
        else if (DEPTH >= 2 && ahead >= 1) asm volatile("s_waitcnt vmcnt(%0)" :: "n"(PER) : "memory");
        else asm volatile("s_waitcnt vmcnt(0)" ::: "memory"); }
    asm volatile("s_waitcnt lgkmcnt(0)" ::: "memory"); __builtin_amdgcn_s_barrier(); asm volatile("" ::: "memory");
#pragma unroll 1
    for (int T = io.t_lo; T < io.t_hi; ++T) A_STEP(T);
#undef A_DMA
#undef A_STEP
}

template <int MODE>
__device__ __forceinline__ void attn_pass_pipe(ldsp lds, LAS float* wsc, const bf16x8 (&qr)[8], const AttnIO& io, f32x16 (&o)[4], float& m_reg, float& l_reg) {
    constexpr int NB = 4, PER = 4;
    const int tid = otid(), lane = tid & 63, r32 = lane & 31, hi = lane >> 5;
    ldsp V_lds = lds; ldsp K_lds = lds + NB * SHM_T;
    const int vbase = (int)(unsigned)(uintptr_t)V_lds + v_rd_base(lane);
    const int wv = __builtin_amdgcn_readfirstlane(tid >> 6);
    const int q0 = __builtin_amdgcn_readfirstlane(io.q - r32);
    size_t ksrc[2], vsrc[2];
#pragma unroll
    for (int i = 0; i < 2; ++i) { const int ch = wv * 2 + i;
        const int kr = ch * 4 + (lane >> 4), kc = (lane & 15) ^ (kr & 7);
        ksrc[i] = (size_t)kr * io.pitch + kc * 8;
        const int sub = ch * 2 + (lane >> 5), kk = (sub >> 2) * 8 + ((lane & 31) >> 2), vk = (kk & ~0xC) | ((kk & 4) << 1) | ((kk & 8) >> 1), vc = (sub & 3) * 32 + (lane & 3) * 8;
        vsrc[i] = (size_t)vk * io.pitch + vc; }
#define P_DMA(T, bf) do { const size_t t0_ = (size_t)((T) * 64) * io.pitch; \
        _Pragma("unroll") for (int i = 0; i < 2; ++i) { \
            glds16((const void*)(io.Kg + t0_ + ksrc[i]), (unsigned)(uintptr_t)(K_lds + (bf) * SHM_T + (wv * 2 + i) * 1024)); \
            glds16((const void*)(io.Vg + t0_ + vsrc[i]), (unsigned)(uintptr_t)(V_lds + (bf) * SHM_T + (wv * 2 + i) * 1024)); } } while (0)
#define P_STEP(C0, C1, N0, N1, T) do { \
        const int T_ = (T); const int vb0 = vbase + ((T_ - io.t_lo) & 3) * SHM_T; \
        if (T_ + 3 < io.t_hi) P_DMA(T_ + 3, (T_ + 3 - io.t_lo) & 3); \
        if (T_ + 1 < io.t_hi) qkt(N0, N1, K_lds + ((T_ + 1 - io.t_lo) & 3) * SHM_T, r32, hi, qr); \
        __builtin_amdgcn_sched_barrier(0); \
        bool on = true, edge; int dq = io.q - T_ * 64 - 4 * hi; unsigned W = 0x7fffffffu; \
        if (MODE == AM_MOBA) { const int blk = T_ >> 2; edge = (blk == io.own); on = edge || ((io.mlo >> blk) & 1u); } \
        else if (MODE == AM_SEL) { const unsigned bit = (T_ < 32) ? ((io.mlo >> T_) & 1u) : ((io.mhi >> (T_ - 32)) & 1u); edge = (T_ == io.own); on = edge || bit; } \
        else { W = 512u; edge = !((T_ * 64 + 63 <= q0) && (q0 + 31 - T_ * 64 < 512)); } \
        if (edge) { const float NEG = -__builtin_inff(); \
          _Pragma("unroll") for (int r = 0; r < 16; ++r) { const int c = (r & 3) + 8 * (r >> 2); \
              if ((unsigned)(dq - c) >= W) C0[r] = NEG; if ((unsigned)(dq - c - 32) >= W) C1[r] = NEG; } } \
        float mx[8]; \
        _Pragma("unroll") for (int r = 0; r < 8; ++r) mx[r] = fmaxf(fmaxf(C0[2 * r], C0[2 * r + 1]), fmaxf(C1[2 * r], C1[2 * r + 1])); \
        float pmax = fmaxf(fmaxf(fmaxf(mx[0], mx[1]), fmaxf(mx[2], mx[3])), fmaxf(fmaxf(mx[4], mx[5]), fmaxf(mx[6], mx[7]))); \
        pmax = on ? pmax : -__builtin_inff(); \
        pmax = half_max(pmax); \
        const float mn = fmaxf(m_reg, pmax); const float alpha = __builtin_amdgcn_exp2f((m_reg - mn) * ATT_C2); m_reg = mn; \
        const float mL = on ? -mn * ATT_C2 : -__builtin_inff(); float ps0 = 0.f, ps1 = 0.f; \
        _Pragma("unroll") for (int r = 0; r < 16; ++r) { C0[r] = __builtin_amdgcn_exp2f(fmaf(C0[r], ATT_C2, mL)); C1[r] = __builtin_amdgcn_exp2f(fmaf(C1[r], ATT_C2, mL)); ps0 += C0[r]; ps1 += C1[r]; } \
        const float ps = half_sum(ps0 + ps1); l_reg = l_reg * alpha + ps; \
        if (__any(alpha < 1.0f)) { if (hi == 0) wsc[r32] = alpha; LDS_WAIT(); \
            _Pragma("unroll") for (int r = 0; r < 16; ++r) { const float al = wsc[crow(r, hi)]; o[0][r] *= al; o[1][r] *= al; o[2][r] *= al; o[3][r] *= al; } } \
        { bf16x8 pa0, pa1, pa2, pa3; PK4(C0, 0, pa0); PK4(C0, 8, pa1); PK4(C1, 0, pa2); PK4(C1, 8, pa3); \
          pv_tile(o, vb0, pa0, pa1, pa2, pa3); } \
          \
        if (T_ + 3 < io.t_hi) asm volatile("s_waitcnt vmcnt(%0)" :: "n"(PER) : "memory"); else asm volatile("s_waitcnt vmcnt(0)" ::: "memory"); \
        asm volatile("s_waitcnt lgkmcnt(0)" ::: "memory"); __builtin_amdgcn_s_barrier(); asm volatile("" ::: "memory"); } while (0)

#pragma unroll
    for (int d0 = 0; d0 < 8; ++d0) asm volatile("" :: "v"(qr[d0]));
    asm volatile("" :: "v"(io.mlo), "v"(io.mhi), "v"(io.q));
#pragma unroll
    for (int d = 0; d < 3; ++d) if (io.t_lo + d < io.t_hi) P_DMA(io.t_lo + d, d);
    if (io.t_lo + 2 < io.t_hi) asm volatile("s_waitcnt vmcnt(%0)" :: "n"(PER) : "memory"); else asm volatile("s_waitcnt vmcnt(0)" ::: "memory");
    asm volatile("s_waitcnt lgkmcnt(0)" ::: "memory"); __builtin_amdgcn_s_barrier(); asm volatile("" ::: "memory");
    f32x16 pA0, pA1, pB0, pB1;
    qkt(pA0, pA1, K_lds, r32, hi, qr);
#pragma unroll 1
    for (int T = io.t_lo; T < io.t_hi; T += 2) {
        P_STEP(pA0, pA1, pB0, pB1, T);
        if (T + 1 < io.t_hi) P_STEP(pB0, pB1, pA0, pA1, T + 1);
    }
#undef P_DMA
#undef P_STEP
}

template <int MODE>
__device__ __forceinline__ void attn_pass_pipe2(ldsp lds, LAS float* wsc, const bf16x8 (&qr)[8], const AttnIO& io, f32x16 (&o)[4], float& m_reg, float& l_reg) {
    constexpr int NB = 4;
    const int tid = otid(), lane = tid & 63, r32 = lane & 31, hi = lane >> 5;
    ldsp V_lds = lds; ldsp K_lds = lds + NB * SHM_T;
    const int vbase = (int)(unsigned)(uintptr_t)V_lds + v_rd_base(lane);
    const int wv = __builtin_amdgcn_readfirstlane(tid >> 6);
    const bool lead = wv < 4;
    const int q0 = __builtin_amdgcn_readfirstlane(io.q - r32);
    size_t ksrc[2], vsrc[2];
#pragma unroll
    for (int i = 0; i < 2; ++i) { const int ch = wv * 2 + i;
        const int kr = ch * 4 + (lane >> 4), kc = (lane & 15) ^ (kr & 7);
        ksrc[i] = (size_t)kr * io.pitch + kc * 8;
        const int sub = ch * 2 + (lane >> 5), kk = (sub >> 2) * 8 + ((lane & 31) >> 2), vk = (kk & ~0xC) | ((kk & 4) << 1) | ((kk & 8) >> 1), vc = (sub & 3) * 32 + (lane & 3) * 8;
        vsrc[i] = (size_t)vk * io.pitch + vc; }
#define Q_DMAK(T) do { const size_t t0_ = (size_t)((T) * 64) * io.pitch; const int bf_ = ((T) - io.t_lo) & 3; \
        _Pragma("unroll") for (int i = 0; i < 2; ++i) glds16((const void*)(io.Kg + t0_ + ksrc[i]), (unsigned)(uintptr_t)(K_lds + bf_ * SHM_T + (wv * 2 + i) * 1024)); } while (0)
#define Q_DMAV(T) do { const size_t t0_ = (size_t)((T) * 64) * io.pitch; const int bf_ = ((T) - io.t_lo) & 3; \
        _Pragma("unroll") for (int i = 0; i < 2; ++i) glds16((const void*)(io.Vg + t0_ + vsrc[i]), (unsigned)(uintptr_t)(V_lds + bf_ * SHM_T + (wv * 2 + i) * 1024)); } while (0)
#define Q_QKT(N0, N1, T_) do { if ((T_) + 1 < io.t_hi) qkt(N0, N1, K_lds + (((T_) + 1 - io.t_lo) & 3) * SHM_T, r32, hi, qr); __builtin_amdgcn_sched_barrier(0); } while (0)
#define Q_PV(TT) do { pv_tile(o, vbase + (((TT) - io.t_lo) & 3) * SHM_T, pa0, pa1, pa2, pa3); __builtin_amdgcn_sched_barrier(0); } while (0)
#define Q_SOFTMAX(C0, C1, T_) do { \
        bool on = true, edge; int dq = io.q - (T_) * 64 - 4 * hi; unsigned W = 0x7fffffffu; \
        if (MODE == AM_MOBA) { const int blk = (T_) >> 2; edge = (blk == io.own); on = edge || ((io.mlo >> blk) & 1u); } \
        else if (MODE == AM_SEL) { const unsigned bit = ((T_) < 32) ? ((io.mlo >> (T_)) & 1u) : ((io.mhi >> ((T_) - 32)) & 1u); edge = ((T_) == io.own); on = edge || bit; } \
        else { W = 512u; edge = !(((T_) * 64 + 63 <= q0) && (q0 + 31 - (T_) * 64 < 512)); } \
        if (edge) { const float NEG = -__builtin_inff(); \
          _Pragma("unroll") for (int r = 0; r < 16; ++r) { const int c = (r & 3) + 8 * (r >> 2); \
              if ((unsigned)(dq - c) >= W) C0[r] = NEG; if ((unsigned)(dq - c - 32) >= W) C1[r] = NEG; } } \
        float mx[8]; \
        _Pragma("unroll") for (int r = 0; r < 8; ++r) mx[r] = fmaxf(fmaxf(C0[2 * r], C0[2 * r + 1]), fmaxf(C1[2 * r], C1[2 * r + 1])); \
        float pmax = fmaxf(fmaxf(fmaxf(mx[0], mx[1]), fmaxf(mx[2], mx[3])), fmaxf(fmaxf(mx[4], mx[5]), fmaxf(mx[6], mx[7]))); \
        pmax = on ? pmax : -__builtin_inff(); \
        pmax = half_max(pmax); \
          \
        const bool upd = __any((pmax - m_reg) * ATT_C2 > ATT_DEFER); float alpha = 1.0f; \
        if (upd) { const float mn = fmaxf(m_reg, pmax); alpha = __builtin_amdgcn_exp2f((m_reg - mn) * ATT_C2); m_reg = mn; } \
        const float mL = on ? -m_reg * ATT_C2 : -__builtin_inff(); float ps0 = 0.f, ps1 = 0.f; \
        _Pragma("unroll") for (int r = 0; r < 16; ++r) { C0[r] = __builtin_amdgcn_exp2f(fmaf(C0[r], ATT_C2, mL)); C1[r] = __builtin_amdgcn_exp2f(fmaf(C1[r], ATT_C2, mL)); ps0 += C0[r]; ps1 += C1[r]; } \
        const float ps = half_sum(ps0 + ps1); l_reg = l_reg * alpha + ps; \
        if (upd) { if (hi == 0) wsc[r32] = alpha; LDS_WAIT(); \
            _Pragma("unroll") for (int r = 0; r < 16; ++r) { const float al = wsc[crow(r, hi)]; o[0][r] *= al; o[1][r] *= al; o[2][r] *= al; o[3][r] *= al; } } \
        PK4(C0, 0, pa0); PK4(C0, 8, pa1); PK4(C1, 0, pa2); PK4(C1, 8, pa3); __builtin_amdgcn_sched_barrier(0); } while (0)
#define Q_STEP(C0, C1, N0, N1, T) do { \
        const int T_ = (T); \
        if (T_ + 3 < io.t_hi) Q_DMAK(T_ + 3); \
        if (T_ + 2 < io.t_hi) Q_DMAV(T_ + 2); \
        if (!lead && T_ > io.t_lo) Q_PV(T_ - 1); \
        Q_QKT(N0, N1, T_); Q_SOFTMAX(C0, C1, T_); \
        if (lead) Q_PV(T_); \
          \
        { const int nk = (T_ + 3 < io.t_hi) ? 2 : 0, nv = (T_ + 2 < io.t_hi) ? 2 : 0; \
          if (nk + nv == 4) asm volatile("s_waitcnt vmcnt(4)" ::: "memory"); else if (nk + nv == 2) asm volatile("s_waitcnt vmcnt(2)" ::: "memory"); else asm volatile("s_waitcnt vmcnt(0)" ::: "memory"); } \
        asm volatile("s_waitcnt lgkmcnt(0)" ::: "memory"); __builtin_amdgcn_s_barrier(); asm volatile("" ::: "memory"); } while (0)

#pragma unroll
    for (int d0 = 0; d0 < 8; ++d0) asm volatile("" :: "v"(qr[d0]));
    asm volatile("" :: "v"(io.mlo), "v"(io.mhi), "v"(io.q));
    Q_DMAK(io.t_lo); Q_DMAV(io.t_lo);
    if (io.t_lo + 1 < io.t_hi) { Q_DMAK(io.t_lo + 1); Q_DMAV(io.t_lo + 1); }
    if (io.t_lo + 2 < io.t_hi) Q_DMAK(io.t_lo + 2);
    { const int young = ((io.t_lo + 1 < io.t_hi) ? 2 : 0) + ((io.t_lo + 2 < io.t_hi) ? 2 : 0);
      if (young == 4) asm volatile("s_waitcnt vmcnt(4)" ::: "memory"); else if (young == 2) asm volatile("s_waitcnt vmcnt(2)" ::: "memory"); else asm volatile("s_waitcnt vmcnt(0)" ::: "memory"); }
    asm volatile("s_waitcnt lgkmcnt(0)" ::: "memory"); __builtin_amdgcn_s_barrier(); asm volatile("" ::: "memory");
    f32x16 pA0, pA1, pB0, pB1; bf16x8 pa0, pa1, pa2, pa3;
    pa0 = pa1 = pa2 = pa3 = (bf16x8){0, 0, 0, 0, 0, 0, 0, 0};
    qkt(pA0, pA1, K_lds, r32, hi, qr);
#pragma unroll 1
    for (int T = io.t_lo; T < io.t_hi; T += 2) {
        Q_STEP(pA0, pA1, pB0, pB1, T);
        if (T + 1 < io.t_hi) Q_STEP(pB0, pB1, pA0, pA1, T + 1);
    }
    if (!lead) Q_PV(io.t_hi - 1);
#undef Q_DMAK
#undef Q_DMAV
#undef Q_QKT
#undef Q_PV
#undef Q_SOFTMAX
#undef Q_STEP
}

__device__ __forceinline__ void load_q(bf16x8 (&qr)[8], const bf16_t* qrow, int hi) {
#pragma unroll
    for (int d0 = 0; d0 < 8; ++d0) qr[d0] = *(const bf16x8*)(qrow + d0 * 16 + hi * 8);
}


__device__ __forceinline__ float dpp_xor1(float v) { return __int_as_float(__builtin_amdgcn_mov_dpp(__float_as_int(v), 0xB1, 0xF, 0xF, true)); }
__device__ __forceinline__ void store_o_bf16(const f32x16 (&o)[4], const LAS float* wsc, bf16_t* dst, size_t pitch, int r32, int hi) {
    float sc[16];
#pragma unroll
    for (int r = 0; r < 16; ++r) sc[r] = wsc[crow(r, hi)];
    asm volatile("" : "+v"(sc[0]), "+v"(sc[1]), "+v"(sc[2]), "+v"(sc[3]), "+v"(sc[4]), "+v"(sc[5]), "+v"(sc[6]), "+v"(sc[7]));
    asm volatile("" : "+v"(sc[8]), "+v"(sc[9]), "+v"(sc[10]), "+v"(sc[11]), "+v"(sc[12]), "+v"(sc[13]), "+v"(sc[14]), "+v"(sc[15]));
#pragma unroll
    for (int d0 = 0; d0 < 4; ++d0) { unsigned pk[16];
#pragma unroll
        for (int r = 0; r < 16; ++r) { const float v = o[d0][r] * sc[r]; pk[r] = cvtpk(v, dpp_xor1(v)); }
        if ((r32 & 1) == 0) {
#pragma unroll
            for (int r = 0; r < 16; ++r) *(unsigned*)(dst + (size_t)crow(r, hi) * pitch + d0 * 32 + r32) = pk[r]; }
        __builtin_amdgcn_sched_barrier(0); }
}

constexpr int MB_Q = 0, MB_KM = 69632, MB_GT = 77824, MB_SELM = 131072, MB_WSC = 132096;
__device__ __forceinline__ void moba_gate(ldsp lds, unsigned char* ws, int unit) {
    const int qb = unit & 15, h = (unit >> 4) & 7, b = unit >> 7;
    const bf16_t* proj = (const bf16_t*)(ws + WS_PROJ);
    const int tid = otid();
    LAS float* KM = (LAS float*)(lds + MB_KM);
    LAS float* GT = (LAS float*)(lds + MB_GT);
    LAS unsigned* SELM = (LAS unsigned*)(lds + MB_SELM);
    const size_t row0 = (size_t)b * SEQ + (size_t)qb * 256;
    const float* km = (const float*)(ws + SM_KMEAN) + (size_t)((b * 8 + h) * 16) * 128;
    {   u32x4 qw[8]; float kw[4];
#pragma unroll
        for (int i = 0; i < 8; ++i) { const int c = tid + 512 * i; qw[i] = *(const u32x4*)(proj + (row0 + (c >> 4)) * NP + C_MQ + h * 128 + (c & 15) * 8); }
#pragma unroll
        for (int i = 0; i < 4; ++i) kw[i] = km[tid + 512 * i];
#pragma unroll
        for (int i = 0; i < 8; ++i) { const int c = tid + 512 * i; *(LAS u32x4*)(lds + MB_Q + (c >> 4) * P272 + (c & 15) * 16) = qw[i]; }
#pragma unroll
        for (int i = 0; i < 4; ++i) KM[tid + 512 * i] = kw[i]; }
    __syncthreads();
    const int ql = tid >> 1, n0 = (tid & 1) * 8;
    float acc[8] = {0, 0, 0, 0, 0, 0, 0, 0};
    if (n0 < qb) {
#pragma unroll 2
        for (int i = 0; i < 16; ++i) { float qf[8]; unpack8(*(const LAS u32x4*)(lds + MB_Q + ql * P272 + i * 16), qf); const int d = 8 * i;
#pragma unroll
            for (int n = 0; n < 8; ++n) { const f32x4 k0 = *(const LAS f32x4*)(KM + (n0 + n) * 128 + d), k1 = *(const LAS f32x4*)(KM + (n0 + n) * 128 + d + 4);
                acc[n] += (qf[0] * k0.x + qf[1] * k0.y) + (qf[2] * k0.z + qf[3] * k0.w) + (qf[4] * k1.x + qf[5] * k1.y) + (qf[6] * k1.z + qf[7] * k1.w); } } }
#pragma unroll
    for (int n = 0; n < 8; ++n) GT[ql * 16 + n0 + n] = acc[n];
    __syncthreads();
    if (tid < 256) { unsigned m = 0u;
        if (qb <= 3) m = (1u << qb) - 1u;
        else { float g[16];
#pragma unroll
            for (int n = 0; n < 16; ++n) g[n] = (n < qb) ? GT[tid * 16 + n] : -__builtin_inff();
#pragma unroll
            for (int pick = 0; pick < 3; ++pick) { float best = -__builtin_inff(); int bi = 0;
#pragma unroll
                for (int n = 0; n < 16; ++n) { const bool tk = g[n] > best; best = tk ? g[n] : best; bi = tk ? n : bi; }
                m |= 1u << bi;
#pragma unroll
                for (int n = 0; n < 16; ++n) g[n] = (n == bi) ? -__builtin_inff() : g[n]; } }
        SELM[tid] = m; }
    __syncthreads();
}
__device__ NOINL void moba_unit(ldsp lds, int unit) {
    unsigned char* ws = ows();
    moba_gate(lds, ws, unit);
    f32x16 o[4] = {}; float m_reg = -1e30f, l_reg = 0.f;
    {   const int qb = unit & 15, h = (unit >> 4) & 7, b = unit >> 7;
        const bf16_t* proj = (const bf16_t*)(ws + WS_PROJ);
        const int tid = otid(), lane = tid & 63, wave = __builtin_amdgcn_readfirstlane(tid >> 6), r32 = lane & 31, hi = lane >> 5;
        const size_t row0 = (size_t)b * SEQ + (size_t)qb * 256;
        bf16x8 qr[8]; load_q(qr, proj + (row0 + wave * 32 + r32) * NP + C_MQ + h * 128, hi);
        AttnIO io; io.Kg = proj + (size_t)b * SEQ * NP + C_MK + h * 128; io.Vg = proj + (size_t)b * SEQ * NP + C_MV + h * 128; io.pitch = NP;
        io.t_lo = 0; io.t_hi = 4 * qb + 4; io.q = qb * 256 + wave * 32 + r32; io.own = qb; io.mlo = ((LAS unsigned*)(lds + MB_SELM))[wave * 32 + r32]; io.mhi = 0u;
        attn_pass_pipe2<AM_MOBA>(lds, (LAS float*)(lds + MB_WSC) + wave * 64, qr, io, o, m_reg, l_reg);
    }
    {   int u2 = unit; OPQ_S(u2); const int tz = otid();
        const int qb = u2 & 15, h = (u2 >> 4) & 7, b = u2 >> 7;
        const int lane = tz & 63, wave = __builtin_amdgcn_readfirstlane(tz >> 6), r32 = lane & 31, hi = lane >> 5;
        LAS float* wsc = (LAS float*)(lds + MB_WSC) + wave * 64;
        const size_t row0 = (size_t)b * SEQ + (size_t)qb * 256;
        if (hi == 0) wsc[r32] = 1.0f / l_reg;
        LDS_WAIT();
        store_o_bf16(o, wsc, (bf16_t*)(ws + WS_Y) + (row0 + wave * 32) * DM + 1024 + h * 128, DM, r32, hi);
    }
    __syncthreads();
}

constexpr int NS_IMP = 65536, NS_SELM = 131072, NS_GATE = 131584, NS_WSC = 135680;
struct NsaIdx { int qt, kvh, b, lane, wave, r32, hi, hl, qh, hh, qloc, qpos; size_t row0; };
__device__ __forceinline__ NsaIdx nsa_idx(int unit, int tid) {
    NsaIdx x; x.qt = unit & 63; x.kvh = (unit >> 6) & 1; x.b = unit >> 7; x.lane = tid & 63; x.wave = __builtin_amdgcn_readfirstlane(tid >> 6); x.r32 = x.lane & 31; x.hi = x.lane >> 5;
    x.hl = x.wave >> 1; x.qh = x.wave & 1; x.hh = x.kvh * 4 + x.hl; x.qloc = x.qh * 32 + x.r32; x.qpos = x.qt * 64 + x.qloc; x.row0 = (size_t)x.b * SEQ + (size_t)x.qt * 64; return x;
}
__device__ NOINL void nsa_cmp_branch(ldsp lds, int unit) {
    unsigned char* ws = ows();
    f32x16 o[4]; float m_reg = -1e30f, l_reg = 0.f;
#pragma unroll
    for (int d = 0; d < 4; ++d) o[d] = f32x16{};
    {   const NsaIdx x = nsa_idx(unit, otid());
        const bf16_t* proj = (const bf16_t*)(ws + WS_PROJ);
        LAS float* GATEL = (LAS float*)(lds + NS_GATE);
        if (x.hi == 0) {
#pragma unroll
            for (int br = 0; br < 3; ++br) GATEL[(x.wave * 32 + x.r32) * 4 + br] = sigmoidf_(bf2f(proj[(x.row0 + x.qloc) * NP + C_NGATE + x.hh * 3 + br])); }
        bf16x8 qr[8]; load_q(qr, proj + (x.row0 + x.qloc) * NP + C_NQ + x.hh * 128, x.hi);
        AttnIO io; io.pitch = 128; io.own = 0; io.mlo = 0u; io.mhi = 0u;
        io.Kg = (const bf16_t*)(ws + SM_KC) + (size_t)(x.b * 2 + x.kvh) * 256 * 128; io.Vg = (const bf16_t*)(ws + SM_VC) + (size_t)(x.b * 2 + x.kvh) * 256 * 128;
        io.t_lo = 0; io.t_hi = ((4 * x.qt + 2) >> 6) + 1; io.q = (x.qpos >= 31) ? ((x.qpos - 31) >> 4) : -1;
        LAS float* wsc = (LAS float*)(lds + NS_WSC) + x.wave * 64;
        attn_pass<AM_CSTAT, 2>(lds, wsc, qr, io, o, m_reg, l_reg, 0.f, nullptr);
        const float inv_l = (l_reg > 0.f) ? 1.0f / l_reg : 0.f;
        attn_pass<AM_COUT, 2>(lds, wsc, qr, io, o, m_reg, l_reg, inv_l, (LAS float*)(lds + NS_IMP) + (x.hl * 64 + x.qloc) * 64);
    }
    {   int u2 = unit; OPQ_S(u2); const int tz = otid();
        const NsaIdx x = nsa_idx(u2, tz);
        const LAS float* GATEL = (const LAS float*)(lds + NS_GATE);
        float* accp = (float*)(ws + WS_NSAACC) + (x.row0 + x.qh * 32) * 1024 + x.hh * 128;
        LDS_WAIT();
        float g0[16];
#pragma unroll
        for (int r = 0; r < 16; ++r) g0[r] = GATEL[(x.wave * 32 + crow(r, x.hi)) * 4 + 0];
        asm volatile("" : "+v"(g0[0]), "+v"(g0[1]), "+v"(g0[2]), "+v"(g0[3]), "+v"(g0[4]), "+v"(g0[5]), "+v"(g0[6]), "+v"(g0[7]));
        asm volatile("" : "+v"(g0[8]), "+v"(g0[9]), "+v"(g0[10]), "+v"(g0[11]), "+v"(g0[12]), "+v"(g0[13]), "+v"(g0[14]), "+v"(g0[15]));
#pragma unroll
        for (int r = 0; r < 16; ++r) { const int row = crow(r, x.hi);
#pragma unroll
            for (int d0 = 0; d0 < 4; ++d0) accp[(size_t)row * 1024 + d0 * 32 + x.r32] = g0[r] * o[d0][r]; }
    }
    __syncthreads();
    {   int u2 = unit; OPQ_S(u2); const int tid = otid();
        const int qt = u2 & 63;
        LAS float* IMP = (LAS float*)(lds + NS_IMP); LAS unsigned* SELM = (LAS unsigned*)(lds + NS_SELM);
        const int q = tid >> 3, jg = tid & 7;
        float v[8];
#pragma unroll
        for (int xx = 0; xx < 8; ++xx) { const int j = jg * 8 + xx; v[xx] = (IMP[(0 * 64 + q) * 64 + j] + IMP[(1 * 64 + q) * 64 + j]) + (IMP[(2 * 64 + q) * 64 + j] + IMP[(3 * 64 + q) * 64 + j]);
            if (j > qt) v[xx] = -__builtin_inff();
            if (j == 0 || j == qt || j == qt - 1) v[xx] = __builtin_inff(); }
        __syncthreads();
#pragma unroll
        for (int xx = 0; xx < 8; ++xx) IMP[q * 64 + jg * 8 + xx] = v[xx];
        __syncthreads();
        int rank[8] = {0, 0, 0, 0, 0, 0, 0, 0};
        for (int j2 = 0; j2 < 64; ++j2) { const float w = IMP[q * 64 + j2];
#pragma unroll
            for (int xx = 0; xx < 8; ++xx) { const int j = jg * 8 + xx; rank[xx] += (w > v[xx] || (w == v[xx] && j2 < j)) ? 1 : 0; } }
        unsigned bits = 0u;
#pragma unroll
        for (int xx = 0; xx < 8; ++xx) bits |= (rank[xx] < 16) ? (1u << xx) : 0u;
        unsigned lo = (jg < 4) ? (bits << (8 * jg)) : 0u, hiw = (jg >= 4) ? (bits << (8 * (jg - 4))) : 0u;
        lo |= __shfl_xor(lo, 1); lo |= __shfl_xor(lo, 2); lo |= __shfl_xor(lo, 4);
        hiw |= __shfl_xor(hiw, 1); hiw |= __shfl_xor(hiw, 2); hiw |= __shfl_xor(hiw, 4);
        if (jg == 0) { SELM[q * 2] = lo; SELM[q * 2 + 1] = hiw; }
        __syncthreads();
    }
}
template <int BR>
__device__ NOINL void nsa_attn_branch(ldsp lds, int unit) {
    unsigned char* ws = ows();
    f32x16 o[4]; float m_reg = -1e30f, l_reg = 0.f;
#pragma unroll
    for (int d = 0; d < 4; ++d) o[d] = f32x16{};
    {   const NsaIdx x = nsa_idx(unit, otid());
        const bf16_t* proj = (const bf16_t*)(ws + WS_PROJ);
        bf16x8 qr[8]; load_q(qr, proj + (x.row0 + x.qloc) * NP + C_NQ + x.hh * 128, x.hi);
        AttnIO io; io.pitch = NP; io.q = x.qpos; io.t_hi = x.qt + 1;
        const LAS unsigned* SELM = (const LAS unsigned*)(lds + NS_SELM);
        LAS float* wsc = (LAS float*)(lds + NS_WSC) + x.wave * 64;
        if (BR == 1) { io.Kg = proj + (size_t)x.b * SEQ * NP + C_NKS + x.kvh * 128; io.Vg = proj + (size_t)x.b * SEQ * NP + C_NVS + x.kvh * 128;
            io.t_lo = 0; io.own = x.qt; io.mlo = SELM[x.qloc * 2]; io.mhi = SELM[x.qloc * 2 + 1];
            attn_pass_pipe2<AM_SEL>(lds, wsc, qr, io, o, m_reg, l_reg); }
        else { io.Kg = proj + (size_t)x.b * SEQ * NP + C_NKW + x.kvh * 128; io.Vg = proj + (size_t)x.b * SEQ * NP + C_NVW + x.kvh * 128;
            io.t_lo = (x.qt >= 8) ? x.qt - 8 : 0; io.own = 0; io.mlo = 0u; io.mhi = 0u;
#ifndef PROBE_WINREP
#define PROBE_WINREP 1
#endif
            int nrep = PROBE_WINREP; OPQ_S(nrep);
#pragma unroll 1
            for (int rp = 0; rp < nrep; ++rp) {
#pragma unroll
                for (int d = 0; d < 4; ++d) o[d] = f32x16{};
                m_reg = -1e30f; l_reg = 0.f;
                attn_pass_pipe2<AM_WIN>(lds, wsc, qr, io, o, m_reg, l_reg); } }
    }
    {   int u2 = unit; OPQ_S(u2); const int tz = otid();
        const NsaIdx x = nsa_idx(u2, tz);
        const LAS float* GATEL = (const LAS float*)(lds + NS_GATE);
        LAS float* wsc = (LAS float*)(lds + NS_WSC) + x.wave * 64;
        float* accp = (float*)(ws + WS_NSAACC) + (x.row0 + x.qh * 32) * 1024 + x.hh * 128;
        if (x.hi == 0) wsc[32 + x.r32] = GATEL[(x.wave * 32 + x.r32) * 4 + BR] / l_reg;
        LDS_WAIT();
        if (BR == 1) {
            float pv[4][16];
#pragma unroll
            for (int d0 = 0; d0 < 4; ++d0)
#pragma unroll
                for (int r = 0; r < 16; ++r) pv[d0][r] = accp[(size_t)crow(r, x.hi) * 1024 + d0 * 32 + x.r32];
            asm volatile("" ::: "memory");
#pragma unroll
            for (int d0 = 0; d0 < 4; ++d0)
#pragma unroll
                for (int r = 0; r < 16; ++r) { const int row = crow(r, x.hi); accp[(size_t)row * 1024 + d0 * 32 + x.r32] = pv[d0][r] + wsc[32 + row] * o[d0][r]; } }
        else { bf16_t* yp = (bf16_t*)(ws + WS_Y) + (x.row0 + x.qh * 32) * DM + 3072 + x.hh * 128;
            float sc[16];
#pragma unroll
            for (int r = 0; r < 16; ++r) sc[r] = wsc[32 + crow(r, x.hi)];
            asm volatile("" : "+v"(sc[0]), "+v"(sc[1]), "+v"(sc[2]), "+v"(sc[3]), "+v"(sc[4]), "+v"(sc[5]), "+v"(sc[6]), "+v"(sc[7]));
            asm volatile("" : "+v"(sc[8]), "+v"(sc[9]), "+v"(sc[10]), "+v"(sc[11]), "+v"(sc[12]), "+v"(sc[13]), "+v"(sc[14]), "+v"(sc[15]));
#pragma unroll
            for (int d0 = 0; d0 < 4; ++d0)
#pragma unroll
                for (int r = 0; r < 16; ++r) o[d0][r] *= sc[r];
            float pv[4][16];
#pragma unroll
            for (int d0 = 0; d0 < 4; ++d0)
#pragma unroll
                for (int r = 0; r < 16; ++r) pv[d0][r] = accp[(size_t)crow(r, x.hi) * 1024 + d0 * 32 + x.r32];
            asm volatile("" ::: "memory");
#pragma unroll
            for (int d0 = 0; d0 < 4; ++d0) { unsigned pk[16];
#pragma unroll
                for (int r = 0; r < 16; ++r) { const float v = pv[d0][r] + o[d0][r]; pk[r] = cvtpk(v, dpp_xor1(v)); }
                if ((x.r32 & 1) == 0) {
#pragma unroll
                    for (int r = 0; r < 16; ++r) *(unsigned*)(yp + (size_t)crow(r, x.hi) * DM + d0 * 32 + x.r32) = pk[r]; }
                __builtin_amdgcn_sched_barrier(0); } }
    }
    __syncthreads();
}

__device__ __forceinline__ void s3_phase(ldsp lds, int layer) {
    int G = gridDim.x, bid = blockIdx.x; OPQ_S(G); OPQ_S(bid);
#ifndef S3_MASK
#define S3_MASK 0x3f
#endif
#ifndef S3_DUP
#define S3_DUP 0
#endif
#define S3REP(b) _Pragma("unroll 1") for (int r3_ = 0; r3_ < 1 + ((S3_DUP >> (b)) & 1); ++r3_)
    for (int u = bid; u < 256; u += G) {
        const int x = u & 7, slot = u >> 3, qbm = slot & 15;
        const int mu = (G == 256) ? ((2 * x + (slot >> 4)) * 16 + qbm) : u;
        if (S3_MASK & 1) S3REP(0) moba_unit(lds, mu); }
    for (int u = bid; u < 256; u += G) {
        int nu;
        if (G == 256) { const int x = u & 7, slot = u >> 3, qbm = slot & 15, r = 2 * (x & 1) + (slot >> 4); nu = (x >> 1) * 64 + (63 - 4 * qbm - r); }
        else { const int qbm = u & 15, bh = u >> 4; nu = (bh >> 2) * 64 + (63 - 4 * qbm - (bh & 3)); }
        if (S3_MASK & 2) S3REP(1) nsa_cmp_branch(lds, nu); if (S3_MASK & 4) S3REP(2) nsa_attn_branch<1>(lds, nu); if (S3_MASK & 8) S3REP(3) nsa_attn_branch<2>(lds, nu); }
    if (S3_MASK & 16) S3REP(4) for (int u = bid; u < 512; u += G) ret_out_unit(lds, layer, u);
    if (S3_MASK & 32) S3REP(5) for (int u = bid; u < 128; u += G) lru_out_unit(lds, u);
}

constexpr int N_PHASES = 16;
struct Args { const float* in[23]; float* out; unsigned char* ws; int ph_lo, ph_hi, li, pad; };
template <class Epi>
__device__ NOINL void gemm_call(ldsp lds, const bf16_t* A, const bf16_t* Bt, int N, int K, Epi E) {
    pg8::Gemm g{A, Bt, MTOK, N, K}; pg8::StaticOrder S; S.init(MTOK, N, (int)gridDim.x, (int)blockIdx.x);
    pg8::gemm_phase<Epi, pg8::StaticOrder, true, true>(lds, g, S, E);
}
template <class Epi>
__device__ NOINL void gemm_call_norm(ldsp lds, const bf16_t* A, const bf16_t* Bt, int N, int K, const float* ssq, Epi E, int Gg) {
    pg8::Gemm g{A, Bt, MTOK, N, K}; pg8::StaticOrder S; S.init(MTOK, N, Gg, (int)blockIdx.x);
    pg8::Unit u0; if (!S.next(0, u0)) return;
    E.fm = (u0.pm >> 3) << 3;
    pg8::epi_rstd_table(ssq, E.fm, (LAS float*)E.xl, otid());
    pg8::gemm_phase<Epi, pg8::StaticOrder, false, true>(lds, g, S, E);
}
__global__ void __launch_bounds__(NTHR, 2) trunk_fwd(Args args) {
    extern __shared__ __attribute__((aligned(16))) unsigned char lds_raw[];
    const ldsp lds = (ldsp)lds_raw;
    volatile LAS unsigned* MISC = (volatile LAS unsigned*)(lds + MISC_OFF);
    if (threadIdx.x < 64) MISC[threadIdx.x] = 0u;
    __syncthreads();
    const int lo = args.ph_lo, hi = args.ph_hi;
    unsigned char* ws = args.ws;
    XcdBarrier bar; bar.bar = (unsigned*)(ws + WS_CTL) + CW_BAR + args.li * XCD_BAR_WORDS; bar.x = 0; bar.st = nullptr;
    if (hi - lo > 1) bar = xcd_barrier_post((unsigned*)(ws + WS_CTL) + CW_BAR + args.li * XCD_BAR_WORDS, MISC + 8);
#ifndef PH_MASK
#define PH_MASK 0xfff
#endif
#define IN(k) (lo <= (k) && (k) < hi)
#define ON(b) ((PH_MASK >> (b)) & 1)
#ifndef PROBE_DUP
#define PROBE_DUP 0
#endif
#define REP(b) _Pragma("unroll 1") for (int rep_ = 0; rep_ < 1 + ((PROBE_DUP >> (b)) & 1); ++rep_)
#define SEAM(k) do { if (IN(k) && IN((k) + 1)) xcd_barrier(bar); } while (0)

    if (ON(0) && IN(0)) REP(0) p0_prologue(lds);
    SEAM(0);
    const ldsp xl = lds + 131072;
#pragma unroll
    for (int layer = 0; layer < 2; ++layer) {
        const int pb = 1 + 7 * layer;
        bf16_t* x_in = (bf16_t*)(ws + (layer == 0 ? WS_XS0 : WS_XS2)); bf16_t* x_mid = (bf16_t*)(ws + WS_XS1); bf16_t* x_out = (bf16_t*)(ws + (layer == 0 ? WS_XS2 : WS_XS0));
        float* ssqa = (float*)(ws + SM_SSQA); float* ssqb = (float*)(ws + SM_SSQB);
        if (ON(5) && IN(pb + 0)) {
            const bool split = (SPLIT_INPROJ0 && layer == 0 && gridDim.x == 256);
            if (split && (int)blockIdx.x >= GEMM0_WGS) deferred_phase(lds, GEMM0_WGS, 0, 9);
            else REP(5) gemm_call_norm(lds, x_in, (const bf16_t*)(ws + WS_WIN) + (size_t)layer * NP * DM, NP, DM, ssqa, pg8::EpiBf16N{(bf16_t*)(ws + WS_PROJ), NP, 0, xl}, split ? GEMM0_WGS : (int)gridDim.x);
        }
        SEAM(pb + 0);
        if (ON(3) && IN(pb + 1)) REP(3) s1_phase(lds, layer);
        SEAM(pb + 1);
        if (ON(3) && IN(pb + 2)) { ret_scan_phase(lds); for (int u = (int)gridDim.x - 1 - (int)blockIdx.x; u < 64; u += (int)gridDim.x) nsa_cmp2_unit(lds, layer, u); }
        SEAM(pb + 2);
        if (ON(4) && IN(pb + 3)) REP(4) s3_phase(lds, layer);
        SEAM(pb + 3);
        if (ON(6) && IN(pb + 4)) REP(6) gemm_call(lds, (const bf16_t*)(ws + WS_Y), (const bf16_t*)(ws + WS_WOUT) + (size_t)layer * DM * DM, DM, DM, pg8::EpiResidB{x_in, x_mid, DM, ssqb, xl});
        SEAM(pb + 4);
        if (ON(7) && IN(pb + 5)) {
            const bool split = (SPLIT_GU0 && layer == 0 && gridDim.x == 256);
            if (split && (int)blockIdx.x >= GU0_WGS) deferred_phase(lds, GU0_WGS, 4, 9);
            else REP(7) gemm_call_norm(lds, x_mid, (const bf16_t*)(ws + WS_WGU) + (size_t)layer * NGU * DM, NGU, DM, ssqb, pg8::EpiSwiGLUN{(bf16_t*)(ws + WS_U), DFF, 0, xl}, split ? GU0_WGS : (int)gridDim.x);
        }
        SEAM(pb + 5);
        if (ON(8) && IN(pb + 6)) REP(8) gemm_call(lds, (const bf16_t*)(ws + WS_U), (const bf16_t*)(ws + WS_WDN) + (size_t)layer * DM * DFF, DM, DFF, pg8::EpiResidB{x_mid, x_out, DM, ssqa, xl});
        SEAM(pb + 6);
    }
    if (ON(1) && IN(15)) final_norm_phase(lds, (const bf16_t*)(ws + WS_XS0), (const float*)(ws + SM_SSQA), inp(22), args.out);
#undef IN
#undef SEAM
}

extern "C" void kernel_launch(void* const* d_in, const int* in_sizes, int n_in, void* d_out, int out_size, void* d_ws, size_t ws_size, hipStream_t stream) {
    static int grid = 0;
    if (grid == 0) {
        if (n_in != 23 || in_sizes[0] != MTOK * DM || out_size != MTOK * DM || ws_size < WS_END) {
            fprintf(stderr, "kernel_launch: unexpected shapes (n_in %d, in0 %d, out %d, ws %zu < %zu); nothing launched\n", n_in, n_in > 0 ? in_sizes[0] : -1, out_size, ws_size, (size_t)WS_END); grid = -1; return; }
        int dev = 0, cus = 0, per_cu = 0;
        if (hipGetDevice(&dev) != hipSuccess || hipDeviceGetAttribute(&cus, hipDeviceAttributeMultiprocessorCount, dev) != hipSuccess) { fprintf(stderr, "kernel_launch: device query failed\n"); grid = -1; return; }
        if (hipFuncSetAttribute((const void*)trunk_fwd, hipFuncAttributeMaxDynamicSharedMemorySize, LDS_BYTES) != hipSuccess) { fprintf(stderr, "kernel_launch: hipFuncSetAttribute(%d B LDS) failed\n", LDS_BYTES); grid = -1; return; }
        if (hipOccupancyMaxActiveBlocksPerMultiprocessor(&per_cu, (const void*)trunk_fwd, NTHR, LDS_BYTES) != hipSuccess || per_cu < 1)
            fprintf(stderr, "kernel_launch: note: occupancy query reports %d workgroups per CU\n", per_cu);
        (void)hipGetLastError();
        grid = cus;
    }
    if (grid < 0) return;
    if (hipMemsetAsync((char*)d_ws + WS_CTL, 0, CTL_ZERO_BYTES, stream) != hipSuccess) { fprintf(stderr, "kernel_launch: memset failed\n"); return; }
    Args a{};
    for (int i = 0; i < 23; ++i) a.in[i] = (const float*)d_in[i];
    a.out = (float*)d_out; a.ws = (unsigned char*)d_ws; a.pad = 0;
#if MK_LAUNCHES == 1
    a.ph_lo = 0; a.ph_hi = N_PHASES; a.li = 0;
    hipLaunchKernelGGL(trunk_fwd, dim3(grid), dim3(NTHR), LDS_BYTES, stream, a);
#else
    for (int k = 0; k < N_PHASES; ++k) { a.ph_lo = k; a.ph_hi = k + 1; a.li = k;
        hipLaunchKernelGGL(trunk_fwd, dim3(grid), dim3(NTHR), LDS_BYTES, stream, a); }
#endif
    const hipError_t le = hipPeekAtLastError();
    if (le != hipSuccess) fprintf(stderr, "kernel_launch: launch failed: %s (grid %d)\n", hipGetErrorName(le), grid);
}
```

```cpp
#include <hip/hip_runtime.h>
#include <cstdio>
#include <cstdint>

#ifndef GEMM_MFMA32
#define GEMM_MFMA32 0
#endif
#ifndef MK_LAUNCHES
#define MK_LAUNCHES 1
#endif

#define LAS __attribute__((address_space(3)))
#define GAS __attribute__((address_space(1)))
typedef unsigned short bf16_t;
typedef short bf16x8 __attribute__((ext_vector_type(8)));
typedef short s16x4 __attribute__((ext_vector_type(4)));
typedef float f32x2 __attribute__((ext_vector_type(2)));
typedef float f32x4 __attribute__((ext_vector_type(4)));
typedef float f32x16 __attribute__((ext_vector_type(16)));
typedef unsigned u32x2 __attribute__((ext_vector_type(2)));
typedef unsigned u32x4 __attribute__((ext_vector_type(4)));
typedef LAS unsigned char* ldsp;

namespace pg8 {
#define PG8_LAS __attribute__((address_space(3)))
constexpr int BM = 256, BK = 64, HALF = 128, HTB = HALF * BK * 2  , STAGE_BYTES = 8 * HTB, NXCD = 8, WGM = 8;

__host__ __device__ __forceinline__ int lds_byte(int r, int c) { const int st = (r >> 4) * 2 + (c >> 5), rr = r & 15, cc = c & 31, ob = rr * 64 + cc * 2; return st * 1024 + (ob ^ (((ob >> 9) & 1) << 5)); }
__host__ __device__ __forceinline__ void stage_rc(int b, int& R, int& C) { const int st = b / 1024, sb = b % 1024, swz = sb ^ (((sb >> 9) & 1) << 5); R = (st >> 1) * 16 + swz / 64; C = (st & 1) * 32 + (swz % 64) / 2; }
__host__ __device__ __forceinline__ int perm32(int rho) { const int n = rho >> 4, i = rho & 15; return 8 * (i >> 2) + 4 * n + (i & 3); }

__host__ __device__ __forceinline__ int perm32x(int rho) { return 16 * ((rho >> 2) & 1) + 4 * (rho >> 3) + (rho & 3); }
struct Unit { int pm, pn; };
struct Gemm { const bf16_t* A; const bf16_t* Bt; int M, N, K; };

struct StaticOrder {
    int nM, nN, nwg, G, c;
    __host__ __device__ void init(int M, int N, int G_, int c_) { nM = M / BM; nN = N / BM; nwg = nM * nN; G = G_; c = c_; }
    __host__ __device__ bool next(int i, Unit& u) const {
        const long L = (long)i * G + c; if (L >= nwg) return false;
        int wgid = (int)L; { const int q = nwg / NXCD, r = nwg % NXCD, xcd = wgid % NXCD, off = wgid / NXCD; wgid = (xcd < r ? xcd * (q + 1) : r * (q + 1) + (xcd - r) * q) + off; }
        const int nig = WGM * nN, gid = wgid / nig, fm = gid * WGM, gsz = (nM - fm) < WGM ? (nM - fm) : WGM;
        u.pm = fm + ((wgid % nig) % gsz); u.pn = (wgid % nig) / gsz; return true;
    }
    __device__ __forceinline__ void a_ready(const Unit&) const {}
    __device__ __forceinline__ void done(const Unit&) const {}
};

__device__ __forceinline__ unsigned cvt_pk_bf16(float lo, float hi) { unsigned r; asm volatile("v_cvt_pk_bf16_f32 %0, %1, %2" : "=v"(r) : "v"(lo), "v"(hi)); return r; }

constexpr float EPI_EPS = 1e-6f;
__device__ __forceinline__ void epi_bar() { asm volatile("s_waitcnt lgkmcnt(0)" ::: "memory"); __builtin_amdgcn_s_barrier(); asm volatile("" ::: "memory"); }
__device__ __forceinline__ void epi_rstd_table(const float* ssq, int fm, PG8_LAS float* RS, int t) {
    f32x4 v[4][4];
#pragma unroll
    for (int q = 0; q < 4; ++q) { const f32x4* p = (const f32x4*)(ssq + (size_t)(fm * BM + t + 512 * q) * 16); v[q][0] = p[0]; v[q][1] = p[1]; v[q][2] = p[2]; v[q][3] = p[3]; }
    asm volatile("" :: "v"(v[0][0]), "v"(v[0][1]), "v"(v[0][2]), "v"(v[0][3]), "v"(v[1][0]), "v"(v[1][1]), "v"(v[1][2]), "v"(v[1][3]),
                    "v"(v[2][0]), "v"(v[2][1]), "v"(v[2][2]), "v"(v[2][3]), "v"(v[3][0]), "v"(v[3][1]), "v"(v[3][2]), "v"(v[3][3]) : "memory");
#pragma unroll
    for (int q = 0; q < 4; ++q) { const int r = t + 512 * q; const f32x4 a = v[q][0], b = v[q][1], c = v[q][2], d = v[q][3];
        const float sm = ((a[0] + a[1]) + (a[2] + a[3])) + ((b[0] + b[1]) + (b[2] + b[3])) + ((c[0] + c[1]) + (c[2] + c[3])) + ((d[0] + d[1]) + (d[2] + d[3]));
        RS[r] = 1.0f / sqrtf(sm * (1.0f / 4096.0f) + EPI_EPS); }
    epi_bar();
}
#if GEMM_MFMA32
struct EpiBf16N {
    static constexpr bool PERM = true, AFTER_DRAIN = false;
    bf16_t* O; int ldc; int fm; PG8_LAS unsigned char* xl;
    __device__ __forceinline__ void operator()(const f32x16 (&acc)[2][2][2], const Unit& u, int wr, int wc, int fr, int fq) const {
        const PG8_LAS float* RS = (const PG8_LAS float*)xl + (u.pm - fm) * BM;
        const int row0 = u.pm * BM + wr * 64 + fr, col0 = u.pn * BM + wc * 32 + 16 * fq;
#pragma unroll
        for (int ai = 0; ai < 2; ++ai)
#pragma unroll
            for (int mt = 0; mt < 2; ++mt) { bf16_t* rowp = O + (size_t)(row0 + ai * HALF + mt * 32) * ldc + col0; const float rs = RS[ai * HALF + wr * 64 + mt * 32 + fr];
#pragma unroll
                for (int bj = 0; bj < 2; ++bj) { const f32x16 v = acc[ai][bj][mt] * rs;
                    u32x4 w0, w1; w0.x = cvt_pk_bf16(v[0], v[1]); w0.y = cvt_pk_bf16(v[2], v[3]); w0.z = cvt_pk_bf16(v[4], v[5]); w0.w = cvt_pk_bf16(v[6], v[7]);
                    w1.x = cvt_pk_bf16(v[8], v[9]); w1.y = cvt_pk_bf16(v[10], v[11]); w1.z = cvt_pk_bf16(v[12], v[13]); w1.w = cvt_pk_bf16(v[14], v[15]);
                    *(u32x4*)(rowp + bj * HALF) = w0; *(u32x4*)(rowp + bj * HALF + 8) = w1; } }
    }
};
struct EpiSwiGLUN {
    static constexpr bool PERM = true, AFTER_DRAIN = false;
    bf16_t* O; int ldc; int fm; PG8_LAS unsigned char* xl;
    __device__ __forceinline__ void operator()(const f32x16 (&acc)[2][2][2], const Unit& u, int wr, int wc, int fr, int fq) const {
        const PG8_LAS float* RS = (const PG8_LAS float*)xl + (u.pm - fm) * BM;
        const int row0 = u.pm * BM + wr * 64 + fr, col0 = u.pn * HALF + wc * 32 + 16 * fq;
#pragma unroll
        for (int ai = 0; ai < 2; ++ai)
#pragma unroll
            for (int mt = 0; mt < 2; ++mt) { bf16_t* rowp = O + (size_t)(row0 + ai * HALF + mt * 32) * ldc + col0; const float rs = RS[ai * HALF + wr * 64 + mt * 32 + fr];
                float r[16];
#pragma unroll
                for (int j = 0; j < 16; ++j) { const float g = acc[ai][0][mt][j] * rs, up = acc[ai][1][mt][j] * rs; r[j] = g * __builtin_amdgcn_rcpf(1.0f + __expf(-g)) * up; }
                u32x4 w0, w1; w0.x = cvt_pk_bf16(r[0], r[1]); w0.y = cvt_pk_bf16(r[2], r[3]); w0.z = cvt_pk_bf16(r[4], r[5]); w0.w = cvt_pk_bf16(r[6], r[7]);
                w1.x = cvt_pk_bf16(r[8], r[9]); w1.y = cvt_pk_bf16(r[10], r[11]); w1.z = cvt_pk_bf16(r[12], r[13]); w1.w = cvt_pk_bf16(r[14], r[15]);
                *(u32x4*)rowp = w0; *(u32x4*)(rowp + 8) = w1; }
    }
};
struct EpiResidB {
    static constexpr bool PERM = true, AFTER_DRAIN = false;
    const bf16_t* res; bf16_t* X; int ldc; float* ssq_out; PG8_LAS unsigned char* xl;
    __device__ __forceinline__ void operator()(const f32x16 (&acc)[2][2][2], const Unit& u, int wr, int wc, int fr, int fq) const {
        PG8_LAS float* SSQL = (PG8_LAS float*)(xl + 8192);
        const int row0 = u.pm * BM + wr * 64 + fr, col0 = u.pn * BM + wc * 32 + 16 * fq;
#pragma unroll
        for (int ai = 0; ai < 2; ++ai) { u32x4 rw[2][2][2];
#pragma unroll
            for (int mt = 0; mt < 2; ++mt)
#pragma unroll
                for (int bj = 0; bj < 2; ++bj) { const bf16_t* rp = res + (size_t)(row0 + ai * HALF + mt * 32) * ldc + col0 + bj * HALF; rw[mt][bj][0] = *(const u32x4*)rp; rw[mt][bj][1] = *(const u32x4*)(rp + 8); }
#pragma unroll
            for (int mt = 0; mt < 2; ++mt) { float sq = 0.f;
#pragma unroll
                for (int bj = 0; bj < 2; ++bj) { const f32x16 a = acc[ai][bj][mt]; float v[16];
#pragma unroll
                    for (int h = 0; h < 2; ++h) { const u32x4 rr = rw[mt][bj][h];
                        v[8 * h + 0] = __uint_as_float(rr.x << 16) + a[8 * h + 0]; v[8 * h + 1] = __uint_as_float(rr.x & 0xffff0000u) + a[8 * h + 1];
                        v[8 * h + 2] = __uint_as_float(rr.y << 16) + a[8 * h + 2]; v[8 * h + 3] = __uint_as_float(rr.y & 0xffff0000u) + a[8 * h + 3];
                        v[8 * h + 4] = __uint_as_float(rr.z << 16) + a[8 * h + 4]; v[8 * h + 5] = __uint_as_float(rr.z & 0xffff0000u) + a[8 * h + 5];
                        v[8 * h + 6] = __uint_as_float(rr.w << 16) + a[8 * h + 6]; v[8 * h + 7] = __uint_as_float(rr.w & 0xffff0000u) + a[8 * h + 7]; }
#pragma unroll
                    for (int j = 0; j < 16; j += 4) sq += (v[j] * v[j] + v[j + 1] * v[j + 1]) + (v[j + 2] * v[j + 2] + v[j + 3] * v[j + 3]);
                    u32x4 w0, w1; w0.x = cvt_pk_bf16(v[0], v[1]); w0.y = cvt_pk_bf16(v[2], v[3]); w0.z = cvt_pk_bf16(v[4], v[5]); w0.w = cvt_pk_bf16(v[6], v[7]);
                    w1.x = cvt_pk_bf16(v[8], v[9]); w1.y = cvt_pk_bf16(v[10], v[11]); w1.z = cvt_pk_bf16(v[12], v[13]); w1.w = cvt_pk_bf16(v[14], v[15]);
                    bf16_t* xp = X + (size_t)(row0 + ai * HALF + mt * 32) * ldc + col0 + bj * HALF; *(u32x4*)xp = w0; *(u32x4*)(xp + 8) = w1; }
                sq += __shfl_xor(sq, 32);
                if (fq == 0) SSQL[(ai * HALF + wr * 64 + mt * 32 + fr) * 4 + wc] = sq; } }
        epi_bar();
        const int t = (wr * 4 + wc) * 64 + fq * 32 + fr;
        if (t < 256) { const f32x4 p = *(const PG8_LAS f32x4*)(SSQL + t * 4); ssq_out[(size_t)(u.pm * BM + t) * 16 + u.pn] = (p[0] + p[1]) + (p[2] + p[3]); }
    }
};
#else
struct EpiBf16N {
    static constexpr bool PERM = true, AFTER_DRAIN = false;
    bf16_t* O; int ldc; int fm; PG8_LAS unsigned char* xl;
    __device__ __forceinline__ void operator()(const f32x4 (&acc)[2][2][4][2], const Unit& u, int wr, int wc, int fr, int fq) const {
        const PG8_LAS float* RS = (const PG8_LAS float*)xl + (u.pm - fm) * BM;
        const int row0 = u.pm * BM + wr * 64 + fr, col0 = u.pn * BM + wc * 32 + 8 * fq;
#pragma unroll
        for (int ai = 0; ai < 2; ++ai)
#pragma unroll
            for (int m = 0; m < 4; ++m) { bf16_t* rowp = O + (size_t)(row0 + ai * HALF + m * 16) * ldc + col0; const float rs = RS[ai * HALF + wr * 64 + m * 16 + fr];
#pragma unroll
                for (int bj = 0; bj < 2; ++bj) { const f32x4 v0 = acc[ai][bj][m][0] * rs, v1 = acc[ai][bj][m][1] * rs;
                    u32x4 w; w.x = cvt_pk_bf16(v0[0], v0[1]); w.y = cvt_pk_bf16(v0[2], v0[3]); w.z = cvt_pk_bf16(v1[0], v1[1]); w.w = cvt_pk_bf16(v1[2], v1[3]);
                    *(u32x4*)(rowp + bj * HALF) = w; } }
    }
};
struct EpiSwiGLUN {
    static constexpr bool PERM = true, AFTER_DRAIN = false;
    bf16_t* O; int ldc; int fm; PG8_LAS unsigned char* xl;
    __device__ __forceinline__ void operator()(const f32x4 (&acc)[2][2][4][2], const Unit& u, int wr, int wc, int fr, int fq) const {
        const PG8_LAS float* RS = (const PG8_LAS float*)xl + (u.pm - fm) * BM;
        const int row0 = u.pm * BM + wr * 64 + fr, col0 = u.pn * HALF + wc * 32 + 8 * fq;
#pragma unroll
        for (int ai = 0; ai < 2; ++ai)
#pragma unroll
            for (int m = 0; m < 4; ++m) { bf16_t* rowp = O + (size_t)(row0 + ai * HALF + m * 16) * ldc + col0; const float rs = RS[ai * HALF + wr * 64 + m * 16 + fr];
                float r[8];
#pragma unroll
                for (int n = 0; n < 2; ++n)
#pragma unroll
                    for (int j = 0; j < 4; ++j) { const float g = acc[ai][0][m][n][j] * rs, up = acc[ai][1][m][n][j] * rs;
                        r[n * 4 + j] = g * __builtin_amdgcn_rcpf(1.0f + __expf(-g)) * up; }
                u32x4 w; w.x = cvt_pk_bf16(r[0], r[1]); w.y = cvt_pk_bf16(r[2], r[3]); w.z = cvt_pk_bf16(r[4], r[5]); w.w = cvt_pk_bf16(r[6], r[7]);
                *(u32x4*)rowp = w; }
    }
};
struct EpiResidB {
    static constexpr bool PERM = true, AFTER_DRAIN = false;
    const bf16_t* res; bf16_t* X; int ldc; float* ssq_out; PG8_LAS unsigned char* xl;
    __device__ __forceinline__ void operator()(const f32x4 (&acc)[2][2][4][2], const Unit& u, int wr, int wc, int fr, int fq) const {
        PG8_LAS float* SSQL = (PG8_LAS float*)(xl + 8192);
        const int row0 = u.pm * BM + wr * 64 + fr, col0 = u.pn * BM + wc * 32 + 8 * fq;
#pragma unroll
        for (int ai = 0; ai < 2; ++ai) { u32x4 rw[4][2];
#pragma unroll
            for (int m = 0; m < 4; ++m)
#pragma unroll
                for (int bj = 0; bj < 2; ++bj) rw[m][bj] = *(const u32x4*)(res + (size_t)(row0 + ai * HALF + m * 16) * ldc + col0 + bj * HALF);
#pragma unroll
            for (int m = 0; m < 4; ++m) { float sq = 0.f;
#pragma unroll
                for (int bj = 0; bj < 2; ++bj) { const u32x4 rr = rw[m][bj]; const f32x4 a0 = acc[ai][bj][m][0], a1 = acc[ai][bj][m][1];
                    float v[8];
                    v[0] = __uint_as_float(rr.x << 16) + a0[0]; v[1] = __uint_as_float(rr.x & 0xffff0000u) + a0[1]; v[2] = __uint_as_float(rr.y << 16) + a0[2]; v[3] = __uint_as_float(rr.y & 0xffff0000u) + a0[3];
                    v[4] = __uint_as_float(rr.z << 16) + a1[0]; v[5] = __uint_as_float(rr.z & 0xffff0000u) + a1[1]; v[6] = __uint_as_float(rr.w << 16) + a1[2]; v[7] = __uint_as_float(rr.w & 0xffff0000u) + a1[3];
                    sq += ((v[0] * v[0] + v[1] * v[1]) + (v[2] * v[2] + v[3] * v[3])) + ((v[4] * v[4] + v[5] * v[5]) + (v[6] * v[6] + v[7] * v[7]));
                    u32x4 w; w.x = cvt_pk_bf16(v[0], v[1]); w.y = cvt_pk_bf16(v[2], v[3]); w.z = cvt_pk_bf16(v[4], v[5]); w.w = cvt_pk_bf16(v[6], v[7]);
                    *(u32x4*)(X + (size_t)(row0 + ai * HALF + m * 16) * ldc + col0 + bj * HALF) = w; }
                sq += __shfl_xor(sq, 16); sq += __shfl_xor(sq, 32);
                if (fq == 0) SSQL[(ai * HALF + wr * 64 + m * 16 + fr) * 4 + wc] = sq; } }
        epi_bar();
        const int t = (wr * 4 + wc) * 64 + fq * 16 + fr;
        if (t < 256) { const f32x4 p = *(const PG8_LAS f32x4*)(SSQL + t * 4); ssq_out[(size_t)(u.pm * BM + t) * 16 + u.pn] = (p[0] + p[1]) + (p[2] + p[3]); }
    }
};
#endif
template <class Epi, class Sched, bool ALIGN_EPI = false, bool SP2 = false>
__device__ __forceinline__ void gemm_phase(PG8_LAS unsigned char* lds, const Gemm g, const Sched& S, const Epi& E) {
    int tid_ = threadIdx.x; asm volatile("" : "+v"(tid_));
#if GEMM_MFMA32
    const int tid = tid_, wid = __builtin_amdgcn_readfirstlane(tid >> 6), lane = tid & 63, wr = wid >> 2, wc = wid & 3, fr = lane & 31, fq = lane >> 5;
#else
    const int tid = tid_, wid = __builtin_amdgcn_readfirstlane(tid >> 6), lane = tid & 63, wr = wid >> 2, wc = wid & 3, fr = lane & 15, fq = lane >> 4;
#endif
    const int K = g.K, nt = K / BK;
    unsigned voffA[2], voffB[2];
#pragma unroll
    for (int i = 0; i < 2; ++i) { int R, C; stage_rc(tid * 16 + i * 8192, R, C); const int Rb = Epi::PERM ? ((R & ~31) + (GEMM_MFMA32 ? perm32x(R & 31) : perm32(R & 31))) : R;
        voffA[i] = (unsigned)(R * K + C) * 2u; voffB[i] = (unsigned)(Rb * K + C) * 2u; }
    const size_t kstep = (size_t)(BK * 2);
    const size_t hstep = (size_t)HALF * K * 2;
    const size_t tstep = 2 * hstep;
    const unsigned ldsw = (unsigned)wid * 1024u;
#if GEMM_MFMA32
    const int aE = lds_byte(wr * 64 + fr, fq * 8), aO = lds_byte(wr * 64 + fr, 16 + fq * 8), bE = lds_byte(wc * 32 + fr, fq * 8), bO = lds_byte(wc * 32 + fr, 16 + fq * 8);
#else
    const int aoff = lds_byte(wr * 64 + fr, fq * 8), boff = lds_byte(wc * 32 + fr, fq * 8);
#endif
#define PG8_SA(b, h) (((b) * 2 + (h)) * HTB)
#define PG8_SB(b, h) ((4 + (b) * 2 + (h)) * HTB)
#define PG8_STAGE(bufoff, gbase, voff) do { _Pragma("unroll") for (int _i = 0; _i < 2; ++_i) \
        __builtin_amdgcn_global_load_lds((const unsigned*)((const char*)(gbase) + (voff)[_i]), (PG8_LAS unsigned*)(lds + (bufoff) + ldsw + _i * 8192), 16, 0, 0); } while (0)
#if GEMM_MFMA32
#define PG8_LDA(dst, b, h) do { _Pragma("unroll") for (int m = 0; m < 2; ++m) _Pragma("unroll") for (int k = 0; k < 4; ++k) dst[m][k] = *(const PG8_LAS bf16x8*)(lds + PG8_SA(b, h) + ((k & 1) ? aO : aE) + (k >> 1) * 1024 + m * 4096); } while (0)
#define PG8_LDB(dst, b, h) do { _Pragma("unroll") for (int k = 0; k < 4; ++k) dst[k] = *(const PG8_LAS bf16x8*)(lds + PG8_SB(b, h) + ((k & 1) ? bO : bE) + (k >> 1) * 1024); } while (0)
#define PG8_MMA(ai, bj, At, Bt) do { __builtin_amdgcn_s_setprio(1); _Pragma("unroll") for (int k = 0; k < 4; ++k) _Pragma("unroll") for (int m = 0; m < 2; ++m) \
        acc[ai][bj][m] = __builtin_amdgcn_mfma_f32_32x32x16_bf16(Bt[k], At[m][k], acc[ai][bj][m], 0, 0, 0); __builtin_amdgcn_s_setprio(0); } while (0)
#define PG8_ZERO_ACC() do { _Pragma("unroll") for (int a = 0; a < 2; ++a) _Pragma("unroll") for (int b = 0; b < 2; ++b) _Pragma("unroll") for (int m = 0; m < 2; ++m) acc[a][b][m] = f32x16{}; } while (0)
#define PG8_MMA2(ai, At, Bx, By) do { __builtin_amdgcn_s_setprio(1); _Pragma("unroll") for (int k = 0; k < 4; ++k) _Pragma("unroll") for (int m = 0; m < 2; ++m) { \
        acc[ai][0][m] = __builtin_amdgcn_mfma_f32_32x32x16_bf16(Bx[k], At[m][k], acc[ai][0][m], 0, 0, 0); \
        acc[ai][1][m] = __builtin_amdgcn_mfma_f32_32x32x16_bf16(By[k], At[m][k], acc[ai][1][m], 0, 0, 0); } __builtin_amdgcn_s_setprio(0); } while (0)
#else
#define PG8_MMA2(ai, At, Bx, By) do { PG8_MMA(ai, 0, At, Bx); PG8_MMA(ai, 1, At, By); } while (0)
#define PG8_LDA(dst, b, h) do { _Pragma("unroll") for (int m = 0; m < 4; ++m) _Pragma("unroll") for (int k = 0; k < 2; ++k) dst[m][k] = *(const PG8_LAS bf16x8*)(lds + PG8_SA(b, h) + aoff + m * 2048 + k * 1024); } while (0)
#define PG8_LDB(dst, b, h) do { _Pragma("unroll") for (int n = 0; n < 2; ++n) _Pragma("unroll") for (int k = 0; k < 2; ++k) dst[n][k] = *(const PG8_LAS bf16x8*)(lds + PG8_SB(b, h) + boff + n * 2048 + k * 1024); } while (0)
#define PG8_MMA(ai, bj, At, Bt) do { __builtin_amdgcn_s_setprio(1); _Pragma("unroll") for (int m = 0; m < 4; ++m) _Pragma("unroll") for (int n = 0; n < 2; ++n) _Pragma("unroll") for (int k = 0; k < 2; ++k) \
        acc[ai][bj][m][n] = __builtin_amdgcn_mfma_f32_16x16x32_bf16(Bt[n][k], At[m][k], acc[ai][bj][m][n], 0, 0, 0); __builtin_amdgcn_s_setprio(0); } while (0)
#define PG8_ZERO_ACC() do { _Pragma("unroll") for (int a = 0; a < 2; ++a) _Pragma("unroll") for (int b = 0; b < 2; ++b) _Pragma("unroll") for (int m = 0; m < 4; ++m) _Pragma("unroll") for (int n = 0; n < 2; ++n) acc[a][b][m][n] = (f32x4){0.f, 0.f, 0.f, 0.f}; } while (0)
#endif
#define PG8_WAIT_V(n) asm volatile("s_waitcnt vmcnt(" #n ")" ::: "memory")
#define PG8_WAIT_L(n) asm volatile("s_waitcnt lgkmcnt(" #n ")" ::: "memory")
#define PG8_BAR __builtin_amdgcn_s_barrier()
#define PG8_SCHED __builtin_amdgcn_sched_barrier(0)
    Unit cur, nxt; int ui = 0;
    if (!S.next(0, cur)) return;
#if GEMM_MFMA32
    f32x16 acc[2][2][2]; bf16x8 At[2][4], B0[4], B1[4];
#else
    f32x4 acc[2][2][4][2]; bf16x8 At[4][2], B0[2][2], B1[2][2];
#endif
    PG8_ZERO_ACC();
    const char* cA = (const char*)g.A + (size_t)cur.pm * tstep; const char* cB = (const char*)g.Bt + (size_t)cur.pn * tstep;
    S.a_ready(cur);
    if constexpr (SP2) {
        PG8_STAGE(PG8_SB(0, 0), cB, voffB); PG8_STAGE(PG8_SB(0, 1), cB + hstep, voffB); PG8_STAGE(PG8_SA(0, 0), cA, voffA); PG8_STAGE(PG8_SA(0, 1), cA + hstep, voffA);
        if (wr == 1) PG8_BAR;
        PG8_WAIT_V(2); PG8_BAR;
        PG8_STAGE(PG8_SB(1, 0), cB + kstep, voffB); PG8_STAGE(PG8_SA(1, 0), cA + kstep, voffA); PG8_STAGE(PG8_SB(1, 1), cB + hstep + kstep, voffB);
        PG8_WAIT_V(6); PG8_BAR;
    } else {
        PG8_STAGE(PG8_SB(0, 0), cB, voffB); PG8_STAGE(PG8_SA(0, 0), cA, voffA); PG8_STAGE(PG8_SB(0, 1), cB + hstep, voffB); PG8_STAGE(PG8_SA(0, 1), cA + hstep, voffA);
        if (wr == 1) PG8_BAR;
        PG8_WAIT_V(4); PG8_BAR;
        PG8_STAGE(PG8_SB(1, 0), cB + kstep, voffB); PG8_STAGE(PG8_SA(1, 0), cA + kstep, voffA); PG8_STAGE(PG8_SB(1, 1), cB + hstep + kstep, voffB);
        PG8_WAIT_V(6); PG8_BAR;
    }
    for (;;) {
        const bool has_next = S.next(ui + 1, nxt);
        const char* nA = has_next ? (const char*)g.A + (size_t)nxt.pm * tstep : cA; const char* nB = has_next ? (const char*)g.Bt + (size_t)nxt.pn * tstep : cB;
        for (int t = 0; t < nt; t += 2) {
            const bool last = (t == nt - 2);
            const char* a1 = cA + (size_t)(t + 1) * kstep;
            const char* a2 = last ? nA : cA + (size_t)(t + 2) * kstep; const char* b2 = last ? nB : cB + (size_t)(t + 2) * kstep;
            const char* a3 = a2 + kstep; const char* b3 = b2 + kstep;
            if (last && has_next) S.a_ready(nxt);
            if constexpr (SP2) {
            PG8_LDB(B0, 0, 0); PG8_LDB(B1, 0, 1); PG8_SCHED; PG8_LDA(At, 0, 0); PG8_STAGE(PG8_SA(1, 1), a1 + hstep, voffA);
            PG8_WAIT_V(8); PG8_WAIT_L(0); PG8_BAR; PG8_MMA2(0, At, B0, B1); PG8_BAR; PG8_SCHED;
            PG8_LDA(At, 0, 1); PG8_STAGE(PG8_SB(0, 0), b2, voffB); PG8_STAGE(PG8_SB(0, 1), b2 + hstep, voffB); PG8_STAGE(PG8_SA(0, 0), a2, voffA);
            PG8_WAIT_V(8); PG8_WAIT_L(0); PG8_BAR; PG8_MMA2(1, At, B0, B1); PG8_BAR; PG8_SCHED;
            PG8_LDB(B0, 1, 0); PG8_LDB(B1, 1, 1); PG8_SCHED; PG8_LDA(At, 1, 0); PG8_STAGE(PG8_SA(0, 1), a2 + hstep, voffA);
            PG8_WAIT_V(8); PG8_WAIT_L(0); PG8_BAR; PG8_MMA2(0, At, B0, B1); PG8_BAR; PG8_SCHED;
            PG8_LDA(At, 1, 1); PG8_STAGE(PG8_SB(1, 0), b3, voffB); PG8_STAGE(PG8_SB(1, 1), b3 + hstep, voffB); PG8_STAGE(PG8_SA(1, 0), a3, voffA);
            PG8_WAIT_V(8); PG8_WAIT_L(0); PG8_BAR; PG8_MMA2(1, At, B0, B1); PG8_BAR; PG8_SCHED;
            } else {
            PG8_LDB(B0, 0, 0); PG8_SCHED; PG8_LDA(At, 0, 0); PG8_STAGE(PG8_SA(1, 1), a1 + hstep, voffA);
            PG8_WAIT_L(8); PG8_BAR; PG8_WAIT_L(0); PG8_MMA(0, 0, At, B0); PG8_BAR; PG8_SCHED;
            PG8_LDB(B1, 0, 1); PG8_STAGE(PG8_SB(0, 0), b2, voffB);
            PG8_BAR; PG8_WAIT_L(0); PG8_MMA(0, 1, At, B1); PG8_BAR;
            PG8_LDA(At, 0, 1); PG8_STAGE(PG8_SA(0, 0), a2, voffA);
            PG8_BAR; PG8_WAIT_L(0); PG8_MMA(1, 0, At, B0); PG8_BAR; PG8_SCHED;
            PG8_STAGE(PG8_SB(0, 1), b2 + hstep, voffB);
            PG8_WAIT_V(6); PG8_BAR; PG8_MMA(1, 1, At, B1); PG8_BAR;
            PG8_LDB(B0, 1, 0); PG8_SCHED; PG8_LDA(At, 1, 0); PG8_STAGE(PG8_SA(0, 1), a2 + hstep, voffA);
            PG8_WAIT_L(8); PG8_BAR; PG8_WAIT_L(0); PG8_MMA(0, 0, At, B0); PG8_BAR; PG8_SCHED;
            PG8_LDB(B1, 1, 1); PG8_STAGE(PG8_SB(1, 0), b3, voffB);
            PG8_BAR; PG8_WAIT_L(0); PG8_MMA(0, 1, At, B1); PG8_BAR;
            PG8_LDA(At, 1, 1); PG8_STAGE(PG8_SA(1, 0), a3, voffA);
            PG8_BAR; PG8_WAIT_L(0); PG8_MMA(1, 0, At, B0); PG8_BAR; PG8_SCHED;
            PG8_STAGE(PG8_SB(1, 1), b3 + hstep, voffB);
            PG8_WAIT_V(6); PG8_BAR; PG8_MMA(1, 1, At, B1); PG8_BAR;
            }
        }
        if constexpr (ALIGN_EPI) { if (wr == 0) PG8_BAR; }
        if constexpr (!Epi::AFTER_DRAIN) { E(acc, cur, wr, wc, fr, fq); S.done(cur); }
        if (!has_next) break;
        PG8_ZERO_ACC();
        cur = nxt; cA = nA; cB = nB; ++ui;
        if constexpr (ALIGN_EPI) { if (wr == 1) PG8_BAR; }
    }
    PG8_WAIT_V(0);
    if constexpr (!ALIGN_EPI) { if (wr == 0) PG8_BAR; }
    PG8_BAR;
    if constexpr (Epi::AFTER_DRAIN) { E.fused(acc, cur, wr, wc, fr, fq, lds, wid, lane); S.done(cur); }
#undef PG8_SA
#undef PG8_SB
#undef PG8_STAGE
#undef PG8_LDA
#undef PG8_LDB
#undef PG8_MMA
#undef PG8_MMA2
#undef PG8_ZERO_ACC
#undef PG8_WAIT_V
#undef PG8_WAIT_L
#undef PG8_BAR
#undef PG8_SCHED
}
}

#define XB_TMO      128
#define XB_XCNT(j)  (256  + 64 * (j))
#define XB_XSUB(j)  (1280 + 64 * (j))
#define XB_XGEN(j)  (2304 + 64 * (j))
#define XB_TOP      3328
#define XB_TOPGEN   3392
#define XCD_BAR_WORDS 3456
#define XB_SPIN_CAP (1u << 18)

__device__ __forceinline__ unsigned xb_ld(unsigned* p)              { return __hip_atomic_load(p, __ATOMIC_RELAXED, __HIP_MEMORY_SCOPE_AGENT); }
__device__ __forceinline__ unsigned xb_add(unsigned* p, unsigned v) { return __hip_atomic_fetch_add(p, v, __ATOMIC_RELAXED, __HIP_MEMORY_SCOPE_AGENT); }
__device__ __forceinline__ unsigned xb_xcc_id() { return (unsigned)__builtin_amdgcn_s_getreg((3 << 11) | 20) & 0xFu; }
#define XB_SPIN(cond, bar) do { unsigned _sp = 0; while (cond) { __builtin_amdgcn_s_sleep(1); \
    if ((++_sp & 255u) == 0u) { if (xb_ld(&(bar)[XB_TMO])) break; if (_sp > XB_SPIN_CAP) { atomicAdd(&(bar)[XB_TMO], 1u); break; } } } } while (0)

struct XcdBarrier {
    unsigned* bar; unsigned x;
    volatile LAS unsigned* st;
};

__device__ __forceinline__ XcdBarrier xcd_barrier_post(unsigned* bar, volatile LAS unsigned* st) {
    XcdBarrier b; b.bar = bar; b.x = xb_xcc_id(); b.st = st;
    if (threadIdx.x == 0) (void)xb_add(&bar[XB_XCNT(b.x)], 1u);
    return b;
}
__device__ __forceinline__ void xcd_barrier_complete(unsigned* bar, unsigned x, unsigned& nloc, unsigned& nx) {
    const unsigned G = gridDim.x * gridDim.y * gridDim.z;
    unsigned sum, cnt, mine, sp = 0u;
    for (;;) {
        sum = 0u; cnt = 0u; mine = 0u;
#pragma unroll
        for (unsigned j = 0; j < 16; ++j) { const unsigned c = xb_ld(&bar[XB_XCNT(j)]); sum += c; cnt += (c > 0u) ? 1u : 0u; mine = (j == x) ? c : mine; }
        if (sum == G) break;
        __builtin_amdgcn_s_sleep(1);
        if ((++sp & 255u) == 0u) { if (xb_ld(&bar[XB_TMO])) break; if (sp > XB_SPIN_CAP) { atomicAdd(&bar[XB_TMO], 1u); break; } }
    }
    nloc = mine > 0u ? mine : 1u; nx = cnt > 0u ? cnt : 1u;
}

__device__ __forceinline__ void xcd_barrier(const XcdBarrier& b) {
    asm volatile("s_waitcnt vmcnt(0)" ::: "memory");
    __syncthreads();
    if (threadIdx.x == 0) {
        unsigned* bar = b.bar;
        __builtin_amdgcn_s_waitcnt(0);
        unsigned nloc = b.st[0], nx = b.st[1];
        if (nloc == 0u) { xcd_barrier_complete(bar, b.x, nloc, nx); b.st[0] = nloc; b.st[1] = nx; }
        const unsigned old = xb_add(&bar[XB_XSUB(b.x)], 1u);
        const unsigned gen = old / nloc;
        if (old + 1u == (gen + 1u) * nloc) {
            __builtin_amdgcn_fence(__ATOMIC_RELEASE, "agent");
            asm volatile("s_waitcnt vmcnt(0)" ::: "memory");
            const unsigned og = xb_add(&bar[XB_TOP], 1u);
            const unsigned tg = og / nx;
            if (og + 1u == (tg + 1u) * nx) xb_add(&bar[XB_TOPGEN], 1u);
            else XB_SPIN(xb_ld(&bar[XB_TOPGEN]) == tg, bar);
            __builtin_amdgcn_fence(__ATOMIC_ACQUIRE, "agent");
            xb_add(&bar[XB_XGEN(b.x)], 1u);
            asm volatile("s_waitcnt vmcnt(0)" ::: "memory");
        } else {
            XB_SPIN(xb_ld(&bar[XB_XGEN(b.x)]) == gen, bar);
            __builtin_amdgcn_fence(__ATOMIC_ACQUIRE, "agent");
            asm volatile("s_waitcnt vmcnt(0)" ::: "memory");
        }
    }
    __syncthreads();
}


constexpr int NWAVES = 8, NTHR = 512;
constexpr int SEQ = 4096, DM = 4096, MTOK = 8192, NP = 12032, INW = 11800, DFF = 11008, NGU = 22016;
constexpr int C_RQ = 0, C_RK = 1024, C_RV = 2048, C_RG = 3072, C_MQ = 4096, C_MK = 5120, C_MV = 6144, C_LX = 7168, C_LG = 8192, C_NQ = 9216,
              C_NKC = 10240, C_NVC = 10496, C_NKS = 10752, C_NVS = 11008, C_NKW = 11264, C_NVW = 11520, C_NGATE = 11776;
constexpr float RMS_EPS = 1e-6f;

constexpr size_t MiB = 1u << 20;
constexpr size_t WS_CTL = 0, CTL_ZERO_BYTES = 1 * MiB;
constexpr size_t WS_ROPEC = 1 * MiB, WS_ROPES = 2 * MiB;
constexpr size_t WS_SMALL = 3 * MiB;
constexpr size_t SM_KMEAN = WS_SMALL;
constexpr size_t SM_LRUCA = WS_SMALL + 256 * 1024;
constexpr size_t SM_LRUCH = WS_SMALL + 512 * 1024;
constexpr size_t SM_CB1P  = WS_SMALL + 768 * 1024;
constexpr size_t SM_CW2T  = WS_SMALL + 1024 * 1024;
constexpr size_t SM_WAT   = WS_SMALL + 2 * MiB;
constexpr size_t SM_WXT   = WS_SMALL + 3 * MiB;
constexpr size_t SM_KC    = WS_SMALL + 4 * MiB;
constexpr size_t SM_VC    = WS_SMALL + 5 * MiB;
constexpr size_t SM_SSQA  = WS_SMALL + 6 * MiB;
constexpr size_t SM_SSQB  = WS_SMALL + 7 * MiB;
constexpr size_t WS_CW1T  = 11 * MiB;
constexpr size_t WS_WIN   = 19 * MiB;
constexpr size_t WS_WOUT  = WS_WIN + 188 * MiB;
constexpr size_t WS_WGU   = WS_WOUT + 64 * MiB;
constexpr size_t WS_WDN   = WS_WGU + 344 * MiB;
constexpr size_t WS_H     = WS_WDN + 172 * MiB;
constexpr size_t WS_PROJ  = WS_H + 64 * MiB;
constexpr size_t WS_Y     = WS_PROJ + 188 * MiB;
constexpr size_t WS_XS0   = WS_Y + 64 * MiB;
constexpr size_t WS_XS1   = WS_XS0 + 64 * MiB;
constexpr size_t WS_XS2   = WS_XS1 + 64 * MiB;
constexpr size_t WS_XB    = WS_XS0 + 128 * MiB;
constexpr size_t WS_U     = WS_XB + 128 * MiB;
constexpr size_t WS_RETKV = WS_U + 172 * MiB;
constexpr size_t WS_LRUH  = WS_RETKV + 32 * MiB;
constexpr size_t WS_LRUP  = WS_LRUH + 32 * MiB;
constexpr size_t WS_NSAACC = WS_LRUP + 32 * MiB;
constexpr size_t WS_END   = WS_NSAACC + 32 * MiB;
constexpr int CW_BAR = 4096;

constexpr int PH_BYTES = 147456;
constexpr int MISC_OFF = PH_BYTES;
constexpr int LDS_BYTES = PH_BYTES + 1024;

#define LDS_WAIT() asm volatile("s_waitcnt lgkmcnt(0)" ::: "memory")
#define VM_WAIT() asm volatile("s_waitcnt vmcnt(0)" ::: "memory")
__device__ __forceinline__ float bf2f(unsigned short b) { return __uint_as_float(((unsigned)b) << 16); }
__device__ __forceinline__ float bflo(unsigned w) { return __uint_as_float(w << 16); }
__device__ __forceinline__ float bfhi(unsigned w) { return __uint_as_float(w & 0xffff0000u); }
__device__ __forceinline__ unsigned f2bf(float f) { unsigned u = __float_as_uint(f); return (u + 0x7fffu + ((u >> 16) & 1u)) >> 16; }
__device__ __forceinline__ unsigned pk2(float lo, float hi) { return f2bf(lo) | (f2bf(hi) << 16); }
__device__ __forceinline__ unsigned cvtpk(float lo, float hi) { unsigned r; asm volatile("v_cvt_pk_bf16_f32 %0, %1, %2" : "=v"(r) : "v"(lo), "v"(hi)); return r; }
__device__ __forceinline__ float wave_sum(float v) {
#pragma unroll
    for (int o = 1; o < 64; o <<= 1) v += __shfl_xor(v, o);
    return v;
}
__device__ __forceinline__ float sigmoidf_(float x) { return __builtin_amdgcn_rcpf(1.0f + __expf(-x)); }
__device__ __forceinline__ float gelu_tanh(float x) { const float z = 0.7978845608028654f * (x + 0.044715f * x * x * x); const float e = __expf(2.0f * z); const float t = 1.0f - 2.0f * __builtin_amdgcn_rcpf(e + 1.0f); return 0.5f * x * (1.0f + t); }
__device__ __forceinline__ void unpack8(const u32x4 w, float (&f)[8]) { f[0] = bflo(w.x); f[1] = bfhi(w.x); f[2] = bflo(w.y); f[3] = bfhi(w.y); f[4] = bflo(w.z); f[5] = bfhi(w.z); f[6] = bflo(w.w); f[7] = bfhi(w.w); }

struct Frame {
    ldsp lds;
    int tid, lane, wave, G, bid;
    unsigned char* ws;
};
#define KAS __attribute__((address_space(4)))
#define OPQ_S(x) asm volatile("" : "+s"(x))
#define OPQ_V(x) asm volatile("" : "+v"(x))
__device__ __forceinline__ int otid() { int t = threadIdx.x; OPQ_V(t); return t; }
#define GAS __attribute__((address_space(1)))
__device__ __forceinline__ unsigned char* ows() { unsigned long long w = ((const unsigned long long KAS*)__builtin_amdgcn_kernarg_segment_ptr())[24]; OPQ_S(w);
    return (unsigned char*)(GAS unsigned char*)w; }
__device__ __forceinline__ const float* inp(int i) { return (const float*)(const GAS float*)((const unsigned long long KAS*)__builtin_amdgcn_kernarg_segment_ptr())[i]; }
__device__ __forceinline__ Frame mk_frame(ldsp lds) {
    Frame F; F.lds = lds; F.tid = otid(); F.lane = F.tid & 63; F.wave = __builtin_amdgcn_readfirstlane(F.tid >> 6); F.G = gridDim.x; F.bid = blockIdx.x;
    F.ws = ows(); return F;
}
#ifdef USE_NOINLINE
#define NOINL __attribute__((noinline))
#else
#define NOINL __forceinline__
#endif

__device__ __forceinline__ void tr_load(f32x4 (&v)[16], const float* __restrict__ W, int N, int k0, int n0, int lane) {
    const int rr = lane >> 4, c4 = (lane & 15) * 4; const bool ok = (n0 + c4) < N;
    const float* src = W + (size_t)(k0 + rr) * N + n0 + c4;
#pragma unroll
    for (int i = 0; i < 16; ++i) v[i] = ok ? *(const f32x4*)(src + (size_t)(4 * i) * N) : (f32x4){0.f, 0.f, 0.f, 0.f};
}
__device__ __forceinline__ void tr_emit(const f32x4 (&v)[16], int K, bf16_t* __restrict__ WT, int k0, int drow0, LAS float* scr, int lane, const float* __restrict__ kscale) {
    const int rr = lane >> 4, c4 = (lane & 15) * 4;
#pragma unroll
    for (int i = 0; i < 16; ++i) { const float kq = kscale ? kscale[k0 + rr + 4 * i] : 1.0f;
        LAS float* d = scr + (rr + 4 * i) * 65 + c4; d[0] = v[i].x * kq; d[1] = v[i].y * kq; d[2] = v[i].z * kq; d[3] = v[i].w * kq; }
    LDS_WAIT(); asm volatile("" ::: "memory");
    const int c = lane & 7;
#pragma unroll
    for (int j = 0; j < 8; ++j) { const int nn = (lane >> 3) + 8 * j; const LAS float* s = scr + (8 * c) * 65 + nn;
        u32x4 o; o.x = cvtpk(s[0 * 65], s[1 * 65]); o.y = cvtpk(s[2 * 65], s[3 * 65]); o.z = cvtpk(s[4 * 65], s[5 * 65]); o.w = cvtpk(s[6 * 65], s[7 * 65]);
        *(u32x4*)(WT + (size_t)(drow0 + nn) * K + k0 + 8 * c) = o; }
    LDS_WAIT(); asm volatile("" ::: "memory");
}
struct TrDesc { const float* W; bf16_t* WT; const float* ks; int K, N, nnb, mode; };
__device__ __forceinline__ void tr_matrix_rt(const float* W, int K, int N, int nnb, bf16_t* WT, LAS float* scr, int gw, int NGW, int lane, const float* kscale, int MODE, int it_lo = 0, int it_hi = 0x7fffffff) {
    const int nkb = K / 64, tot = nkb * nnb; const int hi_ = it_hi < tot ? it_hi : tot;
    int it = it_lo + gw; if (it >= hi_) return;
#define TR_GEO(it_) const int kb_ = (it_) / nnb, n0_ = ((it_) - kb_ * nnb) * 64; \
        const int dr_ = (MODE == 0) ? n0_ : ((n0_ >> 7) * 256 + (n0_ & 127) + (MODE == 2 ? 128 : 0))
    f32x4 va[16], vb[16];
    { TR_GEO(it); tr_load(va, W, N, kb_ * 64, n0_, lane); }
    for (;;) {
        if (it + NGW < hi_) { TR_GEO(it + NGW); tr_load(vb, W, N, kb_ * 64, n0_, lane); }
        { TR_GEO(it); tr_emit(va, K, WT, kb_ * 64, dr_, scr, lane, kscale); }
        it += NGW; if (it >= hi_) break;
        if (it + NGW < hi_) { TR_GEO(it + NGW); tr_load(va, W, N, kb_ * 64, n0_, lane); }
        { TR_GEO(it); tr_emit(vb, K, WT, kb_ * 64, dr_, scr, lane, kscale); }
        it += NGW; if (it >= hi_) break;
    }
#undef TR_GEO
}
__device__ __forceinline__ TrDesc deferred_desc(unsigned char* ws, int j) {
    const int l = j >= 4 ? 1 : 0, k = j >= 4 ? j - 4 : j + 1;
    TrDesc d;
    if (k == 0) { d.W = inp(2) + (size_t)l * DM * INW; d.WT = (bf16_t*)(ws + WS_WIN) + (size_t)l * NP * DM; d.ks = inp(1) + (size_t)l * DM; d.K = DM; d.N = INW; d.nnb = NP / 64; d.mode = 0; }
    else if (k == 1) { d.W = inp(3) + (size_t)l * DM * DM; d.WT = (bf16_t*)(ws + WS_WOUT) + (size_t)l * DM * DM; d.ks = nullptr; d.K = DM; d.N = DM; d.nnb = DM / 64; d.mode = 0; }
    else if (k == 2) { d.W = inp(19) + (size_t)l * DM * DFF; d.WT = (bf16_t*)(ws + WS_WGU) + (size_t)l * NGU * DM; d.ks = inp(18) + (size_t)l * DM; d.K = DM; d.N = DFF; d.nnb = DFF / 64; d.mode = 1; }
    else if (k == 3) { d.W = inp(20) + (size_t)l * DM * DFF; d.WT = (bf16_t*)(ws + WS_WGU) + (size_t)l * NGU * DM; d.ks = inp(18) + (size_t)l * DM; d.K = DM; d.N = DFF; d.nnb = DFF / 64; d.mode = 2; }
    else { d.W = inp(21) + (size_t)l * DFF * DM; d.WT = (bf16_t*)(ws + WS_WDN) + (size_t)l * DM * DFF; d.ks = nullptr; d.K = DFF; d.N = DM; d.nnb = DM / 64; d.mode = 0; }
    return d;
}
__device__ __forceinline__ void convert_deferred(unsigned char* ws, LAS float* scr, int w, int NW, int lane, int j_lo = 0, int j_hi = 9) {
#pragma unroll 1
    for (int j = j_lo; j < j_hi; ++j) { const TrDesc d = deferred_desc(ws, j); tr_matrix_rt(d.W, d.K, d.N, d.nnb, d.WT, scr, w, NW, lane, d.ks, d.mode); }
}
constexpr bool SPLIT_GU0 = false;
constexpr int GU0_WGS = 192;
constexpr bool SPLIT_INPROJ0 = false;
constexpr int GEMM0_WGS = 192;
__device__ NOINL void deferred_phase(ldsp lds_, int first_wg, int j_lo, int j_hi) {
    Frame F = mk_frame(lds_);
    LAS float* scr = (LAS float*)(F.lds + F.wave * 16640);
    convert_deferred(F.ws, scr, (F.bid - first_wg) * NWAVES + F.wave, (F.G - first_wg) * NWAVES, F.lane, j_lo, j_hi);
}
__device__ NOINL void p0_prologue(ldsp lds_) {
    Frame F = mk_frame(lds_);
    LAS float* scr = (LAS float*)(F.lds + F.wave * 16640);
    const int gw = F.bid * NWAVES + F.wave, NGW = F.G * NWAVES, lane = F.lane;
    unsigned char* ws = F.ws;
#pragma unroll 1
    for (int j = 0; j < 41; ++j) {
        TrDesc d; int rot = 0;
        if (j == 0) { d.W = inp(2); d.WT = (bf16_t*)(ws + WS_WIN); d.ks = inp(1); d.K = DM; d.N = INW; d.nnb = NP / 64; }
        else if (j <= 4) { const int q = j - 1, l = q >> 1, wh = q & 1;
            d.W = inp(wh ? 16 : 13) + (size_t)l * 4096 * 256; d.WT = (bf16_t*)(ws + WS_CW1T) + (size_t)(l * 2 + wh) * 256 * 4096; d.ks = nullptr; d.K = 4096; d.N = 256; d.nnb = 4; rot = 512 * j; }
        else if (j <= 8) { const int q = j - 5, l = q >> 1, wh = q & 1;
            d.W = inp(wh ? 17 : 14) + (size_t)l * 256 * 128; d.WT = (bf16_t*)(ws + SM_CW2T) + (size_t)(l * 2 + wh) * 128 * 256; d.ks = nullptr; d.K = 256; d.N = 128; d.nnb = 2; rot = 1536 + 16 * j; }
        else { const int q = j - 9, wx = q & 1, lg = q >> 1;
            d.W = inp(wx ? 9 : 7) + (size_t)lg * 128 * 128; d.WT = (bf16_t*)(ws + (wx ? SM_WXT : SM_WAT)) + (size_t)lg * 128 * 128; d.ks = nullptr; d.K = 128; d.N = 128; d.nnb = 2; rot = 1600 + 8 * q; }
        tr_matrix_rt(d.W, d.K, d.N, d.nnb, d.WT, scr, (gw + rot) % NGW, NGW, lane, d.ks, 0);
    }
    if (F.G != 256) convert_deferred(ws, scr, gw, NGW, lane);
    else if (SPLIT_GU0) convert_deferred(ws, scr, gw, NGW, lane, 0, 4);
    else if (!SPLIT_INPROJ0) convert_deferred(ws, scr, gw, NGW, lane);
    {   const float* x = inp(0); bf16_t* xs = (bf16_t*)(ws + WS_XS0); float* ssq = (float*)(ws + SM_SSQA);
        for (int m = gw; m < MTOK; m += NGW) {
            const f32x4* xr = (const f32x4*)(x + (size_t)m * DM) + lane; u32x2* o = (u32x2*)(xs + (size_t)m * DM) + lane;
            f32x4 v[16];
#pragma unroll
            for (int j = 0; j < 16; ++j) v[j] = xr[64 * j];
            float mine = 0.f;
#pragma unroll
            for (int j = 0; j < 16; ++j) { const float sj = wave_sum((v[j].x * v[j].x + v[j].y * v[j].y) + (v[j].z * v[j].z + v[j].w * v[j].w)); mine = (lane == j) ? sj : mine;
                u32x2 pk; pk.x = cvtpk(v[j].x, v[j].y); pk.y = cvtpk(v[j].z, v[j].w); o[64 * j] = pk; }
            if (lane < 16) ssq[(size_t)m * 16 + lane] = mine; } }
    for (int idx = (F.bid * NTHR + F.tid); idx < SEQ * 64; idx += F.G * NTHR) {
        const int t = idx >> 6, i = idx & 63;
        const float inv = powf(10000.0f, -(float)i * (1.0f / 64.0f));
        const float ang = (float)t * inv;
        double rev = (double)ang * 0.15915494309189535; rev -= rint(rev);
        ((float*)(ws + WS_ROPEC))[idx] = __builtin_amdgcn_cosf((float)rev);
        ((float*)(ws + WS_ROPES))[idx] = __builtin_amdgcn_sinf((float)rev);
    }
    for (int it = (gw + 1800) % NGW; it < 2 * 2 * 32; it += NGW) {
        const int s = it & 31, which = (it >> 5) & 1, l = it >> 6;
        const float* pos = inp(which ? 15 : 12) + (size_t)l * 4096 + s * 128;
        const float* w1 = inp(which ? 16 : 13) + (size_t)l * 4096 * 256 + (size_t)s * 128 * 256;
        float a0 = 0.f, a1 = 0.f, a2 = 0.f, a3 = 0.f;
#pragma unroll 1
        for (int k0 = 0; k0 < 128; k0 += 16) { float pp[16], w0[16], w1v[16], w2[16], w3[16];
#pragma unroll
            for (int x = 0; x < 16; ++x) { const float* wr = w1 + (k0 + x) * 256 + lane; pp[x] = pos[k0 + x]; w0[x] = wr[0]; w1v[x] = wr[64]; w2[x] = wr[128]; w3[x] = wr[192]; }
#pragma unroll
            for (int x = 0; x < 16; ++x) { a0 += pp[x] * w0[x]; a1 += pp[x] * w1v[x]; a2 += pp[x] * w2[x]; a3 += pp[x] * w3[x]; } }
        float* o = (float*)(ws + SM_CB1P) + (size_t)it * 256 + lane;
        o[0] = a0; o[64] = a1; o[128] = a2; o[192] = a3;
    }
}

__device__ NOINL void final_norm_phase(ldsp lds_, const bf16_t* __restrict__ xs, const float* __restrict__ ssq, const float* __restrict__ w, float* __restrict__ outp) {
    Frame F = mk_frame(lds_);
    const int gw = F.bid * NWAVES + F.wave, NGW = F.G * NWAVES, lane = F.lane;
    for (int m = gw; m < MTOK; m += NGW) {
        const float part = ssq[(size_t)m * 16 + (lane & 15)];
        const float rstd = 1.0f / sqrtf(wave_sum(part) * (0.25f / DM) + RMS_EPS);
        const u32x2* xr = (const u32x2*)(xs + (size_t)m * DM) + lane; const f32x4* wr = (const f32x4*)w + lane; f32x4* o = (f32x4*)(outp + (size_t)m * DM) + lane;
        u32x2 v[16];
#pragma unroll
        for (int j = 0; j < 16; ++j) v[j] = xr[64 * j];
#pragma unroll
        for (int j = 0; j < 16; ++j) { const f32x4 ww = wr[64 * j]; f32x4 y; y.x = bflo(v[j].x) * rstd * ww.x; y.y = bfhi(v[j].x) * rstd * ww.y; y.z = bflo(v[j].y) * rstd * ww.z; y.w = bfhi(v[j].y) * rstd * ww.w; o[64 * j] = y; }
    }
}

template <int NT, int KSTEPS>
__device__ __forceinline__ void strip_mma(f32x4 (&acc)[NT], const LAS unsigned char* A, int arow0, int apitch, const LAS unsigned char* Bt, int bpitch, int lane) {
    const int fr = lane & 15, fq = lane >> 4;
#pragma unroll
    for (int ks = 0; ks < KSTEPS; ++ks) {
        const bf16x8 a = *(const LAS bf16x8*)(A + (arow0 + fr) * apitch + (ks * 32 + fq * 8) * 2);
#pragma unroll
        for (int nt = 0; nt < NT; ++nt) {
            const bf16x8 b = *(const LAS bf16x8*)(Bt + (nt * 16 + fr) * bpitch + (ks * 32 + fq * 8) * 2);
            acc[nt] = __builtin_amdgcn_mfma_f32_16x16x32_bf16(a, b, acc[nt], 0, 0, 0);
        }
    }
}
constexpr int P272 = 272;

__device__ __forceinline__ float ret_log_gamma(int h) { return log1pf(-exp2f(-5.0f - (float)h)); }

__device__ __forceinline__ void rope8(const u32x4 w1, const u32x4 w2, const float* __restrict__ cs, const float* __restrict__ sn, float (&r1)[8], float (&r2)[8]) {
    float a[8], b[8]; unpack8(w1, a); unpack8(w2, b);
    const f32x4 c0 = *(const f32x4*)cs, c1 = *(const f32x4*)(cs + 4), s0 = *(const f32x4*)sn, s1 = *(const f32x4*)(sn + 4);
    const float c[8] = {c0.x, c0.y, c0.z, c0.w, c1.x, c1.y, c1.z, c1.w}, s[8] = {s0.x, s0.y, s0.z, s0.w, s1.x, s1.y, s1.z, s1.w};
#pragma unroll
    for (int x = 0; x < 8; ++x) { r1[x] = a[x] * c[x] - b[x] * s[x]; r2[x] = a[x] * s[x] + b[x] * c[x]; }
}

__device__ NOINL void ret_kv_unit(ldsp lds_, int unit) {
    Frame F = mk_frame(lds_);
    const int h = unit & 7, n = (unit >> 3) & 31, b = unit >> 8;
    const bf16_t* proj = (const bf16_t*)(F.ws + WS_PROJ);
    const float* ropec = (const float*)(F.ws + WS_ROPEC); const float* ropes = (const float*)(F.ws + WS_ROPES);
    ldsp vT = F.lds, kT = F.lds + 128 * P272;
    const int tid = F.tid, lane = F.lane, wave = F.wave;
    const size_t row0 = (size_t)b * SEQ + (size_t)n * 128;
    const float lg = ret_log_gamma(h);
    const int c0v = (tid & 15) * 8, c0k = (tid & 7) * 8;
    u32x4 vw[4], kw[2][2]; f32x4 tc[2][2], ts[2][2];
#pragma unroll
    for (int ps = 0; ps < 4; ++ps) { const int j = (tid >> 4) + 32 * ps; vw[ps] = *(const u32x4*)(proj + (row0 + j) * NP + C_RV + h * 128 + c0v); }
#pragma unroll
    for (int ps = 0; ps < 2; ++ps) { const int j = (tid >> 3) + 64 * ps; const int t = n * 128 + j;
        const bf16_t* kr = proj + (row0 + j) * NP + C_RK + h * 128 + c0k;
        kw[ps][0] = *(const u32x4*)kr; kw[ps][1] = *(const u32x4*)(kr + 64);
        tc[ps][0] = *(const f32x4*)(ropec + t * 64 + c0k); tc[ps][1] = *(const f32x4*)(ropec + t * 64 + c0k + 4); ts[ps][0] = *(const f32x4*)(ropes + t * 64 + c0k); ts[ps][1] = *(const f32x4*)(ropes + t * 64 + c0k + 4); }
    asm volatile("" :: "v"(vw[0]), "v"(vw[1]), "v"(vw[2]), "v"(vw[3]), "v"(kw[0][0]), "v"(kw[0][1]), "v"(kw[1][0]), "v"(kw[1][1]),
                    "v"(tc[0][0]), "v"(tc[0][1]), "v"(tc[1][0]), "v"(tc[1][1]), "v"(ts[0][0]), "v"(ts[0][1]), "v"(ts[1][0]), "v"(ts[1][1]) : "memory");
    asm volatile("" : "+v"(vw[0]), "+v"(vw[1]), "+v"(vw[2]), "+v"(vw[3]), "+v"(kw[0][0]), "+v"(kw[0][1]), "+v"(kw[1][0]), "+v"(kw[1][1]));
    asm volatile("" : "+v"(tc[0][0]), "+v"(tc[0][1]), "+v"(tc[1][0]), "+v"(tc[1][1]), "+v"(ts[0][0]), "+v"(ts[0][1]), "+v"(ts[1][0]), "+v"(ts[1][1]));
#pragma unroll
    for (int ps = 0; ps < 4; ++ps) { const int j = (tid >> 4) + 32 * ps; const int c0 = c0v;
        const unsigned ww[4] = {vw[ps].x, vw[ps].y, vw[ps].z, vw[ps].w};
#pragma unroll
        for (int x = 0; x < 8; ++x) *(LAS unsigned short*)(vT + (c0 + x) * P272 + j * 2) = (unsigned short)((x & 1) ? (ww[x >> 1] >> 16) : (ww[x >> 1] & 0xffffu)); }
#pragma unroll
    for (int ps = 0; ps < 2; ++ps) { const int j = (tid >> 3) + 64 * ps; const int c0 = c0k;
        const float cc[8] = {tc[ps][0].x, tc[ps][0].y, tc[ps][0].z, tc[ps][0].w, tc[ps][1].x, tc[ps][1].y, tc[ps][1].z, tc[ps][1].w}, sn[8] = {ts[ps][0].x, ts[ps][0].y, ts[ps][0].z, ts[ps][0].w, ts[ps][1].x, ts[ps][1].y, ts[ps][1].z, ts[ps][1].w};
        float a[8], bb[8], r1[8], r2[8]; unpack8(kw[ps][0], a); unpack8(kw[ps][1], bb);
#pragma unroll
        for (int x = 0; x < 8; ++x) { r1[x] = a[x] * cc[x] - bb[x] * sn[x]; r2[x] = a[x] * sn[x] + bb[x] * cc[x]; }
        const float sc = 0.08838834764831845f * __expf(lg * (float)(127 - j));
#pragma unroll
        for (int x = 0; x < 8; ++x) { *(LAS unsigned short*)(kT + (c0 + x) * P272 + j * 2) = (unsigned short)f2bf(r1[x] * sc);
                                      *(LAS unsigned short*)(kT + (c0 + 64 + x) * P272 + j * 2) = (unsigned short)f2bf(r2[x] * sc); } }
    __syncthreads();
    f32x4 acc[8];
#pragma unroll
    for (int i = 0; i < 8; ++i) acc[i] = (f32x4){0.f, 0.f, 0.f, 0.f};
    strip_mma<8, 4>(acc, vT, wave * 16, P272, kT, P272, lane);
    float* kv = (float*)(F.ws + WS_RETKV) + (size_t)unit * 16384;
    const int fr = lane & 15, fq = lane >> 4;
#pragma unroll
    for (int nt = 0; nt < 8; ++nt)
#pragma unroll
        for (int j = 0; j < 4; ++j) kv[(wave * 16 + 4 * fq + j) * 128 + nt * 16 + fr] = acc[nt][j];
    __syncthreads();
}

__device__ NOINL void moba_kmean_unit(ldsp lds_, int unit) {
    Frame F = mk_frame(lds_);
    const int blk = unit & 15, h = (unit >> 4) & 7, b = unit >> 7;
    const bf16_t* proj = (const bf16_t*)(F.ws + WS_PROJ);
    LAS float* part = (LAS float*)F.lds;
    const int tid = F.tid, d0 = (tid & 15) * 8, p = tid >> 4;
    float s[8] = {0, 0, 0, 0, 0, 0, 0, 0};
#pragma unroll
    for (int kk = 0; kk < 8; ++kk) { const size_t row = (size_t)b * SEQ + blk * 256 + p * 8 + kk;
        float f[8]; unpack8(*(const u32x4*)(proj + row * NP + C_MK + h * 128 + d0), f);
#pragma unroll
        for (int x = 0; x < 8; ++x) s[x] += f[x]; }
#pragma unroll
    for (int x = 0; x < 8; ++x) part[p * 128 + d0 + x] = s[x];
    __syncthreads();
    if (tid < 128) { float a = 0.f;
#pragma unroll 8
        for (int q = 0; q < 32; ++q) a += part[q * 128 + tid];
        ((float*)(F.ws + SM_KMEAN))[(size_t)unit * 128 + tid] = a * (1.0f / 256.0f); }
    __syncthreads();
}

constexpr int CP2 = 528;
constexpr int CMP_B = 64 * CP2, CMP_STG2 = CMP_B + 32 * CP2;
__device__ NOINL void nsa_cmp1_unit(ldsp lds_, int layer, int unit) {
    Frame F = mk_frame(lds_);
    const int nq = unit & 3, rg = (unit >> 2) & 7, kvh = (unit >> 5) & 1, b = (unit >> 6) & 1, which = unit >> 7;
    const bf16_t* proj = (const bf16_t*)(F.ws + WS_PROJ);
    const bf16_t* w1t = (const bf16_t*)(F.ws + WS_CW1T) + (size_t)(layer * 2 + which) * 256 * 4096 + (size_t)(nq * 64) * 4096;
    const float* cb1p = (const float*)(F.ws + SM_CB1P) + (size_t)(layer * 2 + which) * 32 * 256 + nq * 64;
    ldsp stg = F.lds;
    LAS float* biasL = (LAS float*)(F.lds + 2 * CMP_STG2);
    const int tid = F.tid, lane = F.lane, wave = F.wave;
    if (tid < 64) { float a = 0.f; float bv[32];
#pragma unroll
        for (int s = 0; s < 32; ++s) bv[s] = cb1p[s * 256 + tid];
#pragma unroll
        for (int s = 0; s < 32; ++s) a += bv[s];
        biasL[tid] = a; }
    const int kc = (tid & 31) * 8, r0 = tid >> 5;
    const bf16_t* bsrc = w1t + (size_t)r0 * 4096 + kc;
    const bf16_t* asrc[2];
#pragma unroll
    for (int i = 0; i < 2; ++i) { int ncr = rg * 32 + r0 + 16 * i; ncr = ncr > 254 ? 254 : ncr;
        asrc[i] = proj + ((size_t)b * SEQ + 16 * ncr + (kc >> 7)) * NP + (which ? C_NVC : C_NKC) + kvh * 128 + (kc & 127); }
    const int dstb = r0 * CP2 + kc * 2;
    bf16x8 sbA[4], saA[2], sbB[4], saB[2];
#define C_LOAD(SB, SA, s_) do { _Pragma("unroll") for (int i = 0; i < 4; ++i) SB[i] = *(const bf16x8*)(bsrc + (size_t)i * 16 * 4096 + (s_) * 256); \
        _Pragma("unroll") for (int i = 0; i < 2; ++i) SA[i] = *(const bf16x8*)(asrc[i] + (size_t)(2 * (s_)) * NP); } while (0)
#define C_WRITE(SB, SA, bf) do { ldsp d_ = stg + (bf) * CMP_STG2; _Pragma("unroll") for (int i = 0; i < 4; ++i) *(LAS bf16x8*)(d_ + dstb + i * 16 * CP2) = SB[i]; \
        _Pragma("unroll") for (int i = 0; i < 2; ++i) *(LAS bf16x8*)(d_ + CMP_B + dstb + i * 16 * CP2) = SA[i]; } while (0)
#define C_MMA(bf) do { ldsp cur = stg + (bf) * CMP_STG2; strip_mma<1, 8>(acc, cur + CMP_B, (wave >> 2) * 16, CP2, cur + ((wave & 3) * 16) * CP2, CP2, lane); } while (0)
    f32x4 acc[1] = {(f32x4){0.f, 0.f, 0.f, 0.f}};
    C_LOAD(sbA, saA, 0); C_LOAD(sbB, saB, 1);
    C_WRITE(sbA, saA, 0); __syncthreads();
#pragma unroll 1
    for (int s = 0; s < 16; s += 2) {
        if (s + 2 < 16) C_LOAD(sbA, saA, s + 2);
        C_MMA(0);
        C_WRITE(sbB, saB, 1); __syncthreads();
        if (s + 3 < 16) C_LOAD(sbB, saB, s + 3);
        C_MMA(1);
        if (s + 2 < 16) C_WRITE(sbA, saA, 0);
        __syncthreads();
    }
#undef C_LOAD
#undef C_WRITE
#undef C_MMA
    const int fr = lane & 15, fq = lane >> 4;
    bf16_t* hidg = (bf16_t*)(F.ws + WS_H) + (size_t)(((which * 2 + b) * 2 + kvh) * 256 + rg * 32) * 256 + nq * 64;
    {   const int col = (wave & 3) * 16 + fr; const float bv = biasL[col];
#pragma unroll
        for (int j = 0; j < 4; ++j) { const int row = (wave >> 2) * 16 + 4 * fq + j; hidg[(size_t)row * 256 + col] = (bf16_t)f2bf(gelu_tanh(acc[0][j] + bv)); } }
    __syncthreads();
}
__device__ NOINL void nsa_cmp2_unit(ldsp lds_, int layer, int unit) {
    Frame F = mk_frame(lds_);
    const int rg = unit & 7, kvh = (unit >> 3) & 1, b = (unit >> 4) & 1, which = unit >> 5;
    const bf16_t* w2t = (const bf16_t*)(F.ws + SM_CW2T) + (size_t)(layer * 2 + which) * 128 * 256;
    const bf16_t* hidg = (const bf16_t*)(F.ws + WS_H) + (size_t)(((which * 2 + b) * 2 + kvh) * 256 + rg * 32) * 256;
    ldsp hid = F.lds;
    const int tid = F.tid, lane = F.lane, wave = F.wave, fr = lane & 15, fq = lane >> 4;
    bf16x8 bw[8];
    {   u32x4 hw[2];
#pragma unroll
        for (int i = 0; i < 2; ++i) { const int c = tid + 512 * i; hw[i] = *(const u32x4*)(hidg + (size_t)(c >> 5) * 256 + (c & 31) * 8); }
#pragma unroll
        for (int ks = 0; ks < 8; ++ks) bw[ks] = *(const bf16x8*)(w2t + (size_t)(wave * 16 + fr) * 256 + ks * 32 + fq * 8);
        __builtin_amdgcn_sched_barrier(0);
        asm volatile("" : "+v"(hw[0]), "+v"(hw[1]), "+v"(bw[0]), "+v"(bw[1]), "+v"(bw[2]), "+v"(bw[3]), "+v"(bw[4]), "+v"(bw[5]), "+v"(bw[6]), "+v"(bw[7]));
#pragma unroll
        for (int i = 0; i < 2; ++i) { const int c = tid + 512 * i; *(LAS u32x4*)(hid + (c >> 5) * 528 + (c & 31) * 16) = hw[i]; } }
    __syncthreads();
    f32x4 a2[2] = {(f32x4){0.f, 0.f, 0.f, 0.f}, (f32x4){0.f, 0.f, 0.f, 0.f}};
#pragma unroll
    for (int ks = 0; ks < 8; ++ks) {
        const bf16x8 bb = bw[ks];
#pragma unroll
        for (int s = 0; s < 2; ++s) { const bf16x8 a = *(const LAS bf16x8*)(hid + (s * 16 + fr) * 528 + (ks * 32 + fq * 8) * 2);
            a2[s] = __builtin_amdgcn_mfma_f32_16x16x32_bf16(a, bb, a2[s], 0, 0, 0); }
    }
    bf16_t* outp = (bf16_t*)(F.ws + (which ? SM_VC : SM_KC)) + (size_t)((b * 2 + kvh) * 256 + rg * 32) * 128;
#pragma unroll
    for (int s = 0; s < 2; ++s)
#pragma unroll
        for (int j = 0; j < 4; ++j) { const int row = s * 16 + 4 * fq + j; const bool valid = (rg * 32 + row) < 255;
            outp[row * 128 + wave * 16 + fr] = valid ? (bf16_t)f2bf(a2[s][j]) : (bf16_t)0; }
    __syncthreads();
}

__device__ NOINL void lru_local_unit(ldsp lds_, int layer, int unit) {
    Frame F = mk_frame(lds_);
    const int g = unit & 7, tc = (unit >> 3) & 31, b = unit >> 8;
    const bf16_t* proj = (const bf16_t*)(F.ws + WS_PROJ);
    const float* convw = inp(5) + (size_t)layer * 4 * 1024 + g * 128;
    const float* convb = inp(6) + (size_t)layer * 1024 + g * 128;
    const float* ba = inp(8) + (size_t)layer * 1024 + g * 128;
    const float* bx = inp(10) + (size_t)layer * 1024 + g * 128;
    const float* lam = inp(11) + (size_t)layer * 1024 + g * 128;
    const bf16_t* wat = (const bf16_t*)(F.ws + SM_WAT) + (size_t)(layer * 8 + g) * 16384;
    const bf16_t* wxt = (const bf16_t*)(F.ws + SM_WXT) + (size_t)(layer * 8 + g) * 16384;
    ldsp LX = F.lds;
    ldsp XCB = F.lds + 132 * P272;
    ldsp WA = XCB + 128 * P272, WX = WA + 128 * P272;
    LAS float* AL = (LAS float*)F.lds;
    LAS float* UL = (LAS float*)(F.lds + 65536);
    LAS float* PRM = (LAS float*)(F.lds + 140352);
    const int tid = F.tid, lane = F.lane, wave = F.wave;
    const int t0 = tc * 128;
    {   float pv[2]; u32x4 lxw[5], waw[4], wxw[4];
#pragma unroll
        for (int q = 0; q < 2; ++q) { const int i = tid + 512 * q, k = i >> 7, c = i & 127;
            const float* src = (k < 4) ? (convw + k * 1024) : (k == 4) ? convb : (k == 5) ? ba : (k == 6) ? bx : lam;
            pv[q] = src[c]; }
#pragma unroll
        for (int q = 0; q < 5; ++q) { const int i = tid + 512 * q, r = i >> 4, c0 = (i & 15) * 8; const int t = t0 - 3 + r;
            lxw[q] = (u32x4){0u, 0u, 0u, 0u}; if (i < 131 * 16 && t >= 0) lxw[q] = *(const u32x4*)(proj + ((size_t)b * SEQ + t) * NP + C_LX + g * 128 + c0); }
#pragma unroll
        for (int q = 0; q < 4; ++q) { const int i = tid + 512 * q; waw[q] = *(const u32x4*)(wat + i * 8); wxw[q] = *(const u32x4*)(wxt + i * 8); }
#pragma unroll
        for (int q = 0; q < 2; ++q) { const int i = tid + 512 * q; PRM[i] = (i >= 896) ? log1pf(__expf(-pv[q])) : pv[q]; }
#pragma unroll
        for (int q = 0; q < 5; ++q) { const int i = tid + 512 * q, r = i >> 4, c0 = (i & 15) * 8; if (i < 132 * 16) *(LAS u32x4*)(LX + r * P272 + c0 * 2) = lxw[q]; }
#pragma unroll
        for (int q = 0; q < 4; ++q) { const int i = tid + 512 * q, r = i >> 4, c0 = (i & 15) * 8;
            *(LAS u32x4*)(WA + r * P272 + c0 * 2) = waw[q]; *(LAS u32x4*)(WX + r * P272 + c0 * 2) = wxw[q]; }
    }
    __syncthreads();
    {   const int t = tid >> 2, cb0 = (tid & 3) * 32;
#pragma unroll 4
        for (int c = cb0; c < cb0 + 32; c += 2) { float y0 = PRM[512 + c], y1 = PRM[512 + c + 1];
#pragma unroll
            for (int tap = 0; tap < 4; ++tap) { const unsigned w = *(const LAS unsigned*)(LX + (t + tap) * P272 + c * 2);
                y0 += bflo(w) * PRM[tap * 128 + c]; y1 += bfhi(w) * PRM[tap * 128 + c + 1]; }
            *(LAS unsigned*)(XCB + t * P272 + c * 2) = pk2(y0, y1); } }
    __syncthreads();
    f32x4 accR[8], accI[8];
#pragma unroll
    for (int i = 0; i < 8; ++i) { accR[i] = (f32x4){0.f, 0.f, 0.f, 0.f}; accI[i] = (f32x4){0.f, 0.f, 0.f, 0.f}; }
    strip_mma<8, 4>(accR, XCB, wave * 16, P272, WA, P272, lane);
    strip_mma<8, 4>(accI, XCB, wave * 16, P272, WX, P272, lane);
    const int fr = lane & 15, fq = lane >> 4;
    float av[8][4], uv[8][4];
#pragma unroll
    for (int nt = 0; nt < 8; ++nt) { const int c = nt * 16 + fr;
        const float cw0 = PRM[c], cw1 = PRM[128 + c], cw2 = PRM[256 + c], cw3 = PRM[384 + c], cb = PRM[512 + c];
        const float bav = PRM[640 + c], bxv = PRM[768 + c], spl = PRM[896 + c];
#pragma unroll
        for (int j = 0; j < 4; ++j) { const int t = wave * 16 + 4 * fq + j;
            const float xc = cb + bf2f(*(const LAS unsigned short*)(LX + (t + 0) * P272 + c * 2)) * cw0 + bf2f(*(const LAS unsigned short*)(LX + (t + 1) * P272 + c * 2)) * cw1
                                + bf2f(*(const LAS unsigned short*)(LX + (t + 2) * P272 + c * 2)) * cw2 + bf2f(*(const LAS unsigned short*)(LX + (t + 3) * P272 + c * 2)) * cw3;
            const float r = sigmoidf_(accR[nt][j] + bav), ig = sigmoidf_(accI[nt][j] + bxv);
            const float la = -8.0f * r * spl; const float a = __expf(la);
            const float x2 = 2.0f * la;
            const float om = (x2 > -0.02f) ? -x2 * (1.0f + x2 * (0.5f + x2 * 0.16666667f)) : 1.0f - __expf(x2);
            av[nt][j] = a; uv[nt][j] = __builtin_amdgcn_sqrtf(fmaxf(om, 0.0f)) * (ig * xc); } }
    __syncthreads();
#pragma unroll
    for (int nt = 0; nt < 8; ++nt)
#pragma unroll
        for (int j = 0; j < 4; ++j) { const int t = wave * 16 + 4 * fq + j, c = nt * 16 + fr; AL[t * 128 + c] = av[nt][j]; UL[t * 128 + c] = uv[nt][j]; }
    __syncthreads();
    if (tid < 128) { float hh = 0.f, P = 1.f; const size_t base = ((size_t)b * SEQ + t0) * 1024 + g * 128 + tid;
        float* Hp = (float*)(F.ws + WS_LRUH) + base; float* Pp = (float*)(F.ws + WS_LRUP) + base;
#pragma unroll 1
        for (int t0s = 0; t0s < 128; t0s += 16) { float aa[16], uu[16];
#pragma unroll
            for (int i = 0; i < 16; ++i) { aa[i] = AL[(t0s + i) * 128 + tid]; uu[i] = UL[(t0s + i) * 128 + tid]; }
#pragma unroll
            for (int i = 0; i < 16; ++i) { P *= aa[i]; hh = aa[i] * hh + uu[i]; Hp[(size_t)(t0s + i) * 1024] = hh; Pp[(size_t)(t0s + i) * 1024] = P; } }
        ((float*)(F.ws + SM_LRUCA))[(size_t)(b * 32 + tc) * 1024 + g * 128 + tid] = P;
        ((float*)(F.ws + SM_LRUCH))[(size_t)(b * 32 + tc) * 1024 + g * 128 + tid] = hh; }
    __syncthreads();
}

__device__ __forceinline__ void s1_phase(ldsp lds, int layer) {
    int G = gridDim.x, bid = blockIdx.x; OPQ_S(G); OPQ_S(bid);
#ifndef S1_DUP
#define S1_DUP 0
#endif
#define S1REP(b) _Pragma("unroll 1") for (int r1_ = 0; r1_ < 1 + ((S1_DUP >> (b)) & 1); ++r1_)
    S1REP(0) for (int u = bid; u < 512; u += G) ret_kv_unit(lds, u);
    S1REP(1) for (int u = bid; u < 512; u += G) lru_local_unit(lds, layer, u);
    S1REP(2) for (int u = bid; u < 256; u += G) moba_kmean_unit(lds, u);
    S1REP(3) for (int u = bid; u < 256; u += G) nsa_cmp1_unit(lds, layer, u);
}

__device__ NOINL void ret_scan_phase(ldsp lds_) {
    Frame F = mk_frame(lds_);
    for (int gid = F.bid * NTHR + F.tid; gid < 16 * 8192; gid += F.G * NTHR) {
        const int bh = gid >> 13, idx2 = gid & 8191, b = bh >> 3, h = bh & 7;
        f32x2* base = (f32x2*)((float*)(F.ws + WS_RETKV) + (size_t)((b * 32) * 8 + h) * 16384) + idx2;
        const float dc = __expf(ret_log_gamma(h) * 128.0f);
        f32x2 v[32];
#pragma unroll
        for (int n = 0; n < 32; ++n) v[n] = base[(size_t)n * 8 * 8192];
        f32x2 st = {0.f, 0.f};
#pragma unroll
        for (int n = 0; n < 32; ++n) { base[(size_t)n * 8 * 8192] = st; st = st * dc + v[n]; }
    }
}

__device__ __forceinline__ float row16_sum(float v) {
    v += __int_as_float(__builtin_amdgcn_update_dpp(0, __float_as_int(v), 0x128, 0xF, 0xF, false));
    v += __int_as_float(__builtin_amdgcn_update_dpp(0, __float_as_int(v), 0x124, 0xF, 0xF, false));
    v += __int_as_float(__builtin_amdgcn_update_dpp(0, __float_as_int(v), 0x122, 0xF, 0xF, false));
    v += __int_as_float(__builtin_amdgcn_update_dpp(0, __float_as_int(v), 0x121, 0xF, 0xF, false));
    return v;
}
__device__ NOINL void ret_out_unit(ldsp lds_, int layer, int unit) {
    Frame F = mk_frame(lds_);
    const int h = unit & 7, n = (unit >> 3) & 31, b = unit >> 8;
    const bf16_t* proj = (const bf16_t*)(F.ws + WS_PROJ);
    const float* ropec = (const float*)(F.ws + WS_ROPEC); const float* ropes = (const float*)(F.ws + WS_ROPES);
    const float* gain = inp(4) + (size_t)layer * 1024 + h * 128;
    ldsp Q = F.lds, Kt = F.lds + 128 * P272, vT = F.lds + 2 * 128 * P272, ST = F.lds + 3 * 128 * P272;
    const int tid = F.tid, lane = F.lane, wave = F.wave;
    const size_t row0 = (size_t)b * SEQ + (size_t)n * 128;
    const float lg = ret_log_gamma(h);
    const f32x4* kvp = (const f32x4*)((const float*)(F.ws + WS_RETKV) + (size_t)unit * 16384) + tid;
    f32x4 st[8]; u32x4 qw[2][2], kw[2][2], vw[4]; f32x4 tc[2][2], ts[2][2];
    const int c0q = (tid & 7) * 8, c0v = (tid & 15) * 8;
#pragma unroll
    for (int k = 0; k < 8; ++k) st[k] = kvp[512 * k];
#pragma unroll
    for (int ps = 0; ps < 2; ++ps) { const int j = (tid >> 3) + 64 * ps; const int t = n * 128 + j;
        const bf16_t* qrw = proj + (row0 + j) * NP + C_RQ + h * 128 + c0q; const bf16_t* krw = proj + (row0 + j) * NP + C_RK + h * 128 + c0q;
        qw[ps][0] = *(const u32x4*)qrw; qw[ps][1] = *(const u32x4*)(qrw + 64); kw[ps][0] = *(const u32x4*)krw; kw[ps][1] = *(const u32x4*)(krw + 64);
        tc[ps][0] = *(const f32x4*)(ropec + t * 64 + c0q); tc[ps][1] = *(const f32x4*)(ropec + t * 64 + c0q + 4); ts[ps][0] = *(const f32x4*)(ropes + t * 64 + c0q); ts[ps][1] = *(const f32x4*)(ropes + t * 64 + c0q + 4); }
#pragma unroll
    for (int ps = 0; ps < 4; ++ps) { const int j = (tid >> 4) + 32 * ps; vw[ps] = *(const u32x4*)(proj + (row0 + j) * NP + C_RV + h * 128 + c0v); }
    asm volatile("" :: "v"(st[0]), "v"(st[1]), "v"(st[2]), "v"(st[3]), "v"(st[4]), "v"(st[5]), "v"(st[6]), "v"(st[7]), "v"(qw[0][0]), "v"(qw[0][1]), "v"(qw[1][0]), "v"(qw[1][1]),
                    "v"(kw[0][0]), "v"(kw[0][1]), "v"(kw[1][0]), "v"(kw[1][1]), "v"(tc[0][0]), "v"(tc[0][1]), "v"(tc[1][0]), "v"(tc[1][1]), "v"(ts[0][0]), "v"(ts[0][1]), "v"(ts[1][0]), "v"(ts[1][1]),
                    "v"(vw[0]), "v"(vw[1]), "v"(vw[2]), "v"(vw[3]) : "memory");
    asm volatile("" : "+v"(st[0]), "+v"(st[1]), "+v"(st[2]), "+v"(st[3]), "+v"(st[4]), "+v"(st[5]), "+v"(st[6]), "+v"(st[7]));
    asm volatile("" : "+v"(qw[0][0]), "+v"(qw[0][1]), "+v"(qw[1][0]), "+v"(qw[1][1]), "+v"(kw[0][0]), "+v"(kw[0][1]), "+v"(kw[1][0]), "+v"(kw[1][1]));
    asm volatile("" : "+v"(tc[0][0]), "+v"(tc[0][1]), "+v"(tc[1][0]), "+v"(tc[1][1]), "+v"(ts[0][0]), "+v"(ts[0][1]), "+v"(ts[1][0]), "+v"(ts[1][1]));
    asm volatile("" : "+v"(vw[0]), "+v"(vw[1]), "+v"(vw[2]), "+v"(vw[3]));
#pragma unroll
    for (int k = 0; k < 8; ++k) { const int idx = (tid + 512 * k) * 4; const int e = idx >> 7, d = idx & 127;
        u32x2 w; w.x = pk2(st[k].x, st[k].y); w.y = pk2(st[k].z, st[k].w); *(LAS u32x2*)(ST + e * P272 + d * 2) = w; }
#pragma unroll
    for (int ps = 0; ps < 2; ++ps) { const int j = (tid >> 3) + 64 * ps; const int c0 = c0q;
        const float cc[8] = {tc[ps][0].x, tc[ps][0].y, tc[ps][0].z, tc[ps][0].w, tc[ps][1].x, tc[ps][1].y, tc[ps][1].z, tc[ps][1].w}, sn[8] = {ts[ps][0].x, ts[ps][0].y, ts[ps][0].z, ts[ps][0].w, ts[ps][1].x, ts[ps][1].y, ts[ps][1].z, ts[ps][1].w};
        float a[8], bb[8], r1[8], r2[8]; u32x4 w;
        unpack8(qw[ps][0], a); unpack8(qw[ps][1], bb);
#pragma unroll
        for (int x = 0; x < 8; ++x) { r1[x] = a[x] * cc[x] - bb[x] * sn[x]; r2[x] = a[x] * sn[x] + bb[x] * cc[x]; }
        w.x = pk2(r1[0], r1[1]); w.y = pk2(r1[2], r1[3]); w.z = pk2(r1[4], r1[5]); w.w = pk2(r1[6], r1[7]); *(LAS u32x4*)(Q + j * P272 + c0 * 2) = w;
        w.x = pk2(r2[0], r2[1]); w.y = pk2(r2[2], r2[3]); w.z = pk2(r2[4], r2[5]); w.w = pk2(r2[6], r2[7]); *(LAS u32x4*)(Q + j * P272 + (c0 + 64) * 2) = w;
        unpack8(kw[ps][0], a); unpack8(kw[ps][1], bb);
#pragma unroll
        for (int x = 0; x < 8; ++x) { r1[x] = a[x] * cc[x] - bb[x] * sn[x]; r2[x] = a[x] * sn[x] + bb[x] * cc[x]; }
        const float sc = 0.08838834764831845f;
        w.x = pk2(r1[0] * sc, r1[1] * sc); w.y = pk2(r1[2] * sc, r1[3] * sc); w.z = pk2(r1[4] * sc, r1[5] * sc); w.w = pk2(r1[6] * sc, r1[7] * sc); *(LAS u32x4*)(Kt + j * P272 + c0 * 2) = w;
        w.x = pk2(r2[0] * sc, r2[1] * sc); w.y = pk2(r2[2] * sc, r2[3] * sc); w.z = pk2(r2[4] * sc, r2[5] * sc); w.w = pk2(r2[6] * sc, r2[7] * sc); *(LAS u32x4*)(Kt + j * P272 + (c0 + 64) * 2) = w; }
#pragma unroll
    for (int ps = 0; ps < 4; ++ps) { const int j = (tid >> 4) + 32 * ps; const int c0 = c0v;
        const unsigned ww[4] = {vw[ps].x, vw[ps].y, vw[ps].z, vw[ps].w};
#pragma unroll
        for (int x = 0; x < 8; ++x) *(LAS unsigned short*)(vT + (c0 + x) * P272 + j * 2) = (unsigned short)((x & 1) ? (ww[x >> 1] >> 16) : (ww[x >> 1] & 0xffffu)); }
    __syncthreads();
    const int fr = lane & 15, fq = lane >> 4;
    f32x4 accC[8], accS[8];
#pragma unroll
    for (int i = 0; i < 8; ++i) { accC[i] = (f32x4){0.f, 0.f, 0.f, 0.f}; accS[i] = (f32x4){0.f, 0.f, 0.f, 0.f}; }
    strip_mma<8, 4>(accC, Q, wave * 16, P272, ST, P272, lane);
    strip_mma<8, 4>(accS, Q, wave * 16, P272, Kt, P272, lane);
    __syncthreads();
#pragma unroll
    for (int nt = 0; nt < 8; ++nt)
#pragma unroll
        for (int j = 0; j < 4; ++j) { const int i = wave * 16 + 4 * fq + j, jj = nt * 16 + fr;
            const float v = (i >= jj) ? accS[nt][j] * __expf(lg * (float)(i - jj)) : 0.0f;
            *(LAS unsigned short*)(Q + i * P272 + jj * 2) = (unsigned short)f2bf(v); }
    __syncthreads();
#pragma unroll
    for (int i = 0; i < 8; ++i) accS[i] = (f32x4){0.f, 0.f, 0.f, 0.f};
    float gvv[4][8], gn[8]; unsigned graw[4][8];
#pragma unroll
    for (int nt = 0; nt < 8; ++nt) gn[nt] = gain[nt * 16 + fr];
#pragma unroll
    for (int j = 0; j < 4; ++j) { const bf16_t* grow = proj + (row0 + wave * 16 + 4 * fq + j) * NP + C_RG + h * 128;
#pragma unroll
        for (int nt = 0; nt < 8; ++nt) graw[j][nt] = grow[nt * 16 + fr]; }
    __builtin_amdgcn_sched_barrier(0);
    strip_mma<8, 4>(accS, Q, wave * 16, P272, vT, P272, lane);
    __builtin_amdgcn_sched_barrier(0);
#pragma unroll
    for (int j = 0; j < 4; ++j) asm volatile("" : "+v"(graw[j][0]), "+v"(graw[j][1]), "+v"(graw[j][2]), "+v"(graw[j][3]), "+v"(graw[j][4]), "+v"(graw[j][5]), "+v"(graw[j][6]), "+v"(graw[j][7]));
    asm volatile("" : "+v"(gn[0]), "+v"(gn[1]), "+v"(gn[2]), "+v"(gn[3]), "+v"(gn[4]), "+v"(gn[5]), "+v"(gn[6]), "+v"(gn[7]));
#pragma unroll
    for (int j = 0; j < 4; ++j)
#pragma unroll
        for (int nt = 0; nt < 8; ++nt) gvv[j][nt] = bf2f((unsigned short)graw[j][nt]);
#pragma unroll
    for (int j = 0; j < 4; ++j) { const int i = wave * 16 + 4 * fq + j;
        const float dfs = __expf(lg * (float)(i + 1));
        float y[8]; float s = 0.f;
#pragma unroll
        for (int nt = 0; nt < 8; ++nt) { y[nt] = accS[nt][j] + dfs * accC[nt][j]; s += y[nt]; }
        s = row16_sum(s);
        const float mean = s * (1.0f / 128.0f); float q2 = 0.f;
#pragma unroll
        for (int nt = 0; nt < 8; ++nt) { y[nt] -= mean; q2 += y[nt] * y[nt]; }
        q2 = row16_sum(q2);
        const float rstd = 1.0f / sqrtf(q2 * (1.0f / 128.0f) + RMS_EPS);
        bf16_t* yrow = (bf16_t*)(F.ws + WS_Y) + (row0 + i) * DM + 0 + h * 128;
#pragma unroll
        for (int nt = 0; nt < 8; ++nt) { const int e = nt * 16 + fr; const float gv = gvv[j][nt];
            yrow[e] = (bf16_t)f2bf(gv * sigmoidf_(gv) * (y[nt] * rstd * gn[nt])); } }
    __syncthreads();
}

__device__ NOINL void lru_out_unit(ldsp lds_, int unit) {
    Frame F = mk_frame(lds_);
    const int ch = unit & 1, tc = (unit >> 1) & 31, b = unit >> 6;
    const bf16_t* proj = (const bf16_t*)(F.ws + WS_PROJ);
    LAS float* HIN = (LAS float*)F.lds;
    {   const int c = ch * 512 + F.tid;
        const float* CA = (const float*)(F.ws + SM_LRUCA) + (size_t)b * 32 * 1024 + c; const float* CH = (const float*)(F.ws + SM_LRUCH) + (size_t)b * 32 * 1024 + c;
        float H = 0.f; float ca[32], chv[32];
#pragma unroll
        for (int k = 0; k < 32; ++k) { ca[k] = CA[k * 1024]; chv[k] = CH[k * 1024]; }
#pragma unroll
        for (int k = 0; k < 32; ++k) H = (k < tc) ? ca[k] * H + chv[k] : H;
        HIN[F.tid] = H; }
    __syncthreads();
    const int cg = (F.tid & 127) * 4, tsub = F.tid >> 7; const int c0 = ch * 512 + cg;
    const f32x4 Hin = *(const LAS f32x4*)(HIN + cg);
    const size_t r0 = (size_t)b * SEQ + tc * 128 + tsub;
    const float* Hp = (const float*)(F.ws + WS_LRUH) + r0 * 1024 + c0; const float* Pp = (const float*)(F.ws + WS_LRUP) + r0 * 1024 + c0;
    const bf16_t* gp = proj + r0 * NP + C_LG + c0; bf16_t* yp = (bf16_t*)(F.ws + WS_Y) + r0 * DM + 2048 + c0;
#pragma unroll 1
    for (int i0 = 0; i0 < 32; i0 += 8) { f32x4 hv[8], pv[8]; u32x2 gv[8];
#pragma unroll
        for (int x = 0; x < 8; ++x) { const size_t t = (size_t)(i0 + x) * 4; hv[x] = *(const f32x4*)(Hp + t * 1024); pv[x] = *(const f32x4*)(Pp + t * 1024); gv[x] = *(const u32x2*)(gp + t * NP); }
#pragma unroll
        for (int x = 0; x < 8; ++x) { const size_t t = (size_t)(i0 + x) * 4; const f32x4 h = hv[x] + pv[x] * Hin;
            u32x2 w; w.x = cvtpk(h.x * gelu_tanh(bflo(gv[x].x)), h.y * gelu_tanh(bfhi(gv[x].x))); w.y = cvtpk(h.z * gelu_tanh(bflo(gv[x].y)), h.w * gelu_tanh(bfhi(gv[x].y)));
            *(u32x2*)(yp + t * DM) = w; } }
    __syncthreads();
}

constexpr int SHM_T = 16384;
#define KSWZ(row, colB) ((row) * 256 + ((colB) ^ (((row) & 7) << 4)))
__device__ __forceinline__ int v_st(int k, int c) { const int kk = (k & ~0xC) | ((k & 4) << 1) | ((k & 8) >> 1); return ((kk >> 3) * 4 + (c >> 5)) * 512 + ((kk & 7) * 32 + (c & 31)) * 2; }
__device__ __forceinline__ int v_rd_base(int lane) { return ((lane & 3) << 3) | (((lane >> 2) & 3) << 6) | (((lane >> 4) & 1) << 5) | (((lane >> 5) & 1) << 8); }
constexpr int v_rd_off(int d0, int ks, int half) { return d0 * 512 + ks * 4096 + half * 2048; }
__device__ __forceinline__ int crow(int r, int hi) { return (r & 3) + 8 * (r >> 2) + 4 * hi; }
__device__ __forceinline__ float half_max(float v) { auto rr = __builtin_amdgcn_permlane32_swap(__float_as_uint(v), __float_as_uint(v), false, false); return fmaxf(__uint_as_float(rr[0]), __uint_as_float(rr[1])); }
__device__ __forceinline__ float half_sum(float v) { auto rr = __builtin_amdgcn_permlane32_swap(__float_as_uint(v), __float_as_uint(v), false, false); return __uint_as_float(rr[0]) + __uint_as_float(rr[1]); }
__device__ __forceinline__ float half_other(float v) { auto rr = __builtin_amdgcn_permlane32_swap(__float_as_uint(v), __float_as_uint(v), false, false); const float a = __uint_as_float(rr[0]), b = __uint_as_float(rr[1]); return (__lane_id() & 32) ? a : b; }

__device__ __forceinline__ void qkt(f32x16& p0, f32x16& p1, const LAS unsigned char* K_lds, int r32, int hi, const bf16x8 (&qr)[8]) {
    p0 = f32x16{}; p1 = f32x16{};
    const LAS unsigned char* kb[4];
#pragma unroll
    for (int dd = 0; dd < 4; ++dd) kb[dd] = K_lds + KSWZ(r32, (dd * 16 + hi * 8) * 2);
#pragma unroll
    for (int d0 = 0; d0 < 8; ++d0) { const LAS unsigned char* a = kb[d0 & 3] + (d0 >> 2) * 128;
        const bf16x8 b0 = *(const LAS bf16x8*)a;
        const bf16x8 b1 = *(const LAS bf16x8*)(a + 32 * 256);
        p0 = __builtin_amdgcn_mfma_f32_32x32x16_bf16(b0, qr[d0], p0, 0, 0, 0);
        p1 = __builtin_amdgcn_mfma_f32_32x32x16_bf16(b1, qr[d0], p1, 0, 0, 0);
        if (d0 & 1) __builtin_amdgcn_sched_barrier(0); }
}
__device__ __forceinline__ void pv_tile(f32x16 (&o)[4], int vb0, bf16x8 pa0, bf16x8 pa1, bf16x8 pa2, bf16x8 pa3) {
#define TRRD(dst, off) asm volatile("ds_read_b64_tr_b16 %0, %1 offset:%2" : "=&v"(dst) : "v"(vb0), "i"(off) : "memory")
#define PV_D0(d0) do { s16x4 l0, l1, l2, l3, h0, h1, h2, h3; constexpr int b_ = v_rd_off(d0, 0, 0); \
        TRRD(l0, b_); TRRD(h0, b_ + 2048); TRRD(l1, b_ + 4096); TRRD(h1, b_ + 6144); TRRD(l2, b_ + 8192); TRRD(h2, b_ + 10240); TRRD(l3, b_ + 12288); TRRD(h3, b_ + 14336); \
        asm volatile("s_waitcnt lgkmcnt(0)" ::: "memory"); __builtin_amdgcn_sched_barrier(0);   \
        o[d0] = __builtin_amdgcn_mfma_f32_32x32x16_bf16(pa0, (bf16x8){l0[0], l0[1], l0[2], l0[3], h0[0], h0[1], h0[2], h0[3]}, o[d0], 0, 0, 0);   \
        o[d0] = __builtin_amdgcn_mfma_f32_32x32x16_bf16(pa1, (bf16x8){l1[0], l1[1], l1[2], l1[3], h1[0], h1[1], h1[2], h1[3]}, o[d0], 0, 0, 0);   \
        o[d0] = __builtin_amdgcn_mfma_f32_32x32x16_bf16(pa2, (bf16x8){l2[0], l2[1], l2[2], l2[3], h2[0], h2[1], h2[2], h2[3]}, o[d0], 0, 0, 0);   \
        o[d0] = __builtin_amdgcn_mfma_f32_32x32x16_bf16(pa3, (bf16x8){l3[0], l3[1], l3[2], l3[3], h3[0], h3[1], h3[2], h3[3]}, o[d0], 0, 0, 0); } while (0)
    PV_D0(0); PV_D0(1); PV_D0(2); PV_D0(3);
#undef PV_D0
#undef TRRD
}
#define PK4(P, B_, OUT) do { unsigned a0_ = cvtpk(P[B_+0], P[B_+1]), a1_ = cvtpk(P[B_+2], P[B_+3]);                          \
        unsigned b0_ = cvtpk(P[B_+4], P[B_+5]), b1_ = cvtpk(P[B_+6], P[B_+7]);                                             \
        auto r0_ = __builtin_amdgcn_permlane32_swap(a0_, b0_, false, false); auto r1_ = __builtin_amdgcn_permlane32_swap(a1_, b1_, false, false); \
        u32x4 w_ = {r0_[0], r1_[0], r0_[1], r1_[1]}; OUT = __builtin_bit_cast(bf16x8, w_); } while (0)

__device__ __forceinline__ void glds16(const void* gsrc, unsigned lds_dst) { unsigned keep;
    asm volatile("s_mov_b32 %0, m0\n\ts_mov_b32 m0, %2\n\ts_nop 0\n\tglobal_load_lds_dwordx4 %1, off\n\ts_mov_b32 m0, %0" : "=&s"(keep) : "v"(gsrc), "s"(lds_dst) : "memory"); }
enum { AM_MOBA = 0, AM_SEL = 1, AM_WIN = 2, AM_CSTAT = 3, AM_COUT = 4 };
constexpr float ATT_C2 = 1.4426950408889634f * 0.08838834764831845f;
constexpr int ATT_BIG = 1 << 24;
constexpr float ATT_DEFER = 6.0f;

struct AttnIO {
    const bf16_t* Kg; const bf16_t* Vg; int pitch;
    int t_lo, t_hi;
    int q;
    int own;
    unsigned mlo, mhi;
};

template <int MODE, int NB>
__device__ __forceinline__ void attn_pass(ldsp lds, LAS float* wsc, const bf16x8 (&qr)[8], const AttnIO& io, f32x16 (&o)[4], float& m_reg, float& l_reg, float inv_l, LAS float* imp) {
    const int tid = otid(), lane = tid & 63, r32 = lane & 31, hi = lane >> 5;
    ldsp V_lds = lds; ldsp K_lds = lds + NB * SHM_T;
    const int vbase = (int)(unsigned)(uintptr_t)V_lds + v_rd_base(lane);
    constexpr int DEPTH = NB - 1;
    constexpr bool NEEDV = (MODE != AM_CSTAT);
    float carry = 0.f;
    const int wv = __builtin_amdgcn_readfirstlane(tid >> 6);
    size_t ksrc[2], vsrc[2];
#pragma unroll
    for (int i = 0; i < 2; ++i) { const int ch = wv * 2 + i;
        const int kr = ch * 4 + (lane >> 4), kc = (lane & 15) ^ (kr & 7);
        ksrc[i] = (size_t)kr * io.pitch + kc * 8;
        const int sub = ch * 2 + (lane >> 5), kk = (sub >> 2) * 8 + ((lane & 31) >> 2), vk = (kk & ~0xC) | ((kk & 4) << 1) | ((kk & 8) >> 1), vc = (sub & 3) * 32 + (lane & 3) * 8;
        vsrc[i] = (size_t)vk * io.pitch + vc; }
#define A_DMA(T, bf) do { const size_t t0_ = (size_t)((T) * 64) * io.pitch; \
        _Pragma("unroll") for (int i = 0; i < 2; ++i) { \
            glds16((const void*)(io.Kg + t0_ + ksrc[i]), (unsigned)(uintptr_t)(K_lds + (bf) * SHM_T + (wv * 2 + i) * 1024)); \
            if (NEEDV) glds16((const void*)(io.Vg + t0_ + vsrc[i]), (unsigned)(uintptr_t)(V_lds + (bf) * SHM_T + (wv * 2 + i) * 1024)); } } while (0)
#define A_STEP(T) do { \
        const int T_ = (T); const int bsel = (T_ - io.t_lo) & (NB - 1); const int vb0 = vbase + bsel * SHM_T; \
        if (T_ + DEPTH < io.t_hi) A_DMA(T_ + DEPTH, (T_ + DEPTH - io.t_lo) & (NB - 1)); \
        f32x16 p0, p1; qkt(p0, p1, K_lds + bsel * SHM_T, r32, hi, qr); \
        __builtin_amdgcn_sched_barrier(0); \
        int dq; unsigned W = 0x7fffffffu; \
        if (MODE == AM_MOBA) { const int blk = T_ >> 2; dq = (blk == io.own) ? (io.q - T_ * 64) : (((io.mlo >> blk) & 1u) ? ATT_BIG : -1); } \
        else if (MODE == AM_SEL) { const unsigned bit = (T_ < 32) ? ((io.mlo >> T_) & 1u) : ((io.mhi >> (T_ - 32)) & 1u); dq = (T_ == io.own) ? (io.q - T_ * 64) : (bit ? ATT_BIG : -1); } \
        else if (MODE == AM_WIN) { dq = io.q - T_ * 64; W = 512u; } \
        else { dq = io.q - T_ * 64; } \
        dq -= 4 * hi; \
        { const float NEG = -__builtin_inff(); \
          _Pragma("unroll") for (int r = 0; r < 16; ++r) { const int c = (r & 3) + 8 * (r >> 2); \
              if ((unsigned)(dq - c) >= W) p0[r] = NEG; if ((unsigned)(dq - c - 32) >= W) p1[r] = NEG; } } \
        if (MODE == AM_COUT) { \
            const float mL = -m_reg * ATT_C2; \
            _Pragma("unroll") for (int r = 0; r < 16; ++r) { p0[r] = __builtin_amdgcn_exp2f(fmaf(p0[r], ATT_C2, mL)) * inv_l; p1[r] = __builtin_amdgcn_exp2f(fmaf(p1[r], ATT_C2, mL)) * inv_l; } \
              \
            { float prev = carry; \
              _Pragma("unroll") for (int g = 0; g < 8; ++g) { \
                  const float s4 = (g < 4) ? ((p0[4 * (g & 3)] + p0[4 * (g & 3) + 1]) + (p0[4 * (g & 3) + 2] + p0[4 * (g & 3) + 3])) : ((p1[4 * (g & 3)] + p1[4 * (g & 3) + 1]) + (p1[4 * (g & 3) + 2] + p1[4 * (g & 3) + 3])); \
                  const float sp = (g < 4) ? p0[4 * (g & 3) + 3] : p1[4 * (g & 3) + 3]; \
                  const float osp = half_other(sp); \
                  imp[16 * T_ + 2 * g + hi] = s4 + (hi ? osp : prev); prev = osp; } \
              carry = prev; } \
            bf16x8 pa0, pa1, pa2, pa3; PK4(p0, 0, pa0); PK4(p0, 8, pa1); PK4(p1, 0, pa2); PK4(p1, 8, pa3); \
            pv_tile(o, vb0, pa0, pa1, pa2, pa3); \
        } else { \
            float pmax = p0[0]; \
            _Pragma("unroll") for (int r = 1; r < 16; ++r) pmax = fmaxf(pmax, p0[r]); \
            _Pragma("unroll") for (int r = 0; r < 16; ++r) pmax = fmaxf(pmax, p1[r]); \
            pmax = half_max(pmax); \
            const float mn = fmaxf(m_reg, pmax); const float alpha = __builtin_amdgcn_exp2f((m_reg - mn) * ATT_C2); m_reg = mn; \
            const float mL = -mn * ATT_C2; float ps = 0.f; \
            _Pragma("unroll") for (int r = 0; r < 16; ++r) { p0[r] = __builtin_amdgcn_exp2f(fmaf(p0[r], ATT_C2, mL)); p1[r] = __builtin_amdgcn_exp2f(fmaf(p1[r], ATT_C2, mL)); ps += p0[r] + p1[r]; } \
            ps = half_sum(ps); l_reg = l_reg * alpha + ps; \
            if (NEEDV) { \
                if (__any(alpha < 1.0f)) { if (hi == 0) wsc[r32] = alpha; LDS_WAIT(); \
                    _Pragma("unroll") for (int r = 0; r < 16; ++r) { const float al = wsc[crow(r, hi)]; o[0][r] *= al; o[1][r] *= al; o[2][r] *= al; o[3][r] *= al; } } \
                bf16x8 pa0, pa1, pa2, pa3; PK4(p0, 0, pa0); PK4(p0, 8, pa1); PK4(p1, 0, pa2); PK4(p1, 8, pa3); \
                    pv_tile(o, vb0, pa0, pa1, pa2, pa3); } \
        } \
          \
        { const int ahead = io.t_hi - 2 - T_; \
          if (DEPTH >= 3 && ahead >= 2) asm volatile("s_waitcnt vmcnt(%0)" :: "n"(2 * PER) : "memory"); \
          else if (DEPTH >= 2 && ahead >= 1) asm volatile("s_waitcnt vmcnt(%0)" :: "n"(PER) : "memory"); \
          else asm volatile("s_waitcnt vmcnt(0)" ::: "memory"); } \
        asm volatile("s_waitcnt lgkmcnt(0)" ::: "memory"); __builtin_amdgcn_s_barrier(); asm volatile("" ::: "memory"); } while (0)

    constexpr int PER = NEEDV ? 4 : 2;
#pragma unroll
    for (int d0 = 0; d0 < 8; ++d0) asm volatile("" :: "v"(qr[d0]));
    asm volatile("" :: "v"(io.mlo), "v"(io.mhi), "v"(io.q));
#pragma unroll
    for (int d = 0; d < DEPTH; ++d) if (io.t_lo + d < io.t_hi) A_DMA(io.t_lo + d, d);
    {   const int ahead = io.t_hi - 1 - io.t_lo;
        if (DEPTH >= 3 && ahead >= 2) asm volatile("s_waitcnt vmcnt(%0)" :: "n"(2 * PER) : "memory");
        else if (DEPTH >= 2 && ahead >= 1) asm volatile("s_waitcnt vmcnt(%0)" :: "n"(PER) : "memory");
        else asm volatile("s_waitcnt vmcnt(0)" ::: "memory"); }
    asm volatile("s_waitcnt lgkmcnt(0)" ::: "memory"); __builtin_amdgcn_s_barrier(); asm volatile("" ::: "memory");
#pragma unroll 1
    for (int T = io.t_lo; T < io.t_hi; ++T) A_STEP(T);
#undef A_DMA
#undef A_STEP
}

template <int MODE>
__device__ __forceinline__ void attn_pass_pipe(ldsp lds, LAS float* wsc, const bf16x8 (&qr)[8], const AttnIO& io, f32x16 (&o)[4], float& m_reg, float& l_reg) {
    constexpr int NB = 4, PER = 4;
    const int tid = otid(), lane = tid & 63, r32 = lane & 31, hi = lane >> 5;
    ldsp V_lds = lds; ldsp K_lds = lds + NB * SHM_T;
    const int vbase = (int)(unsigned)(uintptr_t)V_lds + v_rd_base(lane);
    const int wv = __builtin_amdgcn_readfirstlane(tid >> 6);
    const int q0 = __builtin_amdgcn_readfirstlane(io.q - r32);
    size_t ksrc[2], vsrc[2];
#pragma unroll
    for (int i = 0; i < 2; ++i) { const int ch = wv * 2 + i;
        const int kr = ch * 4 + (lane >> 4), kc = (lane & 15) ^ (kr & 7);
        ksrc[i] = (size_t)kr * io.pitch + kc * 8;
        const int sub = ch * 2 + (lane >> 5), kk = (sub >> 2) * 8 + ((lane & 31) >> 2), vk = (kk & ~0xC) | ((kk & 4) << 1) | ((kk & 8) >> 1), vc = (sub & 3) * 32 + (lane & 3) * 8;
        vsrc[i] = (size_t)vk * io.pitch + vc; }
#define P_DMA(T, bf) do { const size_t t0_ = (size_t)((T) * 64) * io.pitch; \
        _Pragma("unroll") for (int i = 0; i < 2; ++i) { \
            glds16((const void*)(io.Kg + t0_ + ksrc[i]), (unsigned)(uintptr_t)(K_lds + (bf) * SHM_T + (wv * 2 + i) * 1024)); \
            glds16((const void*)(io.Vg + t0_ + vsrc[i]), (unsigned)(uintptr_t)(V_lds + (bf) * SHM_T + (wv * 2 + i) * 1024)); } } while (0)
#define P_STEP(C0, C1, N0, N1, T) do { \
        const int T_ = (T); const int vb0 = vbase + ((T_ - io.t_lo) & 3) * SHM_T; \
        if (T_ + 3 < io.t_hi) P_DMA(T_ + 3, (T_ + 3 - io.t_lo) & 3); \
        if (T_ + 1 < io.t_hi) qkt(N0, N1, K_lds + ((T_ + 1 - io.t_lo) & 3) * SHM_T, r32, hi, qr); \
        __builtin_amdgcn_sched_barrier(0); \
        bool on = true, edge; int dq = io.q - T_ * 64 - 4 * hi; unsigned W = 0x7fffffffu; \
        if (MODE == AM_MOBA) { const int blk = T_ >> 2; edge = (blk == io.own); on = edge || ((io.mlo >> blk) & 1u); } \
        else if (MODE == AM_SEL) { const unsigned bit = (T_ < 32) ? ((io.mlo >> T_) & 1u) : ((io.mhi >> (T_ - 32)) & 1u); edge = (T_ == io.own); on = edge || bit; } \
        else { W = 512u; edge = !((T_ * 64 + 63 <= q0) && (q0 + 31 - T_ * 64 < 512)); } \
        if (edge) { const float NEG = -__builtin_inff(); \
          _Pragma("unroll") for (int r = 0; r < 16; ++r) { const int c = (r & 3) + 8 * (r >> 2); \
              if ((unsigned)(dq - c) >= W) C0[r] = NEG; if ((unsigned)(dq - c - 32) >= W) C1[r] = NEG; } } \
        float mx[8]; \
        _Pragma("unroll") for (int r = 0; r < 8; ++r) mx[r] = fmaxf(fmaxf(C0[2 * r], C0[2 * r + 1]), fmaxf(C1[2 * r], C1[2 * r + 1])); \
        float pmax = fmaxf(fmaxf(fmaxf(mx[0], mx[1]), fmaxf(mx[2], mx[3])), fmaxf(fmaxf(mx[4], mx[5]), fmaxf(mx[6], mx[7]))); \
        pmax = on ? pmax : -__builtin_inff(); \
        pmax = half_max(pmax); \
        const float mn = fmaxf(m_reg, pmax); const float alpha = __builtin_amdgcn_exp2f((m_reg - mn) * ATT_C2); m_reg = mn; \
        const float mL = on ? -mn * ATT_C2 : -__builtin_inff(); float ps0 = 0.f, ps1 = 0.f; \
        _Pragma("unroll") for (int r = 0; r < 16; ++r) { C0[r] = __builtin_amdgcn_exp2f(fmaf(C0[r], ATT_C2, mL)); C1[r] = __builtin_amdgcn_exp2f(fmaf(C1[r], ATT_C2, mL)); ps0 += C0[r]; ps1 += C1[r]; } \
        const float ps = half_sum(ps0 + ps1); l_reg = l_reg * alpha + ps; \
        if (__any(alpha < 1.0f)) { if (hi == 0) wsc[r32] = alpha; LDS_WAIT(); \
            _Pragma("unroll") for (int r = 0; r < 16; ++r) { const float al = wsc[crow(r, hi)]; o[0][r] *= al; o[1][r] *= al; o[2][r] *= al; o[3][r] *= al; } } \
        { bf16x8 pa0, pa1, pa2, pa3; PK4(C0, 0, pa0); PK4(C0, 8, pa1); PK4(C1, 0, pa2); PK4(C1, 8, pa3); \
          pv_tile(o, vb0, pa0, pa1, pa2, pa3); } \
          \
        if (T_ + 3 < io.t_hi) asm volatile("s_waitcnt vmcnt(%0)" :: "n"(PER) : "memory"); else asm volatile("s_waitcnt vmcnt(0)" ::: "memory"); \
        asm volatile("s_waitcnt lgkmcnt(0)" ::: "memory"); __builtin_amdgcn_s_barrier(); asm volatile("" ::: "memory"); } while (0)

#pragma unroll
    for (int d0 = 0; d0 < 8; ++d0) asm volatile("" :: "v"(qr[d0]));
    asm volatile("" :: "v"(io.mlo), "v"(io.mhi), "v"(io.q));
#pragma unroll
    for (int d = 0; d < 3; ++d) if (io.t_lo + d < io.t_hi) P_DMA(io.t_lo + d, d);
    if (io.t_lo + 2 < io.t_hi) asm volatile("s_waitcnt vmcnt(%0)" :: "n"(PER) : "memory"); else asm volatile("s_waitcnt vmcnt(0)" ::: "memory");
    asm volatile("s_waitcnt lgkmcnt(0)" ::: "memory"); __builtin_amdgcn_s_barrier(); asm volatile("" ::: "memory");
    f32x16 pA0, pA1, pB0, pB1;
    qkt(pA0, pA1, K_lds, r32, hi, qr);
#pragma unroll 1
    for (int T = io.t_lo; T < io.t_hi; T += 2) {
        P_STEP(pA0, pA1, pB0, pB1, T);
        if (T + 1 < io.t_hi) P_STEP(pB0, pB1, pA0, pA1, T + 1);
    }
#undef P_DMA
#undef P_STEP
}

template <int MODE>
__device__ __forceinline__ void attn_pass_pipe2(ldsp lds, LAS float* wsc, const bf16x8 (&qr)[8], const AttnIO& io, f32x16 (&o)[4], float& m_reg, float& l_reg) {
    constexpr int NB = 4;
    const int tid = otid(), lane = tid & 63, r32 = lane & 31, hi = lane >> 5;
    ldsp V_lds = lds; ldsp K_lds = lds + NB * SHM_T;
    const int vbase = (int)(unsigned)(uintptr_t)V_lds + v_rd_base(lane);
    const int wv = __builtin_amdgcn_readfirstlane(tid >> 6);
    const bool lead = wv < 4;
    const int q0 = __builtin_amdgcn_readfirstlane(io.q - r32);
    size_t ksrc[2], vsrc[2];
#pragma unroll
    for (int i = 0; i < 2; ++i) { const int ch = wv * 2 + i;
        const int kr = ch * 4 + (lane >> 4), kc = (lane & 15) ^ (kr & 7);
        ksrc[i] = (size_t)kr * io.pitch + kc * 8;
        const int sub = ch * 2 + (lane >> 5), kk = (sub >> 2) * 8 + ((lane & 31) >> 2), vk = (kk & ~0xC) | ((kk & 4) << 1) | ((kk & 8) >> 1), vc = (sub & 3) * 32 + (lane & 3) * 8;
        vsrc[i] = (size_t)vk * io.pitch + vc; }
#define Q_DMAK(T) do { const size_t t0_ = (size_t)((T) * 64) * io.pitch; const int bf_ = ((T) - io.t_lo) & 3; \
        _Pragma("unroll") for (int i = 0; i < 2; ++i) glds16((const void*)(io.Kg + t0_ + ksrc[i]), (unsigned)(uintptr_t)(K_lds + bf_ * SHM_T + (wv * 2 + i) * 1024)); } while (0)
#define Q_DMAV(T) do { const size_t t0_ = (size_t)((T) * 64) * io.pitch; const int bf_ = ((T) - io.t_lo) & 3; \
        _Pragma("unroll") for (int i = 0; i < 2; ++i) glds16((const void*)(io.Vg + t0_ + vsrc[i]), (unsigned)(uintptr_t)(V_lds + bf_ * SHM_T + (wv * 2 + i) * 1024)); } while (0)
#define Q_QKT(N0, N1, T_) do { if ((T_) + 1 < io.t_hi) qkt(N0, N1, K_lds + (((T_) + 1 - io.t_lo) & 3) * SHM_T, r32, hi, qr); __builtin_amdgcn_sched_barrier(0); } while (0)
#define Q_PV(TT) do { pv_tile(o, vbase + (((TT) - io.t_lo) & 3) * SHM_T, pa0, pa1, pa2, pa3); __builtin_amdgcn_sched_barrier(0); } while (0)
#define Q_SOFTMAX(C0, C1, T_) do { \
        bool on = true, edge; int dq = io.q - (T_) * 64 - 4 * hi; unsigned W = 0x7fffffffu; \
        if (MODE == AM_MOBA) { const int blk = (T_) >> 2; edge = (blk == io.own); on = edge || ((io.mlo >> blk) & 1u); } \
        else if (MODE == AM_SEL) { const unsigned bit = ((T_) < 32) ? ((io.mlo >> (T_)) & 1u) : ((io.mhi >> ((T_) - 32)) & 1u); edge = ((T_) == io.own); on = edge || bit; } \
        else { W = 512u; edge = !(((T_) * 64 + 63 <= q0) && (q0 + 31 - (T_) * 64 < 512)); } \
        if (edge) { const float NEG = -__builtin_inff(); \
          _Pragma("unroll") for (int r = 0; r < 16; ++r) { const int c = (r & 3) + 8 * (r >> 2); \
              if ((unsigned)(dq - c) >= W) C0[r] = NEG; if ((unsigned)(dq - c - 32) >= W) C1[r] = NEG; } } \
        float mx[8]; \
        _Pragma("unroll") for (int r = 0; r < 8; ++r) mx[r] = fmaxf(fmaxf(C0[2 * r], C0[2 * r + 1]), fmaxf(C1[2 * r], C1[2 * r + 1])); \
        float pmax = fmaxf(fmaxf(fmaxf(mx[0], mx[1]), fmaxf(mx[2], mx[3])), fmaxf(fmaxf(mx[4], mx[5]), fmaxf(mx[6], mx[7]))); \
        pmax = on ? pmax : -__builtin_inff(); \
        pmax = half_max(pmax); \
          \
        const bool upd = __any((pmax - m_reg) * ATT_C2 > ATT_DEFER); float alpha = 1.0f; \
        if (upd) { const float mn = fmaxf(m_reg, pmax); alpha = __builtin_amdgcn_exp2f((m_reg - mn) * ATT_C2); m_reg = mn; } \
        const float mL = on ? -m_reg * ATT_C2 : -__builtin_inff(); float ps0 = 0.f, ps1 = 0.f; \
        _Pragma("unroll") for (int r = 0; r < 16; ++r) { C0[r] = __builtin_amdgcn_exp2f(fmaf(C0[r], ATT_C2, mL)); C1[r] = __builtin_amdgcn_exp2f(fmaf(C1[r], ATT_C2, mL)); ps0 += C0[r]; ps1 += C1[r]; } \
        const float ps = half_sum(ps0 + ps1); l_reg = l_reg * alpha + ps; \
        if (upd) { if (hi == 0) wsc[r32] = alpha; LDS_WAIT(); \
            _Pragma("unroll") for (int r = 0; r < 16; ++r) { const float al = wsc[crow(r, hi)]; o[0][r] *= al; o[1][r] *= al; o[2][r] *= al; o[3][r] *= al; } } \
        PK4(C0, 0, pa0); PK4(C0, 8, pa1); PK4(C1, 0, pa2); PK4(C1, 8, pa3); __builtin_amdgcn_sched_barrier(0); } while (0)
#define Q_STEP(C0, C1, N0, N1, T) do { \
        const int T_ = (T); \
        if (T_ + 3 < io.t_hi) Q_DMAK(T_ + 3); \
        if (T_ + 2 < io.t_hi) Q_DMAV(T_ + 2); \
        if (!lead && T_ > io.t_lo) Q_PV(T_ - 1); \
        Q_QKT(N0, N1, T_); Q_SOFTMAX(C0, C1, T_); \
        if (lead) Q_PV(T_); \
          \
        { const int nk = (T_ + 3 < io.t_hi) ? 2 : 0, nv = (T_ + 2 < io.t_hi) ? 2 : 0; \
          if (nk + nv == 4) asm volatile("s_waitcnt vmcnt(4)" ::: "memory"); else if (nk + nv == 2) asm volatile("s_waitcnt vmcnt(2)" ::: "memory"); else asm volatile("s_waitcnt vmcnt(0)" ::: "memory"); } \
        asm volatile("s_waitcnt lgkmcnt(0)" ::: "memory"); __builtin_amdgcn_s_barrier(); asm volatile("" ::: "memory"); } while (0)

#pragma unroll
    for (int d0 = 0; d0 < 8; ++d0) asm volatile("" :: "v"(qr[d0]));
    asm volatile("" :: "v"(io.mlo), "v"(io.mhi), "v"(io.q));
    Q_DMAK(io.t_lo); Q_DMAV(io.t_lo);
    if (io.t_lo + 1 < io.t_hi) { Q_DMAK(io.t_lo + 1); Q_DMAV(io.t_lo + 1); }
    if (io.t_lo + 2 < io.t_hi) Q_DMAK(io.t_lo + 2);
    { const int young = ((io.t_lo + 1 < io.t_hi) ? 2 : 0) + ((io.t_lo + 2 < io.t_hi) ? 2 : 0);
      if (young == 4) asm volatile("s_waitcnt vmcnt(4)" ::: "memory"); else if (young == 2) asm volatile("s_waitcnt vmcnt(2)" ::: "memory"); else asm volatile("s_waitcnt vmcnt(0)" ::: "memory"); }
    asm volatile("s_waitcnt lgkmcnt(0)" ::: "memory"); __builtin_amdgcn_s_barrier(); asm volatile("" ::: "memory");
    f32x16 pA0, pA1, pB0, pB1; bf16x8 pa0, pa1, pa2, pa3;
    pa0 = pa1 = pa2 = pa3 = (bf16x8){0, 0, 0, 0, 0, 0, 0, 0};
    qkt(pA0, pA1, K_lds, r32, hi, qr);
#pragma unroll 1
    for (int T = io.t_lo; T < io.t_hi; T += 2) {
        Q_STEP(pA0, pA1, pB0, pB1, T);
        if (T + 1 < io.t_hi) Q_STEP(pB0, pB1, pA0, pA1, T + 1);
    }
    if (!lead) Q_PV(io.t_hi - 1);
#undef Q_DMAK
#undef Q_DMAV
#undef Q_QKT
#undef Q_PV
#undef Q_SOFTMAX
#undef Q_STEP
}

__device__ __forceinline__ void load_q(bf16x8 (&qr)[8], const bf16_t* qrow, int hi) {
#pragma unroll
    for (int d0 = 0; d0 < 8; ++d0) qr[d0] = *(const bf16x8*)(qrow + d0 * 16 + hi * 8);
}


__device__ __forceinline__ float dpp_xor1(float v) { return __int_as_float(__builtin_amdgcn_mov_dpp(__float_as_int(v), 0xB1, 0xF, 0xF, true)); }
__device__ __forceinline__ void store_o_bf16(const f32x16 (&o)[4], const LAS float* wsc, bf16_t* dst, size_t pitch, int r32, int hi) {
    float sc[16];
#pragma unroll
    for (int r = 0; r < 16; ++r) sc[r] = wsc[crow(r, hi)];
    asm volatile("" : "+v"(sc[0]), "+v"(sc[1]), "+v"(sc[2]), "+v"(sc[3]), "+v"(sc[4]), "+v"(sc[5]), "+v"(sc[6]), "+v"(sc[7]));
    asm volatile("" : "+v"(sc[8]), "+v"(sc[9]), "+v"(sc[10]), "+v"(sc[11]), "+v"(sc[12]), "+v"(sc[13]), "+v"(sc[14]), "+v"(sc[15]));
#pragma unroll
    for (int d0 = 0; d0 < 4; ++d0) { unsigned pk[16];
#pragma unroll
        for (int r = 0; r < 16; ++r) { const float v = o[d0][r] * sc[r]; pk[r] = cvtpk(v, dpp_xor1(v)); }
        if ((r32 & 1) == 0) {
#pragma unroll
            for (int r = 0; r < 16; ++r) *(unsigned*)(dst + (size_t)crow(r, hi) * pitch + d0 * 32 + r32) = pk[r]; }
        __builtin_amdgcn_sched_barrier(0); }
}

constexpr int MB_Q = 0, MB_KM = 69632, MB_GT = 77824, MB_SELM = 131072, MB_WSC = 132096;
__device__ __forceinline__ void moba_gate(ldsp lds, unsigned char* ws, int unit) {
    const int qb = unit & 15, h = (unit >> 4) & 7, b = unit >> 7;
    const bf16_t* proj = (const bf16_t*)(ws + WS_PROJ);
    const int tid = otid();
    LAS float* KM = (LAS float*)(lds + MB_KM);
    LAS float* GT = (LAS float*)(lds + MB_GT);
    LAS unsigned* SELM = (LAS unsigned*)(lds + MB_SELM);
    const size_t row0 = (size_t)b * SEQ + (size_t)qb * 256;
    const float* km = (const float*)(ws + SM_KMEAN) + (size_t)((b * 8 + h) * 16) * 128;
    {   u32x4 qw[8]; float kw[4];
#pragma unroll
        for (int i = 0; i < 8; ++i) { const int c = tid + 512 * i; qw[i] = *(const u32x4*)(proj + (row0 + (c >> 4)) * NP + C_MQ + h * 128 + (c & 15) * 8); }
#pragma unroll
        for (int i = 0; i < 4; ++i) kw[i] = km[tid + 512 * i];
#pragma unroll
        for (int i = 0; i < 8; ++i) { const int c = tid + 512 * i; *(LAS u32x4*)(lds + MB_Q + (c >> 4) * P272 + (c & 15) * 16) = qw[i]; }
#pragma unroll
        for (int i = 0; i < 4; ++i) KM[tid + 512 * i] = kw[i]; }
    __syncthreads();
    const int ql = tid >> 1, n0 = (tid & 1) * 8;
    float acc[8] = {0, 0, 0, 0, 0, 0, 0, 0};
    if (n0 < qb) {
#pragma unroll 2
        for (int i = 0; i < 16; ++i) { float qf[8]; unpack8(*(const LAS u32x4*)(lds + MB_Q + ql * P272 + i * 16), qf); const int d = 8 * i;
#pragma unroll
            for (int n = 0; n < 8; ++n) { const f32x4 k0 = *(const LAS f32x4*)(KM + (n0 + n) * 128 + d), k1 = *(const LAS f32x4*)(KM + (n0 + n) * 128 + d + 4);
                acc[n] += (qf[0] * k0.x + qf[1] * k0.y) + (qf[2] * k0.z + qf[3] * k0.w) + (qf[4] * k1.x + qf[5] * k1.y) + (qf[6] * k1.z + qf[7] * k1.w); } } }
#pragma unroll
    for (int n = 0; n < 8; ++n) GT[ql * 16 + n0 + n] = acc[n];
    __syncthreads();
    if (tid < 256) { unsigned m = 0u;
        if (qb <= 3) m = (1u << qb) - 1u;
        else { float g[16];
#pragma unroll
            for (int n = 0; n < 16; ++n) g[n] = (n < qb) ? GT[tid * 16 + n] : -__builtin_inff();
#pragma unroll
            for (int pick = 0; pick < 3; ++pick) { float best = -__builtin_inff(); int bi = 0;
#pragma unroll
                for (int n = 0; n < 16; ++n) { const bool tk = g[n] > best; best = tk ? g[n] : best; bi = tk ? n : bi; }
                m |= 1u << bi;
#pragma unroll
                for (int n = 0; n < 16; ++n) g[n] = (n == bi) ? -__builtin_inff() : g[n]; } }
        SELM[tid] = m; }
    __syncthreads();
}
__device__ NOINL void moba_unit(ldsp lds, int unit) {
    unsigned char* ws = ows();
    moba_gate(lds, ws, unit);
    f32x16 o[4] = {}; float m_reg = -1e30f, l_reg = 0.f;
    {   const int qb = unit & 15, h = (unit >> 4) & 7, b = unit >> 7;
        const bf16_t* proj = (const bf16_t*)(ws + WS_PROJ);
        const int tid = otid(), lane = tid & 63, wave = __builtin_amdgcn_readfirstlane(tid >> 6), r32 = lane & 31, hi = lane >> 5;
        const size_t row0 = (size_t)b * SEQ + (size_t)qb * 256;
        bf16x8 qr[8]; load_q(qr, proj + (row0 + wave * 32 + r32) * NP + C_MQ + h * 128, hi);
        AttnIO io; io.Kg = proj + (size_t)b * SEQ * NP + C_MK + h * 128; io.Vg = proj + (size_t)b * SEQ * NP + C_MV + h * 128; io.pitch = NP;
        io.t_lo = 0; io.t_hi = 4 * qb + 4; io.q = qb * 256 + wave * 32 + r32; io.own = qb; io.mlo = ((LAS unsigned*)(lds + MB_SELM))[wave * 32 + r32]; io.mhi = 0u;
        attn_pass_pipe2<AM_MOBA>(lds, (LAS float*)(lds + MB_WSC) + wave * 64, qr, io, o, m_reg, l_reg);
    }
    {   int u2 = unit; OPQ_S(u2); const int tz = otid();
        const int qb = u2 & 15, h = (u2 >> 4) & 7, b = u2 >> 7;
        const int lane = tz & 63, wave = __builtin_amdgcn_readfirstlane(tz >> 6), r32 = lane & 31, hi = lane >> 5;
        LAS float* wsc = (LAS float*)(lds + MB_WSC) + wave * 64;
        const size_t row0 = (size_t)b * SEQ + (size_t)qb * 256;
        if (hi == 0) wsc[r32] = 1.0f / l_reg;
        LDS_WAIT();
        store_o_bf16(o, wsc, (bf16_t*)(ws + WS_Y) + (row0 + wave * 32) * DM + 1024 + h * 128, DM, r32, hi);
    }
    __syncthreads();
}

constexpr int NS_IMP = 65536, NS_SELM = 131072, NS_GATE = 131584, NS_WSC = 135680;
struct NsaIdx { int qt, kvh, b, lane, wave, r32, hi, hl, qh, hh, qloc, qpos; size_t row0; };
__device__ __forceinline__ NsaIdx nsa_idx(int unit, int tid) {
    NsaIdx x; x.qt = unit & 63; x.kvh = (unit >> 6) & 1; x.b = unit >> 7; x.lane = tid & 63; x.wave = __builtin_amdgcn_readfirstlane(tid >> 6); x.r32 = x.lane & 31; x.hi = x.lane >> 5;
    x.hl = x.wave >> 1; x.qh = x.wave & 1; x.hh = x.kvh * 4 + x.hl; x.qloc = x.qh * 32 + x.r32; x.qpos = x.qt * 64 + x.qloc; x.row0 = (size_t)x.b * SEQ + (size_t)x.qt * 64; return x;
}
__device__ NOINL void nsa_cmp_branch(ldsp lds, int unit) {
    unsigned char* ws = ows();
    f32x16 o[4]; float m_reg = -1e30f, l_reg = 0.f;
#pragma unroll
    for (int d = 0; d < 4; ++d) o[d] = f32x16{};
    {   const NsaIdx x = nsa_idx(unit, otid());
        const bf16_t* proj = (const bf16_t*)(ws + WS_PROJ);
        LAS float* GATEL = (LAS float*)(lds + NS_GATE);
        if (x.hi == 0) {
#pragma unroll
            for (int br = 0; br < 3; ++br) GATEL[(x.wave * 32 + x.r32) * 4 + br] = sigmoidf_(bf2f(proj[(x.row0 + x.qloc) * NP + C_NGATE + x.hh * 3 + br])); }
        bf16x8 qr[8]; load_q(qr, proj + (x.row0 + x.qloc) * NP + C_NQ + x.hh * 128, x.hi);
        AttnIO io; io.pitch = 128; io.own = 0; io.mlo = 0u; io.mhi = 0u;
        io.Kg = (const bf16_t*)(ws + SM_KC) + (size_t)(x.b * 2 + x.kvh) * 256 * 128; io.Vg = (const bf16_t*)(ws + SM_VC) + (size_t)(x.b * 2 + x.kvh) * 256 * 128;
        io.t_lo = 0; io.t_hi = ((4 * x.qt + 2) >> 6) + 1; io.q = (x.qpos >= 31) ? ((x.qpos - 31) >> 4) : -1;
        LAS float* wsc = (LAS float*)(lds + NS_WSC) + x.wave * 64;
        attn_pass<AM_CSTAT, 2>(lds, wsc, qr, io, o, m_reg, l_reg, 0.f, nullptr);
        const float inv_l = (l_reg > 0.f) ? 1.0f / l_reg : 0.f;
        attn_pass<AM_COUT, 2>(lds, wsc, qr, io, o, m_reg, l_reg, inv_l, (LAS float*)(lds + NS_IMP) + (x.hl * 64 + x.qloc) * 64);
    }
    {   int u2 = unit; OPQ_S(u2); const int tz = otid();
        const NsaIdx x = nsa_idx(u2, tz);
        const LAS float* GATEL = (const LAS float*)(lds + NS_GATE);
        float* accp = (float*)(ws + WS_NSAACC) + (x.row0 + x.qh * 32) * 1024 + x.hh * 128;
        LDS_WAIT();
        float g0[16];
#pragma unroll
        for (int r = 0; r < 16; ++r) g0[r] = GATEL[(x.wave * 32 + crow(r, x.hi)) * 4 + 0];
        asm volatile("" : "+v"(g0[0]), "+v"(g0[1]), "+v"(g0[2]), "+v"(g0[3]), "+v"(g0[4]), "+v"(g0[5]), "+v"(g0[6]), "+v"(g0[7]));
        asm volatile("" : "+v"(g0[8]), "+v"(g0[9]), "+v"(g0[10]), "+v"(g0[11]), "+v"(g0[12]), "+v"(g0[13]), "+v"(g0[14]), "+v"(g0[15]));
#pragma unroll
        for (int r = 0; r < 16; ++r) { const int row = crow(r, x.hi);
#pragma unroll
            for (int d0 = 0; d0 < 4; ++d0) accp[(size_t)row * 1024 + d0 * 32 + x.r32] = g0[r] * o[d0][r]; }
    }
    __syncthreads();
    {   int u2 = unit; OPQ_S(u2); const int tid = otid();
        const int qt = u2 & 63;
        LAS float* IMP = (LAS float*)(lds + NS_IMP); LAS unsigned* SELM = (LAS unsigned*)(lds + NS_SELM);
        const int q = tid >> 3, jg = tid & 7;
        float v[8];
#pragma unroll
        for (int xx = 0; xx < 8; ++xx) { const int j = jg * 8 + xx; v[xx] = (IMP[(0 * 64 + q) * 64 + j] + IMP[(1 * 64 + q) * 64 + j]) + (IMP[(2 * 64 + q) * 64 + j] + IMP[(3 * 64 + q) * 64 + j]);
            if (j > qt) v[xx] = -__builtin_inff();
            if (j == 0 || j == qt || j == qt - 1) v[xx] = __builtin_inff(); }
        __syncthreads();
#pragma unroll
        for (int xx = 0; xx < 8; ++xx) IMP[q * 64 + jg * 8 + xx] = v[xx];
        __syncthreads();
        int rank[8] = {0, 0, 0, 0, 0, 0, 0, 0};
        for (int j2 = 0; j2 < 64; ++j2) { const float w = IMP[q * 64 + j2];
#pragma unroll
            for (int xx = 0; xx < 8; ++xx) { const int j = jg * 8 + xx; rank[xx] += (w > v[xx] || (w == v[xx] && j2 < j)) ? 1 : 0; } }
        unsigned bits = 0u;
#pragma unroll
        for (int xx = 0; xx < 8; ++xx) bits |= (rank[xx] < 16) ? (1u << xx) : 0u;
        unsigned lo = (jg < 4) ? (bits << (8 * jg)) : 0u, hiw = (jg >= 4) ? (bits << (8 * (jg - 4))) : 0u;
        lo |= __shfl_xor(lo, 1); lo |= __shfl_xor(lo, 2); lo |= __shfl_xor(lo, 4);
        hiw |= __shfl_xor(hiw, 1); hiw |= __shfl_xor(hiw, 2); hiw |= __shfl_xor(hiw, 4);
        if (jg == 0) { SELM[q * 2] = lo; SELM[q * 2 + 1] = hiw; }
        __syncthreads();
    }
}
template <int BR>
__device__ NOINL void nsa_attn_branch(ldsp lds, int unit) {
    unsigned char* ws = ows();
    f32x16 o[4]; float m_reg = -1e30f, l_reg = 0.f;
#pragma unroll
    for (int d = 0; d < 4; ++d) o[d] = f32x16{};
    {   const NsaIdx x = nsa_idx(unit, otid());
        const bf16_t* proj = (const bf16_t*)(ws + WS_PROJ);
        bf16x8 qr[8]; load_q(qr, proj + (x.row0 + x.qloc) * NP + C_NQ + x.hh * 128, x.hi);
        AttnIO io; io.pitch = NP; io.q = x.qpos; io.t_hi = x.qt + 1;
        const LAS unsigned* SELM = (const LAS unsigned*)(lds + NS_SELM);
        LAS float* wsc = (LAS float*)(lds + NS_WSC) + x.wave * 64;
        if (BR == 1) { io.Kg = proj + (size_t)x.b * SEQ * NP + C_NKS + x.kvh * 128; io.Vg = proj + (size_t)x.b * SEQ * NP + C_NVS + x.kvh * 128;
            io.t_lo = 0; io.own = x.qt; io.mlo = SELM[x.qloc * 2]; io.mhi = SELM[x.qloc * 2 + 1];
            attn_pass_pipe2<AM_SEL>(lds, wsc, qr, io, o, m_reg, l_reg); }
        else { io.Kg = proj + (size_t)x.b * SEQ * NP + C_NKW + x.kvh * 128; io.Vg = proj + (size_t)x.b * SEQ * NP + C_NVW + x.kvh * 128;
            io.t_lo = (x.qt >= 8) ? x.qt - 8 : 0; io.own = 0; io.mlo = 0u; io.mhi = 0u;
#ifndef PROBE_WINREP
#define PROBE_WINREP 1
#endif
            int nrep = PROBE_WINREP; OPQ_S(nrep);
#pragma unroll 1
            for (int rp = 0; rp < nrep; ++rp) {
#pragma unroll
                for (int d = 0; d < 4; ++d) o[d] = f32x16{};
                m_reg = -1e30f; l_reg = 0.f;
                attn_pass_pipe2<AM_WIN>(lds, wsc, qr, io, o, m_reg, l_reg); } }
    }
    {   int u2 = unit; OPQ_S(u2); const int tz = otid();
        const NsaIdx x = nsa_idx(u2, tz);
        const LAS float* GATEL = (const LAS float*)(lds + NS_GATE);
        LAS float* wsc = (LAS float*)(lds + NS_WSC) + x.wave * 64;
        float* accp = (float*)(ws + WS_NSAACC) + (x.row0 + x.qh * 32) * 1024 + x.hh * 128;
        if (x.hi == 0) wsc[32 + x.r32] = GATEL[(x.wave * 32 + x.r32) * 4 + BR] / l_reg;
        LDS_WAIT();
        if (BR == 1) {
            float pv[4][16];
#pragma unroll
            for (int d0 = 0; d0 < 4; ++d0)
#pragma unroll
                for (int r = 0; r < 16; ++r) pv[d0][r] = accp[(size_t)crow(r, x.hi) * 1024 + d0 * 32 + x.r32];
            asm volatile("" ::: "memory");
#pragma unroll
            for (int d0 = 0; d0 < 4; ++d0)
#pragma unroll
                for (int r = 0; r < 16; ++r) { const int row = crow(r, x.hi); accp[(size_t)row * 1024 + d0 * 32 + x.r32] = pv[d0][r] + wsc[32 + row] * o[d0][r]; } }
        else { bf16_t* yp = (bf16_t*)(ws + WS_Y) + (x.row0 + x.qh * 32) * DM + 3072 + x.hh * 128;
            float sc[16];
#pragma unroll
            for (int r = 0; r < 16; ++r) sc[r] = wsc[32 + crow(r, x.hi)];
            asm volatile("" : "+v"(sc[0]), "+v"(sc[1]), "+v"(sc[2]), "+v"(sc[3]), "+v"(sc[4]), "+v"(sc[5]), "+v"(sc[6]), "+v"(sc[7]));
            asm volatile("" : "+v"(sc[8]), "+v"(sc[9]), "+v"(sc[10]), "+v"(sc[11]), "+v"(sc[12]), "+v"(sc[13]), "+v"(sc[14]), "+v"(sc[15]));
#pragma unroll
            for (int d0 = 0; d0 < 4; ++d0)
#pragma unroll
                for (int r = 0; r < 16; ++r) o[d0][r] *= sc[r];
            float pv[4][16];
#pragma unroll
            for (int d0 = 0; d0 < 4; ++d0)
#pragma unroll
                for (int r = 0; r < 16; ++r) pv[d0][r] = accp[(size_t)crow(r, x.hi) * 1024 + d0 * 32 + x.r32];
            asm volatile("" ::: "memory");
#pragma unroll
            for (int d0 = 0; d0 < 4; ++d0) { unsigned pk[16];
#pragma unroll
                for (int r = 0; r < 16; ++r) { const float v = pv[d0][r] + o[d0][r]; pk[r] = cvtpk(v, dpp_xor1(v)); }
                if ((x.r32 & 1) == 0) {
#pragma unroll
                    for (int r = 0; r < 16; ++r) *(unsigned*)(yp + (size_t)crow(r, x.hi) * DM + d0 * 32 + x.r32) = pk[r]; }
                __builtin_amdgcn_sched_barrier(0); } }
    }
    __syncthreads();
}

__device__ __forceinline__ void s3_phase(ldsp lds, int layer) {
    int G = gridDim.x, bid = blockIdx.x; OPQ_S(G); OPQ_S(bid);
#ifndef S3_MASK
#define S3_MASK 0x3f
#endif
#ifndef S3_DUP
#define S3_DUP 0
#endif
#define S3REP(b) _Pragma("unroll 1") for (int r3_ = 0; r3_ < 1 + ((S3_DUP >> (b)) & 1); ++r3_)
    for (int u = bid; u < 256; u += G) {
        const int x = u & 7, slot = u >> 3, qbm = slot & 15;
        const int mu = (G == 256) ? ((2 * x + (slot >> 4)) * 16 + qbm) : u;
        if (S3_MASK & 1) S3REP(0) moba_unit(lds, mu); }
    for (int u = bid; u < 256; u += G) {
        int nu;
        if (G == 256) { const int x = u & 7, slot = u >> 3, qbm = slot & 15, r = 2 * (x & 1) + (slot >> 4); nu = (x >> 1) * 64 + (63 - 4 * qbm - r); }
        else { const int qbm = u & 15, bh = u >> 4; nu = (bh >> 2) * 64 + (63 - 4 * qbm - (bh & 3)); }
        if (S3_MASK & 2) S3REP(1) nsa_cmp_branch(lds, nu); if (S3_MASK & 4) S3REP(2) nsa_attn_branch<1>(lds, nu); if (S3_MASK & 8) S3REP(3) nsa_attn_branch<2>(lds, nu); }
    if (S3_MASK & 16) S3REP(4) for (int u = bid; u < 512; u += G) ret_out_unit(lds, layer, u);
    if (S3_MASK & 32) S3REP(5) for (int u = bid; u < 128; u += G) lru_out_unit(lds, u);
}

constexpr int N_PHASES = 16;
struct Args { const float* in[23]; float* out; unsigned char* ws; int ph_lo, ph_hi, li, pad; };
template <class Epi>
__device__ NOINL void gemm_call(ldsp lds, const bf16_t* A, const bf16_t* Bt, int N, int K, Epi E) {
    pg8::Gemm g{A, Bt, MTOK, N, K}; pg8::StaticOrder S; S.init(MTOK, N, (int)gridDim.x, (int)blockIdx.x);
    pg8::gemm_phase<Epi, pg8::StaticOrder, true, true>(lds, g, S, E);
}
template <class Epi>
__device__ NOINL void gemm_call_norm(ldsp lds, const bf16_t* A, const bf16_t* Bt, int N, int K, const float* ssq, Epi E, int Gg) {
    pg8::Gemm g{A, Bt, MTOK, N, K}; pg8::StaticOrder S; S.init(MTOK, N, Gg, (int)blockIdx.x);
    pg8::Unit u0; if (!S.next(0, u0)) return;
    E.fm = (u0.pm >> 3) << 3;
    pg8::epi_rstd_table(ssq, E.fm, (LAS float*)E.xl, otid());
    pg8::gemm_phase<Epi, pg8::StaticOrder, false, true>(lds, g, S, E);
}
__global__ void __launch_bounds__(NTHR, 2) trunk_fwd(Args args) {
    extern __shared__ __attribute__((aligned(16))) unsigned char lds_raw[];
    const ldsp lds = (ldsp)lds_raw;
    volatile LAS unsigned* MISC = (volatile LAS unsigned*)(lds + MISC_OFF);
    if (threadIdx.x < 64) MISC[threadIdx.x] = 0u;
    __syncthreads();
    const int lo = args.ph_lo, hi = args.ph_hi;
    unsigned char* ws = args.ws;
    XcdBarrier bar; bar.bar = (unsigned*)(ws + WS_CTL) + CW_BAR + args.li * XCD_BAR_WORDS; bar.x = 0; bar.st = nullptr;
    if (hi - lo > 1) bar = xcd_barrier_post((unsigned*)(ws + WS_CTL) + CW_BAR + args.li * XCD_BAR_WORDS, MISC + 8);
#ifndef PH_MASK
#define PH_MASK 0xfff
#endif
#define IN(k) (lo <= (k) && (k) < hi)
#define ON(b) ((PH_MASK >> (b)) & 1)
#ifndef PROBE_DUP
#define PROBE_DUP 0
#endif
#define REP(b) _Pragma("unroll 1") for (int rep_ = 0; rep_ < 1 + ((PROBE_DUP >> (b)) & 1); ++rep_)
#define SEAM(k) do { if (IN(k) && IN((k) + 1)) xcd_barrier(bar); } while (0)

    if (ON(0) && IN(0)) REP(0) p0_prologue(lds);
    SEAM(0);
    const ldsp xl = lds + 131072;
#pragma unroll
    for (int layer = 0; layer < 2; ++layer) {
        const int pb = 1 + 7 * layer;
        bf16_t* x_in = (bf16_t*)(ws + (layer == 0 ? WS_XS0 : WS_XS2)); bf16_t* x_mid = (bf16_t*)(ws + WS_XS1); bf16_t* x_out = (bf16_t*)(ws + (layer == 0 ? WS_XS2 : WS_XS0));
        float* ssqa = (float*)(ws + SM_SSQA); float* ssqb = (float*)(ws + SM_SSQB);
        if (ON(5) && IN(pb + 0)) {
            const bool split = (SPLIT_INPROJ0 && layer == 0 && gridDim.x == 256);
            if (split && (int)blockIdx.x >= GEMM0_WGS) deferred_phase(lds, GEMM0_WGS, 0, 9);
            else REP(5) gemm_call_norm(lds, x_in, (const bf16_t*)(ws + WS_WIN) + (size_t)layer * NP * DM, NP, DM, ssqa, pg8::EpiBf16N{(bf16_t*)(ws + WS_PROJ), NP, 0, xl}, split ? GEMM0_WGS : (int)gridDim.x);
        }
        SEAM(pb + 0);
        if (ON(3) && IN(pb + 1)) REP(3) s1_phase(lds, layer);
        SEAM(pb + 1);
        if (ON(3) && IN(pb + 2)) { ret_scan_phase(lds); for (int u = (int)gridDim.x - 1 - (int)blockIdx.x; u < 64; u += (int)gridDim.x) nsa_cmp2_unit(lds, layer, u); }
        SEAM(pb + 2);
        if (ON(4) && IN(pb + 3)) REP(4) s3_phase(lds, layer);
        SEAM(pb + 3);
        if (ON(6) && IN(pb + 4)) REP(6) gemm_call(lds, (const bf16_t*)(ws + WS_Y), (const bf16_t*)(ws + WS_WOUT) + (size_t)layer * DM * DM, DM, DM, pg8::EpiResidB{x_in, x_mid, DM, ssqb, xl});
        SEAM(pb + 4);
        if (ON(7) && IN(pb + 5)) {
            const bool split = (SPLIT_GU0 && layer == 0 && gridDim.x == 256);
            if (split && (int)blockIdx.x >= GU0_WGS) deferred_phase(lds, GU0_WGS, 4, 9);
            else REP(7) gemm_call_norm(lds, x_mid, (const bf16_t*)(ws + WS_WGU) + (size_t)layer * NGU * DM, NGU, DM, ssqb, pg8::EpiSwiGLUN{(bf16_t*)(ws + WS_U), DFF, 0, xl}, split ? GU0_WGS : (int)gridDim.x);
        }
        SEAM(pb + 5);
        if (ON(8) && IN(pb + 6)) REP(8) gemm_call(lds, (const bf16_t*)(ws + WS_U), (const bf16_t*)(ws + WS_WDN) + (size_t)layer * DM * DFF, DM, DFF, pg8::EpiResidB{x_mid, x_out, DM, ssqa, xl});
        SEAM(pb + 6);
    }
    if (ON(1) && IN(15)) final_norm_phase(lds, (const bf16_t*)(ws + WS_XS0), (const float*)(ws + SM_SSQA), inp(22), args.out);
#undef IN
#undef SEAM
}

extern "C" void kernel_launch(void* const* d_in, const int* in_sizes, int n_in, void* d_out, int out_size, void* d_ws, size_t ws_size, hipStream_t stream) {
    static int grid = 0;
    if (grid == 0) {
        if (n_in != 23 || in_sizes[0] != MTOK * DM || out_size != MTOK * DM || ws_size < WS_END) {
            fprintf(stderr, "kernel_launch: unexpected shapes (n_in %d, in0 %d, out %d, ws %zu < %zu); nothing launched\n", n_in, n_in > 0 ? in_sizes[0] : -1, out_size, ws_size, (size_t)WS_END); grid = -1; return; }
        int dev = 0, cus = 0, per_cu = 0;
        if (hipGetDevice(&dev) != hipSuccess || hipDeviceGetAttribute(&cus, hipDeviceAttributeMultiprocessorCount, dev) != hipSuccess) { fprintf(stderr, "kernel_launch: device query failed\n"); grid = -1; return; }
        if (hipFuncSetAttribute((const void*)trunk_fwd, hipFuncAttributeMaxDynamicSharedMemorySize, LDS_BYTES) != hipSuccess) { fprintf(stderr, "kernel_launch: hipFuncSetAttribute(%d B LDS) failed\n", LDS_BYTES); grid = -1; return; }
        if (hipOccupancyMaxActiveBlocksPerMultiprocessor(&per_cu, (const void*)trunk_fwd, NTHR, LDS_BYTES) != hipSuccess || per_cu < 1)
            fprintf(stderr, "kernel_launch: note: occupancy query reports %d workgroups per CU\n", per_cu);
        (void)hipGetLastError();
        grid = cus;
    }
    if (grid < 0) return;
    if (hipMemsetAsync((char*)d_ws + WS_CTL, 0, CTL_ZERO_BYTES, stream) != hipSuccess) { fprintf(stderr, "kernel_launch: memset failed\n"); return; }
    Args a{};
    for (int i = 0; i < 23; ++i) a.in[i] = (const float*)d_in[i];
    a.out = (float*)d_out; a.ws = (unsigned char*)d_ws; a.pad = 0;
#if MK_LAUNCHES == 1
    a.ph_lo = 0; a.ph_hi = N_PHASES; a.li = 0;
    hipLaunchKernelGGL(trunk_fwd, dim3(grid), dim3(NTHR), LDS_BYTES, stream, a);
#else
    for (int k = 0; k < N_PHASES; ++k) { a.ph_lo = k; a.ph_hi = k + 1; a.li = k;
        hipLaunchKernelGGL(trunk_fwd, dim3(grid), dim3(NTHR), LDS_BYTES, stream, a); }
#endif
    const hipError_t le = hipPeekAtLastError();
    if (le != hipSuccess) fprintf(stderr, "kernel_launch: launch failed: %s (grid %d)\n", hipGetErrorName(le), grid);
}
```

```cpp
#include <hip/hip_runtime.h>
#include <cstdio>
#include <cstdint>

#ifndef GEMM_MFMA32
#define GEMM_MFMA32 0
#endif
#ifndef MK_LAUNCHES
#define MK_LAUNCHES 1
#endif

#define LAS __attribute__((address_space(3)))
#define GAS __attribute__((address_space(1)))
typedef unsigned short bf16_t;
typedef short bf16x8 __attribute__((ext_vector_type(8)));
typedef short s16x4 __attribute__((ext_vector_type(4)));
typedef float f32x2 __attribute__((ext_vector_type(2)));
typedef float f32x4 __attribute__((ext_vector_type(4)));
typedef float f32x16 __attribute__((ext_vector_type(16)));
typedef unsigned u32x2 __attribute__((ext_vector_type(2)));
typedef unsigned u32x4 __attribute__((ext_vector_type(4)));
typedef LAS unsigned char* ldsp;

namespace pg8 {
#define PG8_LAS __attribute__((address_space(3)))
constexpr int BM = 256, BK = 64, HALF = 128, HTB = HALF * BK * 2  , STAGE_BYTES = 8 * HTB, NXCD = 8, WGM = 8;

__host__ __device__ __forceinline__ int lds_byte(int r, int c) { const int st = (r >> 4) * 2 + (c >> 5), rr = r & 15, cc = c & 31, ob = rr * 64 + cc * 2; return st * 1024 + (ob ^ (((ob >> 9) & 1) << 5)); }
__host__ __device__ __forceinline__ void stage_rc(int b, int& R, int& C) { const int st = b / 1024, sb = b % 1024, swz = sb ^ (((sb >> 9) & 1) << 5); R = (st >> 1) * 16 + swz / 64; C = (st & 1) * 32 + (swz % 64) / 2; }
__host__ __device__ __forceinline__ int perm32(int rho) { const int n = rho >> 4, i = rho & 15; return 8 * (i >> 2) + 4 * n + (i & 3); }

__host__ __device__ __forceinline__ int perm32x(int rho) { return 16 * ((rho >> 2) & 1) + 4 * (rho >> 3) + (rho & 3); }
struct Unit { int pm, pn; };
struct Gemm { const bf16_t* A; const bf16_t* Bt; int M, N, K; };

struct StaticOrder {
    int nM, nN, nwg, G, c;
    __host__ __device__ void init(int M, int N, int G_, int c_) { nM = M / BM; nN = N / BM; nwg = nM * nN; G = G_; c = c_; }
    __host__ __device__ bool next(int i, Unit& u) const {
        const long L = (long)i * G + c; if (L >= nwg) return false;
        int wgid = (int)L; { const int q = nwg / NXCD, r = nwg % NXCD, xcd = wgid % NXCD, off = wgid / NXCD; wgid = (xcd < r ? xcd * (q + 1) : r * (q + 1) + (xcd - r) * q) + off; }
        const int nig = WGM * nN, gid = wgid / nig, fm = gid * WGM, gsz = (nM - fm) < WGM ? (nM - fm) : WGM;
        u.pm = fm + ((wgid % nig) % gsz); u.pn = (wgid % nig) / gsz; return true;
    }
    __device__ __forceinline__ void a_ready(const Unit&) const {}
    __device__ __forceinline__ void done(const Unit&) const {}
};

__device__ __forceinline__ unsigned cvt_pk_bf16(float lo, float hi) { unsigned r; asm volatile("v_cvt_pk_bf16_f32 %0, %1, %2" : "=v"(r) : "v"(lo), "v"(hi)); return r; }

constexpr float EPI_EPS = 1e-6f;
__device__ __forceinline__ void epi_bar() { asm volatile("s_waitcnt lgkmcnt(0)" ::: "memory"); __builtin_amdgcn_s_barrier(); asm volatile("" ::: "memory"); }
__device__ __forceinline__ void epi_rstd_table(const float* ssq, int fm, PG8_LAS float* RS, int t) {
    f32x4 v[4][4];
#pragma unroll
    for (int q = 0; q < 4; ++q) { const f32x4* p = (const f32x4*)(ssq + (size_t)(fm * BM + t + 512 * q) * 16); v[q][0] = p[0]; v[q][1] = p[1]; v[q][2] = p[2]; v[q][3] = p[3]; }
    asm volatile("" :: "v"(v[0][0]), "v"(v[0][1]), "v"(v[0][2]), "v"(v[0][3]), "v"(v[1][0]), "v"(v[1][1]), "v"(v[1][2]), "v"(v[1][3]),
                    "v"(v[2][0]), "v"(v[2][1]), "v"(v[2][2]), "v"(v[2][3]), "v"(v[3][0]), "v"(v[3][1]), "v"(v[3][2]), "v"(v[3][3]) : "memory");
#pragma unroll
    for (int q = 0; q < 4; ++q) { const int r = t + 512 * q; const f32x4 a = v[q][0], b = v[q][1], c = v[q][2], d = v[q][3];
        const float sm = ((a[0] + a[1]) + (a[2] + a[3])) + ((b[0] + b[1]) + (b[2] + b[3])) + ((c[0] + c[1]) + (c[2] + c[3])) + ((d[0] + d[1]) + (d[2] + d[3]));
        RS[r] = 1.0f / sqrtf(sm * (1.0f / 4096.0f) + EPI_EPS); }
    epi_bar();
}
#if GEMM_MFMA32
struct EpiBf16N {
    static constexpr bool PERM = true, AFTER_DRAIN = false;
    bf16_t* O; int ldc; int fm; PG8_LAS unsigned char* xl;
    __device__ __forceinline__ void operator()(const f32x16 (&acc)[2][2][2], const Unit& u, int wr, int wc, int fr, int fq) const {
        const PG8_LAS float* RS = (const PG8_LAS float*)xl + (u.pm - fm) * BM;
        const int row0 = u.pm * BM + wr * 64 + fr, col0 = u.pn * BM + wc * 32 + 16 * fq;
#pragma unroll
        for (int ai = 0; ai < 2; ++ai)
#pragma unroll
            for (int mt = 0; mt < 2; ++mt) { bf16_t* rowp = O + (size_t)(row0 + ai * HALF + mt * 32) * ldc + col0; const float rs = RS[ai * HALF + wr * 64 + mt * 32 + fr];
#pragma unroll
                for (int bj = 0; bj < 2; ++bj) { const f32x16 v = acc[ai][bj][mt] * rs;
                    u32x4 w0, w1; w0.x = cvt_pk_bf16(v[0], v[1]); w0.y = cvt_pk_bf16(v[2], v[3]); w0.z = cvt_pk_bf16(v[4], v[5]); w0.w = cvt_pk_bf16(v[6], v[7]);
                    w1.x = cvt_pk_bf16(v[8], v[9]); w1.y = cvt_pk_bf16(v[10], v[11]); w1.z = cvt_pk_bf16(v[12], v[13]); w1.w = cvt_pk_bf16(v[14], v[15]);
                    *(u32x4*)(rowp + bj * HALF) = w0; *(u32x4*)(rowp + bj * HALF + 8) = w1; } }
    }
};
struct EpiSwiGLUN {
    static constexpr bool PERM = true, AFTER_DRAIN = false;
    bf16_t* O; int ldc; int fm; PG8_LAS unsigned char* xl;
    __device__ __forceinline__ void operator()(const f32x16 (&acc)[2][2][2], const Unit& u, int wr, int wc, int fr, int fq) const {
        const PG8_LAS float* RS = (const PG8_LAS float*)xl + (u.pm - fm) * BM;
        const int row0 = u.pm * BM + wr * 64 + fr, col0 = u.pn * HALF + wc * 32 + 16 * fq;
#pragma unroll
        for (int ai = 0; ai < 2; ++ai)
#pragma unroll
            for (int mt = 0; mt < 2; ++mt) { bf16_t* rowp = O + (size_t)(row0 + ai * HALF + mt * 32) * ldc + col0; const float rs = RS[ai * HALF + wr * 64 + mt * 32 + fr];
                float r[16];
#pragma unroll
                for (int j = 0; j < 16; ++j) { const float g = acc[ai][0][mt][j] * rs, up = acc[ai][1][mt][j] * rs; r[j] = g * __builtin_amdgcn_rcpf(1.0f + __expf(-g)) * up; }
                u32x4 w0, w1; w0.x = cvt_pk_bf16(r[0], r[1]); w0.y = cvt_pk_bf16(r[2], r[3]); w0.z = cvt_pk_bf16(r[4], r[5]); w0.w = cvt_pk_bf16(r[6], r[7]);
                w1.x = cvt_pk_bf16(r[8], r[9]); w1.y = cvt_pk_bf16(r[10], r[11]); w1.z = cvt_pk_bf16(r[12], r[13]); w1.w = cvt_pk_bf16(r[14], r[15]);
                *(u32x4*)rowp = w0; *(u32x4*)(rowp + 8) = w1; }
    }
};
struct EpiResidB {
    static constexpr bool PERM = true, AFTER_DRAIN = false;
    const bf16_t* res; bf16_t* X; int ldc; float* ssq_out; PG8_LAS unsigned char* xl;
    __device__ __forceinline__ void operator()(const f32x16 (&acc)[2][2][2], const Unit& u, int wr, int wc, int fr, int fq) const {
        PG8_LAS float* SSQL = (PG8_LAS float*)(xl + 8192);
        const int row0 = u.pm * BM + wr * 64 + fr, col0 = u.pn * BM + wc * 32 + 16 * fq;
#pragma unroll
        for (int ai = 0; ai < 2; ++ai) { u32x4 rw[2][2][2];
#pragma unroll
            for (int mt = 0; mt < 2; ++mt)
#pragma unroll
                for (int bj = 0; bj < 2; ++bj) { const bf16_t* rp = res + (size_t)(row0 + ai * HALF + mt * 32) * ldc + col0 + bj * HALF; rw[mt][bj][0] = *(const u32x4*)rp; rw[mt][bj][1] = *(const u32x4*)(rp + 8); }
#pragma unroll
            for (int mt = 0; mt < 2; ++mt) { float sq = 0.f;
#pragma unroll
                for (int bj = 0; bj < 2; ++bj) { const f32x16 a = acc[ai][bj][mt]; float v[16];
#pragma unroll
                    for (int h = 0; h < 2; ++h) { const u32x4 rr = rw[mt][bj][h];
                        v[8 * h + 0] = __uint_as_float(rr.x << 16) + a[8 * h + 0]; v[8 * h + 1] = __uint_as_float(rr.x & 0xffff0000u) + a[8 * h + 1];
                        v[8 * h + 2] = __uint_as_float(rr.y << 16) + a[8 * h + 2]; v[8 * h + 3] = __uint_as_float(rr.y & 0xffff0000u) + a[8 * h + 3];
                        v[8 * h + 4] = __uint_as_float(rr.z << 16) + a[8 * h + 4]; v[8 * h + 5] = __uint_as_float(rr.z & 0xffff0000u) + a[8 * h + 5];
                        v[8 * h + 6] = __uint_as_float(rr.w << 16) + a[8 * h + 6]; v[8 * h + 7] = __uint_as_float(rr.w & 0xffff0000u) + a[8 * h + 7]; }
#pragma unroll
                    for (int j = 0; j < 16; j += 4) sq += (v[j] * v[j] + v[j + 1] * v[j + 1]) + (v[j + 2] * v[j + 2] + v[j + 3] * v[j + 3]);
                    u32x4 w0, w1; w0.x = cvt_pk_bf16(v[0], v[1]); w0.y = cvt_pk_bf16(v[2], v[3]); w0.z = cvt_pk_bf16(v[4], v[5]); w0.w = cvt_pk_bf16(v[6], v[7]);
                    w1.x = cvt_pk_bf16(v[8], v[9]); w1.y = cvt_pk_bf16(v[10], v[11]); w1.z = cvt_pk_bf16(v[12], v[13]); w1.w = cvt_pk_bf16(v[14], v[15]);
                    bf16_t* xp = X + (size_t)(row0 + ai * HALF + mt * 32) * ldc + col0 + bj * HALF; *(u32x4*)xp = w0; *(u32x4*)(xp + 8) = w1; }
                sq += __shfl_xor(sq, 32);
                if (fq == 0) SSQL[(ai * HALF + wr * 64 + mt * 32 + fr) * 4 + wc] = sq; } }
        epi_bar();
        const int t = (wr * 4 + wc) * 64 + fq * 32 + fr;
        if (t < 256) { const f32x4 p = *(const PG8_LAS f32x4*)(SSQL + t * 4); ssq_out[(size_t)(u.pm * BM + t) * 16 + u.pn] = (p[0] + p[1]) + (p[2] + p[3]); }
    }
};
#else
struct EpiBf16N {
    static constexpr bool PERM = true, AFTER_DRAIN = false;
    bf16_t* O; int ldc; int fm; PG8_LAS unsigned char* xl;
    __device__ __forceinline__ void operator()(const f32x4 (&acc)[2][2][4][2], const Unit& u, int wr, int wc, int fr, int fq) const {
        const PG8_LAS float* RS = (const PG8_LAS float*)xl + (u.pm - fm) * BM;
        const int row0 = u.pm * BM + wr * 64 + fr, col0 = u.pn * BM + wc * 32 + 8 * fq;
#pragma unroll
        for (int ai = 0; ai < 2; ++ai)
#pragma unroll
            for (int m = 0; m < 4; ++m) { bf16_t* rowp = O + (size_t)(row0 + ai * HALF + m * 16) * ldc + col0; const float rs = RS[ai * HALF + wr * 64 + m * 16 + fr];
#pragma unroll
                for (int bj = 0; bj < 2; ++bj) { const f32x4 v0 = acc[ai][bj][m][0] * rs, v1 = acc[ai][bj][m][1] * rs;
                    u32x4 w; w.x = cvt_pk_bf16(v0[0], v0[1]); w.y = cvt_pk_bf16(v0[2], v0[3]); w.z = cvt_pk_bf16(v1[0], v1[1]); w.w = cvt_pk_bf16(v1[2], v1[3]);
                    *(u32x4*)(rowp + bj * HALF) = w; } }
    }
};
struct EpiSwiGLUN {
    static constexpr bool PERM = true, AFTER_DRAIN = false;
    bf16_t* O; int ldc; int fm; PG8_LAS unsigned char* xl;
    __device__ __forceinline__ void operator()(const f32x4 (&acc)[2][2][4][2], const Unit& u, int wr, int wc, int fr, int fq) const {
        const PG8_LAS float* RS = (const PG8_LAS float*)xl + (u.pm - fm) * BM;
        const int row0 = u.pm * BM + wr * 64 + fr, col0 = u.pn * HALF + wc * 32 + 8 * fq;
#pragma unroll
        for (int ai = 0; ai < 2; ++ai)
#pragma unroll
            for (int m = 0; m < 4; ++m) { bf16_t* rowp = O + (size_t)(row0 + ai * HALF + m * 16) * ldc + col0; const float rs = RS[ai * HALF + wr * 64 + m * 16 + fr];
                float r[8];
#pragma unroll
                for (int n = 0; n < 2; ++n)
#pragma unroll
                    for (int j = 0; j < 4; ++j) { const float g = acc[ai][0][m][n][j] * rs, up = acc[ai][1][m][n][j] * rs;
                        r[n * 4 + j] = g * __builtin_amdgcn_rcpf(1.0f + __expf(-g)) * up; }
                u32x4 w; w.x = cvt_pk_bf16(r[0], r[1]); w.y = cvt_pk_bf16(r[2], r[3]); w.z = cvt_pk_bf16(r[4], r[5]); w.w = cvt_pk_bf16(r[6], r[7]);
                *(u32x4*)rowp = w; }
    }
};
struct EpiResidB {
    static constexpr bool PERM = true, AFTER_DRAIN = false;
    const bf16_t* res; bf16_t* X; int ldc; float* ssq_out; PG8_LAS unsigned char* xl;
    __device__ __forceinline__ void operator()(const f32x4 (&acc)[2][2][4][2], const Unit& u, int wr, int wc, int fr, int fq) const {
        PG8_LAS float* SSQL = (PG8_LAS float*)(xl + 8192);
        const int row0 = u.pm * BM + wr * 64 + fr, col0 = u.pn * BM + wc * 32 + 8 * fq;
#pragma unroll
        for (int ai = 0; ai < 2; ++ai) { u32x4 rw[4][2];
#pragma unroll
            for (int m = 0; m < 4; ++m)
#pragma unroll
                for (int bj = 0; bj < 2; ++bj) rw[m][bj] = *(const u32x4*)(res + (size_t)(row0 + ai * HALF + m * 16) * ldc + col0 + bj * HALF);
#pragma unroll
            for (int m = 0; m < 4; ++m) { float sq = 0.f;
#pragma unroll
                for (int bj = 0; bj < 2; ++bj) { const u32x4 rr = rw[m][bj]; const f32x4 a0 = acc[ai][bj][m][0], a1 = acc[ai][bj][m][1];
                    float v[8];
                    v[0] = __uint_as_float(rr.x << 16) + a0[0]; v[1] = __uint_as_float(rr.x & 0xffff0000u) + a0[1]; v[2] = __uint_as_float(rr.y << 16) + a0[2]; v[3] = __uint_as_float(rr.y & 0xffff0000u) + a0[3];
                    v[4] = __uint_as_float(rr.z << 16) + a1[0]; v[5] = __uint_as_float(rr.z & 0xffff0000u) + a1[1]; v[6] = __uint_as_float(rr.w << 16) + a1[2]; v[7] = __uint_as_float(rr.w & 0xffff0000u) + a1[3];
                    sq += ((v[0] * v[0] + v[1] * v[1]) + (v[2] * v[2] + v[3] * v[3])) + ((v[4] * v[4] + v[5] * v[5]) + (v[6] * v[6] + v[7] * v[7]));
                    u32x4 w; w.x = cvt_pk_bf16(v[0], v[1]); w.y = cvt_pk_bf16(v[2], v[3]); w.z = cvt_pk_bf16(v[4], v[5]); w.w = cvt_pk_bf16(v[6], v[7]);
                    *(u32x4*)(X + (size_t)(row0 + ai * HALF + m * 16) * ldc + col0 + bj * HALF) = w; }
                sq += __shfl_xor(sq, 16); sq += __shfl_xor(sq, 32);
                if (fq == 0) SSQL[(ai * HALF + wr * 64 + m * 16 + fr) * 4 + wc] = sq; } }
        epi_bar();
        const int t = (wr * 4 + wc) * 64 + fq * 16 + fr;
        if (t < 256) { const f32x4 p = *(const PG8_LAS f32x4*)(SSQL + t * 4); ssq_out[(size_t)(u.pm * BM + t) * 16 + u.pn] = (p[0] + p[1]) + (p[2] + p[3]); }
    }
};
#endif
template <class Epi, class Sched, bool ALIGN_EPI = false, bool SP2 = false>
__device__ __forceinline__ void gemm_phase(PG8_LAS unsigned char* lds, const Gemm g, const Sched& S, const Epi& E) {
    int tid_ = threadIdx.x; asm volatile("" : "+v"(tid_));
#if GEMM_MFMA32
    const int tid = tid_, wid = __builtin_amdgcn_readfirstlane(tid >> 6), lane = tid & 63, wr = wid >> 2, wc = wid & 3, fr = lane & 31, fq = lane >> 5;
#else
    const int tid = tid_, wid = __builtin_amdgcn_readfirstlane(tid >> 6), lane = tid & 63, wr = wid >> 2, wc = wid & 3, fr = lane & 15, fq = lane >> 4;
#endif
    const int K = g.K, nt = K / BK;
    unsigned voffA[2], voffB[2];
#pragma unroll
    for (int i = 0; i < 2; ++i) { int R, C; stage_rc(tid * 16 + i * 8192, R, C); const int Rb = Epi::PERM ? ((R & ~31) + (GEMM_MFMA32 ? perm32x(R & 31) : perm32(R & 31))) : R;
        voffA[i] = (unsigned)(R * K + C) * 2u; voffB[i] = (unsigned)(Rb * K + C) * 2u; }
    const size_t kstep = (size_t)(BK * 2);
    const size_t hstep = (size_t)HALF * K * 2;
    const size_t tstep = 2 * hstep;
    const unsigned ldsw = (unsigned)wid * 1024u;
#if GEMM_MFMA32
    const int aE = lds_byte(wr * 64 + fr, fq * 8), aO = lds_byte(wr * 64 + fr, 16 + fq * 8), bE = lds_byte(wc * 32 + fr, fq * 8), bO = lds_byte(wc * 32 + fr, 16 + fq * 8);
#else
    const int aoff = lds_byte(wr * 64 + fr, fq * 8), boff = lds_byte(wc * 32 + fr, fq * 8);
#endif
#define PG8_SA(b, h) (((b) * 2 + (h)) * HTB)
#define PG8_SB(b, h) ((4 + (b) * 2 + (h)) * HTB)
#define PG8_STAGE(bufoff, gbase, voff) do { _Pragma("unroll") for (int _i = 0; _i < 2; ++_i) \
        __builtin_amdgcn_global_load_lds((const unsigned*)((const char*)(gbase) + (voff)[_i]), (PG8_LAS unsigned*)(lds + (bufoff) + ldsw + _i * 8192), 16, 0, 0); } while (0)
#if GEMM_MFMA32
#define PG8_LDA(dst, b, h) do { _Pragma("unroll") for (int m = 0; m < 2; ++m) _Pragma("unroll") for (int k = 0; k < 4; ++k) dst[m][k] = *(const PG8_LAS bf16x8*)(lds + PG8_SA(b, h) + ((k & 1) ? aO : aE) + (k >> 1) * 1024 + m * 4096); } while (0)
#define PG8_LDB(dst, b, h) do { _Pragma("unroll") for (int k = 0; k < 4; ++k) dst[k] = *(const PG8_LAS bf16x8*)(lds + PG8_SB(b, h) + ((k & 1) ? bO : bE) + (k >> 1) * 1024); } while (0)
#define PG8_MMA(ai, bj, At, Bt) do { __builtin_amdgcn_s_setprio(1); _Pragma("unroll") for (int k = 0; k < 4; ++k) _Pragma("unroll") for (int m = 0; m < 2; ++m) \
        acc[ai][bj][m] = __builtin_amdgcn_mfma_f32_32x32x16_bf16(Bt[k], At[m][k], acc[ai][bj][m], 0, 0, 0); __builtin_amdgcn_s_setprio(0); } while (0)
#define PG8_ZERO_ACC() do { _Pragma("unroll") for (int a = 0; a < 2; ++a) _Pragma("unroll") for (int b = 0; b < 2; ++b) _Pragma("unroll") for (int m = 0; m < 2; ++m) acc[a][b][m] = f32x16{}; } while (0)
#define PG8_MMA2(ai, At, Bx, By) do { __builtin_amdgcn_s_setprio(1); _Pragma("unroll") for (int k = 0; k < 4; ++k) _Pragma("unroll") for (int m = 0; m < 2; ++m) { \
        acc[ai][0][m] = __builtin_amdgcn_mfma_f32_32x32x16_bf16(Bx[k], At[m][k], acc[ai][0][m], 0, 0, 0); \
        acc[ai][1][m] = __builtin_amdgcn_mfma_f32_32x32x16_bf16(By[k], At[m][k], acc[ai][1][m], 0, 0, 0); } __builtin_amdgcn_s_setprio(0); } while (0)
#else
#define PG8_MMA2(ai, At, Bx, By) do { PG8_MMA(ai, 0, At, Bx); PG8_MMA(ai, 1, At, By); } while (0)
#define PG8_LDA(dst, b, h) do { _Pragma("unroll") for (int m = 0; m < 4; ++m) _Pragma("unroll") for (int k = 0; k < 2; ++k) dst[m][k] = *(const PG8_LAS bf16x8*)(lds + PG8_SA(b, h) + aoff + m * 2048 + k * 1024); } while (0)
#define PG8_LDB(dst, b, h) do { _Pragma("unroll") for (int n = 0; n < 2; ++n) _Pragma("unroll") for (int k = 0; k < 2; ++k) dst[n][k] = *(const PG8_LAS bf16x8*)(lds + PG8_SB(b, h) + boff + n * 2048 + k * 1024); } while (0)
#define PG8_MMA(ai, bj, At, Bt) do { __builtin_amdgcn_s_setprio(1); _Pragma("unroll") for (int m = 0; m < 4; ++m) _Pragma("unroll") for (int n = 0; n < 2; ++n) _Pragma("unroll") for (int k = 0; k < 2; ++k) \
        acc[ai][bj][m][n] = __builtin_amdgcn_mfma_f32_16x16x32_bf16(Bt[n][k], At[m][k], acc[ai][bj][m][n], 0, 0, 0); __builtin_amdgcn_s_setprio(0); } while (0)
#define PG8_ZERO_ACC() do { _Pragma("unroll") for (int a = 0; a < 2; ++a) _Pragma("unroll") for (int b = 0; b < 2; ++b) _Pragma("unroll") for (int m = 0; m < 4; ++m) _Pragma("unroll") for (int n = 0; n < 2; ++n) acc[a][b][m][n] = (f32x4){0.f, 0.f, 0.f, 0.f}; } while (0)
#endif
#define PG8_WAIT_V(n) asm volatile("s_waitcnt vmcnt(" #n ")" ::: "memory")
#define PG8_WAIT_L(n) asm volatile("s_waitcnt lgkmcnt(" #n ")" ::: "memory")
#define PG8_BAR __builtin_amdgcn_s_barrier()
#define PG8_SCHED __builtin_amdgcn_sched_barrier(0)
    Unit cur, nxt; int ui = 0;
    if (!S.next(0, cur)) return;
#if GEMM_MFMA32
    f32x16 acc[2][2][2]; bf16x8 At[2][4], B0[4], B1[4];
#else
    f32x4 acc[2][2][4][2]; bf16x8 At[4][2], B0[2][2], B1[2][2];
#endif
    PG8_ZERO_ACC();
    const char* cA = (const char*)g.A + (size_t)cur.pm * tstep; const char* cB = (const char*)g.Bt + (size_t)cur.pn * tstep;
    S.a_ready(cur);
    if constexpr (SP2) {
        PG8_STAGE(PG8_SB(0, 0), cB, voffB); PG8_STAGE(PG8_SB(0, 1), cB + hstep, voffB); PG8_STAGE(PG8_SA(0, 0), cA, voffA); PG8_STAGE(PG8_SA(0, 1), cA + hstep, voffA);
        if (wr == 1) PG8_BAR;
        PG8_WAIT_V(2); PG8_BAR;
        PG8_STAGE(PG8_SB(1, 0), cB + kstep, voffB); PG8_STAGE(PG8_SA(1, 0), cA + kstep, voffA); PG8_STAGE(PG8_SB(1, 1), cB + hstep + kstep, voffB);
        PG8_WAIT_V(6); PG8_BAR;
    } else {
        PG8_STAGE(PG8_SB(0, 0), cB, voffB); PG8_STAGE(PG8_SA(0, 0), cA, voffA); PG8_STAGE(PG8_SB(0, 1), cB + hstep, voffB); PG8_STAGE(PG8_SA(0, 1), cA + hstep, voffA);
        if (wr == 1) PG8_BAR;
        PG8_WAIT_V(4); PG8_BAR;
        PG8_STAGE(PG8_SB(1, 0), cB + kstep, voffB); PG8_STAGE(PG8_SA(1, 0), cA + kstep, voffA); PG8_STAGE(PG8_SB(1, 1), cB + hstep + kstep, voffB);
        PG8_WAIT_V(6); PG8_BAR;
    }
    for (;;) {
        const bool has_next = S.next(ui + 1, nxt);
        const char* nA = has_next ? (const char*)g.A + (size_t)nxt.pm * tstep : cA; const char* nB = has_next ? (const char*)g.Bt + (size_t)nxt.pn * tstep : cB;
        for (int t = 0; t < nt; t += 2) {
            const bool last = (t == nt - 2);
            const char* a1 = cA + (size_t)(t + 1) * kstep;
            const char* a2 = last ? nA : cA + (size_t)(t + 2) * kstep; const char* b2 = last ? nB : cB + (size_t)(t + 2) * kstep;
            const char* a3 = a2 + kstep; const char* b3 = b2 + kstep;
            if (last && has_next) S.a_ready(nxt);
            if constexpr (SP2) {
            PG8_LDB(B0, 0, 0); PG8_LDB(B1, 0, 1); PG8_SCHED; PG8_LDA(At, 0, 0); PG8_STAGE(PG8_SA(1, 1), a1 + hstep, voffA);
            PG8_WAIT_V(8); PG8_WAIT_L(0); PG8_BAR; PG8_MMA2(0, At, B0, B1); PG8_BAR; PG8_SCHED;
            PG8_LDA(At, 0, 1); PG8_STAGE(PG8_SB(0, 0), b2, voffB); PG8_STAGE(PG8_SB(0, 1), b2 + hstep, voffB); PG8_STAGE(PG8_SA(0, 0), a2, voffA);
            PG8_WAIT_V(8); PG8_WAIT_L(0); PG8_BAR; PG8_MMA2(1, At, B0, B1); PG8_BAR; PG8_SCHED;
            PG8_LDB(B0, 1, 0); PG8_LDB(B1, 1, 1); PG8_SCHED; PG8_LDA(At, 1, 0); PG8_STAGE(PG8_SA(0, 1), a2 + hstep, voffA);
            PG8_WAIT_V(8); PG8_WAIT_L(0); PG8_BAR; PG8_MMA2(0, At, B0, B1); PG8_BAR; PG8_SCHED;
            PG8_LDA(At, 1, 1); PG8_STAGE(PG8_SB(1, 0), b3, voffB); PG8_STAGE(PG8_SB(1, 1), b3 + hstep, voffB); PG8_STAGE(PG8_SA(1, 0), a3, voffA);
            PG8_WAIT_V(8); PG8_WAIT_L(0); PG8_BAR; PG8_MMA2(1, At, B0, B1); PG8_BAR; PG8_SCHED;
            } else {
            PG8_LDB(B0, 0, 0); PG8_SCHED; PG8_LDA(At, 0, 0); PG8_STAGE(PG8_SA(1, 1), a1 + hstep, voffA);
            PG8_WAIT_L(8); PG8_BAR; PG8_WAIT_L(0); PG8_MMA(0, 0, At, B0); PG8_BAR; PG8_SCHED;
            PG8_LDB(B1, 0, 1); PG8_STAGE(PG8_SB(0, 0), b2, voffB);
            PG8_BAR; PG8_WAIT_L(0); PG8_MMA(0, 1, At, B1); PG8_BAR;
            PG8_LDA(At, 0, 1); PG8_STAGE(PG8_SA(0, 0), a2, voffA);
            PG8_BAR; PG8_WAIT_L(0); PG8_MMA(1, 0, At, B0); PG8_BAR; PG8_SCHED;
            PG8_STAGE(PG8_SB(0, 1), b2 + hstep, voffB);
            PG8_WAIT_V(6); PG8_BAR; PG8_MMA(1, 1, At, B1); PG8_BAR;
            PG8_LDB(B0, 1, 0); PG8_SCHED; PG8_LDA(At, 1, 0); PG8_STAGE(PG8_SA(0, 1), a2 + hstep, voffA);
            PG8_WAIT_L(8); PG8_BAR; PG8_WAIT_L(0); PG8_MMA(0, 0, At, B0); PG8_BAR; PG8_SCHED;
            PG8_LDB(B1, 1, 1); PG8_STAGE(PG8_SB(1, 0), b3, voffB);
            PG8_BAR; PG8_WAIT_L(0); PG8_MMA(0, 1, At, B1); PG8_BAR;
            PG8_LDA(At, 1, 1); PG8_STAGE(PG8_SA(1, 0), a3, voffA);
            PG8_BAR; PG8_WAIT_L(0); PG8_MMA(1, 0, At, B0); PG8_BAR; PG8_SCHED;
            PG8_STAGE(PG8_SB(1, 1), b3 + hstep, voffB);
            PG8_WAIT_V(6); PG8_BAR; PG8_MMA(1, 1, At, B1); PG8_BAR;
            }
        }
        if constexpr (ALIGN_EPI) { if (wr == 0) PG8_BAR; }
        if constexpr (!Epi::AFTER_DRAIN) { E(acc, cur, wr, wc, fr, fq); S.done(cur); }
        if (!has_next) break;
        PG8_ZERO_ACC();
        cur = nxt; cA = nA; cB = nB; ++ui;
        if constexpr (ALIGN_EPI) { if (wr == 1) PG8_BAR; }
    }
    PG8_WAIT_V(0);
    if constexpr (!ALIGN_EPI) { if (wr == 0) PG8_BAR; }
    PG8_BAR;
    if constexpr (Epi::AFTER_DRAIN) { E.fused(acc, cur, wr, wc, fr, fq, lds, wid, lane); S.done(cur); }
#undef PG8_SA
#undef PG8_SB
#undef PG8_STAGE
#undef PG8_LDA
#undef PG8_LDB
#undef PG8_MMA
#undef PG8_MMA2
#undef PG8_ZERO_ACC
#undef PG8_WAIT_V
#undef PG8_WAIT_L
#undef PG8_BAR
#undef PG8_SCHED
}
}

#define XB_TMO      128
#define XB_XCNT(j)  (256  + 64 * (j))
#define XB_XSUB(j)  (1280 + 64 * (j))
#define XB_XGEN(j)  (2304 + 64 * (j))
#define XB_TOP      3328
#define XB_TOPGEN   3392
#define XCD_BAR_WORDS 3456
#define XB_SPIN_CAP (1u << 18)

__device__ __forceinline__ unsigned xb_ld(unsigned* p)              { return __hip_atomic_load(p, __ATOMIC_RELAXED, __HIP_MEMORY_SCOPE_AGENT); }
__device__ __forceinline__ unsigned xb_add(unsigned* p, unsigned v) { return __hip_atomic_fetch_add(p, v, __ATOMIC_RELAXED, __HIP_MEMORY_SCOPE_AGENT); }
__device__ __forceinline__ unsigned xb_xcc_id() { return (unsigned)__builtin_amdgcn_s_getreg((3 << 11) | 20) & 0xFu; }
#define XB_SPIN(cond, bar) do { unsigned _sp = 0; while (cond) { __builtin_amdgcn_s_sleep(1); \
    if ((++_sp & 255u) == 0u) { if (xb_ld(&(bar)[XB_TMO])) break; if (_sp > XB_SPIN_CAP) { atomicAdd(&(bar)[XB_TMO], 1u); break; } } } } while (0)

struct XcdBarrier {
    unsigned* bar; unsigned x;
    volatile LAS unsigned* st;
};

__device__ __forceinline__ XcdBarrier xcd_barrier_post(unsigned* bar, volatile LAS unsigned* st) {
    XcdBarrier b; b.bar = bar; b.x = xb_xcc_id(); b.st = st;
    if (threadIdx.x == 0) (void)xb_add(&bar[XB_XCNT(b.x)], 1u);
    return b;
}
__device__ __forceinline__ void xcd_barrier_complete(unsigned* bar, unsigned x, unsigned& nloc, unsigned& nx) {
    const unsigned G = gridDim.x * gridDim.y * gridDim.z;
    unsigned sum, cnt, mine, sp = 0u;
    for (;;) {
        sum = 0u; cnt = 0u; mine = 0u;
#pragma unroll
        for (unsigned j = 0; j < 16; ++j) { const unsigned c = xb_ld(&bar[XB_XCNT(j)]); sum += c; cnt += (c > 0u) ? 1u : 0u; mine = (j == x) ? c : mine; }
        if (sum == G) break;
        __builtin_amdgcn_s_sleep(1);
        if ((++sp & 255u) == 0u) { if (xb_ld(&bar[XB_TMO])) break; if (sp > XB_SPIN_CAP) { atomicAdd(&bar[XB_TMO], 1u); break; } }
    }
    nloc = mine > 0u ? mine : 1u; nx = cnt > 0u ? cnt : 1u;
}

__device__ __forceinline__ void xcd_barrier(const XcdBarrier& b) {
    asm volatile("s_waitcnt vmcnt(0)" ::: "memory");
    __syncthreads();
    if (threadIdx.x == 0) {
        unsigned* bar = b.bar;
        __builtin_amdgcn_s_waitcnt(0);
        unsigned nloc = b.st[0], nx = b.st[1];
        if (nloc == 0u) { xcd_barrier_complete(bar, b.x, nloc, nx); b.st[0] = nloc; b.st[1] = nx; }
        const unsigned old = xb_add(&bar[XB_XSUB(b.x)], 1u);
        const unsigned gen = old / nloc;
        if (old + 1u == (gen + 1u) * nloc) {
            __builtin_amdgcn_fence(__ATOMIC_RELEASE, "agent");
            asm volatile("s_waitcnt vmcnt(0)" ::: "memory");
            const unsigned og = xb_add(&bar[XB_TOP], 1u);
            const unsigned tg = og / nx;
            if (og + 1u == (tg + 1u) * nx) xb_add(&bar[XB_TOPGEN], 1u);
            else XB_SPIN(xb_ld(&bar[XB_TOPGEN]) == tg, bar);
            __builtin_amdgcn_fence(__ATOMIC_ACQUIRE, "agent");
            xb_add(&bar[XB_XGEN(b.x)], 1u);
            asm volatile("s_waitcnt vmcnt(0)" ::: "memory");
        } else {
            XB_SPIN(xb_ld(&bar[XB_XGEN(b.x)]) == gen, bar);
            __builtin_amdgcn_fence(__ATOMIC_ACQUIRE, "agent");
            asm volatile("s_waitcnt vmcnt(0)" ::: "memory");
        }
    }
    __syncthreads();
}


constexpr int NWAVES = 8, NTHR = 512;
constexpr int SEQ = 4096, DM = 4096, MTOK = 8192, NP = 12032, INW = 11800, DFF = 11008, NGU = 22016;
constexpr int C_RQ = 0, C_RK = 1024, C_RV = 2048, C_RG = 3072, C_MQ = 4096, C_MK = 5120, C_MV = 6144, C_LX = 7168, C_LG = 8192, C_NQ = 9216,
              C_NKC = 10240, C_NVC = 10496, C_NKS = 10752, C_NVS = 11008, C_NKW = 11264, C_NVW = 11520, C_NGATE = 11776;
constexpr float RMS_EPS = 1e-6f;

constexpr size_t MiB = 1u << 20;
constexpr size_t WS_CTL = 0, CTL_ZERO_BYTES = 1 * MiB;
constexpr size_t WS_ROPEC = 1 * MiB, WS_ROPES = 2 * MiB;
constexpr size_t WS_SMALL = 3 * MiB;
constexpr size_t SM_KMEAN = WS_SMALL;
constexpr size_t SM_LRUCA = WS_SMALL + 256 * 1024;
constexpr size_t SM_LRUCH = WS_SMALL + 512 * 1024;
constexpr size_t SM_CB1P  = WS_SMALL + 768 * 1024;
constexpr size_t SM_CW2T  = WS_SMALL + 1024 * 1024;
constexpr size_t SM_WAT   = WS_SMALL + 2 * MiB;
constexpr size_t SM_WXT   = WS_SMALL + 3 * MiB;
constexpr size_t SM_KC    = WS_SMALL + 4 * MiB;
constexpr size_t SM_VC    = WS_SMALL + 5 * MiB;
constexpr size_t SM_SSQA  = WS_SMALL + 6 * MiB;
constexpr size_t SM_SSQB  = WS_SMALL + 7 * MiB;
constexpr size_t WS_CW1T  = 11 * MiB;
constexpr size_t WS_WIN   = 19 * MiB;
constexpr size_t WS_WOUT  = WS_WIN + 188 * MiB;
constexpr size_t WS_WGU   = WS_WOUT + 64 * MiB;
constexpr size_t WS_WDN   = WS_WGU + 344 * MiB;
constexpr size_t WS_H     = WS_WDN + 172 * MiB;
constexpr size_t WS_PROJ  = WS_H + 64 * MiB;
constexpr size_t WS_Y     = WS_PROJ + 188 * MiB;
constexpr size_t WS_XS0   = WS_Y + 64 * MiB;
constexpr size_t WS_XS1   = WS_XS0 + 64 * MiB;
constexpr size_t WS_XS2   = WS_XS1 + 64 * MiB;
constexpr size_t WS_XB    = WS_XS0 + 128 * MiB;
constexpr size_t WS_U     = WS_XB + 128 * MiB;
constexpr size_t WS_RETKV = WS_U + 172 * MiB;
constexpr size_t WS_LRUH  = WS_RETKV + 32 * MiB;
constexpr size_t WS_LRUP  = WS_LRUH + 32 * MiB;
constexpr size_t WS_NSAACC = WS_LRUP + 32 * MiB;
constexpr size_t WS_END   = WS_NSAACC + 32 * MiB;
constexpr int CW_BAR = 4096;

constexpr int PH_BYTES = 147456;
constexpr int MISC_OFF = PH_BYTES;
constexpr int LDS_BYTES = PH_BYTES + 1024;

#define LDS_WAIT() asm volatile("s_waitcnt lgkmcnt(0)" ::: "memory")
#define VM_WAIT() asm volatile("s_waitcnt vmcnt(0)" ::: "memory")
__device__ __forceinline__ float bf2f(unsigned short b) { return __uint_as_float(((unsigned)b) << 16); }
__device__ __forceinline__ float bflo(unsigned w) { return __uint_as_float(w << 16); }
__device__ __forceinline__ float bfhi(unsigned w) { return __uint_as_float(w & 0xffff0000u); }
__device__ __forceinline__ unsigned f2bf(float f) { unsigned u = __float_as_uint(f); return (u + 0x7fffu + ((u >> 16) & 1u)) >> 16; }
__device__ __forceinline__ unsigned pk2(float lo, float hi) { return f2bf(lo) | (f2bf(hi) << 16); }
__device__ __forceinline__ unsigned cvtpk(float lo, float hi) { unsigned r; asm volatile("v_cvt_pk_bf16_f32 %0, %1, %2" : "=v"(r) : "v"(lo), "v"(hi)); return r; }
__device__ __forceinline__ float wave_sum(float v) {
#pragma unroll
    for (int o = 1; o < 64; o <<= 1) v += __shfl_xor(v, o);
    return v;
}
__device__ __forceinline__ float sigmoidf_(float x) { return __builtin_amdgcn_rcpf(1.0f + __expf(-x)); }
__device__ __forceinline__ float gelu_tanh(float x) { const float z = 0.7978845608028654f * (x + 0.044715f * x * x * x); const float e = __expf(2.0f * z); const float t = 1.0f - 2.0f * __builtin_amdgcn_rcpf(e + 1.0f); return 0.5f * x * (1.0f + t); }
__device__ __forceinline__ void unpack8(const u32x4 w, float (&f)[8]) { f[0] = bflo(w.x); f[1] = bfhi(w.x); f[2] = bflo(w.y); f[3] = bfhi(w.y); f[4] = bflo(w.z); f[5] = bfhi(w.z); f[6] = bflo(w.w); f[7] = bfhi(w.w); }

struct Frame {
    ldsp lds;
    int tid, lane, wave, G, bid;
    unsigned char* ws;
};
#define KAS __attribute__((address_space(4)))
#define OPQ_S(x) asm volatile("" : "+s"(x))
#define OPQ_V(x) asm volatile("" : "+v"(x))
__device__ __forceinline__ int otid() { int t = threadIdx.x; OPQ_V(t); return t; }
#define GAS __attribute__((address_space(1)))
__device__ __forceinline__ unsigned char* ows() { unsigned long long w = ((const unsigned long long KAS*)__builtin_amdgcn_kernarg_segment_ptr())[24]; OPQ_S(w);
    return (unsigned char*)(GAS unsigned char*)w; }
__device__ __forceinline__ const float* inp(int i) { return (const float*)(const GAS float*)((const unsigned long long KAS*)__builtin_amdgcn_kernarg_segment_ptr())[i]; }
__device__ __forceinline__ Frame mk_frame(ldsp lds) {
    Frame F; F.lds = lds; F.tid = otid(); F.lane = F.tid & 63; F.wave = __builtin_amdgcn_readfirstlane(F.tid >> 6); F.G = gridDim.x; F.bid = blockIdx.x;
    F.ws = ows(); return F;
}
#ifdef USE_NOINLINE
#define NOINL __attribute__((noinline))
#else
#define NOINL __forceinline__
#endif

__device__ __forceinline__ void tr_load(f32x4 (&v)[16], const float* __restrict__ W, int N, int k0, int n0, int lane) {
    const int rr = lane >> 4, c4 = (lane & 15) * 4; const bool ok = (n0 + c4) < N;
    const float* src = W + (size_t)(k0 + rr) * N + n0 + c4;
#pragma unroll
    for (int i = 0; i < 16; ++i) v[i] = ok ? *(const f32x4*)(src + (size_t)(4 * i) * N) : (f32x4){0.f, 0.f, 0.f, 0.f};
}
__device__ __forceinline__ void tr_emit(const f32x4 (&v)[16], int K, bf16_t* __restrict__ WT, int k0, int drow0, LAS float* scr, int lane, const float* __restrict__ kscale) {
    const int rr = lane >> 4, c4 = (lane & 15) * 4;
#pragma unroll
    for (int i = 0; i < 16; ++i) { const float kq = kscale ? kscale[k0 + rr + 4 * i] : 1.0f;
        LAS float* d = scr + (rr + 4 * i) * 65 + c4; d[0] = v[i].x * kq; d[1] = v[i].y * kq; d[2] = v[i].z * kq; d[3] = v[i].w * kq; }
    LDS_WAIT(); asm volatile("" ::: "memory");
    const int c = lane & 7;
#pragma unroll
    for (int j = 0; j < 8; ++j) { const int nn = (lane >> 3) + 8 * j; const LAS float* s = scr + (8 * c) * 65 + nn;
        u32x4 o; o.x = cvtpk(s[0 * 65], s[1 * 65]); o.y = cvtpk(s[2 * 65], s[3 * 65]); o.z = cvtpk(s[4 * 65], s[5 * 65]); o.w = cvtpk(s[6 * 65], s[7 * 65]);
        *(u32x4*)(WT + (size_t)(drow0 + nn) * K + k0 + 8 * c) = o; }
    LDS_WAIT(); asm volatile("" ::: "memory");
}
struct TrDesc { const float* W; bf16_t* WT; const float* ks; int K, N, nnb, mode; };
__device__ __forceinline__ void tr_matrix_rt(const float* W, int K, int N, int nnb, bf16_t* WT, LAS float* scr, int gw, int NGW, int lane, const float* kscale, int MODE, int it_lo = 0, int it_hi = 0x7fffffff) {
    const int nkb = K / 64, tot = nkb * nnb; const int hi_ = it_hi < tot ? it_hi : tot;
    int it = it_lo + gw; if (it >= hi_) return;
#define TR_GEO(it_) const int kb_ = (it_) / nnb, n0_ = ((it_) - kb_ * nnb) * 64; \
        const int dr_ = (MODE == 0) ? n0_ : ((n0_ >> 7) * 256 + (n0_ & 127) + (MODE == 2 ? 128 : 0))
    f32x4 va[16], vb[16];
    { TR_GEO(it); tr_load(va, W, N, kb_ * 64, n0_, lane); }
    for (;;) {
        if (it + NGW < hi_) { TR_GEO(it + NGW); tr_load(vb, W, N, kb_ * 64, n0_, lane); }
        { TR_GEO(it); tr_emit(va, K, WT, kb_ * 64, dr_, scr, lane, kscale); }
        it += NGW; if (it >= hi_) break;
        if (it + NGW < hi_) { TR_GEO(it + NGW); tr_load(va, W, N, kb_ * 64, n0_, lane); }
        { TR_GEO(it); tr_emit(vb, K, WT, kb_ * 64, dr_, scr, lane, kscale); }
        it += NGW; if (it >= hi_) break;
    }
#undef TR_GEO
}
__device__ __forceinline__ TrDesc deferred_desc(unsigned char* ws, int j) {
    const int l = j >= 4 ? 1 : 0, k = j >= 4 ? j - 4 : j + 1;
    TrDesc d;
    if (k == 0) { d.W = inp(2) + (size_t)l * DM * INW; d.WT = (bf16_t*)(ws + WS_WIN) + (size_t)l * NP * DM; d.ks = inp(1) + (size_t)l * DM; d.K = DM; d.N = INW; d.nnb = NP / 64; d.mode = 0; }
    else if (k == 1) { d.W = inp(3) + (size_t)l * DM * DM; d.WT = (bf16_t*)(ws + WS_WOUT) + (size_t)l * DM * DM; d.ks = nullptr; d.K = DM; d.N = DM; d.nnb = DM / 64; d.mode = 0; }
    else if (k == 2) { d.W = inp(19) + (size_t)l * DM * DFF; d.WT = (bf16_t*)(ws + WS_WGU) + (size_t)l * NGU * DM; d.ks = inp(18) + (size_t)l * DM; d.K = DM; d.N = DFF; d.nnb = DFF / 64; d.mode = 1; }
    else if (k == 3) { d.W = inp(20) + (size_t)l * DM * DFF; d.WT = (bf16_t*)(ws + WS_WGU) + (size_t)l * NGU * DM; d.ks = inp(18) + (size_t)l * DM; d.K = DM; d.N = DFF; d.nnb = DFF / 64; d.mode = 2; }
    else { d.W = inp(21) + (size_t)l * DFF * DM; d.WT = (bf16_t*)(ws + WS_WDN) + (size_t)l * DM * DFF; d.ks = nullptr; d.K = DFF; d.N = DM; d.nnb = DM / 64; d.mode = 0; }
    return d;
}
__device__ __forceinline__ void convert_deferred(unsigned char* ws, LAS float* scr, int w, int NW, int lane, int j_lo = 0, int j_hi = 9) {
#pragma unroll 1
    for (int j = j_lo; j < j_hi; ++j) { const TrDesc d = deferred_desc(ws, j); tr_matrix_rt(d.W, d.K, d.N, d.nnb, d.WT, scr, w, NW, lane, d.ks, d.mode); }
}
constexpr bool SPLIT_GU0 = false;
constexpr int GU0_WGS = 192;
constexpr bool SPLIT_INPROJ0 = false;
constexpr int GEMM0_WGS = 192;
__device__ NOINL void deferred_phase(ldsp lds_, int first_wg, int j_lo, int j_hi) {
    Frame F = mk_frame(lds_);
    LAS float* scr = (LAS float*)(F.lds + F.wave * 16640);
    convert_deferred(F.ws, scr, (F.bid - first_wg) * NWAVES + F.wave, (F.G - first_wg) * NWAVES, F.lane, j_lo, j_hi);
}
__device__ NOINL void p0_prologue(ldsp lds_) {
    Frame F = mk_frame(lds_);
    LAS float* scr = (LAS float*)(F.lds + F.wave * 16640);
    const int gw = F.bid * NWAVES + F.wave, NGW = F.G * NWAVES, lane = F.lane;
    unsigned char* ws = F.ws;
#pragma unroll 1
    for (int j = 0; j < 41; ++j) {
        TrDesc d; int rot = 0;
        if (j == 0) { d.W = inp(2); d.WT = (bf16_t*)(ws + WS_WIN); d.ks = inp(1); d.K = DM; d.N = INW; d.nnb = NP / 64; }
        else if (j <= 4) { const int q = j - 1, l = q >> 1, wh = q & 1;
            d.W = inp(wh ? 16 : 13) + (size_t)l * 4096 * 256; d.WT = (bf16_t*)(ws + WS_CW1T) + (size_t)(l * 2 + wh) * 256 * 4096; d.ks = nullptr; d.K = 4096; d.N = 256; d.nnb = 4; rot = 512 * j; }
        else if (j <= 8) { const int q = j - 5, l = q >> 1, wh = q & 1;
            d.W = inp(wh ? 17 : 14) + (size_t)l * 256 * 128; d.WT = (bf16_t*)(ws + SM_CW2T) + (size_t)(l * 2 + wh) * 128 * 256; d.ks = nullptr; d.K = 256; d.N = 128; d.nnb = 2; rot = 1536 + 16 * j; }
        else { const int q = j - 9, wx = q & 1, lg = q >> 1;
            d.W = inp(wx ? 9 : 7) + (size_t)lg * 128 * 128; d.WT = (bf16_t*)(ws + (wx ? SM_WXT : SM_WAT)) + (size_t)lg * 128 * 128; d.ks = nullptr; d.K = 128; d.N = 128; d.nnb = 2; rot = 1600 + 8 * q; }
        tr_matrix_rt(d.W, d.K, d.N, d.nnb, d.WT, scr, (gw + rot) % NGW, NGW, lane, d.ks, 0);
    }
    if (F.G != 256) convert_deferred(ws, scr, gw, NGW, lane);
    else if (SPLIT_GU0) convert_deferred(ws, scr, gw, NGW, lane, 0, 4);
    else if (!SPLIT_INPROJ0) convert_deferred(ws, scr, gw, NGW, lane);
    {   const float* x = inp(0); bf16_t* xs = (bf16_t*)(ws + WS_XS0); float* ssq = (float*)(ws + SM_SSQA);
        for (int m = gw; m < MTOK; m += NGW) {
            const f32x4* xr = (const f32x4*)(x + (size_t)m * DM) + lane; u32x2* o = (u32x2*)(xs + (size_t)m * DM) + lane;
            f32x4 v[16];
#pragma unroll
            for (int j = 0; j < 16; ++j) v[j] = xr[64 * j];
            float mine = 0.f;
#pragma unroll
            for (int j = 0; j < 16; ++j) { const float sj = wave_sum((v[j].x * v[j].x + v[j].y * v[j].y) + (v[j].z * v[j].z + v[j].w * v[j].w)); mine = (lane == j) ? sj : mine;
                u32x2 pk; pk.x = cvtpk(v[j].x, v[j].y); pk.y = cvtpk(v[j].z, v[j].w); o[64 * j] = pk; }
            if (lane < 16) ssq[(size_t)m * 16 + lane] = mine; } }
    for (int idx = (F.bid * NTHR + F.tid); idx < SEQ * 64; idx += F.G * NTHR) {
        const int t = idx >> 6, i = idx & 63;
        const float inv = powf(10000.0f, -(float)i * (1.0f / 64.0f));
        const float ang = (float)t * inv;
        double rev = (double)ang * 0.15915494309189535; rev -= rint(rev);
        ((float*)(ws + WS_ROPEC))[idx] = __builtin_amdgcn_cosf((float)rev);
        ((float*)(ws + WS_ROPES))[idx] = __builtin_amdgcn_sinf((float)rev);
    }
    for (int it = (gw + 1800) % NGW; it < 2 * 2 * 32; it += NGW) {
        const int s = it & 31, which = (it >> 5) & 1, l = it >> 6;
        const float* pos = inp(which ? 15 : 12) + (size_t)l * 4096 + s * 128;
        const float* w1 = inp(which ? 16 : 13) + (size_t)l * 4096 * 256 + (size_t)s * 128 * 256;
        float a0 = 0.f, a1 = 0.f, a2 = 0.f, a3 = 0.f;
#pragma unroll 1
        for (int k0 = 0; k0 < 128; k0 += 16) { float pp[16], w0[16], w1v[16], w2[16], w3[16];
#pragma unroll
            for (int x = 0; x < 16; ++x) { const float* wr = w1 + (k0 + x) * 256 + lane; pp[x] = pos[k0 + x]; w0[x] = wr[0]; w1v[x] = wr[64]; w2[x] = wr[128]; w3[x] = wr[192]; }
#pragma unroll
            for (int x = 0; x < 16; ++x) { a0 += pp[x] * w0[x]; a1 += pp[x] * w1v[x]; a2 += pp[x] * w2[x]; a3 += pp[x] * w3[x]; } }
        float* o = (float*)(ws + SM_CB1P) + (size_t)it * 256 + lane;
        o[0] = a0; o[64] = a1; o[128] = a2; o[192] = a3;
    }
}

__device__ NOINL void final_norm_phase(ldsp lds_, const bf16_t* __restrict__ xs, const float* __restrict__ ssq, const float* __restrict__ w, float* __restrict__ outp) {
    Frame F = mk_frame(lds_);
    const int gw = F.bid * NWAVES + F.wave, NGW = F.G * NWAVES, lane = F.lane;
    for (int m = gw; m < MTOK; m += NGW) {
        const float part = ssq[(size_t)m * 16 + (lane & 15)];
        const float rstd = 1.0f / sqrtf(wave_sum(part) * (0.25f / DM) + RMS_EPS);
        const u32x2* xr = (const u32x2*)(xs + (size_t)m * DM) + lane; const f32x4* wr = (const f32x4*)w + lane; f32x4* o = (f32x4*)(outp + (size_t)m * DM) + lane;
        u32x2 v[16];
#pragma unroll
        for (int j = 0; j < 16; ++j) v[j] = xr[64 * j];
#pragma unroll
        for (int j = 0; j < 16; ++j) { const f32x4 ww = wr[64 * j]; f32x4 y; y.x = bflo(v[j].x) * rstd * ww.x; y.y = bfhi(v[j].x) * rstd * ww.y; y.z = bflo(v[j].y) * rstd * ww.z; y.w = bfhi(v[j].y) * rstd * ww.w; o[64 * j] = y; }
    }
}

template <int NT, int KSTEPS>
__device__ __forceinline__ void strip_mma(f32x4 (&acc)[NT], const LAS unsigned char* A, int arow0, int apitch, const LAS unsigned char* Bt, int bpitch, int lane) {
    const int fr = lane & 15, fq = lane >> 4;
#pragma unroll
    for (int ks = 0; ks < KSTEPS; ++ks) {
        const bf16x8 a = *(const LAS bf16x8*)(A + (arow0 + fr) * apitch + (ks * 32 + fq * 8) * 2);
#pragma unroll
        for (int nt = 0; nt < NT; ++nt) {
            const bf16x8 b = *(const LAS bf16x8*)(Bt + (nt * 16 + fr) * bpitch + (ks * 32 + fq * 8) * 2);
            acc[nt] = __builtin_amdgcn_mfma_f32_16x16x32_bf16(a, b, acc[nt], 0, 0, 0);
        }
    }
}
constexpr int P272 = 272;

__device__ __forceinline__ float ret_log_gamma(int h) { return log1pf(-exp2f(-5.0f - (float)h)); }

__device__ __forceinline__ void rope8(const u32x4 w1, const u32x4 w2, const float* __restrict__ cs, const float* __restrict__ sn, float (&r1)[8], float (&r2)[8]) {
    float a[8], b[8]; unpack8(w1, a); unpack8(w2, b);
    const f32x4 c0 = *(const f32x4*)cs, c1 = *(const f32x4*)(cs + 4), s0 = *(const f32x4*)sn, s1 = *(const f32x4*)(sn + 4);
    const float c[8] = {c0.x, c0.y, c0.z, c0.w, c1.x, c1.y, c1.z, c1.w}, s[8] = {s0.x, s0.y, s0.z, s0.w, s1.x, s1.y, s1.z, s1.w};
#pragma unroll
    for (int x = 0; x < 8; ++x) { r1[x] = a[x] * c[x] - b[x] * s[x]; r2[x] = a[x] * s[x] + b[x] * c[x]; }
}

__device__ NOINL void ret_kv_unit(ldsp lds_, int unit) {
    Frame F = mk_frame(lds_);
    const int h = unit & 7, n = (unit >> 3) & 31, b = unit >> 8;
    const bf16_t* proj = (const bf16_t*)(F.ws + WS_PROJ);
    const float* ropec = (const float*)(F.ws + WS_ROPEC); const float* ropes = (const float*)(F.ws + WS_ROPES);
    ldsp vT = F.lds, kT = F.lds + 128 * P272;
    const int tid = F.tid, lane = F.lane, wave = F.wave;
    const size_t row0 = (size_t)b * SEQ + (size_t)n * 128;
    const float lg = ret_log_gamma(h);
    const int c0v = (tid & 15) * 8, c0k = (tid & 7) * 8;
    u32x4 vw[4], kw[2][2]; f32x4 tc[2][2], ts[2][2];
#pragma unroll
    for (int ps = 0; ps < 4; ++ps) { const int j = (tid >> 4) + 32 * ps; vw[ps] = *(const u32x4*)(proj + (row0 + j) * NP + C_RV + h * 128 + c0v); }
#pragma unroll
    for (int ps = 0; ps < 2; ++ps) { const int j = (tid >> 3) + 64 * ps; const int t = n * 128 + j;
        const bf16_t* kr = proj + (row0 + j) * NP + C_RK + h * 128 + c0k;
        kw[ps][0] = *(const u32x4*)kr; kw[ps][1] = *(const u32x4*)(kr + 64);
        tc[ps][0] = *(const f32x4*)(ropec + t * 64 + c0k); tc[ps][1] = *(const f32x4*)(ropec + t * 64 + c0k + 4); ts[ps][0] = *(const f32x4*)(ropes + t * 64 + c0k); ts[ps][1] = *(const f32x4*)(ropes + t * 64 + c0k + 4); }
    asm volatile("" :: "v"(vw[0]), "v"(vw[1]), "v"(vw[2]), "v"(vw[3]), "v"(kw[0][0]), "v"(kw[0][1]), "v"(kw[1][0]), "v"(kw[1][1]),
                    "v"(tc[0][0]), "v"(tc[0][1]), "v"(tc[1][0]), "v"(tc[1][1]), "v"(ts[0][0]), "v"(ts[0][1]), "v"(ts[1][0]), "v"(ts[1][1]) : "memory");
    asm volatile("" : "+v"(vw[0]), "+v"(vw[1]), "+v"(vw[2]), "+v"(vw[3]), "+v"(kw[0][0]), "+v"(kw[0][1]), "+v"(kw[1][0]), "+v"(kw[1][1]));
    asm volatile("" : "+v"(tc[0][0]), "+v"(tc[0][1]), "+v"(tc[1][0]), "+v"(tc[1][1]), "+v"(ts[0][0]), "+v"(ts[0][1]), "+v"(ts[1][0]), "+v"(ts[1][1]));
#pragma unroll
    for (int ps = 0; ps < 4; ++ps) { const int j = (tid >> 4) + 32 * ps; const int c0 = c0v;
        const unsigned ww[4] = {vw[ps].x, vw[ps].y, vw[ps].z, vw[ps].w};
#pragma unroll
        for (int x = 0; x < 8; ++x) *(LAS unsigned short*)(vT + (c0 + x) * P272 + j * 2) = (unsigned short)((x & 1) ? (ww[x >> 1] >> 16) : (ww[x >> 1] & 0xffffu)); }
#pragma unroll
    for (int ps = 0; ps < 2; ++ps) { const int j = (tid >> 3) + 64 * ps; const int c0 = c0k;
        const float cc[8] = {tc[ps][0].x, tc[ps][0].y, tc[ps][0].z, tc[ps][0].w, tc[ps][1].x, tc[ps][1].y, tc[ps][1].z, tc[ps][1].w}, sn[8] = {ts[ps][0].x, ts[ps][0].y, ts[ps][0].z, ts[ps][0].w, ts[ps][1].x, ts[ps][1].y, ts[ps][1].z, ts[ps][1].w};
        float a[8], bb[8], r1[8], r2[8]; unpack8(kw[ps][0], a); unpack8(kw[ps][1], bb);
#pragma unroll
        for (int x = 0; x < 8; ++x) { r1[x] = a[x] * cc[x] - bb[x] * sn[x]; r2[x] = a[x] * sn[x] + bb[x] * cc[x]; }
        const float sc = 0.08838834764831845f * __expf(lg * (float)(127 - j));
#pragma unroll
        for (int x = 0; x < 8; ++x) { *(LAS unsigned short*)(kT + (c0 + x) * P272 + j * 2) = (unsigned short)f2bf(r1[x] * sc);
                                      *(LAS unsigned short*)(kT + (c0 + 64 + x) * P272 + j * 2) = (unsigned short)f2bf(r2[x] * sc); } }
    __syncthreads();
    f32x4 acc[8];
#pragma unroll
    for (int i = 0; i < 8; ++i) acc[i] = (f32x4){0.f, 0.f, 0.f, 0.f};
    strip_mma<8, 4>(acc, vT, wave * 16, P272, kT, P272, lane);
    float* kv = (float*)(F.ws + WS_RETKV) + (size_t)unit * 16384;
    const int fr = lane & 15, fq = lane >> 4;
#pragma unroll
    for (int nt = 0; nt < 8; ++nt)
#pragma unroll
        for (int j = 0; j < 4; ++j) kv[(wave * 16 + 4 * fq + j) * 128 + nt * 16 + fr] = acc[nt][j];
    __syncthreads();
}

__device__ NOINL void moba_kmean_unit(ldsp lds_, int unit) {
    Frame F = mk_frame(lds_);
    const int blk = unit & 15, h = (unit >> 4) & 7, b = unit >> 7;
    const bf16_t* proj = (const bf16_t*)(F.ws + WS_PROJ);
    LAS float* part = (LAS float*)F.lds;
    const int tid = F.tid, d0 = (tid & 15) * 8, p = tid >> 4;
    float s[8] = {0, 0, 0, 0, 0, 0, 0, 0};
#pragma unroll
    for (int kk = 0; kk < 8; ++kk) { const size_t row = (size_t)b * SEQ + blk * 256 + p * 8 + kk;
        float f[8]; unpack8(*(const u32x4*)(proj + row * NP + C_MK + h * 128 + d0), f);
#pragma unroll
        for (int x = 0; x < 8; ++x) s[x] += f[x]; }
#pragma unroll
    for (int x = 0; x < 8; ++x) part[p * 128 + d0 + x] = s[x];
    __syncthreads();
    if (tid < 128) { float a = 0.f;
#pragma unroll 8
        for (int q = 0; q < 32; ++q) a += part[q * 128 + tid];
        ((float*)(F.ws + SM_KMEAN))[(size_t)unit * 128 + tid] = a * (1.0f / 256.0f); }
    __syncthreads();
}

constexpr int CP2 = 528;
constexpr int CMP_B = 64 * CP2, CMP_STG2 = CMP_B + 32 * CP2;
__device__ NOINL void nsa_cmp1_unit(ldsp lds_, int layer, int unit) {
    Frame F = mk_frame(lds_);
    const int nq = unit & 3, rg = (unit >> 2) & 7, kvh = (unit >> 5) & 1, b = (unit >> 6) & 1, which = unit >> 7;
    const bf16_t* proj = (const bf16_t*)(F.ws + WS_PROJ);
    const bf16_t* w1t = (const bf16_t*)(F.ws + WS_CW1T) + (size_t)(layer * 2 + which) * 256 * 4096 + (size_t)(nq * 64) * 4096;
    const float* cb1p = (const float*)(F.ws + SM_CB1P) + (size_t)(layer * 2 + which) * 32 * 256 + nq * 64;
    ldsp stg = F.lds;
    LAS float* biasL = (LAS float*)(F.lds + 2 * CMP_STG2);
    const int tid = F.tid, lane = F.lane, wave = F.wave;
    if (tid < 64) { float a = 0.f; float bv[32];
#pragma unroll
        for (int s = 0; s < 32; ++s) bv[s] = cb1p[s * 256 + tid];
#pragma unroll
        for (int s = 0; s < 32; ++s) a += bv[s];
        biasL[tid] = a; }
    const int kc = (tid & 31) * 8, r0 = tid >> 5;
    const bf16_t* bsrc = w1t + (size_t)r0 * 4096 + kc;
    const bf16_t* asrc[2];
#pragma unroll
    for (int i = 0; i < 2; ++i) { int ncr = rg * 32 + r0 + 16 * i; ncr = ncr > 254 ? 254 : ncr;
        asrc[i] = proj + ((size_t)b * SEQ + 16 * ncr + (kc >> 7)) * NP + (which ? C_NVC : C_NKC) + kvh * 128 + (kc & 127); }
    const int dstb = r0 * CP2 + kc * 2;
    bf16x8 sbA[4], saA[2], sbB[4], saB[2];
#define C_LOAD(SB, SA, s_) do { _Pragma("unroll") for (int i = 0; i < 4; ++i) SB[i] = *(const bf16x8*)(bsrc + (size_t)i * 16 * 4096 + (s_) * 256); \
        _Pragma("unroll") for (int i = 0; i < 2; ++i) SA[i] = *(const bf16x8*)(asrc[i] + (size_t)(2 * (s_)) * NP); } while (0)
#define C_WRITE(SB, SA, bf) do { ldsp d_ = stg + (bf) * CMP_STG2; _Pragma("unroll") for (int i = 0; i < 4; ++i) *(LAS bf16x8*)(d_ + dstb + i * 16 * CP2) = SB[i]; \
        _Pragma("unroll") for (int i = 0; i < 2; ++i) *(LAS bf16x8*)(d_ + CMP_B + dstb + i * 16 * CP2) = SA[i]; } while (0)
#define C_MMA(bf) do { ldsp cur = stg + (bf) * CMP_STG2; strip_mma<1, 8>(acc, cur + CMP_B, (wave >> 2) * 16, CP2, cur + ((wave & 3) * 16) * CP2, CP2, lane); } while (0)
    f32x4 acc[1] = {(f32x4){0.f, 0.f, 0.f, 0.f}};
    C_LOAD(sbA, saA, 0); C_LOAD(sbB, saB, 1);
    C_WRITE(sbA, saA, 0); __syncthreads();
#pragma unroll 1
    for (int s = 0; s < 16; s += 2) {
        if (s + 2 < 16) C_LOAD(sbA, saA, s + 2);
        C_MMA(0);
        C_WRITE(sbB, saB, 1); __syncthreads();
        if (s + 3 < 16) C_LOAD(sbB, saB, s + 3);
        C_MMA(1);
        if (s + 2 < 16) C_WRITE(sbA, saA, 0);
        __syncthreads();
    }
#undef C_LOAD
#undef C_WRITE
#undef C_MMA
    const int fr = lane & 15, fq = lane >> 4;
    bf16_t* hidg = (bf16_t*)(F.ws + WS_H) + (size_t)(((which * 2 + b) * 2 + kvh) * 256 + rg * 32) * 256 + nq * 64;
    {   const int col = (wave & 3) * 16 + fr; const float bv = biasL[col];
#pragma unroll
        for (int j = 0; j < 4; ++j) { const int row = (wave >> 2) * 16 + 4 * fq + j; hidg[(size_t)row * 256 + col] = (bf16_t)f2bf(gelu_tanh(acc[0][j] + bv)); } }
    __syncthreads();
}
__device__ NOINL void nsa_cmp2_unit(ldsp lds_, int layer, int unit) {
    Frame F = mk_frame(lds_);
    const int rg = unit & 7, kvh = (unit >> 3) & 1, b = (unit >> 4) & 1, which = unit >> 5;
    const bf16_t* w2t = (const bf16_t*)(F.ws + SM_CW2T) + (size_t)(layer * 2 + which) * 128 * 256;
    const bf16_t* hidg = (const bf16_t*)(F.ws + WS_H) + (size_t)(((which * 2 + b) * 2 + kvh) * 256 + rg * 32) * 256;
    ldsp hid = F.lds;
    const int tid = F.tid, lane = F.lane, wave = F.wave, fr = lane & 15, fq = lane >> 4;
    bf16x8 bw[8];
    {   u32x4 hw[2];
#pragma unroll
        for (int i = 0; i < 2; ++i) { const int c = tid + 512 * i; hw[i] = *(const u32x4*)(hidg + (size_t)(c >> 5) * 256 + (c & 31) * 8); }
#pragma unroll
        for (int ks = 0; ks < 8; ++ks) bw[ks] = *(const bf16x8*)(w2t + (size_t)(wave * 16 + fr) * 256 + ks * 32 + fq * 8);
        __builtin_amdgcn_sched_barrier(0);
        asm volatile("" : "+v"(hw[0]), "+v"(hw[1]), "+v"(bw[0]), "+v"(bw[1]), "+v"(bw[2]), "+v"(bw[3]), "+v"(bw[4]), "+v"(bw[5]), "+v"(bw[6]), "+v"(bw[7]));
#pragma unroll
        for (int i = 0; i < 2; ++i) { const int c = tid + 512 * i; *(LAS u32x4*)(hid + (c >> 5) * 528 + (c & 31) * 16) = hw[i]; } }
    __syncthreads();
    f32x4 a2[2] = {(f32x4){0.f, 0.f, 0.f, 0.f}, (f32x4){0.f, 0.f, 0.f, 0.f}};
#pragma unroll
    for (int ks = 0; ks < 8; ++ks) {
        const bf16x8 bb = bw[ks];
#pragma unroll
        for (int s = 0; s < 2; ++s) { const bf16x8 a = *(const LAS bf16x8*)(hid + (s * 16 + fr) * 528 + (ks * 32 + fq * 8) * 2);
            a2[s] = __builtin_amdgcn_mfma_f32_16x16x32_bf16(a, bb, a2[s], 0, 0, 0); }
    }
    bf16_t* outp = (bf16_t*)(F.ws + (which ? SM_VC : SM_KC)) + (size_t)((b * 2 + kvh) * 256 + rg * 32) * 128;
#pragma unroll
    for (int s = 0; s < 2; ++s)
#pragma unroll
        for (int j = 0; j < 4; ++j) { const int row = s * 16 + 4 * fq + j; const bool valid = (rg * 32 + row) < 255;
            outp[row * 128 + wave * 16 + fr] = valid ? (bf16_t)f2bf(a2[s][j]) : (bf16_t)0; }
    __syncthreads();
}

__device__ NOINL void lru_local_unit(ldsp lds_, int layer, int unit) {
    Frame F = mk_frame(lds_);
    const int g = unit & 7, tc = (unit >> 3) & 31, b = unit >> 8;
    const bf16_t* proj = (const bf16_t*)(F.ws + WS_PROJ);
    const float* convw = inp(5) + (size_t)layer * 4 * 1024 + g * 128;
    const float* convb = inp(6) + (size_t)layer * 1024 + g * 128;
    const float* ba = inp(8) + (size_t)layer * 1024 + g * 128;
    const float* bx = inp(10) + (size_t)layer * 1024 + g * 128;
    const float* lam = inp(11) + (size_t)layer * 1024 + g * 128;
    const bf16_t* wat = (const bf16_t*)(F.ws + SM_WAT) + (size_t)(layer * 8 + g) * 16384;
    const bf16_t* wxt = (const bf16_t*)(F.ws + SM_WXT) + (size_t)(layer * 8 + g) * 16384;
    ldsp LX = F.lds;
    ldsp XCB = F.lds + 132 * P272;
    ldsp WA = XCB + 128 * P272, WX = WA + 128 * P272;
    LAS float* AL = (LAS float*)F.lds;
    LAS float* UL = (LAS float*)(F.lds + 65536);
    LAS float* PRM = (LAS float*)(F.lds + 140352);
    const int tid = F.tid, lane = F.lane, wave = F.wave;
    const int t0 = tc * 128;
    {   float pv[2]; u32x4 lxw[5], waw[4], wxw[4];
#pragma unroll
        for (int q = 0; q < 2; ++q) { const int i = tid + 512 * q, k = i >> 7, c = i & 127;
            const float* src = (k < 4) ? (convw + k * 1024) : (k == 4) ? convb : (k == 5) ? ba : (k == 6) ? bx : lam;
            pv[q] = src[c]; }
#pragma unroll
        for (int q = 0; q < 5; ++q) { const int i = tid + 512 * q, r = i >> 4, c0 = (i & 15) * 8; const int t = t0 - 3 + r;
            lxw[q] = (u32x4){0u, 0u, 0u, 0u}; if (i < 131 * 16 && t >= 0) lxw[q] = *(const u32x4*)(proj + ((size_t)b * SEQ + t) * NP + C_LX + g * 128 + c0); }
#pragma unroll
        for (int q = 0; q < 4; ++q) { const int i = tid + 512 * q; waw[q] = *(const u32x4*)(wat + i * 8); wxw[q] = *(const u32x4*)(wxt + i * 8); }
#pragma unroll
        for (int q = 0; q < 2; ++q) { const int i = tid + 512 * q; PRM[i] = (i >= 896) ? log1pf(__expf(-pv[q])) : pv[q]; }
#pragma unroll
        for (int q = 0; q < 5; ++q) { const int i = tid + 512 * q, r = i >> 4, c0 = (i & 15) * 8; if (i < 132 * 16) *(LAS u32x4*)(LX + r * P272 + c0 * 2) = lxw[q]; }
#pragma unroll
        for (int q = 0; q < 4; ++q) { const int i = tid + 512 * q, r = i >> 4, c0 = (i & 15) * 8;
            *(LAS u32x4*)(WA + r * P272 + c0 * 2) = waw[q]; *(LAS u32x4*)(WX + r * P272 + c0 * 2) = wxw[q]; }
    }
    __syncthreads();
    {   const int t = tid >> 2, cb0 = (tid & 3) * 32;
#pragma unroll 4
        for (int c = cb0; c < cb0 + 32; c += 2) { float y0 = PRM[512 + c], y1 = PRM[512 + c + 1];
#pragma unroll
            for (int tap = 0; tap < 4; ++tap) { const unsigned w = *(const LAS unsigned*)(LX + (t + tap) * P272 + c * 2);
                y0 += bflo(w) * PRM[tap * 128 + c]; y1 += bfhi(w) * PRM[tap * 128 + c + 1]; }
            *(LAS unsigned*)(XCB + t * P272 + c * 2) = pk2(y0, y1); } }
    __syncthreads();
    f32x4 accR[8], accI[8];
#pragma unroll
    for (int i = 0; i < 8; ++i) { accR[i] = (f32x4){0.f, 0.f, 0.f, 0.f}; accI[i] = (f32x4){0.f, 0.f, 0.f, 0.f}; }
    strip_mma<8, 4>(accR, XCB, wave * 16, P272, WA, P272, lane);
    strip_mma<8, 4>(accI, XCB, wave * 16, P272, WX, P272, lane);
    const int fr = lane & 15, fq = lane >> 4;
    float av[8][4], uv[8][4];
#pragma unroll
    for (int nt = 0; nt < 8; ++nt) { const int c = nt * 16 + fr;
        const float cw0 = PRM[c], cw1 = PRM[128 + c], cw2 = PRM[256 + c], cw3 = PRM[384 + c], cb = PRM[512 + c];
        const float bav = PRM[640 + c], bxv = PRM[768 + c], spl = PRM[896 + c];
#pragma unroll
        for (int j = 0; j < 4; ++j) { const int t = wave * 16 + 4 * fq + j;
            const float xc = cb + bf2f(*(const LAS unsigned short*)(LX + (t + 0) * P272 + c * 2)) * cw0 + bf2f(*(const LAS unsigned short*)(LX + (t + 1) * P272 + c * 2)) * cw1
                                + bf2f(*(const LAS unsigned short*)(LX + (t + 2) * P272 + c * 2)) * cw2 + bf2f(*(const LAS unsigned short*)(LX + (t + 3) * P272 + c * 2)) * cw3;
            const float r = sigmoidf_(accR[nt][j] + bav), ig = sigmoidf_(accI[nt][j] + bxv);
            const float la = -8.0f * r * spl; const float a = __expf(la);
            const float x2 = 2.0f * la;
            const float om = (x2 > -0.02f) ? -x2 * (1.0f + x2 * (0.5f + x2 * 0.16666667f)) : 1.0f - __expf(x2);
            av[nt][j] = a; uv[nt][j] = __builtin_amdgcn_sqrtf(fmaxf(om, 0.0f)) * (ig * xc); } }
    __syncthreads();
#pragma unroll
    for (int nt = 0; nt < 8; ++nt)
#pragma unroll
        for (int j = 0; j < 4; ++j) { const int t = wave * 16 + 4 * fq + j, c = nt * 16 + fr; AL[t * 128 + c] = av[nt][j]; UL[t * 128 + c] = uv[nt][j]; }
    __syncthreads();
    if (tid < 128) { float hh = 0.f, P = 1.f; const size_t base = ((size_t)b * SEQ + t0) * 1024 + g * 128 + tid;
        float* Hp = (float*)(F.ws + WS_LRUH) + base; float* Pp = (float*)(F.ws + WS_LRUP) + base;
#pragma unroll 1
        for (int t0s = 0; t0s < 128; t0s += 16) { float aa[16], uu[16];
#pragma unroll
            for (int i = 0; i < 16; ++i) { aa[i] = AL[(t0s + i) * 128 + tid]; uu[i] = UL[(t0s + i) * 128 + tid]; }
#pragma unroll
            for (int i = 0; i < 16; ++i) { P *= aa[i]; hh = aa[i] * hh + uu[i]; Hp[(size_t)(t0s + i) * 1024] = hh; Pp[(size_t)(t0s + i) * 1024] = P; } }
        ((float*)(F.ws + SM_LRUCA))[(size_t)(b * 32 + tc) * 1024 + g * 128 + tid] = P;
        ((float*)(F.ws + SM_LRUCH))[(size_t)(b * 32 + tc) * 1024 + g * 128 + tid] = hh; }
    __syncthreads();
}

__device__ __forceinline__ void s1_phase(ldsp lds, int layer) {
    int G = gridDim.x, bid = blockIdx.x; OPQ_S(G); OPQ_S(bid);
#ifndef S1_DUP
#define S1_DUP 0
#endif
#define S1REP(b) _Pragma("unroll 1") for (int r1_ = 0; r1_ < 1 + ((S1_DUP >> (b)) & 1); ++r1_)
    S1REP(0) for (int u = bid; u < 512; u += G) ret_kv_unit(lds, u);
    S1REP(1) for (int u = bid; u < 512; u += G) lru_local_unit(lds, layer, u);
    S1REP(2) for (int u = bid; u < 256; u += G) moba_kmean_unit(lds, u);
    S1REP(3) for (int u = bid; u < 256; u += G) nsa_cmp1_unit(lds, layer, u);
}

__device__ NOINL void ret_scan_phase(ldsp lds_) {
    Frame F = mk_frame(lds_);
    for (int gid = F.bid * NTHR + F.tid; gid < 16 * 8192; gid += F.G * NTHR) {
        const int bh = gid >> 13, idx2 = gid & 8191, b = bh >> 3, h = bh & 7;
        f32x2* base = (f32x2*)((float*)(F.ws + WS_RETKV) + (size_t)((b * 32) * 8 + h) * 16384) + idx2;
        const float dc = __expf(ret_log_gamma(h) * 128.0f);
        f32x2 v[32];
#pragma unroll
        for (int n = 0; n < 32; ++n) v[n] = base[(size_t)n * 8 * 8192];
        f32x2 st = {0.f, 0.f};
#pragma unroll
        for (int n = 0; n < 32; ++n) { base[(size_t)n * 8 * 8192] = st; st = st * dc + v[n]; }
    }
}

__device__ __forceinline__ float row16_sum(float v) {
    v += __int_as_float(__builtin_amdgcn_update_dpp(0, __float_as_int(v), 0x128, 0xF, 0xF, false));
    v += __int_as_float(__builtin_amdgcn_update_dpp(0, __float_as_int(v), 0x124, 0xF, 0xF, false));
    v += __int_as_float(__builtin_amdgcn_update_dpp(0, __float_as_int(v), 0x122, 0xF, 0xF, false));
    v += __int_as_float(__builtin_amdgcn_update_dpp(0, __float_as_int(v), 0x121, 0xF, 0xF, false));
    return v;
}
__device__ NOINL void ret_out_unit(ldsp lds_, int layer, int unit) {
    Frame F = mk_frame(lds_);
    const int h = unit & 7, n = (unit >> 3) & 31, b = unit >> 8;
    const bf16_t* proj = (const bf16_t*)(F.ws + WS_PROJ);
    const float* ropec = (const float*)(F.ws + WS_ROPEC); const float* ropes = (const float*)(F.ws + WS_ROPES);
    const float* gain = inp(4) + (size_t)layer * 1024 + h * 128;
    ldsp Q = F.lds, Kt = F.lds + 128 * P272, vT = F.lds + 2 * 128 * P272, ST = F.lds + 3 * 128 * P272;
    const int tid = F.tid, lane = F.lane, wave = F.wave;
    const size_t row0 = (size_t)b * SEQ + (size_t)n * 128;
    const float lg = ret_log_gamma(h);
    const f32x4* kvp = (const f32x4*)((const float*)(F.ws + WS_RETKV) + (size_t)unit * 16384) + tid;
    f32x4 st[8]; u32x4 qw[2][2], kw[2][2], vw[4]; f32x4 tc[2][2], ts[2][2];
    const int c0q = (tid & 7) * 8, c0v = (tid & 15) * 8;
#pragma unroll
    for (int k = 0; k < 8; ++k) st[k] = kvp[512 * k];
#pragma unroll
    for (int ps = 0; ps < 2; ++ps) { const int j = (tid >> 3) + 64 * ps; const int t = n * 128 + j;
        const bf16_t* qrw = proj + (row0 + j) * NP + C_RQ + h * 128 + c0q; const bf16_t* krw = proj + (row0 + j) * NP + C_RK + h * 128 + c0q;
        qw[ps][0] = *(const u32x4*)qrw; qw[ps][1] = *(const u32x4*)(qrw + 64); kw[ps][0] = *(const u32x4*)krw; kw[ps][1] = *(const u32x4*)(krw + 64);
        tc[ps][0] = *(const f32x4*)(ropec + t * 64 + c0q); tc[ps][1] = *(const f32x4*)(ropec + t * 64 + c0q + 4); ts[ps][0] = *(const f32x4*)(ropes + t * 64 + c0q); ts[ps][1] = *(const f32x4*)(ropes + t * 64 + c0q + 4); }
#pragma unroll
    for (int ps = 0; ps < 4; ++ps) { const int j = (tid >> 4) + 32 * ps; vw[ps] = *(const u32x4*)(proj + (row0 + j) * NP + C_RV + h * 128 + c0v); }
    asm volatile("" :: "v"(st[0]), "v"(st[1]), "v"(st[2]), "v"(st[3]), "v"(st[4]), "v"(st[5]), "v"(st[6]), "v"(st[7]), "v"(qw[0][0]), "v"(qw[0][1]), "v"(qw[1][0]), "v"(qw[1][1]),
                    "v"(kw[0][0]), "v"(kw[0][1]), "v"(kw[1][0]), "v"(kw[1][1]), "v"(tc[0][0]), "v"(tc[0][1]), "v"(tc[1][0]), "v"(tc[1][1]), "v"(ts[0][0]), "v"(ts[0][1]), "v"(ts[1][0]), "v"(ts[1][1]),
                    "v"(vw[0]), "v"(vw[1]), "v"(vw[2]), "v"(vw[3]) : "memory");
    asm volatile("" : "+v"(st[0]), "+v"(st[1]), "+v"(st[2]), "+v"(st[3]), "+v"(st[4]), "+v"(st[5]), "+v"(st[6]), "+v"(st[7]));
    asm volatile("" : "+v"(qw[0][0]), "+v"(qw[0][1]), "+v"(qw[1][0]), "+v"(qw[1][1]), "+v"(kw[0][0]), "+v"(kw[0][1]), "+v"(kw[1][0]), "+v"(kw[1][1]));
    asm volatile("" : "+v"(tc[0][0]), "+v"(tc[0][1]), "+v"(tc[1][0]), "+v"(tc[1][1]), "+v"(ts[0][0]), "+v"(ts[0][1]), "+v"(ts[1][0]), "+v"(ts[1][1]));
    asm volatile("" : "+v"(vw[0]), "+v"(vw[1]), "+v"(vw[2]), "+v"(vw[3]));
#pragma unroll
    for (int k = 0; k < 8; ++k) { const int idx = (tid + 512 * k) * 4; const int e = idx >> 7, d = idx & 127;
        u32x2 w; w.x = pk2(st[k].x, st[k].y); w.y = pk2(st[k].z, st[k].w); *(LAS u32x2*)(ST + e * P272 + d * 2) = w; }
#pragma unroll
    for (int ps = 0; ps < 2; ++ps) { const int j = (tid >> 3) + 64 * ps; const int c0 = c0q;
        const float cc[8] = {tc[ps][0].x, tc[ps][0].y, tc[ps][0].z, tc[ps][0].w, tc[ps][1].x, tc[ps][1].y, tc[ps][1].z, tc[ps][1].w}, sn[8] = {ts[ps][0].x, ts[ps][0].y, ts[ps][0].z, ts[ps][0].w, ts[ps][1].x, ts[ps][1].y, ts[ps][1].z, ts[ps][1].w};
        float a[8], bb[8], r1[8], r2[8]; u32x4 w;
        unpack8(qw[ps][0], a); unpack8(qw[ps][1], bb);
#pragma unroll
        for (int x = 0; x < 8; ++x) { r1[x] = a[x] * cc[x] - bb[x] * sn[x]; r2[x] = a[x] * sn[x] + bb[x] * cc[x]; }
        w.x = pk2(r1[0], r1[1]); w.y = pk2(r1[2], r1[3]); w.z = pk2(r1[4], r1[5]); w.w = pk2(r1[6], r1[7]); *(LAS u32x4*)(Q + j * P272 + c0 * 2) = w;
        w.x = pk2(r2[0], r2[1]); w.y = pk2(r2[2], r2[3]); w.z = pk2(r2[4], r2[5]); w.w = pk2(r2[6], r2[7]); *(LAS u32x4*)(Q + j * P272 + (c0 + 64) * 2) = w;
        unpack8(kw[ps][0], a); unpack8(kw[ps][1], bb);
#pragma unroll
        for (int x = 0; x < 8; ++x) { r1[x] = a[x] * cc[x] - bb[x] * sn[x]; r2[x] = a[x] * sn[x] + bb[x] * cc[x]; }
        const float sc = 0.08838834764831845f;
        w.x = pk2(r1[0] * sc, r1[1] * sc); w.y = pk2(r1[2] * sc, r1[3] * sc); w.z = pk2(r1[4] * sc, r1[5] * sc); w.w = pk2(r1[6] * sc, r1[7] * sc); *(LAS u32x4*)(Kt + j * P272 + c0 * 2) = w;
        w.x = pk2(r2[0] * sc, r2[1] * sc); w.y = pk2(r2[2] * sc, r2[3] * sc); w.z = pk2(r2[4] * sc, r2[5] * sc); w.w = pk2(r2[6] * sc, r2[7] * sc); *(LAS u32x4*)(Kt + j * P272 + (c0 + 64) * 2) = w; }
#pragma unroll
    for (int ps = 0; ps < 4; ++ps) { const int j = (tid >> 4) + 32 * ps; const int c0 = c0v;
        const unsigned ww[4] = {vw[ps].x, vw[ps].y, vw[ps].z, vw[ps].w};
#pragma unroll
        for (int x = 0; x < 8; ++x) *(LAS unsigned short*)(vT + (c0 + x) * P272 + j * 2) = (unsigned short)((x & 1) ? (ww[x >> 1] >> 16) : (ww[x >> 1] & 0xffffu)); }
    __syncthreads();
    const int fr = lane & 15, fq = lane >> 4;
    f32x4 accC[8], accS[8];
#pragma unroll
    for (int i = 0; i < 8; ++i) { accC[i] = (f32x4){0.f, 0.f, 0.f, 0.f}; accS[i] = (f32x4){0.f, 0.f, 0.f, 0.f}; }
    strip_mma<8, 4>(accC, Q, wave * 16, P272, ST, P272, lane);
    strip_mma<8, 4>(accS, Q, wave * 16, P272, Kt, P272, lane);
    __syncthreads();
#pragma unroll
    for (int nt = 0; nt < 8; ++nt)
#pragma unroll
        for (int j = 0; j < 4; ++j) { const int i = wave * 16 + 4 * fq + j, jj = nt * 16 + fr;
            const float v = (i >= jj) ? accS[nt][j] * __expf(lg * (float)(i - jj)) : 0.0f;
            *(LAS unsigned short*)(Q + i * P272 + jj * 2) = (unsigned short)f2bf(v); }
    __syncthreads();
#pragma unroll
    for (int i = 0; i < 8; ++i) accS[i] = (f32x4){0.f, 0.f, 0.f, 0.f};
    float gvv[4][8], gn[8]; unsigned graw[4][8];
#pragma unroll
    for (int nt = 0; nt < 8; ++nt) gn[nt] = gain[nt * 16 + fr];
#pragma unroll
    for (int j = 0; j < 4; ++j) { const bf16_t* grow = proj + (row0 + wave * 16 + 4 * fq + j) * NP + C_RG + h * 128;
#pragma unroll
        for (int nt = 0; nt < 8; ++nt) graw[j][nt] = grow[nt * 16 + fr]; }
    __builtin_amdgcn_sched_barrier(0);
    strip_mma<8, 4>(accS, Q, wave * 16, P272, vT, P272, lane);
    __builtin_amdgcn_sched_barrier(0);
#pragma unroll
    for (int j = 0; j < 4; ++j) asm volatile("" : "+v"(graw[j][0]), "+v"(graw[j][1]), "+v"(graw[j][2]), "+v"(graw[j][3]), "+v"(graw[j][4]), "+v"(graw[j][5]), "+v"(graw[j][6]), "+v"(graw[j][7]));
    asm volatile("" : "+v"(gn[0]), "+v"(gn[1]), "+v"(gn[2]), "+v"(gn[3]), "+v"(gn[4]), "+v"(gn[5]), "+v"(gn[6]), "+v"(gn[7]));
#pragma unroll
    for (int j = 0; j < 4; ++j)
#pragma unroll
        for (int nt = 0; nt < 8; ++nt) gvv[j][nt] = bf2f((unsigned short)graw[j][nt]);
#pragma unroll
    for (int j = 0; j < 4; ++j) { const int i = wave * 16 + 4 * fq + j;
        const float dfs = __expf(lg * (float)(i + 1));
        float y[8]; float s = 0.f;
#pragma unroll
        for (int nt = 0; nt < 8; ++nt) { y[nt] = accS[nt][j] + dfs * accC[nt][j]; s += y[nt]; }
        s = row16_sum(s);
        const float mean = s * (1.0f / 128.0f); float q2 = 0.f;
#pragma unroll
        for (int nt = 0; nt < 8; ++nt) { y[nt] -= mean; q2 += y[nt] * y[nt]; }
        q2 = row16_sum(q2);
        const float rstd = 1.0f / sqrtf(q2 * (1.0f / 128.0f) + RMS_EPS);
        bf16_t* yrow = (bf16_t*)(F.ws + WS_Y) + (row0 + i) * DM + 0 + h * 128;
#pragma unroll
        for (int nt = 0; nt < 8; ++nt) { const int e = nt * 16 + fr; const float gv = gvv[j][nt];
            yrow[e] = (bf16_t)f2bf(gv * sigmoidf_(gv) * (y[nt] * rstd * gn[nt])); } }
    __syncthreads();
}

__device__ NOINL void lru_out_unit(ldsp lds_, int unit, int q_lo, int q_hi) {
    Frame F = mk_frame(lds_);
    const int ch = unit & 1, tc = (unit >> 1) & 31, b = unit >> 6;
    const bf16_t* proj = (const bf16_t*)(F.ws + WS_PROJ);
    LAS float* HIN = (LAS float*)F.lds;
    {   const int c = ch * 512 + F.tid;
        const float* CA = (const float*)(F.ws + SM_LRUCA) + (size_t)b * 32 * 1024 + c; const float* CH = (const float*)(F.ws + SM_LRUCH) + (size_t)b * 32 * 1024 + c;
        float H = 0.f; float ca[32], chv[32];
#pragma unroll
        for (int k = 0; k < 32; ++k) { ca[k] = CA[k * 1024]; chv[k] = CH[k * 1024]; }
#pragma unroll
        for (int k = 0; k < 32; ++k) H = (k < tc) ? ca[k] * H + chv[k] : H;
        HIN[F.tid] = H; }
    __syncthreads();
    const int cg = (F.tid & 127) * 4, tsub = F.tid >> 7; const int c0 = ch * 512 + cg;
    const f32x4 Hin = *(const LAS f32x4*)(HIN + cg);
    const size_t r0 = (size_t)b * SEQ + tc * 128 + tsub;
    const float* Hp = (const float*)(F.ws + WS_LRUH) + r0 * 1024 + c0; const float* Pp = (const float*)(F.ws + WS_LRUP) + r0 * 1024 + c0;
    const bf16_t* gp = proj + r0 * NP + C_LG + c0; bf16_t* yp = (bf16_t*)(F.ws + WS_Y) + r0 * DM + 2048 + c0;
#define LRU_LOAD(hv, pv, gv, i0_) do { _Pragma("unroll") for (int x = 0; x < 8; ++x) { const size_t t = (size_t)((i0_) + x) * 4; hv[x] = *(const f32x4*)(Hp + t * 1024); pv[x] = *(const f32x4*)(Pp + t * 1024); gv[x] = *(const u32x2*)(gp + t * NP); } } while (0)
#define LRU_EMIT(hv, pv, gv, i0_) do { _Pragma("unroll") for (int x = 0; x < 8; ++x) { const size_t t = (size_t)((i0_) + x) * 4; const f32x4 h = hv[x] + pv[x] * Hin; \
            u32x2 w; w.x = cvtpk(h.x * gelu_tanh(bflo(gv[x].x)), h.y * gelu_tanh(bfhi(gv[x].x))); w.y = cvtpk(h.z * gelu_tanh(bflo(gv[x].y)), h.w * gelu_tanh(bfhi(gv[x].y))); \
            *(u32x2*)(yp + t * DM) = w; } } while (0)
    f32x4 hA[8], pA[8], hB[8], pB[8]; u32x2 gA[8], gB[8];
    int i0 = q_lo * 8; const int i1 = q_hi * 8;
    LRU_LOAD(hA, pA, gA, i0);
#pragma unroll 1
    for (;;) {
        if (i0 + 8 >= i1) { LRU_EMIT(hA, pA, gA, i0); break; }
        LRU_LOAD(hB, pB, gB, i0 + 8);
        LRU_EMIT(hA, pA, gA, i0);
        if (i0 + 16 >= i1) { LRU_EMIT(hB, pB, gB, i0 + 8); break; }
        LRU_LOAD(hA, pA, gA, i0 + 16);
        LRU_EMIT(hB, pB, gB, i0 + 8);
        i0 += 16;
    }
#undef LRU_LOAD
#undef LRU_EMIT
    __syncthreads();
}

constexpr int SHM_T = 16384;
#define KSWZ(row, colB) ((row) * 256 + ((colB) ^ (((row) & 7) << 4)))
__device__ __forceinline__ int v_st(int k, int c) { const int kk = (k & ~0xC) | ((k & 4) << 1) | ((k & 8) >> 1); return ((kk >> 3) * 4 + (c >> 5)) * 512 + ((kk & 7) * 32 + (c & 31)) * 2; }
__device__ __forceinline__ int v_rd_base(int lane) { return ((lane & 3) << 3) | (((lane >> 2) & 3) << 6) | (((lane >> 4) & 1) << 5) | (((lane >> 5) & 1) << 8); }
constexpr int v_rd_off(int d0, int ks, int half) { return d0 * 512 + ks * 4096 + half * 2048; }
__device__ __forceinline__ int crow(int r, int hi) { return (r & 3) + 8 * (r >> 2) + 4 * hi; }
__device__ __forceinline__ float half_max(float v) { auto rr = __builtin_amdgcn_permlane32_swap(__float_as_uint(v), __float_as_uint(v), false, false); return fmaxf(__uint_as_float(rr[0]), __uint_as_float(rr[1])); }
__device__ __forceinline__ float half_sum(float v) { auto rr = __builtin_amdgcn_permlane32_swap(__float_as_uint(v), __float_as_uint(v), false, false); return __uint_as_float(rr[0]) + __uint_as_float(rr[1]); }
__device__ __forceinline__ float half_other(float v) { auto rr = __builtin_amdgcn_permlane32_swap(__float_as_uint(v), __float_as_uint(v), false, false); const float a = __uint_as_float(rr[0]), b = __uint_as_float(rr[1]); return (__lane_id() & 32) ? a : b; }

__device__ __forceinline__ void qkt(f32x16& p0, f32x16& p1, const LAS unsigned char* K_lds, int r32, int hi, const bf16x8 (&qr)[8]) {
    p0 = f32x16{}; p1 = f32x16{};
    const LAS unsigned char* kb[4];
#pragma unroll
    for (int dd = 0; dd < 4; ++dd) kb[dd] = K_lds + KSWZ(r32, (dd * 16 + hi * 8) * 2);
#pragma unroll
    for (int d0 = 0; d0 < 8; ++d0) { const LAS unsigned char* a = kb[d0 & 3] + (d0 >> 2) * 128;
        const bf16x8 b0 = *(const LAS bf16x8*)a;
        const bf16x8 b1 = *(const LAS bf16x8*)(a + 32 * 256);
        p0 = __builtin_amdgcn_mfma_f32_32x32x16_bf16(b0, qr[d0], p0, 0, 0, 0);
        p1 = __builtin_amdgcn_mfma_f32_32x32x16_bf16(b1, qr[d0], p1, 0, 0, 0);
        if (d0 & 1) __builtin_amdgcn_sched_barrier(0); }
}
__device__ __forceinline__ void pv_tile(f32x16 (&o)[4], int vb0, bf16x8 pa0, bf16x8 pa1, bf16x8 pa2, bf16x8 pa3) {
#define TRRD(dst, off) asm volatile("ds_read_b64_tr_b16 %0, %1 offset:%2" : "=&v"(dst) : "v"(vb0), "i"(off) : "memory")
#define PV_D0(d0) do { s16x4 l0, l1, l2, l3, h0, h1, h2, h3; constexpr int b_ = v_rd_off(d0, 0, 0); \
        TRRD(l0, b_); TRRD(h0, b_ + 2048); TRRD(l1, b_ + 4096); TRRD(h1, b_ + 6144); TRRD(l2, b_ + 8192); TRRD(h2, b_ + 10240); TRRD(l3, b_ + 12288); TRRD(h3, b_ + 14336); \
        asm volatile("s_waitcnt lgkmcnt(0)" ::: "memory"); __builtin_amdgcn_sched_barrier(0);   \
        o[d0] = __builtin_amdgcn_mfma_f32_32x32x16_bf16(pa0, (bf16x8){l0[0], l0[1], l0[2], l0[3], h0[0], h0[1], h0[2], h0[3]}, o[d0], 0, 0, 0);   \
        o[d0] = __builtin_amdgcn_mfma_f32_32x32x16_bf16(pa1, (bf16x8){l1[0], l1[1], l1[2], l1[3], h1[0], h1[1], h1[2], h1[3]}, o[d0], 0, 0, 0);   \
        o[d0] = __builtin_amdgcn_mfma_f32_32x32x16_bf16(pa2, (bf16x8){l2[0], l2[1], l2[2], l2[3], h2[0], h2[1], h2[2], h2[3]}, o[d0], 0, 0, 0);   \
        o[d0] = __builtin_amdgcn_mfma_f32_32x32x16_bf16(pa3, (bf16x8){l3[0], l3[1], l3[2], l3[3], h3[0], h3[1], h3[2], h3[3]}, o[d0], 0, 0, 0); } while (0)
    PV_D0(0); PV_D0(1); PV_D0(2); PV_D0(3);
#undef PV_D0
#undef TRRD
}
#define PK4(P, B_, OUT) do { unsigned a0_ = cvtpk(P[B_+0], P[B_+1]), a1_ = cvtpk(P[B_+2], P[B_+3]);                          \
        unsigned b0_ = cvtpk(P[B_+4], P[B_+5]), b1_ = cvtpk(P[B_+6], P[B_+7]);                                             \
        auto r0_ = __builtin_amdgcn_permlane32_swap(a0_, b0_, false, false); auto r1_ = __builtin_amdgcn_permlane32_swap(a1_, b1_, false, false); \
        u32x4 w_ = {r0_[0], r1_[0], r0_[1], r1_[1]}; OUT = __builtin_bit_cast(bf16x8, w_); } while (0)

__device__ __forceinline__ void glds16(const void* gsrc, unsigned lds_dst) { unsigned keep;
    asm volatile("s_mov_b32 %0, m0\n\ts_mov_b32 m0, %2\n\ts_nop 0\n\tglobal_load_lds_dwordx4 %1, off\n\ts_mov_b32 m0, %0" : "=&s"(keep) : "v"(gsrc), "s"(lds_dst) : "memory"); }
enum { AM_MOBA = 0, AM_SEL = 1, AM_WIN = 2, AM_CSTAT = 3, AM_COUT = 4 };
constexpr float ATT_C2 = 1.4426950408889634f * 0.08838834764831845f;
constexpr int ATT_BIG = 1 << 24;
constexpr float ATT_DEFER = 6.0f;

struct AttnIO {
    const bf16_t* Kg; const bf16_t* Vg; int pitch;
    int t_lo, t_hi;
    int q;
    int own;
    unsigned mlo, mhi;
};

template <int MODE, int NB>
__device__ __forceinline__ void attn_pass(ldsp lds, LAS float* wsc, const bf16x8 (&qr)[8], const AttnIO& io, f32x16 (&o)[4], float& m_reg, float& l_reg, float inv_l, LAS float* imp) {
    const int tid = otid(), lane = tid & 63, r32 = lane & 31, hi = lane >> 5;
    ldsp V_lds = lds; ldsp K_lds = lds + NB * SHM_T;
    const int vbase = (int)(unsigned)(uintptr_t)V_lds + v_rd_base(lane);
    constexpr int DEPTH = NB - 1;
    constexpr bool NEEDV = (MODE != AM_CSTAT);
    float carry = 0.f;
    const int wv = __builtin_amdgcn_readfirstlane(tid >> 6);
    size_t ksrc[2], vsrc[2];
#pragma unroll
    for (int i = 0; i < 2; ++i) { const int ch = wv * 2 + i;
        const int kr = ch * 4 + (lane >> 4), kc = (lane & 15) ^ (kr & 7);
        ksrc[i] = (size_t)kr * io.pitch + kc * 8;
        const int sub = ch * 2 + (lane >> 5), kk = (sub >> 2) * 8 + ((lane & 31) >> 2), vk = (kk & ~0xC) | ((kk & 4) << 1) | ((kk & 8) >> 1), vc = (sub & 3) * 32 + (lane & 3) * 8;
        vsrc[i] = (size_t)vk * io.pitch + vc; }
#define A_DMA(T, bf) do { const size_t t0_ = (size_t)((T) * 64) * io.pitch; \
        _Pragma("unroll") for (int i = 0; i < 2; ++i) { \
            glds16((const void*)(io.Kg + t0_ + ksrc[i]), (unsigned)(uintptr_t)(K_lds + (bf) * SHM_T + (wv * 2 + i) * 1024)); \
            if (NEEDV) glds16((const void*)(io.Vg + t0_ + vsrc[i]), (unsigned)(uintptr_t)(V_lds + (bf) * SHM_T + (wv * 2 + i) * 1024)); } } while (0)
#define A_STEP(T) do { \
        const int T_ = (T); const int bsel = (T_ - io.t_lo) & (NB - 1); const int vb0 = vbase + bsel * SHM_T; \
        if (T_ + DEPTH < io.t_hi) A_DMA(T_ + DEPTH, (T_ + DEPTH - io.t_lo) & (NB - 1)); \
        f32x16 p0, p1; qkt(p0, p1, K_lds + bsel * SHM_T, r32, hi, qr); \
        __builtin_amdgcn_sched_barrier(0); \
        int dq; unsigned W = 0x7fffffffu; \
        if (MODE == AM_MOBA) { const int blk = T_ >> 2; dq = (blk == io.own) ? (io.q - T_ * 64) : (((io.mlo >> blk) & 1u) ? ATT_BIG : -1); } \
        else if (MODE == AM_SEL) { const unsigned bit = (T_ < 32) ? ((io.mlo >> T_) & 1u) : ((io.mhi >> (T_ - 32)) & 1u); dq = (T_ == io.own) ? (io.q - T_ * 64) : (bit ? ATT_BIG : -1); } \
        else if (MODE == AM_WIN) { dq = io.q - T_ * 64; W = 512u; } \
        else { dq = io.q - T_ * 64; } \
        dq -= 4 * hi; \
        { const float NEG = -__builtin_inff(); \
          _Pragma("unroll") for (int r = 0; r < 16; ++r) { const int c = (r & 3) + 8 * (r >> 2); \
              if ((unsigned)(dq - c) >= W) p0[r] = NEG; if ((unsigned)(dq - c - 32) >= W) p1[r] = NEG; } } \
        if (MODE == AM_COUT) { \
            const float mL = -m_reg * ATT_C2; \
            _Pragma("unroll") for (int r = 0; r < 16; ++r) { p0[r] = __builtin_amdgcn_exp2f(fmaf(p0[r], ATT_C2, mL)) * inv_l; p1[r] = __builtin_amdgcn_exp2f(fmaf(p1[r], ATT_C2, mL)) * inv_l; } \
              \
            { float prev = carry; \
              _Pragma("unroll") for (int g = 0; g < 8; ++g) { \
                  const float s4 = (g < 4) ? ((p0[4 * (g & 3)] + p0[4 * (g & 3) + 1]) + (p0[4 * (g & 3) + 2] + p0[4 * (g & 3) + 3])) : ((p1[4 * (g & 3)] + p1[4 * (g & 3) + 1]) + (p1[4 * (g & 3) + 2] + p1[4 * (g & 3) + 3])); \
                  const float sp = (g < 4) ? p0[4 * (g & 3) + 3] : p1[4 * (g & 3) + 3]; \
                  const float osp = half_other(sp); \
                  imp[16 * T_ + 2 * g + hi] = s4 + (hi ? osp : prev); prev = osp; } \
              carry = prev; } \
            bf16x8 pa0, pa1, pa2, pa3; PK4(p0, 0, pa0); PK4(p0, 8, pa1); PK4(p1, 0, pa2); PK4(p1, 8, pa3); \
            pv_tile(o, vb0, pa0, pa1, pa2, pa3); \
        } else { \
            float pmax = p0[0]; \
            _Pragma("unroll") for (int r = 1; r < 16; ++r) pmax = fmaxf(pmax, p0[r]); \
            _Pragma("unroll") for (int r = 0; r < 16; ++r) pmax = fmaxf(pmax, p1[r]); \
            pmax = half_max(pmax); \
            const float mn = fmaxf(m_reg, pmax); const float alpha = __builtin_amdgcn_exp2f((m_reg - mn) * ATT_C2); m_reg = mn; \
            const float mL = -mn * ATT_C2; float ps = 0.f; \
            _Pragma("unroll") for (int r = 0; r < 16; ++r) { p0[r] = __builtin_amdgcn_exp2f(fmaf(p0[r], ATT_C2, mL)); p1[r] = __builtin_amdgcn_exp2f(fmaf(p1[r], ATT_C2, mL)); ps += p0[r] + p1[r]; } \
            ps = half_sum(ps); l_reg = l_reg * alpha + ps; \
            if (NEEDV) { \
                if (__any(alpha < 1.0f)) { if (hi == 0) wsc[r32] = alpha; LDS_WAIT(); \
                    _Pragma("unroll") for (int r = 0; r < 16; ++r) { const float al = wsc[crow(r, hi)]; o[0][r] *= al; o[1][r] *= al; o[2][r] *= al; o[3][r] *= al; } } \
                bf16x8 pa0, pa1, pa2, pa3; PK4(p0, 0, pa0); PK4(p0, 8, pa1); PK4(p1, 0, pa2); PK4(p1, 8, pa3); \
                    pv_tile(o, vb0, pa0, pa1, pa2, pa3); } \
        } \
          \
        { const int ahead = io.t_hi - 2 - T_; \
          if (DEPTH >= 3 && ahead >= 2) asm volatile("s_waitcnt vmcnt(%0)" :: "n"(2 * PER) : "memory"); \
          else if (DEPTH >= 2 && ahead >= 1) asm volatile("s_waitcnt vmcnt(%0)" :: "n"(PER) : "memory"); \
          else asm volatile("s_waitcnt vmcnt(0)" ::: "memory"); } \
        asm volatile("s_waitcnt lgkmcnt(0)" ::: "memory"); __builtin_amdgcn_s_barrier(); asm volatile("" ::: "memory"); } while (0)

    constexpr int PER = NEEDV ? 4 : 2;
#pragma unroll
    for (int d0 = 0; d0 < 8; ++d0) asm volatile("" :: "v"(qr[d0]));
    asm volatile("" :: "v"(io.mlo), "v"(io.mhi), "v"(io.q));
#pragma unroll
    for (int d = 0; d < DEPTH; ++d) if (io.t_lo + d < io.t_hi) A_DMA(io.t_lo + d, d);
    {   const int ahead = io.t_hi - 1 - io.t_lo;
        if (DEPTH >= 3 && ahead >= 2) asm volatile("s_waitcnt vmcnt(%0)" :: "n"(2 * PER) : "memory");
        else if (DEPTH >= 2 && ahead >= 1) asm volatile("s_waitcnt vmcnt(%0)" :: "n"(PER) : "memory");
        else asm volatile("s_waitcnt vmcnt(0)" ::: "memory"); }
    asm volatile("s_waitcnt lgkmcnt(0)" ::: "memory"); __builtin_amdgcn_s_barrier(); asm volatile("" ::: "memory");
#pragma unroll 1
    for (int T = io.t_lo; T < io.t_hi; ++T) A_STEP(T);
#undef A_DMA
#undef A_STEP
}

template <int MODE>
__device__ __forceinline__ void attn_pass_pipe(ldsp lds, LAS float* wsc, const bf16x8 (&qr)[8], const AttnIO& io, f32x16 (&o)[4], float& m_reg, float& l_reg) {
    constexpr int NB = 4, PER = 4;
    const int tid = otid(), lane = tid & 63, r32 = lane & 31, hi = lane >> 5;
    ldsp V_lds = lds; ldsp K_lds = lds + NB * SHM_T;
    const int vbase = (int)(unsigned)(uintptr_t)V_lds + v_rd_base(lane);
    const int wv = __builtin_amdgcn_readfirstlane(tid >> 6);
    const int q0 = __builtin_amdgcn_readfirstlane(io.q - r32);
    size_t ksrc[2], vsrc[2];
#pragma unroll
    for (int i = 0; i < 2; ++i) { const int ch = wv * 2 + i;
        const int kr = ch * 4 + (lane >> 4), kc = (lane & 15) ^ (kr & 7);
        ksrc[i] = (size_t)kr * io.pitch + kc * 8;
        const int sub = ch * 2 + (lane >> 5), kk = (sub >> 2) * 8 + ((lane & 31) >> 2), vk = (kk & ~0xC) | ((kk & 4) << 1) | ((kk & 8) >> 1), vc = (sub & 3) * 32 + (lane & 3) * 8;
        vsrc[i] = (size_t)vk * io.pitch + vc; }
#define P_DMA(T, bf) do { const size_t t0_ = (size_t)((T) * 64) * io.pitch; \
        _Pragma("unroll") for (int i = 0; i < 2; ++i) { \
            glds16((const void*)(io.Kg + t0_ + ksrc[i]), (unsigned)(uintptr_t)(K_lds + (bf) * SHM_T + (wv * 2 + i) * 1024)); \
            glds16((const void*)(io.Vg + t0_ + vsrc[i]), (unsigned)(uintptr_t)(V_lds + (bf) * SHM_T + (wv * 2 + i) * 1024)); } } while (0)
#define P_STEP(C0, C1, N0, N1, T) do { \
        const int T_ = (T); const int vb0 = vbase + ((T_ - io.t_lo) & 3) * SHM_T; \
        if (T_ + 3 < io.t_hi) P_DMA(T_ + 3, (T_ + 3 - io.t_lo) & 3); \
        if (T_ + 1 < io.t_hi) qkt(N0, N1, K_lds + ((T_ + 1 - io.t_lo) & 3) * SHM_T, r32, hi, qr); \
        __builtin_amdgcn_sched_barrier(0); \
        bool on = true, edge; int dq = io.q - T_ * 64 - 4 * hi; unsigned W = 0x7fffffffu; \
        if (MODE == AM_MOBA) { const int blk = T_ >> 2; edge = (blk == io.own); on = edge || ((io.mlo >> blk) & 1u); } \
        else if (MODE == AM_SEL) { const unsigned bit = (T_ < 32) ? ((io.mlo >> T_) & 1u) : ((io.mhi >> (T_ - 32)) & 1u); edge = (T_ == io.own); on = edge || bit; } \
        else { W = 512u; edge = !((T_ * 64 + 63 <= q0) && (q0 + 31 - T_ * 64 < 512)); } \
        if (edge) { const float NEG = -__builtin_inff(); \
          _Pragma("unroll") for (int r = 0; r < 16; ++r) { const int c = (r & 3) + 8 * (r >> 2); \
              if ((unsigned)(dq - c) >= W) C0[r] = NEG; if ((unsigned)(dq - c - 32) >= W) C1[r] = NEG; } } \
        float mx[8]; \
        _Pragma("unroll") for (int r = 0; r < 8; ++r) mx[r] = fmaxf(fmaxf(C0[2 * r], C0[2 * r + 1]), fmaxf(C1[2 * r], C1[2 * r + 1])); \
        float pmax = fmaxf(fmaxf(fmaxf(mx[0], mx[1]), fmaxf(mx[2], mx[3])), fmaxf(fmaxf(mx[4], mx[5]), fmaxf(mx[6], mx[7]))); \
        pmax = on ? pmax : -__builtin_inff(); \
        pmax = half_max(pmax); \
        const float mn = fmaxf(m_reg, pmax); const float alpha = __builtin_amdgcn_exp2f((m_reg - mn) * ATT_C2); m_reg = mn; \
        const float mL = on ? -mn * ATT_C2 : -__builtin_inff(); float ps0 = 0.f, ps1 = 0.f; \
        _Pragma("unroll") for (int r = 0; r < 16; ++r) { C0[r] = __builtin_amdgcn_exp2f(fmaf(C0[r], ATT_C2, mL)); C1[r] = __builtin_amdgcn_exp2f(fmaf(C1[r], ATT_C2, mL)); ps0 += C0[r]; ps1 += C1[r]; } \
        const float ps = half_sum(ps0 + ps1); l_reg = l_reg * alpha + ps; \
        if (__any(alpha < 1.0f)) { if (hi == 0) wsc[r32] = alpha; LDS_WAIT(); \
            _Pragma("unroll") for (int r = 0; r < 16; ++r) { const float al = wsc[crow(r, hi)]; o[0][r] *= al; o[1][r] *= al; o[2][r] *= al; o[3][r] *= al; } } \
        { bf16x8 pa0, pa1, pa2, pa3; PK4(C0, 0, pa0); PK4(C0, 8, pa1); PK4(C1, 0, pa2); PK4(C1, 8, pa3); \
          pv_tile(o, vb0, pa0, pa1, pa2, pa3); } \
          \
        if (T_ + 3 < io.t_hi) asm volatile("s_waitcnt vmcnt(%0)" :: "n"(PER) : "memory"); else asm volatile("s_waitcnt vmcnt(0)" ::: "memory"); \
        asm volatile("s_waitcnt lgkmcnt(0)" ::: "memory"); __builtin_amdgcn_s_barrier(); asm volatile("" ::: "memory"); } while (0)

#pragma unroll
    for (int d0 = 0; d0 < 8; ++d0) asm volatile("" :: "v"(qr[d0]));
    asm volatile("" :: "v"(io.mlo), "v"(io.mhi), "v"(io.q));
#pragma unroll
    for (int d = 0; d < 3; ++d) if (io.t_lo + d < io.t_hi) P_DMA(io.t_lo + d, d);
    if (io.t_lo + 2 < io.t_hi) asm volatile("s_waitcnt vmcnt(%0)" :: "n"(PER) : "memory"); else asm volatile("s_waitcnt vmcnt(0)" ::: "memory");
    asm volatile("s_waitcnt lgkmcnt(0)" ::: "memory"); __builtin_amdgcn_s_barrier(); asm volatile("" ::: "memory");
    f32x16 pA0, pA1, pB0, pB1;
    qkt(pA0, pA1, K_lds, r32, hi, qr);
#pragma unroll 1
    for (int T = io.t_lo; T < io.t_hi; T += 2) {
        P_STEP(pA0, pA1, pB0, pB1, T);
        if (T + 1 < io.t_hi) P_STEP(pB0, pB1, pA0, pA1, T + 1);
    }
#undef P_DMA
#undef P_STEP
}

template <int MODE>
__device__ __forceinline__ void attn_pass_pipe2(ldsp lds, LAS float* wsc, const bf16x8 (&qr)[8], const AttnIO& io, f32x16 (&o)[4], float& m_reg, float& l_reg) {
    constexpr int NB = 4;
    const int tid = otid(), lane = tid & 63, r32 = lane & 31, hi = lane >> 5;
    ldsp V_lds = lds; ldsp K_lds = lds + NB * SHM_T;
    const int vbase = (int)(unsigned)(uintptr_t)V_lds + v_rd_base(lane);
    const int wv = __builtin_amdgcn_readfirstlane(tid >> 6);
    const bool lead = wv < 4;
    const int q0 = __builtin_amdgcn_readfirstlane(io.q - r32);
    size_t ksrc[2], vsrc[2];
#pragma unroll
    for (int i = 0; i < 2; ++i) { const int ch = wv * 2 + i;
        const int kr = ch * 4 + (lane >> 4), kc = (lane & 15) ^ (kr & 7);
        ksrc[i] = (size_t)kr * io.pitch + kc * 8;
        const int sub = ch * 2 + (lane >> 5), kk = (sub >> 2) * 8 + ((lane & 31) >> 2), vk = (kk & ~0xC) | ((kk & 4) << 1) | ((kk & 8) >> 1), vc = (sub & 3) * 32 + (lane & 3) * 8;
        vsrc[i] = (size_t)vk * io.pitch + vc; }
#define Q_DMAK(T) do { const size_t t0_ = (size_t)((T) * 64) * io.pitch; const int bf_ = ((T) - io.t_lo) & 3; \
        _Pragma("unroll") for (int i = 0; i < 2; ++i) glds16((const void*)(io.Kg + t0_ + ksrc[i]), (unsigned)(uintptr_t)(K_lds + bf_ * SHM_T + (wv * 2 + i) * 1024)); } while (0)
#define Q_DMAV(T) do { const size_t t0_ = (size_t)((T) * 64) * io.pitch; const int bf_ = ((T) - io.t_lo) & 3; \
        _Pragma("unroll") for (int i = 0; i < 2; ++i) glds16((const void*)(io.Vg + t0_ + vsrc[i]), (unsigned)(uintptr_t)(V_lds + bf_ * SHM_T + (wv * 2 + i) * 1024)); } while (0)
#define Q_QKT(N0, N1, T_) do { if ((T_) + 1 < io.t_hi) qkt(N0, N1, K_lds + (((T_) + 1 - io.t_lo) & 3) * SHM_T, r32, hi, qr); __builtin_amdgcn_sched_barrier(0); } while (0)
#define Q_PV(TT) do { pv_tile(o, vbase + (((TT) - io.t_lo) & 3) * SHM_T, pa0, pa1, pa2, pa3); __builtin_amdgcn_sched_barrier(0); } while (0)
#define Q_SOFTMAX(C0, C1, T_) do { \
        bool on = true, edge; int dq = io.q - (T_) * 64 - 4 * hi; unsigned W = 0x7fffffffu; \
        if (MODE == AM_MOBA) { const int blk = (T_) >> 2; edge = (blk == io.own); on = edge || ((io.mlo >> blk) & 1u); } \
        else if (MODE == AM_SEL) { const unsigned bit = ((T_) < 32) ? ((io.mlo >> (T_)) & 1u) : ((io.mhi >> ((T_) - 32)) & 1u); edge = ((T_) == io.own); on = edge || bit; } \
        else { W = 512u; edge = !(((T_) * 64 + 63 <= q0) && (q0 + 31 - (T_) * 64 < 512)); } \
        if (edge) { const float NEG = -__builtin_inff(); \
          _Pragma("unroll") for (int r = 0; r < 16; ++r) { const int c = (r & 3) + 8 * (r >> 2); \
              if ((unsigned)(dq - c) >= W) C0[r] = NEG; if ((unsigned)(dq - c - 32) >= W) C1[r] = NEG; } } \
        float mx[8]; \
        _Pragma("unroll") for (int r = 0; r < 8; ++r) mx[r] = fmaxf(fmaxf(C0[2 * r], C0[2 * r + 1]), fmaxf(C1[2 * r], C1[2 * r + 1])); \
        float pmax = fmaxf(fmaxf(fmaxf(mx[0], mx[1]), fmaxf(mx[2], mx[3])), fmaxf(fmaxf(mx[4], mx[5]), fmaxf(mx[6], mx[7]))); \
        pmax = on ? pmax : -__builtin_inff(); \
        pmax = half_max(pmax); \
          \
        const bool upd = __any((pmax - m_reg) * ATT_C2 > ATT_DEFER); float alpha = 1.0f; \
        if (upd) { const float mn = fmaxf(m_reg, pmax); alpha = __builtin_amdgcn_exp2f((m_reg - mn) * ATT_C2); m_reg = mn; } \
        const float mL = on ? -m_reg * ATT_C2 : -__builtin_inff(); float ps0 = 0.f, ps1 = 0.f; \
        _Pragma("unroll") for (int r = 0; r < 16; ++r) { C0[r] = __builtin_amdgcn_exp2f(fmaf(C0[r], ATT_C2, mL)); C1[r] = __builtin_amdgcn_exp2f(fmaf(C1[r], ATT_C2, mL)); ps0 += C0[r]; ps1 += C1[r]; } \
        const float ps = half_sum(ps0 + ps1); l_reg = l_reg * alpha + ps; \
        if (upd) { if (hi == 0) wsc[r32] = alpha; LDS_WAIT(); \
            _Pragma("unroll") for (int r = 0; r < 16; ++r) { const float al = wsc[crow(r, hi)]; o[0][r] *= al; o[1][r] *= al; o[2][r] *= al; o[3][r] *= al; } } \
        PK4(C0, 0, pa0); PK4(C0, 8, pa1); PK4(C1, 0, pa2); PK4(C1, 8, pa3); __builtin_amdgcn_sched_barrier(0); } while (0)
#define Q_STEP(C0, C1, N0, N1, T) do { \
        const int T_ = (T); \
        if (T_ + 3 < io.t_hi) Q_DMAK(T_ + 3); \
        if (T_ + 2 < io.t_hi) Q_DMAV(T_ + 2); \
        if (!lead && T_ > io.t_lo) Q_PV(T_ - 1); \
        Q_QKT(N0, N1, T_); Q_SOFTMAX(C0, C1, T_); \
        if (lead) Q_PV(T_); \
          \
        { const int nk = (T_ + 3 < io.t_hi) ? 2 : 0, nv = (T_ + 2 < io.t_hi) ? 2 : 0; \
          if (nk + nv == 4) asm volatile("s_waitcnt vmcnt(4)" ::: "memory"); else if (nk + nv == 2) asm volatile("s_waitcnt vmcnt(2)" ::: "memory"); else asm volatile("s_waitcnt vmcnt(0)" ::: "memory"); } \
        asm volatile("s_waitcnt lgkmcnt(0)" ::: "memory"); __builtin_amdgcn_s_barrier(); asm volatile("" ::: "memory"); } while (0)

#pragma unroll
    for (int d0 = 0; d0 < 8; ++d0) asm volatile("" :: "v"(qr[d0]));
    asm volatile("" :: "v"(io.mlo), "v"(io.mhi), "v"(io.q));
    Q_DMAK(io.t_lo); Q_DMAV(io.t_lo);
    if (io.t_lo + 1 < io.t_hi) { Q_DMAK(io.t_lo + 1); Q_DMAV(io.t_lo + 1); }
    if (io.t_lo + 2 < io.t_hi) Q_DMAK(io.t_lo + 2);
    { const int young = ((io.t_lo + 1 < io.t_hi) ? 2 : 0) + ((io.t_lo + 2 < io.t_hi) ? 2 : 0);
      if (young == 4) asm volatile("s_waitcnt vmcnt(4)" ::: "memory"); else if (young == 2) asm volatile("s_waitcnt vmcnt(2)" ::: "memory"); else asm volatile("s_waitcnt vmcnt(0)" ::: "memory"); }
    asm volatile("s_waitcnt lgkmcnt(0)" ::: "memory"); __builtin_amdgcn_s_barrier(); asm volatile("" ::: "memory");
    f32x16 pA0, pA1, pB0, pB1; bf16x8 pa0, pa1, pa2, pa3;
    pa0 = pa1 = pa2 = pa3 = (bf16x8){0, 0, 0, 0, 0, 0, 0, 0};
    qkt(pA0, pA1, K_lds, r32, hi, qr);
#pragma unroll 1
    for (int T = io.t_lo; T < io.t_hi; T += 2) {
        Q_STEP(pA0, pA1, pB0, pB1, T);
        if (T + 1 < io.t_hi) Q_STEP(pB0, pB1, pA0, pA1, T + 1);
    }
    if (!lead) Q_PV(io.t_hi - 1);
#undef Q_DMAK
#undef Q_DMAV
#undef Q_QKT
#undef Q_PV
#undef Q_SOFTMAX
#undef Q_STEP
}

__device__ __forceinline__ void load_q(bf16x8 (&qr)[8], const bf16_t* qrow, int hi) {
#pragma unroll
    for (int d0 = 0; d0 < 8; ++d0) qr[d0] = *(const bf16x8*)(qrow + d0 * 16 + hi * 8);
}


__device__ __forceinline__ float dpp_xor1(float v) { return __int_as_float(__builtin_amdgcn_mov_dpp(__float_as_int(v), 0xB1, 0xF, 0xF, true)); }
__device__ __forceinline__ void store_o_bf16(const f32x16 (&o)[4], const LAS float* wsc, bf16_t* dst, size_t pitch, int r32, int hi) {
    float sc[16];
#pragma unroll
    for (int r = 0; r < 16; ++r) sc[r] = wsc[crow(r, hi)];
    asm volatile("" : "+v"(sc[0]), "+v"(sc[1]), "+v"(sc[2]), "+v"(sc[3]), "+v"(sc[4]), "+v"(sc[5]), "+v"(sc[6]), "+v"(sc[7]));
    asm volatile("" : "+v"(sc[8]), "+v"(sc[9]), "+v"(sc[10]), "+v"(sc[11]), "+v"(sc[12]), "+v"(sc[13]), "+v"(sc[14]), "+v"(sc[15]));
#pragma unroll
    for (int d0 = 0; d0 < 4; ++d0) { unsigned pk[16];
#pragma unroll
        for (int r = 0; r < 16; ++r) { const float v = o[d0][r] * sc[r]; pk[r] = cvtpk(v, dpp_xor1(v)); }
        if ((r32 & 1) == 0) {
#pragma unroll
            for (int r = 0; r < 16; ++r) *(unsigned*)(dst + (size_t)crow(r, hi) * pitch + d0 * 32 + r32) = pk[r]; }
        __builtin_amdgcn_sched_barrier(0); }
}

constexpr int MB_Q = 0, MB_KM = 69632, MB_GT = 77824, MB_SELM = 131072, MB_WSC = 132096;
__device__ __forceinline__ void moba_gate(ldsp lds, unsigned char* ws, int unit) {
    const int qb = unit & 15, h = (unit >> 4) & 7, b = unit >> 7;
    const bf16_t* proj = (const bf16_t*)(ws + WS_PROJ);
    const int tid = otid();
    LAS float* KM = (LAS float*)(lds + MB_KM);
    LAS float* GT = (LAS float*)(lds + MB_GT);
    LAS unsigned* SELM = (LAS unsigned*)(lds + MB_SELM);
    const size_t row0 = (size_t)b * SEQ + (size_t)qb * 256;
    const float* km = (const float*)(ws + SM_KMEAN) + (size_t)((b * 8 + h) * 16) * 128;
    {   u32x4 qw[8]; float kw[4];
#pragma unroll
        for (int i = 0; i < 8; ++i) { const int c = tid + 512 * i; qw[i] = *(const u32x4*)(proj + (row0 + (c >> 4)) * NP + C_MQ + h * 128 + (c & 15) * 8); }
#pragma unroll
        for (int i = 0; i < 4; ++i) kw[i] = km[tid + 512 * i];
#pragma unroll
        for (int i = 0; i < 8; ++i) { const int c = tid + 512 * i; *(LAS u32x4*)(lds + MB_Q + (c >> 4) * P272 + (c & 15) * 16) = qw[i]; }
#pragma unroll
        for (int i = 0; i < 4; ++i) KM[tid + 512 * i] = kw[i]; }
    __syncthreads();
    const int ql = tid >> 1, n0 = (tid & 1) * 8;
    float acc[8] = {0, 0, 0, 0, 0, 0, 0, 0};
    if (n0 < qb) {
#pragma unroll 2
        for (int i = 0; i < 16; ++i) { float qf[8]; unpack8(*(const LAS u32x4*)(lds + MB_Q + ql * P272 + i * 16), qf); const int d = 8 * i;
#pragma unroll
            for (int n = 0; n < 8; ++n) { const f32x4 k0 = *(const LAS f32x4*)(KM + (n0 + n) * 128 + d), k1 = *(const LAS f32x4*)(KM + (n0 + n) * 128 + d + 4);
                acc[n] += (qf[0] * k0.x + qf[1] * k0.y) + (qf[2] * k0.z + qf[3] * k0.w) + (qf[4] * k1.x + qf[5] * k1.y) + (qf[6] * k1.z + qf[7] * k1.w); } } }
#pragma unroll
    for (int n = 0; n < 8; ++n) GT[ql * 16 + n0 + n] = acc[n];
    __syncthreads();
    if (tid < 256) { unsigned m = 0u;
        if (qb <= 3) m = (1u << qb) - 1u;
        else { float g[16];
#pragma unroll
            for (int n = 0; n < 16; ++n) g[n] = (n < qb) ? GT[tid * 16 + n] : -__builtin_inff();
#pragma unroll
            for (int pick = 0; pick < 3; ++pick) { float best = -__builtin_inff(); int bi = 0;
#pragma unroll
                for (int n = 0; n < 16; ++n) { const bool tk = g[n] > best; best = tk ? g[n] : best; bi = tk ? n : bi; }
                m |= 1u << bi;
#pragma unroll
                for (int n = 0; n < 16; ++n) g[n] = (n == bi) ? -__builtin_inff() : g[n]; } }
        SELM[tid] = m; }
    __syncthreads();
}
__device__ NOINL void moba_unit(ldsp lds, int unit) {
    unsigned char* ws = ows();
    moba_gate(lds, ws, unit);
    f32x16 o[4] = {}; float m_reg = -1e30f, l_reg = 0.f;
    {   const int qb = unit & 15, h = (unit >> 4) & 7, b = unit >> 7;
        const bf16_t* proj = (const bf16_t*)(ws + WS_PROJ);
        const int tid = otid(), lane = tid & 63, wave = __builtin_amdgcn_readfirstlane(tid >> 6), r32 = lane & 31, hi = lane >> 5;
        const size_t row0 = (size_t)b * SEQ + (size_t)qb * 256;
        bf16x8 qr[8]; load_q(qr, proj + (row0 + wave * 32 + r32) * NP + C_MQ + h * 128, hi);
        AttnIO io; io.Kg = proj + (size_t)b * SEQ * NP + C_MK + h * 128; io.Vg = proj + (size_t)b * SEQ * NP + C_MV + h * 128; io.pitch = NP;
        io.t_lo = 0; io.t_hi = 4 * qb + 4; io.q = qb * 256 + wave * 32 + r32; io.own = qb; io.mlo = ((LAS unsigned*)(lds + MB_SELM))[wave * 32 + r32]; io.mhi = 0u;
        attn_pass_pipe2<AM_MOBA>(lds, (LAS float*)(lds + MB_WSC) + wave * 64, qr, io, o, m_reg, l_reg);
    }
    {   int u2 = unit; OPQ_S(u2); const int tz = otid();
        const int qb = u2 & 15, h = (u2 >> 4) & 7, b = u2 >> 7;
        const int lane = tz & 63, wave = __builtin_amdgcn_readfirstlane(tz >> 6), r32 = lane & 31, hi = lane >> 5;
        LAS float* wsc = (LAS float*)(lds + MB_WSC) + wave * 64;
        const size_t row0 = (size_t)b * SEQ + (size_t)qb * 256;
        if (hi == 0) wsc[r32] = 1.0f / l_reg;
        LDS_WAIT();
        store_o_bf16(o, wsc, (bf16_t*)(ws + WS_Y) + (row0 + wave * 32) * DM + 1024 + h * 128, DM, r32, hi);
    }
    __syncthreads();
}

constexpr int NS_IMP = 65536, NS_SELM = 131072, NS_GATE = 131584, NS_WSC = 135680;
struct NsaIdx { int qt, kvh, b, lane, wave, r32, hi, hl, qh, hh, qloc, qpos; size_t row0; };
__device__ __forceinline__ NsaIdx nsa_idx(int unit, int tid) {
    NsaIdx x; x.qt = unit & 63; x.kvh = (unit >> 6) & 1; x.b = unit >> 7; x.lane = tid & 63; x.wave = __builtin_amdgcn_readfirstlane(tid >> 6); x.r32 = x.lane & 31; x.hi = x.lane >> 5;
    x.hl = x.wave >> 1; x.qh = x.wave & 1; x.hh = x.kvh * 4 + x.hl; x.qloc = x.qh * 32 + x.r32; x.qpos = x.qt * 64 + x.qloc; x.row0 = (size_t)x.b * SEQ + (size_t)x.qt * 64; return x;
}
__device__ NOINL void nsa_cmp_branch(ldsp lds, int unit) {
    unsigned char* ws = ows();
    f32x16 o[4]; float m_reg = -1e30f, l_reg = 0.f;
#pragma unroll
    for (int d = 0; d < 4; ++d) o[d] = f32x16{};
    {   const NsaIdx x = nsa_idx(unit, otid());
        const bf16_t* proj = (const bf16_t*)(ws + WS_PROJ);
        LAS float* GATEL = (LAS float*)(lds + NS_GATE);
        if (x.hi == 0) {
#pragma unroll
            for (int br = 0; br < 3; ++br) GATEL[(x.wave * 32 + x.r32) * 4 + br] = sigmoidf_(bf2f(proj[(x.row0 + x.qloc) * NP + C_NGATE + x.hh * 3 + br])); }
        bf16x8 qr[8]; load_q(qr, proj + (x.row0 + x.qloc) * NP + C_NQ + x.hh * 128, x.hi);
        AttnIO io; io.pitch = 128; io.own = 0; io.mlo = 0u; io.mhi = 0u;
        io.Kg = (const bf16_t*)(ws + SM_KC) + (size_t)(x.b * 2 + x.kvh) * 256 * 128; io.Vg = (const bf16_t*)(ws + SM_VC) + (size_t)(x.b * 2 + x.kvh) * 256 * 128;
        io.t_lo = 0; io.t_hi = ((4 * x.qt + 2) >> 6) + 1; io.q = (x.qpos >= 31) ? ((x.qpos - 31) >> 4) : -1;
        LAS float* wsc = (LAS float*)(lds + NS_WSC) + x.wave * 64;
        attn_pass<AM_CSTAT, 2>(lds, wsc, qr, io, o, m_reg, l_reg, 0.f, nullptr);
        const float inv_l = (l_reg > 0.f) ? 1.0f / l_reg : 0.f;
        attn_pass<AM_COUT, 2>(lds, wsc, qr, io, o, m_reg, l_reg, inv_l, (LAS float*)(lds + NS_IMP) + (x.hl * 64 + x.qloc) * 64);
    }
    {   int u2 = unit; OPQ_S(u2); const int tz = otid();
        const NsaIdx x = nsa_idx(u2, tz);
        const LAS float* GATEL = (const LAS float*)(lds + NS_GATE);
        float* accp = (float*)(ws + WS_NSAACC) + (x.row0 + x.qh * 32) * 1024 + x.hh * 128;
        LDS_WAIT();
        float g0[16];
#pragma unroll
        for (int r = 0; r < 16; ++r) g0[r] = GATEL[(x.wave * 32 + crow(r, x.hi)) * 4 + 0];
        asm volatile("" : "+v"(g0[0]), "+v"(g0[1]), "+v"(g0[2]), "+v"(g0[3]), "+v"(g0[4]), "+v"(g0[5]), "+v"(g0[6]), "+v"(g0[7]));
        asm volatile("" : "+v"(g0[8]), "+v"(g0[9]), "+v"(g0[10]), "+v"(g0[11]), "+v"(g0[12]), "+v"(g0[13]), "+v"(g0[14]), "+v"(g0[15]));
#pragma unroll
        for (int r = 0; r < 16; ++r) { const int row = crow(r, x.hi);
#pragma unroll
            for (int d0 = 0; d0 < 4; ++d0) accp[(size_t)row * 1024 + d0 * 32 + x.r32] = g0[r] * o[d0][r]; }
    }
    __syncthreads();
    {   int u2 = unit; OPQ_S(u2); const int tid = otid();
        const int qt = u2 & 63;
        LAS float* IMP = (LAS float*)(lds + NS_IMP); LAS unsigned* SELM = (LAS unsigned*)(lds + NS_SELM);
        const int q = tid >> 3, jg = tid & 7;
        float v[8];
#pragma unroll
        for (int xx = 0; xx < 8; ++xx) { const int j = jg * 8 + xx; v[xx] = (IMP[(0 * 64 + q) * 64 + j] + IMP[(1 * 64 + q) * 64 + j]) + (IMP[(2 * 64 + q) * 64 + j] + IMP[(3 * 64 + q) * 64 + j]);
            if (j > qt) v[xx] = -__builtin_inff();
            if (j == 0 || j == qt || j == qt - 1) v[xx] = __builtin_inff(); }
        __syncthreads();
#pragma unroll
        for (int xx = 0; xx < 8; ++xx) IMP[q * 64 + jg * 8 + xx] = v[xx];
        __syncthreads();
        int rank[8] = {0, 0, 0, 0, 0, 0, 0, 0};
        for (int j2 = 0; j2 < 64; ++j2) { const float w = IMP[q * 64 + j2];
#pragma unroll
            for (int xx = 0; xx < 8; ++xx) { const int j = jg * 8 + xx; rank[xx] += (w > v[xx] || (w == v[xx] && j2 < j)) ? 1 : 0; } }
        unsigned bits = 0u;
#pragma unroll
        for (int xx = 0; xx < 8; ++xx) bits |= (rank[xx] < 16) ? (1u << xx) : 0u;
        unsigned lo = (jg < 4) ? (bits << (8 * jg)) : 0u, hiw = (jg >= 4) ? (bits << (8 * (jg - 4))) : 0u;
        lo |= __shfl_xor(lo, 1); lo |= __shfl_xor(lo, 2); lo |= __shfl_xor(lo, 4);
        hiw |= __shfl_xor(hiw, 1); hiw |= __shfl_xor(hiw, 2); hiw |= __shfl_xor(hiw, 4);
        if (jg == 0) { SELM[q * 2] = lo; SELM[q * 2 + 1] = hiw; }
        __syncthreads();
    }
}
template <int BR>
__device__ NOINL void nsa_attn_branch(ldsp lds, int unit) {
    unsigned char* ws = ows();
    f32x16 o[4]; float m_reg = -1e30f, l_reg = 0.f;
#pragma unroll
    for (int d = 0; d < 4; ++d) o[d] = f32x16{};
    {   const NsaIdx x = nsa_idx(unit, otid());
        const bf16_t* proj = (const bf16_t*)(ws + WS_PROJ);
        bf16x8 qr[8]; load_q(qr, proj + (x.row0 + x.qloc) * NP + C_NQ + x.hh * 128, x.hi);
        AttnIO io; io.pitch = NP; io.q = x.qpos; io.t_hi = x.qt + 1;
        const LAS unsigned* SELM = (const LAS unsigned*)(lds + NS_SELM);
        LAS float* wsc = (LAS float*)(lds + NS_WSC) + x.wave * 64;
        if (BR == 1) { io.Kg = proj + (size_t)x.b * SEQ * NP + C_NKS + x.kvh * 128; io.Vg = proj + (size_t)x.b * SEQ * NP + C_NVS + x.kvh * 128;
            io.t_lo = 0; io.own = x.qt; io.mlo = SELM[x.qloc * 2]; io.mhi = SELM[x.qloc * 2 + 1];
            attn_pass_pipe2<AM_SEL>(lds, wsc, qr, io, o, m_reg, l_reg); }
        else { io.Kg = proj + (size_t)x.b * SEQ * NP + C_NKW + x.kvh * 128; io.Vg = proj + (size_t)x.b * SEQ * NP + C_NVW + x.kvh * 128;
            io.t_lo = (x.qt >= 8) ? x.qt - 8 : 0; io.own = 0; io.mlo = 0u; io.mhi = 0u;
#ifndef PROBE_WINREP
#define PROBE_WINREP 1
#endif
            int nrep = PROBE_WINREP; OPQ_S(nrep);
#pragma unroll 1
            for (int rp = 0; rp < nrep; ++rp) {
#pragma unroll
                for (int d = 0; d < 4; ++d) o[d] = f32x16{};
                m_reg = -1e30f; l_reg = 0.f;
                attn_pass_pipe2<AM_WIN>(lds, wsc, qr, io, o, m_reg, l_reg); } }
    }
    {   int u2 = unit; OPQ_S(u2); const int tz = otid();
        const NsaIdx x = nsa_idx(u2, tz);
        const LAS float* GATEL = (const LAS float*)(lds + NS_GATE);
        LAS float* wsc = (LAS float*)(lds + NS_WSC) + x.wave * 64;
        float* accp = (float*)(ws + WS_NSAACC) + (x.row0 + x.qh * 32) * 1024 + x.hh * 128;
        if (x.hi == 0) wsc[32 + x.r32] = GATEL[(x.wave * 32 + x.r32) * 4 + BR] / l_reg;
        LDS_WAIT();
        if (BR == 1) {
            float pv[4][16];
#pragma unroll
            for (int d0 = 0; d0 < 4; ++d0)
#pragma unroll
                for (int r = 0; r < 16; ++r) pv[d0][r] = accp[(size_t)crow(r, x.hi) * 1024 + d0 * 32 + x.r32];
            asm volatile("" ::: "memory");
#pragma unroll
            for (int d0 = 0; d0 < 4; ++d0)
#pragma unroll
                for (int r = 0; r < 16; ++r) { const int row = crow(r, x.hi); accp[(size_t)row * 1024 + d0 * 32 + x.r32] = pv[d0][r] + wsc[32 + row] * o[d0][r]; } }
        else { bf16_t* yp = (bf16_t*)(ws + WS_Y) + (x.row0 + x.qh * 32) * DM + 3072 + x.hh * 128;
            float sc[16];
#pragma unroll
            for (int r = 0; r < 16; ++r) sc[r] = wsc[32 + crow(r, x.hi)];
            asm volatile("" : "+v"(sc[0]), "+v"(sc[1]), "+v"(sc[2]), "+v"(sc[3]), "+v"(sc[4]), "+v"(sc[5]), "+v"(sc[6]), "+v"(sc[7]));
            asm volatile("" : "+v"(sc[8]), "+v"(sc[9]), "+v"(sc[10]), "+v"(sc[11]), "+v"(sc[12]), "+v"(sc[13]), "+v"(sc[14]), "+v"(sc[15]));
#pragma unroll
            for (int d0 = 0; d0 < 4; ++d0)
#pragma unroll
                for (int r = 0; r < 16; ++r) o[d0][r] *= sc[r];
            float pv[4][16];
#pragma unroll
            for (int d0 = 0; d0 < 4; ++d0)
#pragma unroll
                for (int r = 0; r < 16; ++r) pv[d0][r] = accp[(size_t)crow(r, x.hi) * 1024 + d0 * 32 + x.r32];
            asm volatile("" ::: "memory");
#pragma unroll
            for (int d0 = 0; d0 < 4; ++d0) { unsigned pk[16];
#pragma unroll
                for (int r = 0; r < 16; ++r) { const float v = pv[d0][r] + o[d0][r]; pk[r] = cvtpk(v, dpp_xor1(v)); }
                if ((x.r32 & 1) == 0) {
#pragma unroll
                    for (int r = 0; r < 16; ++r) *(unsigned*)(yp + (size_t)crow(r, x.hi) * DM + d0 * 32 + x.r32) = pk[r]; }
                __builtin_amdgcn_sched_barrier(0); } }
    }
    __syncthreads();
}

__device__ __forceinline__ void s3_phase(ldsp lds, int layer) {
    int G = gridDim.x, bid = blockIdx.x; OPQ_S(G); OPQ_S(bid);
#ifndef S3_MASK
#define S3_MASK 0x3f
#endif
#ifndef S3_DUP
#define S3_DUP 0
#endif
#define S3REP(b) _Pragma("unroll 1") for (int r3_ = 0; r3_ < 1 + ((S3_DUP >> (b)) & 1); ++r3_)
    for (int u = bid; u < 256; u += G) {
        const int x = u & 7, slot = u >> 3, qbm = slot & 15;
        const int mu = (G == 256) ? ((2 * x + (slot >> 4)) * 16 + qbm) : u;
        if (S3_MASK & 1) S3REP(0) moba_unit(lds, mu); }
    for (int u = bid; u < 256; u += G) {
        int nu;
        if (G == 256) { const int x = u & 7, slot = u >> 3, qbm = slot & 15, r = 2 * (x & 1) + (slot >> 4); nu = (x >> 1) * 64 + (63 - 4 * qbm - r); }
        else { const int qbm = u & 15, bh = u >> 4; nu = (bh >> 2) * 64 + (63 - 4 * qbm - (bh & 3)); }
        if (S3_MASK & 2) S3REP(1) nsa_cmp_branch(lds, nu); if (S3_MASK & 4) S3REP(2) nsa_attn_branch<1>(lds, nu); if (S3_MASK & 8) S3REP(3) nsa_attn_branch<2>(lds, nu); }
    if (S3_MASK & 16) S3REP(4) for (int u = bid; u < 512; u += G) ret_out_unit(lds, layer, u);
    if (S3_MASK & 32) S3REP(5) { if (G == 256) lru_out_unit(lds, bid >> 1, (bid & 1) * 2, (bid & 1) * 2 + 2); else for (int u = bid; u < 128; u += G) lru_out_unit(lds, u, 0, 4); }
}

constexpr int N_PHASES = 16;
struct Args { const float* in[23]; float* out; unsigned char* ws; int ph_lo, ph_hi, li, pad; };
template <class Epi>
__device__ NOINL void gemm_call(ldsp lds, const bf16_t* A, const bf16_t* Bt, int N, int K, Epi E) {
    pg8::Gemm g{A, Bt, MTOK, N, K}; pg8::StaticOrder S; S.init(MTOK, N, (int)gridDim.x, (int)blockIdx.x);
    pg8::gemm_phase<Epi, pg8::StaticOrder, true, true>(lds, g, S, E);
}
template <class Epi>
__device__ NOINL void gemm_call_norm(ldsp lds, const bf16_t* A, const bf16_t* Bt, int N, int K, const float* ssq, Epi E, int Gg) {
    pg8::Gemm g{A, Bt, MTOK, N, K}; pg8::StaticOrder S; S.init(MTOK, N, Gg, (int)blockIdx.x);
    pg8::Unit u0; if (!S.next(0, u0)) return;
    E.fm = (u0.pm >> 3) << 3;
    pg8::epi_rstd_table(ssq, E.fm, (LAS float*)E.xl, otid());
    pg8::gemm_phase<Epi, pg8::StaticOrder, false, true>(lds, g, S, E);
}
__global__ void __launch_bounds__(NTHR, 2) trunk_fwd(Args args) {
    extern __shared__ __attribute__((aligned(16))) unsigned char lds_raw[];
    const ldsp lds = (ldsp)lds_raw;
    volatile LAS unsigned* MISC = (volatile LAS unsigned*)(lds + MISC_OFF);
    if (threadIdx.x < 64) MISC[threadIdx.x] = 0u;
    __syncthreads();
    const int lo = args.ph_lo, hi = args.ph_hi;
    unsigned char* ws = args.ws;
    XcdBarrier bar; bar.bar = (unsigned*)(ws + WS_CTL) + CW_BAR + args.li * XCD_BAR_WORDS; bar.x = 0; bar.st = nullptr;
    if (hi - lo > 1) bar = xcd_barrier_post((unsigned*)(ws + WS_CTL) + CW_BAR + args.li * XCD_BAR_WORDS, MISC + 8);
#ifndef PH_MASK
#define PH_MASK 0xfff
#endif
#define IN(k) (lo <= (k) && (k) < hi)
#define ON(b) ((PH_MASK >> (b)) & 1)
#ifndef PROBE_DUP
#define PROBE_DUP 0
#endif
#define REP(b) _Pragma("unroll 1") for (int rep_ = 0; rep_ < 1 + ((PROBE_DUP >> (b)) & 1); ++rep_)
#define SEAM(k) do { if (IN(k) && IN((k) + 1)) xcd_barrier(bar); } while (0)

    if (ON(0) && IN(0)) REP(0) p0_prologue(lds);
    SEAM(0);
    const ldsp xl = lds + 131072;
#pragma unroll
    for (int layer = 0; layer < 2; ++layer) {
        const int pb = 1 + 7 * layer;
        bf16_t* x_in = (bf16_t*)(ws + (layer == 0 ? WS_XS0 : WS_XS2)); bf16_t* x_mid = (bf16_t*)(ws + WS_XS1); bf16_t* x_out = (bf16_t*)(ws + (layer == 0 ? WS_XS2 : WS_XS0));
        float* ssqa = (float*)(ws + SM_SSQA); float* ssqb = (float*)(ws + SM_SSQB);
        if (ON(5) && IN(pb + 0)) {
            const bool split = (SPLIT_INPROJ0 && layer == 0 && gridDim.x == 256);
            if (split && (int)blockIdx.x >= GEMM0_WGS) deferred_phase(lds, GEMM0_WGS, 0, 9);
            else REP(5) gemm_call_norm(lds, x_in, (const bf16_t*)(ws + WS_WIN) + (size_t)layer * NP * DM, NP, DM, ssqa, pg8::EpiBf16N{(bf16_t*)(ws + WS_PROJ), NP, 0, xl}, split ? GEMM0_WGS : (int)gridDim.x);
        }
        SEAM(pb + 0);
        if (ON(3) && IN(pb + 1)) REP(3) s1_phase(lds, layer);
        SEAM(pb + 1);
        if (ON(3) && IN(pb + 2)) { ret_scan_phase(lds); for (int u = (int)gridDim.x - 1 - (int)blockIdx.x; u < 64; u += (int)gridDim.x) nsa_cmp2_unit(lds, layer, u); }
        SEAM(pb + 2);
        if (ON(4) && IN(pb + 3)) REP(4) s3_phase(lds, layer);
        SEAM(pb + 3);
        if (ON(6) && IN(pb + 4)) REP(6) gemm_call(lds, (const bf16_t*)(ws + WS_Y), (const bf16_t*)(ws + WS_WOUT) + (size_t)layer * DM * DM, DM, DM, pg8::EpiResidB{x_in, x_mid, DM, ssqb, xl});
        SEAM(pb + 4);
        if (ON(7) && IN(pb + 5)) {
            const bool split = (SPLIT_GU0 && layer == 0 && gridDim.x == 256);
            if (split && (int)blockIdx.x >= GU0_WGS) deferred_phase(lds, GU0_WGS, 4, 9);
            else REP(7) gemm_call_norm(lds, x_mid, (const bf16_t*)(ws + WS_WGU) + (size_t)layer * NGU * DM, NGU, DM, ssqb, pg8::EpiSwiGLUN{(bf16_t*)(ws + WS_U), DFF, 0, xl}, split ? GU0_WGS : (int)gridDim.x);
        }
        SEAM(pb + 5);
        if (ON(8) && IN(pb + 6)) REP(8) gemm_call(lds, (const bf16_t*)(ws + WS_U), (const bf16_t*)(ws + WS_WDN) + (size_t)layer * DM * DFF, DM, DFF, pg8::EpiResidB{x_mid, x_out, DM, ssqa, xl});
        SEAM(pb + 6);
    }
    if (ON(1) && IN(15)) final_norm_phase(lds, (const bf16_t*)(ws + WS_XS0), (const float*)(ws + SM_SSQA), inp(22), args.out);
#undef IN
#undef SEAM
}

extern "C" void kernel_launch(void* const* d_in, const int* in_sizes, int n_in, void* d_out, int out_size, void* d_ws, size_t ws_size, hipStream_t stream) {
    static int grid = 0;
    if (grid == 0) {
        if (n_in != 23 || in_sizes[0] != MTOK * DM || out_size != MTOK * DM || ws_size < WS_END) {
            fprintf(stderr, "kernel_launch: unexpected shapes (n_in %d, in0 %d, out %d, ws %zu < %zu); nothing launched\n", n_in, n_in > 0 ? in_sizes[0] : -1, out_size, ws_size, (size_t)WS_END); grid = -1; return; }
        int dev = 0, cus = 0, per_cu = 0;
        if (hipGetDevice(&dev) != hipSuccess || hipDeviceGetAttribute(&cus, hipDeviceAttributeMultiprocessorCount, dev) != hipSuccess) { fprintf(stderr, "kernel_launch: device query failed\n"); grid = -1; return; }
        if (hipFuncSetAttribute((const void*)trunk_fwd, hipFuncAttributeMaxDynamicSharedMemorySize, LDS_BYTES) != hipSuccess) { fprintf(stderr, "kernel_launch: hipFuncSetAttribute(%d B LDS) failed\n", LDS_BYTES); grid = -1; return; }
        if (hipOccupancyMaxActiveBlocksPerMultiprocessor(&per_cu, (const void*)trunk_fwd, NTHR, LDS_BYTES) != hipSuccess || per_cu < 1)
            fprintf(stderr, "kernel_launch: note: occupancy query reports %d workgroups per CU\n", per_cu);
        (void)hipGetLastError();
        grid = cus;
    }
    if (grid < 0) return;
    if (hipMemsetAsync((char*)d_ws + WS_CTL, 0, CTL_ZERO_BYTES, stream) != hipSuccess) { fprintf(stderr, "kernel_launch: memset failed\n"); return; }
    Args a{};
    for (int i = 0; i < 23; ++i) a.in[i] = (const float*)d_in[i];
    a.out = (float*)d_out; a.ws = (unsigned char*)d_ws; a.pad = 0;
#if MK_LAUNCHES == 1
    a.ph_lo = 0; a.ph_hi = N_PHASES; a.li = 0;
    hipLaunchKernelGGL(trunk_fwd, dim3(grid), dim3(NTHR), LDS_BYTES, stream, a);
#else
    for (int k = 0; k < N_PHASES; ++k) { a.ph_lo = k; a.ph_hi = k + 1; a.li = k;
        hipLaunchKernelGGL(trunk_fwd, dim3(grid), dim3(NTHR), LDS_BYTES, stream, a); }
#endif
    const hipError_t le = hipPeekAtLastError();
    if (le != hipSuccess) fprintf(stderr, "kernel_launch: launch failed: %s (grid %d)\n", hipGetErrorName(le), grid);
}
```

```cpp
#include <hip/hip_runtime.h>
#include <cstdio>
#include <cstdint>

#ifndef GEMM_MFMA32
#define GEMM_MFMA32 0
#endif
#ifndef MK_LAUNCHES
#define MK_LAUNCHES 1
#endif

#define LAS __attribute__((address_space(3)))
#define GAS __attribute__((address_space(1)))
typedef unsigned short bf16_t;
typedef short bf16x8 __attribute__((ext_vector_type(8)));
typedef short s16x4 __attribute__((ext_vector_type(4)));
typedef float f32x2 __attribute__((ext_vector_type(2)));
typedef float f32x4 __attribute__((ext_vector_type(4)));
typedef float f32x16 __attribute__((ext_vector_type(16)));
typedef unsigned u32x2 __attribute__((ext_vector_type(2)));
typedef unsigned u32x4 __attribute__((ext_vector_type(4)));
typedef LAS unsigned char* ldsp;

namespace pg8 {
#define PG8_LAS __attribute__((address_space(3)))
constexpr int BM = 256, BK = 64, HALF = 128, HTB = HALF * BK * 2  , STAGE_BYTES = 8 * HTB, NXCD = 8, WGM = 8;

__host__ __device__ __forceinline__ int lds_byte(int r, int c) { const int st = (r >> 4) * 2 + (c >> 5), rr = r & 15, cc = c & 31, ob = rr * 64 + cc * 2; return st * 1024 + (ob ^ (((ob >> 9) & 1) << 5)); }
__host__ __device__ __forceinline__ void stage_rc(int b, int& R, int& C) { const int st = b / 1024, sb = b % 1024, swz = sb ^ (((sb >> 9) & 1) << 5); R = (st >> 1) * 16 + swz / 64; C = (st & 1) * 32 + (swz % 64) / 2; }
__host__ __device__ __forceinline__ int perm32(int rho) { const int n = rho >> 4, i = rho & 15; return 8 * (i >> 2) + 4 * n + (i & 3); }

__host__ __device__ __forceinline__ int perm32x(int rho) { return 16 * ((rho >> 2) & 1) + 4 * (rho >> 3) + (rho & 3); }
struct Unit { int pm, pn; };
struct Gemm { const bf16_t* A; const bf16_t* Bt; int M, N, K; };

struct StaticOrder {
    int nM, nN, nwg, G, c;
    __host__ __device__ void init(int M, int N, int G_, int c_) { nM = M / BM; nN = N / BM; nwg = nM * nN; G = G_; c = c_; }
    __host__ __device__ bool next(int i, Unit& u) const {
        const long L = (long)i * G + c; if (L >= nwg) return false;
        int wgid = (int)L; { const int q = nwg / NXCD, r = nwg % NXCD, xcd = wgid % NXCD, off = wgid / NXCD; wgid = (xcd < r ? xcd * (q + 1) : r * (q + 1) + (xcd - r) * q) + off; }
        const int nig = WGM * nN, gid = wgid / nig, fm = gid * WGM, gsz = (nM - fm) < WGM ? (nM - fm) : WGM;
        u.pm = fm + ((wgid % nig) % gsz); u.pn = (wgid % nig) / gsz; return true;
    }
    __device__ __forceinline__ void a_ready(const Unit&) const {}
    __device__ __forceinline__ void done(const Unit&) const {}
};

__device__ __forceinline__ unsigned cvt_pk_bf16(float lo, float hi) { unsigned r; asm volatile("v_cvt_pk_bf16_f32 %0, %1, %2" : "=v"(r) : "v"(lo), "v"(hi)); return r; }

constexpr float EPI_EPS = 1e-6f;
__device__ __forceinline__ void epi_bar() { asm volatile("s_waitcnt lgkmcnt(0)" ::: "memory"); __builtin_amdgcn_s_barrier(); asm volatile("" ::: "memory"); }
__device__ __forceinline__ void epi_rstd_table(const float* ssq, int fm, PG8_LAS float* RS, int t) {
    f32x4 v[4][4];
#pragma unroll
    for (int q = 0; q < 4; ++q) { const f32x4* p = (const f32x4*)(ssq + (size_t)(fm * BM + t + 512 * q) * 16); v[q][0] = p[0]; v[q][1] = p[1]; v[q][2] = p[2]; v[q][3] = p[3]; }
    asm volatile("" :: "v"(v[0][0]), "v"(v[0][1]), "v"(v[0][2]), "v"(v[0][3]), "v"(v[1][0]), "v"(v[1][1]), "v"(v[1][2]), "v"(v[1][3]),
                    "v"(v[2][0]), "v"(v[2][1]), "v"(v[2][2]), "v"(v[2][3]), "v"(v[3][0]), "v"(v[3][1]), "v"(v[3][2]), "v"(v[3][3]) : "memory");
#pragma unroll
    for (int q = 0; q < 4; ++q) { const int r = t + 512 * q; const f32x4 a = v[q][0], b = v[q][1], c = v[q][2], d = v[q][3];
        const float sm = ((a[0] + a[1]) + (a[2] + a[3])) + ((b[0] + b[1]) + (b[2] + b[3])) + ((c[0] + c[1]) + (c[2] + c[3])) + ((d[0] + d[1]) + (d[2] + d[3]));
        RS[r] = 1.0f / sqrtf(sm * (1.0f / 4096.0f) + EPI_EPS); }
    epi_bar();
}
#if GEMM_MFMA32
struct EpiBf16N {
    static constexpr bool PERM = true, AFTER_DRAIN = false;
    bf16_t* O; int ldc; int fm; PG8_LAS unsigned char* xl;
    __device__ __forceinline__ void operator()(const f32x16 (&acc)[2][2][2], const Unit& u, int wr, int wc, int fr, int fq) const {
        const PG8_LAS float* RS = (const PG8_LAS float*)xl + (u.pm - fm) * BM;
        const int row0 = u.pm * BM + wr * 64 + fr, col0 = u.pn * BM + wc * 32 + 16 * fq;
#pragma unroll
        for (int ai = 0; ai < 2; ++ai)
#pragma unroll
            for (int mt = 0; mt < 2; ++mt) { bf16_t* rowp = O + (size_t)(row0 + ai * HALF + mt * 32) * ldc + col0; const float rs = RS[ai * HALF + wr * 64 + mt * 32 + fr];
#pragma unroll
                for (int bj = 0; bj < 2; ++bj) { const f32x16 v = acc[ai][bj][mt] * rs;
                    u32x4 w0, w1; w0.x = cvt_pk_bf16(v[0], v[1]); w0.y = cvt_pk_bf16(v[2], v[3]); w0.z = cvt_pk_bf16(v[4], v[5]); w0.w = cvt_pk_bf16(v[6], v[7]);
                    w1.x = cvt_pk_bf16(v[8], v[9]); w1.y = cvt_pk_bf16(v[10], v[11]); w1.z = cvt_pk_bf16(v[12], v[13]); w1.w = cvt_pk_bf16(v[14], v[15]);
                    *(u32x4*)(rowp + bj * HALF) = w0; *(u32x4*)(rowp + bj * HALF + 8) = w1; } }
    }
};
struct EpiSwiGLUN {
    static constexpr bool PERM = true, AFTER_DRAIN = false;
    bf16_t* O; int ldc; int fm; PG8_LAS unsigned char* xl;
    __device__ __forceinline__ void operator()(const f32x16 (&acc)[2][2][2], const Unit& u, int wr, int wc, int fr, int fq) const {
        const PG8_LAS float* RS = (const PG8_LAS float*)xl + (u.pm - fm) * BM;
        const int row0 = u.pm * BM + wr * 64 + fr, col0 = u.pn * HALF + wc * 32 + 16 * fq;
#pragma unroll
        for (int ai = 0; ai < 2; ++ai)
#pragma unroll
            for (int mt = 0; mt < 2; ++mt) { bf16_t* rowp = O + (size_t)(row0 + ai * HALF + mt * 32) * ldc + col0; const float rs = RS[ai * HALF + wr * 64 + mt * 32 + fr];
                float r[16];
#pragma unroll
                for (int j = 0; j < 16; ++j) { const float g = acc[ai][0][mt][j] * rs, up = acc[ai][1][mt][j] * rs; r[j] = g * __builtin_amdgcn_rcpf(1.0f + __expf(-g)) * up; }
                u32x4 w0, w1; w0.x = cvt_pk_bf16(r[0], r[1]); w0.y = cvt_pk_bf16(r[2], r[3]); w0.z = cvt_pk_bf16(r[4], r[5]); w0.w = cvt_pk_bf16(r[6], r[7]);
                w1.x = cvt_pk_bf16(r[8], r[9]); w1.y = cvt_pk_bf16(r[10], r[11]); w1.z = cvt_pk_bf16(r[12], r[13]); w1.w = cvt_pk_bf16(r[14], r[15]);
                *(u32x4*)rowp = w0; *(u32x4*)(rowp + 8) = w1; }
    }
};
struct EpiResidB {
    static constexpr bool PERM = true, AFTER_DRAIN = false;
    const bf16_t* res; bf16_t* X; int ldc; float* ssq_out; PG8_LAS unsigned char* xl;
    __device__ __forceinline__ void operator()(const f32x16 (&acc)[2][2][2], const Unit& u, int wr, int wc, int fr, int fq) const {
        PG8_LAS float* SSQL = (PG8_LAS float*)(xl + 8192);
        const int row0 = u.pm * BM + wr * 64 + fr, col0 = u.pn * BM + wc * 32 + 16 * fq;
#pragma unroll
        for (int ai = 0; ai < 2; ++ai) { u32x4 rw[2][2][2];
#pragma unroll
            for (int mt = 0; mt < 2; ++mt)
#pragma unroll
                for (int bj = 0; bj < 2; ++bj) { const bf16_t* rp = res + (size_t)(row0 + ai * HALF + mt * 32) * ldc + col0 + bj * HALF; rw[mt][bj][0] = *(const u32x4*)rp; rw[mt][bj][1] = *(const u32x4*)(rp + 8); }
#pragma unroll
            for (int mt = 0; mt < 2; ++mt) { float sq = 0.f;
#pragma unroll
                for (int bj = 0; bj < 2; ++bj) { const f32x16 a = acc[ai][bj][mt]; float v[16];
#pragma unroll
                    for (int h = 0; h < 2; ++h) { const u32x4 rr = rw[mt][bj][h];
                        v[8 * h + 0] = __uint_as_float(rr.x << 16) + a[8 * h + 0]; v[8 * h + 1] = __uint_as_float(rr.x & 0xffff0000u) + a[8 * h + 1];
                        v[8 * h + 2] = __uint_as_float(rr.y << 16) + a[8 * h + 2]; v[8 * h + 3] = __uint_as_float(rr.y & 0xffff0000u) + a[8 * h + 3];
                        v[8 * h + 4] = __uint_as_float(rr.z << 16) + a[8 * h + 4]; v[8 * h + 5] = __uint_as_float(rr.z & 0xffff0000u) + a[8 * h + 5];
                        v[8 * h + 6] = __uint_as_float(rr.w << 16) + a[8 * h + 6]; v[8 * h + 7] = __uint_as_float(rr.w & 0xffff0000u) + a[8 * h + 7]; }
#pragma unroll
                    for (int j = 0; j < 16; j += 4) sq += (v[j] * v[j] + v[j + 1] * v[j + 1]) + (v[j + 2] * v[j + 2] + v[j + 3] * v[j + 3]);
                    u32x4 w0, w1; w0.x = cvt_pk_bf16(v[0], v[1]); w0.y = cvt_pk_bf16(v[2], v[3]); w0.z = cvt_pk_bf16(v[4], v[5]); w0.w = cvt_pk_bf16(v[6], v[7]);
                    w1.x = cvt_pk_bf16(v[8], v[9]); w1.y = cvt_pk_bf16(v[10], v[11]); w1.z = cvt_pk_bf16(v[12], v[13]); w1.w = cvt_pk_bf16(v[14], v[15]);
                    bf16_t* xp = X + (size_t)(row0 + ai * HALF + mt * 32) * ldc + col0 + bj * HALF; *(u32x4*)xp = w0; *(u32x4*)(xp + 8) = w1; }
                sq += __shfl_xor(sq, 32);
                if (fq == 0) SSQL[(ai * HALF + wr * 64 + mt * 32 + fr) * 4 + wc] = sq; } }
        epi_bar();
        const int t = (wr * 4 + wc) * 64 + fq * 32 + fr;
        if (t < 256) { const f32x4 p = *(const PG8_LAS f32x4*)(SSQL + t * 4); ssq_out[(size_t)(u.pm * BM + t) * 16 + u.pn] = (p[0] + p[1]) + (p[2] + p[3]); }
    }
};
#else
struct EpiBf16N {
    static constexpr bool PERM = true, AFTER_DRAIN = false;
    bf16_t* O; int ldc; int fm; PG8_LAS unsigned char* xl;
    __device__ __forceinline__ void operator()(const f32x4 (&acc)[2][2][4][2], const Unit& u, int wr, int wc, int fr, int fq) const {
        const PG8_LAS float* RS = (const PG8_LAS float*)xl + (u.pm - fm) * BM;
        const int row0 = u.pm * BM + wr * 64 + fr, col0 = u.pn * BM + wc * 32 + 8 * fq;
#pragma unroll
        for (int ai = 0; ai < 2; ++ai)
#pragma unroll
            for (int m = 0; m < 4; ++m) { bf16_t* rowp = O + (size_t)(row0 + ai * HALF + m * 16) * ldc + col0; const float rs = RS[ai * HALF + wr * 64 + m * 16 + fr];
#pragma unroll
                for (int bj = 0; bj < 2; ++bj) { const f32x4 v0 = acc[ai][bj][m][0] * rs, v1 = acc[ai][bj][m][1] * rs;
                    u32x4 w; w.x = cvt_pk_bf16(v0[0], v0[1]); w.y = cvt_pk_bf16(v0[2], v0[3]); w.z = cvt_pk_bf16(v1[0], v1[1]); w.w = cvt_pk_bf16(v1[2], v1[3]);
                    *(u32x4*)(rowp + bj * HALF) = w; } }
    }
};
struct EpiSwiGLUN {
    static constexpr bool PERM = true, AFTER_DRAIN = false;
    bf16_t* O; int ldc; int fm; PG8_LAS unsigned char* xl;
    __device__ __forceinline__ void operator()(const f32x4 (&acc)[2][2][4][2], const Unit& u, int wr, int wc, int fr, int fq) const {
        const PG8_LAS float* RS = (const PG8_LAS float*)xl + (u.pm - fm) * BM;
        const int row0 = u.pm * BM + wr * 64 + fr, col0 = u.pn * HALF + wc * 32 + 8 * fq;
#pragma unroll
        for (int ai = 0; ai < 2; ++ai)
#pragma unroll
            for (int m = 0; m < 4; ++m) { bf16_t* rowp = O + (size_t)(row0 + ai * HALF + m * 16) * ldc + col0; const float rs = RS[ai * HALF + wr * 64 + m * 16 + fr];
                float r[8];
#pragma unroll
                for (int n = 0; n < 2; ++n)
#pragma unroll
                    for (int j = 0; j < 4; ++j) { const float g = acc[ai][0][m][n][j] * rs, up = acc[ai][1][m][n][j] * rs;
                        r[n * 4 + j] = g * __builtin_amdgcn_rcpf(1.0f + __expf(-g)) * up; }
                u32x4 w; w.x = cvt_pk_bf16(r[0], r[1]); w.y = cvt_pk_bf16(r[2], r[3]); w.z = cvt_pk_bf16(r[4], r[5]); w.w = cvt_pk_bf16(r[6], r[7]);
                *(u32x4*)rowp = w; }
    }
};
struct EpiResidB {
    static constexpr bool PERM = true, AFTER_DRAIN = false;
    const bf16_t* res; bf16_t* X; int ldc; float* ssq_out; PG8_LAS unsigned char* xl;
    __device__ __forceinline__ void operator()(const f32x4 (&acc)[2][2][4][2], const Unit& u, int wr, int wc, int fr, int fq) const {
        PG8_LAS float* SSQL = (PG8_LAS float*)(xl + 8192);
        const int row0 = u.pm * BM + wr * 64 + fr, col0 = u.pn * BM + wc * 32 + 8 * fq;
#pragma unroll
        for (int ai = 0; ai < 2; ++ai) { u32x4 rw[4][2];
#pragma unroll
            for (int m = 0; m < 4; ++m)
#pragma unroll
                for (int bj = 0; bj < 2; ++bj) rw[m][bj] = *(const u32x4*)(res + (size_t)(row0 + ai * HALF + m * 16) * ldc + col0 + bj * HALF);
#pragma unroll
            for (int m = 0; m < 4; ++m) { float sq = 0.f;
#pragma unroll
                for (int bj = 0; bj < 2; ++bj) { const u32x4 rr = rw[m][bj]; const f32x4 a0 = acc[ai][bj][m][0], a1 = acc[ai][bj][m][1];
                    float v[8];
                    v[0] = __uint_as_float(rr.x << 16) + a0[0]; v[1] = __uint_as_float(rr.x & 0xffff0000u) + a0[1]; v[2] = __uint_as_float(rr.y << 16) + a0[2]; v[3] = __uint_as_float(rr.y & 0xffff0000u) + a0[3];
                    v[4] = __uint_as_float(rr.z << 16) + a1[0]; v[5] = __uint_as_float(rr.z & 0xffff0000u) + a1[1]; v[6] = __uint_as_float(rr.w << 16) + a1[2]; v[7] = __uint_as_float(rr.w & 0xffff0000u) + a1[3];
                    sq += ((v[0] * v[0] + v[1] * v[1]) + (v[2] * v[2] + v[3] * v[3])) + ((v[4] * v[4] + v[5] * v[5]) + (v[6] * v[6] + v[7] * v[7]));
                    u32x4 w; w.x = cvt_pk_bf16(v[0], v[1]); w.y = cvt_pk_bf16(v[2], v[3]); w.z = cvt_pk_bf16(v[4], v[5]); w.w = cvt_pk_bf16(v[6], v[7]);
                    *(u32x4*)(X + (size_t)(row0 + ai * HALF + m * 16) * ldc + col0 + bj * HALF) = w; }
                sq += __shfl_xor(sq, 16); sq += __shfl_xor(sq, 32);
                if (fq == 0) SSQL[(ai * HALF + wr * 64 + m * 16 + fr) * 4 + wc] = sq; } }
        epi_bar();
        const int t = (wr * 4 + wc) * 64 + fq * 16 + fr;
        if (t < 256) { const f32x4 p = *(const PG8_LAS f32x4*)(SSQL + t * 4); ssq_out[(size_t)(u.pm * BM + t) * 16 + u.pn] = (p[0] + p[1]) + (p[2] + p[3]); }
    }
};
#endif
template <class Epi, class Sched, bool ALIGN_EPI = false, bool SP2 = false>
__device__ __forceinline__ void gemm_phase(PG8_LAS unsigned char* lds, const Gemm g, const Sched& S, const Epi& E) {
    int tid_ = threadIdx.x; asm volatile("" : "+v"(tid_));
#if GEMM_MFMA32
    const int tid = tid_, wid = __builtin_amdgcn_readfirstlane(tid >> 6), lane = tid & 63, wr = wid >> 2, wc = wid & 3, fr = lane & 31, fq = lane >> 5;
#else
    const int tid = tid_, wid = __builtin_amdgcn_readfirstlane(tid >> 6), lane = tid & 63, wr = wid >> 2, wc = wid & 3, fr = lane & 15, fq = lane >> 4;
#endif
    const int K = g.K, nt = K / BK;
    unsigned voffA[2], voffB[2];
#pragma unroll
    for (int i = 0; i < 2; ++i) { int R, C; stage_rc(tid * 16 + i * 8192, R, C); const int Rb = Epi::PERM ? ((R & ~31) + (GEMM_MFMA32 ? perm32x(R & 31) : perm32(R & 31))) : R;
        voffA[i] = (unsigned)(R * K + C) * 2u; voffB[i] = (unsigned)(Rb * K + C) * 2u; }
    const size_t kstep = (size_t)(BK * 2);
    const size_t hstep = (size_t)HALF * K * 2;
    const size_t tstep = 2 * hstep;
    const unsigned ldsw = (unsigned)wid * 1024u;
#if GEMM_MFMA32
    const int aE = lds_byte(wr * 64 + fr, fq * 8), aO = lds_byte(wr * 64 + fr, 16 + fq * 8), bE = lds_byte(wc * 32 + fr, fq * 8), bO = lds_byte(wc * 32 + fr, 16 + fq * 8);
#else
    const int aoff = lds_byte(wr * 64 + fr, fq * 8), boff = lds_byte(wc * 32 + fr, fq * 8);
#endif
#define PG8_SA(b, h) (((b) * 2 + (h)) * HTB)
#define PG8_SB(b, h) ((4 + (b) * 2 + (h)) * HTB)
#define PG8_STAGE(bufoff, gbase, voff) do { _Pragma("unroll") for (int _i = 0; _i < 2; ++_i) \
        __builtin_amdgcn_global_load_lds((const unsigned*)((const char*)(gbase) + (voff)[_i]), (PG8_LAS unsigned*)(lds + (bufoff) + ldsw + _i * 8192), 16, 0, 0); } while (0)
#if GEMM_MFMA32
#define PG8_LDA(dst, b, h) do { _Pragma("unroll") for (int m = 0; m < 2; ++m) _Pragma("unroll") for (int k = 0; k < 4; ++k) dst[m][k] = *(const PG8_LAS bf16x8*)(lds + PG8_SA(b, h) + ((k & 1) ? aO : aE) + (k >> 1) * 1024 + m * 4096); } while (0)
#define PG8_LDB(dst, b, h) do { _Pragma("unroll") for (int k = 0; k < 4; ++k) dst[k] = *(const PG8_LAS bf16x8*)(lds + PG8_SB(b, h) + ((k & 1) ? bO : bE) + (k >> 1) * 1024); } while (0)
#define PG8_MMA(ai, bj, At, Bt) do { __builtin_amdgcn_s_setprio(1); _Pragma("unroll") for (int k = 0; k < 4; ++k) _Pragma("unroll") for (int m = 0; m < 2; ++m) \
        acc[ai][bj][m] = __builtin_amdgcn_mfma_f32_32x32x16_bf16(Bt[k], At[m][k], acc[ai][bj][m], 0, 0, 0); __builtin_amdgcn_s_setprio(0); } while (0)
#define PG8_ZERO_ACC() do { _Pragma("unroll") for (int a = 0; a < 2; ++a) _Pragma("unroll") for (int b = 0; b < 2; ++b) _Pragma("unroll") for (int m = 0; m < 2; ++m) acc[a][b][m] = f32x16{}; } while (0)
#define PG8_MMA2(ai, At, Bx, By) do { __builtin_amdgcn_s_setprio(1); _Pragma("unroll") for (int k = 0; k < 4; ++k) _Pragma("unroll") for (int m = 0; m < 2; ++m) { \
        acc[ai][0][m] = __builtin_amdgcn_mfma_f32_32x32x16_bf16(Bx[k], At[m][k], acc[ai][0][m], 0, 0, 0); \
        acc[ai][1][m] = __builtin_amdgcn_mfma_f32_32x32x16_bf16(By[k], At[m][k], acc[ai][1][m], 0, 0, 0); } __builtin_amdgcn_s_setprio(0); } while (0)
#else
#define PG8_MMA2(ai, At, Bx, By) do { PG8_MMA(ai, 0, At, Bx); PG8_MMA(ai, 1, At, By); } while (0)
#define PG8_LDA(dst, b, h) do { _Pragma("unroll") for (int m = 0; m < 4; ++m) _Pragma("unroll") for (int k = 0; k < 2; ++k) dst[m][k] = *(const PG8_LAS bf16x8*)(lds + PG8_SA(b, h) + aoff + m * 2048 + k * 1024); } while (0)
#define PG8_LDB(dst, b, h) do { _Pragma("unroll") for (int n = 0; n < 2; ++n) _Pragma("unroll") for (int k = 0; k < 2; ++k) dst[n][k] = *(const PG8_LAS bf16x8*)(lds + PG8_SB(b, h) + boff + n * 2048 + k * 1024); } while (0)
#define PG8_MMA(ai, bj, At, Bt) do { __builtin_amdgcn_s_setprio(1); _Pragma("unroll") for (int m = 0; m < 4; ++m) _Pragma("unroll") for (int n = 0; n < 2; ++n) _Pragma("unroll") for (int k = 0; k < 2; ++k) \
        acc[ai][bj][m][n] = __builtin_amdgcn_mfma_f32_16x16x32_bf16(Bt[n][k], At[m][k], acc[ai][bj][m][n], 0, 0, 0); __builtin_amdgcn_s_setprio(0); } while (0)
#define PG8_ZERO_ACC() do { _Pragma("unroll") for (int a = 0; a < 2; ++a) _Pragma("unroll") for (int b = 0; b < 2; ++b) _Pragma("unroll") for (int m = 0; m < 4; ++m) _Pragma("unroll") for (int n = 0; n < 2; ++n) acc[a][b][m][n] = (f32x4){0.f, 0.f, 0.f, 0.f}; } while (0)
#endif
#define PG8_WAIT_V(n) asm volatile("s_waitcnt vmcnt(" #n ")" ::: "memory")
#define PG8_WAIT_L(n) asm volatile("s_waitcnt lgkmcnt(" #n ")" ::: "memory")
#define PG8_BAR __builtin_amdgcn_s_barrier()
#define PG8_SCHED __builtin_amdgcn_sched_barrier(0)
    Unit cur, nxt; int ui = 0;
    if (!S.next(0, cur)) return;
#if GEMM_MFMA32
    f32x16 acc[2][2][2]; bf16x8 At[2][4], B0[4], B1[4];
#else
    f32x4 acc[2][2][4][2]; bf16x8 At[4][2], B0[2][2], B1[2][2];
#endif
    PG8_ZERO_ACC();
    const char* cA = (const char*)g.A + (size_t)cur.pm * tstep; const char* cB = (const char*)g.Bt + (size_t)cur.pn * tstep;
    S.a_ready(cur);
    if constexpr (SP2) {
        PG8_STAGE(PG8_SB(0, 0), cB, voffB); PG8_STAGE(PG8_SB(0, 1), cB + hstep, voffB); PG8_STAGE(PG8_SA(0, 0), cA, voffA); PG8_STAGE(PG8_SA(0, 1), cA + hstep, voffA);
        if (wr == 1) PG8_BAR;
        PG8_WAIT_V(2); PG8_BAR;
        PG8_STAGE(PG8_SB(1, 0), cB + kstep, voffB); PG8_STAGE(PG8_SA(1, 0), cA + kstep, voffA); PG8_STAGE(PG8_SB(1, 1), cB + hstep + kstep, voffB);
        PG8_WAIT_V(6); PG8_BAR;
    } else {
        PG8_STAGE(PG8_SB(0, 0), cB, voffB); PG8_STAGE(PG8_SA(0, 0), cA, voffA); PG8_STAGE(PG8_SB(0, 1), cB + hstep, voffB); PG8_STAGE(PG8_SA(0, 1), cA + hstep, voffA);
        if (wr == 1) PG8_BAR;
        PG8_WAIT_V(4); PG8_BAR;
        PG8_STAGE(PG8_SB(1, 0), cB + kstep, voffB); PG8_STAGE(PG8_SA(1, 0), cA + kstep, voffA); PG8_STAGE(PG8_SB(1, 1), cB + hstep + kstep, voffB);
        PG8_WAIT_V(6); PG8_BAR;
    }
    for (;;) {
        const bool has_next = S.next(ui + 1, nxt);
        const char* nA = has_next ? (const char*)g.A + (size_t)nxt.pm * tstep : cA; const char* nB = has_next ? (const char*)g.Bt + (size_t)nxt.pn * tstep : cB;
        for (int t = 0; t < nt; t += 2) {
            const bool last = (t == nt - 2);
            const char* a1 = cA + (size_t)(t + 1) * kstep;
            const char* a2 = last ? nA : cA + (size_t)(t + 2) * kstep; const char* b2 = last ? nB : cB + (size_t)(t + 2) * kstep;
            const char* a3 = a2 + kstep; const char* b3 = b2 + kstep;
            if (last && has_next) S.a_ready(nxt);
            if constexpr (SP2) {
            PG8_LDB(B0, 0, 0); PG8_LDB(B1, 0, 1); PG8_SCHED; PG8_LDA(At, 0, 0); PG8_STAGE(PG8_SA(1, 1), a1 + hstep, voffA);
            PG8_WAIT_V(8); PG8_WAIT_L(0); PG8_BAR; PG8_MMA2(0, At, B0, B1); PG8_BAR; PG8_SCHED;
            PG8_LDA(At, 0, 1); PG8_STAGE(PG8_SB(0, 0), b2, voffB); PG8_STAGE(PG8_SB(0, 1), b2 + hstep, voffB); PG8_STAGE(PG8_SA(0, 0), a2, voffA);
            PG8_WAIT_V(8); PG8_WAIT_L(0); PG8_BAR; PG8_MMA2(1, At, B0, B1); PG8_BAR; PG8_SCHED;
            PG8_LDB(B0, 1, 0); PG8_LDB(B1, 1, 1); PG8_SCHED; PG8_LDA(At, 1, 0); PG8_STAGE(PG8_SA(0, 1), a2 + hstep, voffA);
            PG8_WAIT_V(8); PG8_WAIT_L(0); PG8_BAR; PG8_MMA2(0, At, B0, B1); PG8_BAR; PG8_SCHED;
            PG8_LDA(At, 1, 1); PG8_STAGE(PG8_SB(1, 0), b3, voffB); PG8_STAGE(PG8_SB(1, 1), b3 + hstep, voffB); PG8_STAGE(PG8_SA(1, 0), a3, voffA);
            PG8_WAIT_V(8); PG8_WAIT_L(0); PG8_BAR; PG8_MMA2(1, At, B0, B1); PG8_BAR; PG8_SCHED;
            } else {
            PG8_LDB(B0, 0, 0); PG8_SCHED; PG8_LDA(At, 0, 0); PG8_STAGE(PG8_SA(1, 1), a1 + hstep, voffA);
            PG8_WAIT_L(8); PG8_BAR; PG8_WAIT_L(0); PG8_MMA(0, 0, At, B0); PG8_BAR; PG8_SCHED;
            PG8_LDB(B1, 0, 1); PG8_STAGE(PG8_SB(0, 0), b2, voffB);
            PG8_BAR; PG8_WAIT_L(0); PG8_MMA(0, 1, At, B1); PG8_BAR;
            PG8_LDA(At, 0, 1); PG8_STAGE(PG8_SA(0, 0), a2, voffA);
            PG8_BAR; PG8_WAIT_L(0); PG8_MMA(1, 0, At, B0); PG8_BAR; PG8_SCHED;
            PG8_STAGE(PG8_SB(0, 1), b2 + hstep, voffB);
            PG8_WAIT_V(6); PG8_BAR; PG8_MMA(1, 1, At, B1); PG8_BAR;
            PG8_LDB(B0, 1, 0); PG8_SCHED; PG8_LDA(At, 1, 0); PG8_STAGE(PG8_SA(0, 1), a2 + hstep, voffA);
            PG8_WAIT_L(8); PG8_BAR; PG8_WAIT_L(0); PG8_MMA(0, 0, At, B0); PG8_BAR; PG8_SCHED;
            PG8_LDB(B1, 1, 1); PG8_STAGE(PG8_SB(1, 0), b3, voffB);
            PG8_BAR; PG8_WAIT_L(0); PG8_MMA(0, 1, At, B1); PG8_BAR;
            PG8_LDA(At, 1, 1); PG8_STAGE(PG8_SA(1, 0), a3, voffA);
            PG8_BAR; PG8_WAIT_L(0); PG8_MMA(1, 0, At, B0); PG8_BAR; PG8_SCHED;
            PG8_STAGE(PG8_SB(1, 1), b3 + hstep, voffB);
            PG8_WAIT_V(6); PG8_BAR; PG8_MMA(1, 1, At, B1); PG8_BAR;
            }
        }
        if constexpr (ALIGN_EPI) { if (wr == 0) PG8_BAR; }
        if constexpr (!Epi::AFTER_DRAIN) { E(acc, cur, wr, wc, fr, fq); S.done(cur); }
        if (!has_next) break;
        PG8_ZERO_ACC();
        cur = nxt; cA = nA; cB = nB; ++ui;
        if constexpr (ALIGN_EPI) { if (wr == 1) PG8_BAR; }
    }
    PG8_WAIT_V(0);
    if constexpr (!ALIGN_EPI) { if (wr == 0) PG8_BAR; }
    PG8_BAR;
    if constexpr (Epi::AFTER_DRAIN) { E.fused(acc, cur, wr, wc, fr, fq, lds, wid, lane); S.done(cur); }
#undef PG8_SA
#undef PG8_SB
#undef PG8_STAGE
#undef PG8_LDA
#undef PG8_LDB
#undef PG8_MMA
#undef PG8_MMA2
#undef PG8_ZERO_ACC
#undef PG8_WAIT_V
#undef PG8_WAIT_L
#undef PG8_BAR
#undef PG8_SCHED
}
}

#define XB_TMO      128
#define XB_XCNT(j)  (256  + 64 * (j))
#define XB_XSUB(j)  (1280 + 64 * (j))
#define XB_XGEN(j)  (2304 + 64 * (j))
#define XB_TOP      3328
#define XB_TOPGEN   3392
#define XCD_BAR_WORDS 3456
#define XB_SPIN_CAP (1u << 18)

__device__ __forceinline__ unsigned xb_ld(unsigned* p)              { return __hip_atomic_load(p, __ATOMIC_RELAXED, __HIP_MEMORY_SCOPE_AGENT); }
__device__ __forceinline__ unsigned xb_add(unsigned* p, unsigned v) { return __hip_atomic_fetch_add(p, v, __ATOMIC_RELAXED, __HIP_MEMORY_SCOPE_AGENT); }
__device__ __forceinline__ unsigned xb_xcc_id() { return (unsigned)__builtin_amdgcn_s_getreg((3 << 11) | 20) & 0xFu; }
#define XB_SPIN(cond, bar) do { unsigned _sp = 0; while (cond) { __builtin_amdgcn_s_sleep(1); \
    if ((++_sp & 255u) == 0u) { if (xb_ld(&(bar)[XB_TMO])) break; if (_sp > XB_SPIN_CAP) { atomicAdd(&(bar)[XB_TMO], 1u); break; } } } } while (0)

struct XcdBarrier {
    unsigned* bar; unsigned x;
    volatile LAS unsigned* st;
};

__device__ __forceinline__ XcdBarrier xcd_barrier_post(unsigned* bar, volatile LAS unsigned* st) {
    XcdBarrier b; b.bar = bar; b.x = xb_xcc_id(); b.st = st;
    if (threadIdx.x == 0) (void)xb_add(&bar[XB_XCNT(b.x)], 1u);
    return b;
}
__device__ __forceinline__ void xcd_barrier_complete(unsigned* bar, unsigned x, unsigned& nloc, unsigned& nx) {
    const unsigned G = gridDim.x * gridDim.y * gridDim.z;
    unsigned sum, cnt, mine, sp = 0u;
    for (;;) {
        sum = 0u; cnt = 0u; mine = 0u;
#pragma unroll
        for (unsigned j = 0; j < 16; ++j) { const unsigned c = xb_ld(&bar[XB_XCNT(j)]); sum += c; cnt += (c > 0u) ? 1u : 0u; mine = (j == x) ? c : mine; }
        if (sum == G) break;
        __builtin_amdgcn_s_sleep(1);
        if ((++sp & 255u) == 0u) { if (xb_ld(&bar[XB_TMO])) break; if (sp > XB_SPIN_CAP) { atomicAdd(&bar[XB_TMO], 1u); break; } }
    }
    nloc = mine > 0u ? mine : 1u; nx = cnt > 0u ? cnt : 1u;
}

__device__ __forceinline__ void xcd_barrier(const XcdBarrier& b) {
    asm volatile("s_waitcnt vmcnt(0)" ::: "memory");
    __syncthreads();
    if (threadIdx.x == 0) {
        unsigned* bar = b.bar;
        __builtin_amdgcn_s_waitcnt(0);
        unsigned nloc = b.st[0], nx = b.st[1];
        if (nloc == 0u) { xcd_barrier_complete(bar, b.x, nloc, nx); b.st[0] = nloc; b.st[1] = nx; }
        const unsigned old = xb_add(&bar[XB_XSUB(b.x)], 1u);
        const unsigned gen = old / nloc;
        if (old + 1u == (gen + 1u) * nloc) {
            __builtin_amdgcn_fence(__ATOMIC_RELEASE, "agent");
            asm volatile("s_waitcnt vmcnt(0)" ::: "memory");
            const unsigned og = xb_add(&bar[XB_TOP], 1u);
            const unsigned tg = og / nx;
            if (og + 1u == (tg + 1u) * nx) xb_add(&bar[XB_TOPGEN], 1u);
            else XB_SPIN(xb_ld(&bar[XB_TOPGEN]) == tg, bar);
            __builtin_amdgcn_fence(__ATOMIC_ACQUIRE, "agent");
            xb_add(&bar[XB_XGEN(b.x)], 1u);
            asm volatile("s_waitcnt vmcnt(0)" ::: "memory");
        } else {
            XB_SPIN(xb_ld(&bar[XB_XGEN(b.x)]) == gen, bar);
            __builtin_amdgcn_fence(__ATOMIC_ACQUIRE, "agent");
            asm volatile("s_waitcnt vmcnt(0)" ::: "memory");
        }
    }
    __syncthreads();
}


constexpr int NWAVES = 8, NTHR = 512;
constexpr int SEQ = 4096, DM = 4096, MTOK = 8192, NP = 12032, INW = 11800, DFF = 11008, NGU = 22016;
constexpr int C_RQ = 0, C_RK = 1024, C_RV = 2048, C_RG = 3072, C_MQ = 4096, C_MK = 5120, C_MV = 6144, C_LX = 7168, C_LG = 8192, C_NQ = 9216,
              C_NKC = 10240, C_NVC = 10496, C_NKS = 10752, C_NVS = 11008, C_NKW = 11264, C_NVW = 11520, C_NGATE = 11776;
constexpr float RMS_EPS = 1e-6f;

constexpr size_t MiB = 1u << 20;
constexpr size_t WS_CTL = 0, CTL_ZERO_BYTES = 1 * MiB;
constexpr size_t WS_ROPEC = 1 * MiB, WS_ROPES = 2 * MiB;
constexpr size_t WS_SMALL = 3 * MiB;
constexpr size_t SM_KMEAN = WS_SMALL;
constexpr size_t SM_LRUCA = WS_SMALL + 256 * 1024;
constexpr size_t SM_LRUCH = WS_SMALL + 512 * 1024;
constexpr size_t SM_CB1P  = WS_SMALL + 768 * 1024;
constexpr size_t SM_CW2T  = WS_SMALL + 1024 * 1024;
constexpr size_t SM_WAT   = WS_SMALL + 2 * MiB;
constexpr size_t SM_WXT   = WS_SMALL + 3 * MiB;
constexpr size_t SM_KC    = WS_SMALL + 4 * MiB;
constexpr size_t SM_VC    = WS_SMALL + 5 * MiB;
constexpr size_t SM_SSQA  = WS_SMALL + 6 * MiB;
constexpr size_t SM_SSQB  = WS_SMALL + 7 * MiB;
constexpr size_t WS_CW1T  = 11 * MiB;
constexpr size_t WS_WIN   = 19 * MiB;
constexpr size_t WS_WOUT  = WS_WIN + 188 * MiB;
constexpr size_t WS_WGU   = WS_WOUT + 64 * MiB;
constexpr size_t WS_WDN   = WS_WGU + 344 * MiB;
constexpr size_t WS_H     = WS_WDN + 172 * MiB;
constexpr size_t WS_PROJ  = WS_H + 64 * MiB;
constexpr size_t WS_Y     = WS_PROJ + 188 * MiB;
constexpr size_t WS_XS0   = WS_Y + 64 * MiB;
constexpr size_t WS_XS1   = WS_XS0 + 64 * MiB;
constexpr size_t WS_XS2   = WS_XS1 + 64 * MiB;
constexpr size_t WS_XB    = WS_XS0 + 128 * MiB;
constexpr size_t WS_U     = WS_XB + 128 * MiB;
constexpr size_t WS_RETKV = WS_U + 172 * MiB;
constexpr size_t WS_LRUH  = WS_RETKV + 32 * MiB;
constexpr size_t WS_LRUP  = WS_LRUH + 32 * MiB;
constexpr size_t WS_NSAACC = WS_LRUP + 32 * MiB;
constexpr size_t WS_END   = WS_NSAACC + 32 * MiB;
constexpr int CW_BAR = 4096;

constexpr int PH_BYTES = 147456;
constexpr int MISC_OFF = PH_BYTES;
constexpr int LDS_BYTES = PH_BYTES + 1024;

#define LDS_WAIT() asm volatile("s_waitcnt lgkmcnt(0)" ::: "memory")
#define VM_WAIT() asm volatile("s_waitcnt vmcnt(0)" ::: "memory")
__device__ __forceinline__ float bf2f(unsigned short b) { return __uint_as_float(((unsigned)b) << 16); }
__device__ __forceinline__ float bflo(unsigned w) { return __uint_as_float(w << 16); }
__device__ __forceinline__ float bfhi(unsigned w) { return __uint_as_float(w & 0xffff0000u); }
__device__ __forceinline__ unsigned f2bf(float f) { unsigned u = __float_as_uint(f); return (u + 0x7fffu + ((u >> 16) & 1u)) >> 16; }
__device__ __forceinline__ unsigned pk2(float lo, float hi) { return f2bf(lo) | (f2bf(hi) << 16); }
__device__ __forceinline__ unsigned cvtpk(float lo, float hi) { unsigned r; asm volatile("v_cvt_pk_bf16_f32 %0, %1, %2" : "=v"(r) : "v"(lo), "v"(hi)); return r; }
__device__ __forceinline__ float wave_sum(float v) {
#pragma unroll
    for (int o = 1; o < 64; o <<= 1) v += __shfl_xor(v, o);
    return v;
}
__device__ __forceinline__ float sigmoidf_(float x) { return __builtin_amdgcn_rcpf(1.0f + __expf(-x)); }
__device__ __forceinline__ float gelu_tanh(float x) { const float z = 0.7978845608028654f * (x + 0.044715f * x * x * x); const float e = __expf(2.0f * z); const float t = 1.0f - 2.0f * __builtin_amdgcn_rcpf(e + 1.0f); return 0.5f * x * (1.0f + t); }
__device__ __forceinline__ void unpack8(const u32x4 w, float (&f)[8]) { f[0] = bflo(w.x); f[1] = bfhi(w.x); f[2] = bflo(w.y); f[3] = bfhi(w.y); f[4] = bflo(w.z); f[5] = bfhi(w.z); f[6] = bflo(w.w); f[7] = bfhi(w.w); }

struct Frame {
    ldsp lds;
    int tid, lane, wave, G, bid;
    unsigned char* ws;
};
#define KAS __attribute__((address_space(4)))
#define OPQ_S(x) asm volatile("" : "+s"(x))
#define OPQ_V(x) asm volatile("" : "+v"(x))
__device__ __forceinline__ int otid() { int t = threadIdx.x; OPQ_V(t); return t; }
#define GAS __attribute__((address_space(1)))
__device__ __forceinline__ unsigned char* ows() { unsigned long long w = ((const unsigned long long KAS*)__builtin_amdgcn_kernarg_segment_ptr())[24]; OPQ_S(w);
    return (unsigned char*)(GAS unsigned char*)w; }
__device__ __forceinline__ const float* inp(int i) { return (const float*)(const GAS float*)((const unsigned long long KAS*)__builtin_amdgcn_kernarg_segment_ptr())[i]; }
__device__ __forceinline__ Frame mk_frame(ldsp lds) {
    Frame F; F.lds = lds; F.tid = otid(); F.lane = F.tid & 63; F.wave = __builtin_amdgcn_readfirstlane(F.tid >> 6); F.G = gridDim.x; F.bid = blockIdx.x;
    F.ws = ows(); return F;
}
#ifdef USE_NOINLINE
#define NOINL __attribute__((noinline))
#else
#define NOINL __forceinline__
#endif

__device__ __forceinline__ void tr_load(f32x4 (&v)[16], const float* __restrict__ W, int N, int k0, int n0, int lane) {
    const int rr = lane >> 4, c4 = (lane & 15) * 4; const bool ok = (n0 + c4) < N;
    const float* src = W + (size_t)(k0 + rr) * N + n0 + c4;
#pragma unroll
    for (int i = 0; i < 16; ++i) v[i] = ok ? *(const f32x4*)(src + (size_t)(4 * i) * N) : (f32x4){0.f, 0.f, 0.f, 0.f};
}
__device__ __forceinline__ void tr_emit(const f32x4 (&v)[16], int K, bf16_t* __restrict__ WT, int k0, int drow0, LAS float* scr, int lane, const float* __restrict__ kscale) {
    const int rr = lane >> 4, c4 = (lane & 15) * 4;
#pragma unroll
    for (int i = 0; i < 16; ++i) { const float kq = kscale ? kscale[k0 + rr + 4 * i] : 1.0f;
        LAS float* d = scr + (rr + 4 * i) * 65 + c4; d[0] = v[i].x * kq; d[1] = v[i].y * kq; d[2] = v[i].z * kq; d[3] = v[i].w * kq; }
    LDS_WAIT(); asm volatile("" ::: "memory");
    const int c = lane & 7;
#pragma unroll
    for (int j = 0; j < 8; ++j) { const int nn = (lane >> 3) + 8 * j; const LAS float* s = scr + (8 * c) * 65 + nn;
        u32x4 o; o.x = cvtpk(s[0 * 65], s[1 * 65]); o.y = cvtpk(s[2 * 65], s[3 * 65]); o.z = cvtpk(s[4 * 65], s[5 * 65]); o.w = cvtpk(s[6 * 65], s[7 * 65]);
        *(u32x4*)(WT + (size_t)(drow0 + nn) * K + k0 + 8 * c) = o; }
    LDS_WAIT(); asm volatile("" ::: "memory");
}
struct TrDesc { const float* W; bf16_t* WT; const float* ks; int K, N, nnb, mode; };
__device__ __forceinline__ void tr_matrix_rt(const float* W, int K, int N, int nnb, bf16_t* WT, LAS float* scr, int gw, int NGW, int lane, const float* kscale, int MODE, int it_lo = 0, int it_hi = 0x7fffffff) {
    const int nkb = K / 64, tot = nkb * nnb; const int hi_ = it_hi < tot ? it_hi : tot;
    int it = it_lo + gw; if (it >= hi_) return;
#define TR_GEO(it_) const int kb_ = (it_) / nnb, n0_ = ((it_) - kb_ * nnb) * 64; \
        const int dr_ = (MODE == 0) ? n0_ : ((n0_ >> 7) * 256 + (n0_ & 127) + (MODE == 2 ? 128 : 0))
    f32x4 va[16], vb[16];
    { TR_GEO(it); tr_load(va, W, N, kb_ * 64, n0_, lane); }
    for (;;) {
        if (it + NGW < hi_) { TR_GEO(it + NGW); tr_load(vb, W, N, kb_ * 64, n0_, lane); }
        { TR_GEO(it); tr_emit(va, K, WT, kb_ * 64, dr_, scr, lane, kscale); }
        it += NGW; if (it >= hi_) break;
        if (it + NGW < hi_) { TR_GEO(it + NGW); tr_load(va, W, N, kb_ * 64, n0_, lane); }
        { TR_GEO(it); tr_emit(vb, K, WT, kb_ * 64, dr_, scr, lane, kscale); }
        it += NGW; if (it >= hi_) break;
    }
#undef TR_GEO
}
__device__ __forceinline__ TrDesc deferred_desc(unsigned char* ws, int j) {
    const int l = j >= 4 ? 1 : 0, k = j >= 4 ? j - 4 : j + 1;
    TrDesc d;
    if (k == 0) { d.W = inp(2) + (size_t)l * DM * INW; d.WT = (bf16_t*)(ws + WS_WIN) + (size_t)l * NP * DM; d.ks = inp(1) + (size_t)l * DM; d.K = DM; d.N = INW; d.nnb = NP / 64; d.mode = 0; }
    else if (k == 1) { d.W = inp(3) + (size_t)l * DM * DM; d.WT = (bf16_t*)(ws + WS_WOUT) + (size_t)l * DM * DM; d.ks = nullptr; d.K = DM; d.N = DM; d.nnb = DM / 64; d.mode = 0; }
    else if (k == 2) { d.W = inp(19) + (size_t)l * DM * DFF; d.WT = (bf16_t*)(ws + WS_WGU) + (size_t)l * NGU * DM; d.ks = inp(18) + (size_t)l * DM; d.K = DM; d.N = DFF; d.nnb = DFF / 64; d.mode = 1; }
    else if (k == 3) { d.W = inp(20) + (size_t)l * DM * DFF; d.WT = (bf16_t*)(ws + WS_WGU) + (size_t)l * NGU * DM; d.ks = inp(18) + (size_t)l * DM; d.K = DM; d.N = DFF; d.nnb = DFF / 64; d.mode = 2; }
    else { d.W = inp(21) + (size_t)l * DFF * DM; d.WT = (bf16_t*)(ws + WS_WDN) + (size_t)l * DM * DFF; d.ks = nullptr; d.K = DFF; d.N = DM; d.nnb = DM / 64; d.mode = 0; }
    return d;
}
__device__ __forceinline__ void convert_deferred(unsigned char* ws, LAS float* scr, int w, int NW, int lane, int j_lo = 0, int j_hi = 9) {
#pragma unroll 1
    for (int j = j_lo; j < j_hi; ++j) { const TrDesc d = deferred_desc(ws, j); tr_matrix_rt(d.W, d.K, d.N, d.nnb, d.WT, scr, w, NW, lane, d.ks, d.mode); }
}
constexpr bool SPLIT_GU0 = false;
constexpr int GU0_WGS = 192;
constexpr bool SPLIT_INPROJ0 = false;
constexpr int GEMM0_WGS = 192;
__device__ NOINL void deferred_phase(ldsp lds_, int first_wg, int j_lo, int j_hi) {
    Frame F = mk_frame(lds_);
    LAS float* scr = (LAS float*)(F.lds + F.wave * 16640);
    convert_deferred(F.ws, scr, (F.bid - first_wg) * NWAVES + F.wave, (F.G - first_wg) * NWAVES, F.lane, j_lo, j_hi);
}
__device__ NOINL void p0_prologue(ldsp lds_) {
    Frame F = mk_frame(lds_);
    LAS float* scr = (LAS float*)(F.lds + F.wave * 16640);
    const int gw = F.bid * NWAVES + F.wave, NGW = F.G * NWAVES, lane = F.lane;
    unsigned char* ws = F.ws;
#pragma unroll 1
    for (int j = 0; j < 41; ++j) {
        TrDesc d; int rot = 0;
        if (j == 0) { d.W = inp(2); d.WT = (bf16_t*)(ws + WS_WIN); d.ks = inp(1); d.K = DM; d.N = INW; d.nnb = NP / 64; }
        else if (j <= 4) { const int q = j - 1, l = q >> 1, wh = q & 1;
            d.W = inp(wh ? 16 : 13) + (size_t)l * 4096 * 256; d.WT = (bf16_t*)(ws + WS_CW1T) + (size_t)(l * 2 + wh) * 256 * 4096; d.ks = nullptr; d.K = 4096; d.N = 256; d.nnb = 4; rot = 512 * j; }
        else if (j <= 8) { const int q = j - 5, l = q >> 1, wh = q & 1;
            d.W = inp(wh ? 17 : 14) + (size_t)l * 256 * 128; d.WT = (bf16_t*)(ws + SM_CW2T) + (size_t)(l * 2 + wh) * 128 * 256; d.ks = nullptr; d.K = 256; d.N = 128; d.nnb = 2; rot = 1536 + 16 * j; }
        else { const int q = j - 9, wx = q & 1, lg = q >> 1;
            d.W = inp(wx ? 9 : 7) + (size_t)lg * 128 * 128; d.WT = (bf16_t*)(ws + (wx ? SM_WXT : SM_WAT)) + (size_t)lg * 128 * 128; d.ks = nullptr; d.K = 128; d.N = 128; d.nnb = 2; rot = 1600 + 8 * q; }
        tr_matrix_rt(d.W, d.K, d.N, d.nnb, d.WT, scr, (gw + rot) % NGW, NGW, lane, d.ks, 0);
    }
    if (F.G != 256) convert_deferred(ws, scr, gw, NGW, lane);
    else if (SPLIT_GU0) convert_deferred(ws, scr, gw, NGW, lane, 0, 4);
    else if (!SPLIT_INPROJ0) convert_deferred(ws, scr, gw, NGW, lane);
    {   const float* x = inp(0); bf16_t* xs = (bf16_t*)(ws + WS_XS0); float* ssq = (float*)(ws + SM_SSQA);
        for (int m = gw; m < MTOK; m += NGW) {
            const f32x4* xr = (const f32x4*)(x + (size_t)m * DM) + lane; u32x2* o = (u32x2*)(xs + (size_t)m * DM) + lane;
            f32x4 v[16];
#pragma unroll
            for (int j = 0; j < 16; ++j) v[j] = xr[64 * j];
            float mine = 0.f;
#pragma unroll
            for (int j = 0; j < 16; ++j) { const float sj = wave_sum((v[j].x * v[j].x + v[j].y * v[j].y) + (v[j].z * v[j].z + v[j].w * v[j].w)); mine = (lane == j) ? sj : mine;
                u32x2 pk; pk.x = cvtpk(v[j].x, v[j].y); pk.y = cvtpk(v[j].z, v[j].w); o[64 * j] = pk; }
            if (lane < 16) ssq[(size_t)m * 16 + lane] = mine; } }
    for (int idx = (F.bid * NTHR + F.tid); idx < SEQ * 64; idx += F.G * NTHR) {
        const int t = idx >> 6, i = idx & 63;
        const float inv = powf(10000.0f, -(float)i * (1.0f / 64.0f));
        const float ang = (float)t * inv;
        double rev = (double)ang * 0.15915494309189535; rev -= rint(rev);
        ((float*)(ws + WS_ROPEC))[idx] = __builtin_amdgcn_cosf((float)rev);
        ((float*)(ws + WS_ROPES))[idx] = __builtin_amdgcn_sinf((float)rev);
    }
    for (int it = (gw + 1800) % NGW; it < 2 * 2 * 32; it += NGW) {
        const int s = it & 31, which = (it >> 5) & 1, l = it >> 6;
        const float* pos = inp(which ? 15 : 12) + (size_t)l * 4096 + s * 128;
        const float* w1 = inp(which ? 16 : 13) + (size_t)l * 4096 * 256 + (size_t)s * 128 * 256;
        float a0 = 0.f, a1 = 0.f, a2 = 0.f, a3 = 0.f;
#pragma unroll 1
        for (int k0 = 0; k0 < 128; k0 += 16) { float pp[16], w0[16], w1v[16], w2[16], w3[16];
#pragma unroll
            for (int x = 0; x < 16; ++x) { const float* wr = w1 + (k0 + x) * 256 + lane; pp[x] = pos[k0 + x]; w0[x] = wr[0]; w1v[x] = wr[64]; w2[x] = wr[128]; w3[x] = wr[192]; }
#pragma unroll
            for (int x = 0; x < 16; ++x) { a0 += pp[x] * w0[x]; a1 += pp[x] * w1v[x]; a2 += pp[x] * w2[x]; a3 += pp[x] * w3[x]; } }
        float* o = (float*)(ws + SM_CB1P) + (size_t)it * 256 + lane;
        o[0] = a0; o[64] = a1; o[128] = a2; o[192] = a3;
    }
}

__device__ NOINL void final_norm_phase(ldsp lds_, const bf16_t* __restrict__ xs, const float* __restrict__ ssq, const float* __restrict__ w, float* __restrict__ outp) {
    Frame F = mk_frame(lds_);
    const int gw = F.bid * NWAVES + F.wave, NGW = F.G * NWAVES, lane = F.lane;
    for (int m = gw; m < MTOK; m += NGW) {
        const float part = ssq[(size_t)m * 16 + (lane & 15)];
        const float rstd = 1.0f / sqrtf(wave_sum(part) * (0.25f / DM) + RMS_EPS);
        const u32x2* xr = (const u32x2*)(xs + (size_t)m * DM) + lane; const f32x4* wr = (const f32x4*)w + lane; f32x4* o = (f32x4*)(outp + (size_t)m * DM) + lane;
        u32x2 v[16];
#pragma unroll
        for (int j = 0; j < 16; ++j) v[j] = xr[64 * j];
#pragma unroll
        for (int j = 0; j < 16; ++j) { const f32x4 ww = wr[64 * j]; f32x4 y; y.x = bflo(v[j].x) * rstd * ww.x; y.y = bfhi(v[j].x) * rstd * ww.y; y.z = bflo(v[j].y) * rstd * ww.z; y.w = bfhi(v[j].y) * rstd * ww.w; o[64 * j] = y; }
    }
}

template <int NT, int KSTEPS>
__device__ __forceinline__ void strip_mma(f32x4 (&acc)[NT], const LAS unsigned char* A, int arow0, int apitch, const LAS unsigned char* Bt, int bpitch, int lane) {
    const int fr = lane & 15, fq = lane >> 4;
#pragma unroll
    for (int ks = 0; ks < KSTEPS; ++ks) {
        const bf16x8 a = *(const LAS bf16x8*)(A + (arow0 + fr) * apitch + (ks * 32 + fq * 8) * 2);
#pragma unroll
        for (int nt = 0; nt < NT; ++nt) {
            const bf16x8 b = *(const LAS bf16x8*)(Bt + (nt * 16 + fr) * bpitch + (ks * 32 + fq * 8) * 2);
            acc[nt] = __builtin_amdgcn_mfma_f32_16x16x32_bf16(a, b, acc[nt], 0, 0, 0);
        }
    }
}
constexpr int P272 = 272;

__device__ __forceinline__ float ret_log_gamma(int h) { return log1pf(-exp2f(-5.0f - (float)h)); }

__device__ __forceinline__ void rope8(const u32x4 w1, const u32x4 w2, const float* __restrict__ cs, const float* __restrict__ sn, float (&r1)[8], float (&r2)[8]) {
    float a[8], b[8]; unpack8(w1, a); unpack8(w2, b);
    const f32x4 c0 = *(const f32x4*)cs, c1 = *(const f32x4*)(cs + 4), s0 = *(const f32x4*)sn, s1 = *(const f32x4*)(sn + 4);
    const float c[8] = {c0.x, c0.y, c0.z, c0.w, c1.x, c1.y, c1.z, c1.w}, s[8] = {s0.x, s0.y, s0.z, s0.w, s1.x, s1.y, s1.z, s1.w};
#pragma unroll
    for (int x = 0; x < 8; ++x) { r1[x] = a[x] * c[x] - b[x] * s[x]; r2[x] = a[x] * s[x] + b[x] * c[x]; }
}

__device__ NOINL void ret_kv_unit(ldsp lds_, int unit) {
    Frame F = mk_frame(lds_);
    const int h = unit & 7, n = (unit >> 3) & 31, b = unit >> 8;
    const bf16_t* proj = (const bf16_t*)(F.ws + WS_PROJ);
    const float* ropec = (const float*)(F.ws + WS_ROPEC); const float* ropes = (const float*)(F.ws + WS_ROPES);
    ldsp vT = F.lds, kT = F.lds + 128 * P272;
    const int tid = F.tid, lane = F.lane, wave = F.wave;
    const size_t row0 = (size_t)b * SEQ + (size_t)n * 128;
    const float lg = ret_log_gamma(h);
    const int c0v = (tid & 15) * 8, c0k = (tid & 7) * 8;
    u32x4 vw[4], kw[2][2]; f32x4 tc[2][2], ts[2][2];
#pragma unroll
    for (int ps = 0; ps < 4; ++ps) { const int j = (tid >> 4) + 32 * ps; vw[ps] = *(const u32x4*)(proj + (row0 + j) * NP + C_RV + h * 128 + c0v); }
#pragma unroll
    for (int ps = 0; ps < 2; ++ps) { const int j = (tid >> 3) + 64 * ps; const int t = n * 128 + j;
        const bf16_t* kr = proj + (row0 + j) * NP + C_RK + h * 128 + c0k;
        kw[ps][0] = *(const u32x4*)kr; kw[ps][1] = *(const u32x4*)(kr + 64);
        tc[ps][0] = *(const f32x4*)(ropec + t * 64 + c0k); tc[ps][1] = *(const f32x4*)(ropec + t * 64 + c0k + 4); ts[ps][0] = *(const f32x4*)(ropes + t * 64 + c0k); ts[ps][1] = *(const f32x4*)(ropes + t * 64 + c0k + 4); }
    asm volatile("" :: "v"(vw[0]), "v"(vw[1]), "v"(vw[2]), "v"(vw[3]), "v"(kw[0][0]), "v"(kw[0][1]), "v"(kw[1][0]), "v"(kw[1][1]),
                    "v"(tc[0][0]), "v"(tc[0][1]), "v"(tc[1][0]), "v"(tc[1][1]), "v"(ts[0][0]), "v"(ts[0][1]), "v"(ts[1][0]), "v"(ts[1][1]) : "memory");
    asm volatile("" : "+v"(vw[0]), "+v"(vw[1]), "+v"(vw[2]), "+v"(vw[3]), "+v"(kw[0][0]), "+v"(kw[0][1]), "+v"(kw[1][0]), "+v"(kw[1][1]));
    asm volatile("" : "+v"(tc[0][0]), "+v"(tc[0][1]), "+v"(tc[1][0]), "+v"(tc[1][1]), "+v"(ts[0][0]), "+v"(ts[0][1]), "+v"(ts[1][0]), "+v"(ts[1][1]));
#pragma unroll
    for (int ps = 0; ps < 4; ++ps) { const int j = (tid >> 4) + 32 * ps; const int c0 = c0v;
        const unsigned ww[4] = {vw[ps].x, vw[ps].y, vw[ps].z, vw[ps].w};
#pragma unroll
        for (int x = 0; x < 8; ++x) *(LAS unsigned short*)(vT + (c0 + x) * P272 + j * 2) = (unsigned short)((x & 1) ? (ww[x >> 1] >> 16) : (ww[x >> 1] & 0xffffu)); }
#pragma unroll
    for (int ps = 0; ps < 2; ++ps) { const int j = (tid >> 3) + 64 * ps; const int c0 = c0k;
        const float cc[8] = {tc[ps][0].x, tc[ps][0].y, tc[ps][0].z, tc[ps][0].w, tc[ps][1].x, tc[ps][1].y, tc[ps][1].z, tc[ps][1].w}, sn[8] = {ts[ps][0].x, ts[ps][0].y, ts[ps][0].z, ts[ps][0].w, ts[ps][1].x, ts[ps][1].y, ts[ps][1].z, ts[ps][1].w};
        float a[8], bb[8], r1[8], r2[8]; unpack8(kw[ps][0], a); unpack8(kw[ps][1], bb);
#pragma unroll
        for (int x = 0; x < 8; ++x) { r1[x] = a[x] * cc[x] - bb[x] * sn[x]; r2[x] = a[x] * sn[x] + bb[x] * cc[x]; }
        const float sc = 0.08838834764831845f * __expf(lg * (float)(127 - j));
#pragma unroll
        for (int x = 0; x < 8; ++x) { *(LAS unsigned short*)(kT + (c0 + x) * P272 + j * 2) = (unsigned short)f2bf(r1[x] * sc);
                                      *(LAS unsigned short*)(kT + (c0 + 64 + x) * P272 + j * 2) = (unsigned short)f2bf(r2[x] * sc); } }
    __syncthreads();
    f32x4 acc[8];
#pragma unroll
    for (int i = 0; i < 8; ++i) acc[i] = (f32x4){0.f, 0.f, 0.f, 0.f};
    strip_mma<8, 4>(acc, vT, wave * 16, P272, kT, P272, lane);
    float* kv = (float*)(F.ws + WS_RETKV) + (size_t)unit * 16384;
    const int fr = lane & 15, fq = lane >> 4;
#pragma unroll
    for (int nt = 0; nt < 8; ++nt)
#pragma unroll
        for (int j = 0; j < 4; ++j) kv[(wave * 16 + 4 * fq + j) * 128 + nt * 16 + fr] = acc[nt][j];
    __syncthreads();
}

__device__ NOINL void moba_kmean_unit(ldsp lds_, int unit) {
    Frame F = mk_frame(lds_);
    const int blk = unit & 15, h = (unit >> 4) & 7, b = unit >> 7;
    const bf16_t* proj = (const bf16_t*)(F.ws + WS_PROJ);
    LAS float* part = (LAS float*)F.lds;
    const int tid = F.tid, d0 = (tid & 15) * 8, p = tid >> 4;
    float s[8] = {0, 0, 0, 0, 0, 0, 0, 0};
#pragma unroll
    for (int kk = 0; kk < 8; ++kk) { const size_t row = (size_t)b * SEQ + blk * 256 + p * 8 + kk;
        float f[8]; unpack8(*(const u32x4*)(proj + row * NP + C_MK + h * 128 + d0), f);
#pragma unroll
        for (int x = 0; x < 8; ++x) s[x] += f[x]; }
#pragma unroll
    for (int x = 0; x < 8; ++x) part[p * 128 + d0 + x] = s[x];
    __syncthreads();
    if (tid < 128) { float a = 0.f;
#pragma unroll 8
        for (int q = 0; q < 32; ++q) a += part[q * 128 + tid];
        ((float*)(F.ws + SM_KMEAN))[(size_t)unit * 128 + tid] = a * (1.0f / 256.0f); }
    __syncthreads();
}

constexpr int CP2 = 528;
constexpr int CMP_B = 64 * CP2, CMP_STG2 = CMP_B + 32 * CP2;
__device__ NOINL void nsa_cmp1_unit(ldsp lds_, int layer, int unit) {
    Frame F = mk_frame(lds_);
    const int nq = unit & 3, rg = (unit >> 2) & 7, kvh = (unit >> 5) & 1, b = (unit >> 6) & 1, which = unit >> 7;
    const bf16_t* proj = (const bf16_t*)(F.ws + WS_PROJ);
    const bf16_t* w1t = (const bf16_t*)(F.ws + WS_CW1T) + (size_t)(layer * 2 + which) * 256 * 4096 + (size_t)(nq * 64) * 4096;
    const float* cb1p = (const float*)(F.ws + SM_CB1P) + (size_t)(layer * 2 + which) * 32 * 256 + nq * 64;
    ldsp stg = F.lds;
    LAS float* biasL = (LAS float*)(F.lds + 2 * CMP_STG2);
    const int tid = F.tid, lane = F.lane, wave = F.wave;
    if (tid < 64) { float a = 0.f; float bv[32];
#pragma unroll
        for (int s = 0; s < 32; ++s) bv[s] = cb1p[s * 256 + tid];
#pragma unroll
        for (int s = 0; s < 32; ++s) a += bv[s];
        biasL[tid] = a; }
    const int kc = (tid & 31) * 8, r0 = tid >> 5;
    const bf16_t* bsrc = w1t + (size_t)r0 * 4096 + kc;
    const bf16_t* asrc[2];
#pragma unroll
    for (int i = 0; i < 2; ++i) { int ncr = rg * 32 + r0 + 16 * i; ncr = ncr > 254 ? 254 : ncr;
        asrc[i] = proj + ((size_t)b * SEQ + 16 * ncr + (kc >> 7)) * NP + (which ? C_NVC : C_NKC) + kvh * 128 + (kc & 127); }
    const int dstb = r0 * CP2 + kc * 2;
    bf16x8 sbA[4], saA[2], sbB[4], saB[2];
#define C_LOAD(SB, SA, s_) do { _Pragma("unroll") for (int i = 0; i < 4; ++i) SB[i] = *(const bf16x8*)(bsrc + (size_t)i * 16 * 4096 + (s_) * 256); \
        _Pragma("unroll") for (int i = 0; i < 2; ++i) SA[i] = *(const bf16x8*)(asrc[i] + (size_t)(2 * (s_)) * NP); } while (0)
#define C_WRITE(SB, SA, bf) do { ldsp d_ = stg + (bf) * CMP_STG2; _Pragma("unroll") for (int i = 0; i < 4; ++i) *(LAS bf16x8*)(d_ + dstb + i * 16 * CP2) = SB[i]; \
        _Pragma("unroll") for (int i = 0; i < 2; ++i) *(LAS bf16x8*)(d_ + CMP_B + dstb + i * 16 * CP2) = SA[i]; } while (0)
#define C_MMA(bf) do { ldsp cur = stg + (bf) * CMP_STG2; strip_mma<1, 8>(acc, cur + CMP_B, (wave >> 2) * 16, CP2, cur + ((wave & 3) * 16) * CP2, CP2, lane); } while (0)
    f32x4 acc[1] = {(f32x4){0.f, 0.f, 0.f, 0.f}};
    C_LOAD(sbA, saA, 0); C_LOAD(sbB, saB, 1);
    C_WRITE(sbA, saA, 0); __syncthreads();
#pragma unroll 1
    for (int s = 0; s < 16; s += 2) {
        if (s + 2 < 16) C_LOAD(sbA, saA, s + 2);
        C_MMA(0);
        C_WRITE(sbB, saB, 1); __syncthreads();
        if (s + 3 < 16) C_LOAD(sbB, saB, s + 3);
        C_MMA(1);
        if (s + 2 < 16) C_WRITE(sbA, saA, 0);
        __syncthreads();
    }
#undef C_LOAD
#undef C_WRITE
#undef C_MMA
    const int fr = lane & 15, fq = lane >> 4;
    bf16_t* hidg = (bf16_t*)(F.ws + WS_H) + (size_t)(((which * 2 + b) * 2 + kvh) * 256 + rg * 32) * 256 + nq * 64;
    {   const int col = (wave & 3) * 16 + fr; const float bv = biasL[col];
#pragma unroll
        for (int j = 0; j < 4; ++j) { const int row = (wave >> 2) * 16 + 4 * fq + j; hidg[(size_t)row * 256 + col] = (bf16_t)f2bf(gelu_tanh(acc[0][j] + bv)); } }
    __syncthreads();
}
__device__ NOINL void nsa_cmp2_unit(ldsp lds_, int layer, int unit) {
    Frame F = mk_frame(lds_);
    const int rg = unit & 7, kvh = (unit >> 3) & 1, b = (unit >> 4) & 1, which = unit >> 5;
    const bf16_t* w2t = (const bf16_t*)(F.ws + SM_CW2T) + (size_t)(layer * 2 + which) * 128 * 256;
    const bf16_t* hidg = (const bf16_t*)(F.ws + WS_H) + (size_t)(((which * 2 + b) * 2 + kvh) * 256 + rg * 32) * 256;
    ldsp hid = F.lds;
    const int tid = F.tid, lane = F.lane, wave = F.wave, fr = lane & 15, fq = lane >> 4;
    bf16x8 bw[8];
    {   u32x4 hw[2];
#pragma unroll
        for (int i = 0; i < 2; ++i) { const int c = tid + 512 * i; hw[i] = *(const u32x4*)(hidg + (size_t)(c >> 5) * 256 + (c & 31) * 8); }
#pragma unroll
        for (int ks = 0; ks < 8; ++ks) bw[ks] = *(const bf16x8*)(w2t + (size_t)(wave * 16 + fr) * 256 + ks * 32 + fq * 8);
        __builtin_amdgcn_sched_barrier(0);
        asm volatile("" : "+v"(hw[0]), "+v"(hw[1]), "+v"(bw[0]), "+v"(bw[1]), "+v"(bw[2]), "+v"(bw[3]), "+v"(bw[4]), "+v"(bw[5]), "+v"(bw[6]), "+v"(bw[7]));
#pragma unroll
        for (int i = 0; i < 2; ++i) { const int c = tid + 512 * i; *(LAS u32x4*)(hid + (c >> 5) * 528 + (c & 31) * 16) = hw[i]; } }
    __syncthreads();
    f32x4 a2[2] = {(f32x4){0.f, 0.f, 0.f, 0.f}, (f32x4){0.f, 0.f, 0.f, 0.f}};
#pragma unroll
    for (int ks = 0; ks < 8; ++ks) {
        const bf16x8 bb = bw[ks];
#pragma unroll
        for (int s = 0; s < 2; ++s) { const bf16x8 a = *(const LAS bf16x8*)(hid + (s * 16 + fr) * 528 + (ks * 32 + fq * 8) * 2);
            a2[s] = __builtin_amdgcn_mfma_f32_16x16x32_bf16(a, bb, a2[s], 0, 0, 0); }
    }
    bf16_t* outp = (bf16_t*)(F.ws + (which ? SM_VC : SM_KC)) + (size_t)((b * 2 + kvh) * 256 + rg * 32) * 128;
#pragma unroll
    for (int s = 0; s < 2; ++s)
#pragma unroll
        for (int j = 0; j < 4; ++j) { const int row = s * 16 + 4 * fq + j; const bool valid = (rg * 32 + row) < 255;
            outp[row * 128 + wave * 16 + fr] = valid ? (bf16_t)f2bf(a2[s][j]) : (bf16_t)0; }
    __syncthreads();
}

__device__ NOINL void lru_local_unit(ldsp lds_, int layer, int unit) {
    Frame F = mk_frame(lds_);
    const int g = unit & 7, tc = (unit >> 3) & 31, b = unit >> 8;
    const bf16_t* proj = (const bf16_t*)(F.ws + WS_PROJ);
    const float* convw = inp(5) + (size_t)layer * 4 * 1024 + g * 128;
    const float* convb = inp(6) + (size_t)layer * 1024 + g * 128;
    const float* ba = inp(8) + (size_t)layer * 1024 + g * 128;
    const float* bx = inp(10) + (size_t)layer * 1024 + g * 128;
    const float* lam = inp(11) + (size_t)layer * 1024 + g * 128;
    const bf16_t* wat = (const bf16_t*)(F.ws + SM_WAT) + (size_t)(layer * 8 + g) * 16384;
    const bf16_t* wxt = (const bf16_t*)(F.ws + SM_WXT) + (size_t)(layer * 8 + g) * 16384;
    ldsp LX = F.lds;
    ldsp XCB = F.lds + 132 * P272;
    ldsp WA = XCB + 128 * P272, WX = WA + 128 * P272;
    LAS float* AL = (LAS float*)F.lds;
    LAS float* UL = (LAS float*)(F.lds + 65536);
    LAS float* PRM = (LAS float*)(F.lds + 140352);
    const int tid = F.tid, lane = F.lane, wave = F.wave;
    const int t0 = tc * 128;
    {   float pv[2]; u32x4 lxw[5], waw[4], wxw[4];
#pragma unroll
        for (int q = 0; q < 2; ++q) { const int i = tid + 512 * q, k = i >> 7, c = i & 127;
            const float* src = (k < 4) ? (convw + k * 1024) : (k == 4) ? convb : (k == 5) ? ba : (k == 6) ? bx : lam;
            pv[q] = src[c]; }
#pragma unroll
        for (int q = 0; q < 5; ++q) { const int i = tid + 512 * q, r = i >> 4, c0 = (i & 15) * 8; const int t = t0 - 3 + r;
            lxw[q] = (u32x4){0u, 0u, 0u, 0u}; if (i < 131 * 16 && t >= 0) lxw[q] = *(const u32x4*)(proj + ((size_t)b * SEQ + t) * NP + C_LX + g * 128 + c0); }
#pragma unroll
        for (int q = 0; q < 4; ++q) { const int i = tid + 512 * q; waw[q] = *(const u32x4*)(wat + i * 8); wxw[q] = *(const u32x4*)(wxt + i * 8); }
#pragma unroll
        for (int q = 0; q < 2; ++q) { const int i = tid + 512 * q; PRM[i] = (i >= 896) ? log1pf(__expf(-pv[q])) : pv[q]; }
#pragma unroll
        for (int q = 0; q < 5; ++q) { const int i = tid + 512 * q, r = i >> 4, c0 = (i & 15) * 8; if (i < 132 * 16) *(LAS u32x4*)(LX + r * P272 + c0 * 2) = lxw[q]; }
#pragma unroll
        for (int q = 0; q < 4; ++q) { const int i = tid + 512 * q, r = i >> 4, c0 = (i & 15) * 8;
            *(LAS u32x4*)(WA + r * P272 + c0 * 2) = waw[q]; *(LAS u32x4*)(WX + r * P272 + c0 * 2) = wxw[q]; }
    }
    __syncthreads();
    {   const int t = tid >> 2, cb0 = (tid & 3) * 32;
#pragma unroll 4
        for (int c = cb0; c < cb0 + 32; c += 2) { float y0 = PRM[512 + c], y1 = PRM[512 + c + 1];
#pragma unroll
            for (int tap = 0; tap < 4; ++tap) { const unsigned w = *(const LAS unsigned*)(LX + (t + tap) * P272 + c * 2);
                y0 += bflo(w) * PRM[tap * 128 + c]; y1 += bfhi(w) * PRM[tap * 128 + c + 1]; }
            *(LAS unsigned*)(XCB + t * P272 + c * 2) = pk2(y0, y1); } }
    __syncthreads();
    f32x4 accR[8], accI[8];
#pragma unroll
    for (int i = 0; i < 8; ++i) { accR[i] = (f32x4){0.f, 0.f, 0.f, 0.f}; accI[i] = (f32x4){0.f, 0.f, 0.f, 0.f}; }
    strip_mma<8, 4>(accR, XCB, wave * 16, P272, WA, P272, lane);
    strip_mma<8, 4>(accI, XCB, wave * 16, P272, WX, P272, lane);
    const int fr = lane & 15, fq = lane >> 4;
    float av[8][4], uv[8][4];
#pragma unroll
    for (int nt = 0; nt < 8; ++nt) { const int c = nt * 16 + fr;
        const float cw0 = PRM[c], cw1 = PRM[128 + c], cw2 = PRM[256 + c], cw3 = PRM[384 + c], cb = PRM[512 + c];
        const float bav = PRM[640 + c], bxv = PRM[768 + c], spl = PRM[896 + c];
#pragma unroll
        for (int j = 0; j < 4; ++j) { const int t = wave * 16 + 4 * fq + j;
            const float xc = cb + bf2f(*(const LAS unsigned short*)(LX + (t + 0) * P272 + c * 2)) * cw0 + bf2f(*(const LAS unsigned short*)(LX + (t + 1) * P272 + c * 2)) * cw1
                                + bf2f(*(const LAS unsigned short*)(LX + (t + 2) * P272 + c * 2)) * cw2 + bf2f(*(const LAS unsigned short*)(LX + (t + 3) * P272 + c * 2)) * cw3;
            const float r = sigmoidf_(accR[nt][j] + bav), ig = sigmoidf_(accI[nt][j] + bxv);
            const float la = -8.0f * r * spl; const float a = __expf(la);
            const float x2 = 2.0f * la;
            const float om = (x2 > -0.02f) ? -x2 * (1.0f + x2 * (0.5f + x2 * 0.16666667f)) : 1.0f - __expf(x2);
            av[nt][j] = a; uv[nt][j] = __builtin_amdgcn_sqrtf(fmaxf(om, 0.0f)) * (ig * xc); } }
    __syncthreads();
#pragma unroll
    for (int nt = 0; nt < 8; ++nt)
#pragma unroll
        for (int j = 0; j < 4; ++j) { const int t = wave * 16 + 4 * fq + j, c = nt * 16 + fr; AL[t * 128 + c] = av[nt][j]; UL[t * 128 + c] = uv[nt][j]; }
    __syncthreads();
    if (tid < 128) { float hh = 0.f, P = 1.f; const size_t base = ((size_t)b * SEQ + t0) * 1024 + g * 128 + tid;
        float* Hp = (float*)(F.ws + WS_LRUH) + base; float* Pp = (float*)(F.ws + WS_LRUP) + base;
#pragma unroll 1
        for (int t0s = 0; t0s < 128; t0s += 16) { float aa[16], uu[16];
#pragma unroll
            for (int i = 0; i < 16; ++i) { aa[i] = AL[(t0s + i) * 128 + tid]; uu[i] = UL[(t0s + i) * 128 + tid]; }
#pragma unroll
            for (int i = 0; i < 16; ++i) { P *= aa[i]; hh = aa[i] * hh + uu[i]; Hp[(size_t)(t0s + i) * 1024] = hh; Pp[(size_t)(t0s + i) * 1024] = P; } }
        ((float*)(F.ws + SM_LRUCA))[(size_t)(b * 32 + tc) * 1024 + g * 128 + tid] = P;
        ((float*)(F.ws + SM_LRUCH))[(size_t)(b * 32 + tc) * 1024 + g * 128 + tid] = hh; }
    __syncthreads();
}

__device__ __forceinline__ void s1_phase(ldsp lds, int layer) {
    int G = gridDim.x, bid = blockIdx.x; OPQ_S(G); OPQ_S(bid);
#ifndef S1_DUP
#define S1_DUP 0
#endif
#define S1REP(b) _Pragma("unroll 1") for (int r1_ = 0; r1_ < 1 + ((S1_DUP >> (b)) & 1); ++r1_)
    S1REP(0) for (int u = bid; u < 512; u += G) ret_kv_unit(lds, u);
    S1REP(1) for (int u = bid; u < 512; u += G) lru_local_unit(lds, layer, u);
    S1REP(2) for (int u = bid; u < 256; u += G) moba_kmean_unit(lds, u);
    S1REP(3) for (int u = bid; u < 256; u += G) nsa_cmp1_unit(lds, layer, u);
}

__device__ NOINL void ret_scan_phase(ldsp lds_) {
    Frame F = mk_frame(lds_);
    for (int gid = F.bid * NTHR + F.tid; gid < 16 * 8192; gid += F.G * NTHR) {
        const int bh = gid >> 13, idx2 = gid & 8191, b = bh >> 3, h = bh & 7;
        f32x2* base = (f32x2*)((float*)(F.ws + WS_RETKV) + (size_t)((b * 32) * 8 + h) * 16384) + idx2;
        const float dc = __expf(ret_log_gamma(h) * 128.0f);
        f32x2 v[32];
#pragma unroll
        for (int n = 0; n < 32; ++n) v[n] = base[(size_t)n * 8 * 8192];
        f32x2 st = {0.f, 0.f};
#pragma unroll
        for (int n = 0; n < 32; ++n) { base[(size_t)n * 8 * 8192] = st; st = st * dc + v[n]; }
    }
}

__device__ __forceinline__ float row16_sum(float v) {
    v += __int_as_float(__builtin_amdgcn_update_dpp(0, __float_as_int(v), 0x128, 0xF, 0xF, false));
    v += __int_as_float(__builtin_amdgcn_update_dpp(0, __float_as_int(v), 0x124, 0xF, 0xF, false));
    v += __int_as_float(__builtin_amdgcn_update_dpp(0, __float_as_int(v), 0x122, 0xF, 0xF, false));
    v += __int_as_float(__builtin_amdgcn_update_dpp(0, __float_as_int(v), 0x121, 0xF, 0xF, false));
    return v;
}
__device__ NOINL void ret_out_unit(ldsp lds_, int layer, int unit) {
    Frame F = mk_frame(lds_);
    const int h = unit & 7, n = (unit >> 3) & 31, b = unit >> 8;
    const bf16_t* proj = (const bf16_t*)(F.ws + WS_PROJ);
    const float* ropec = (const float*)(F.ws + WS_ROPEC); const float* ropes = (const float*)(F.ws + WS_ROPES);
    const float* gain = inp(4) + (size_t)layer * 1024 + h * 128;
    ldsp Q = F.lds, Kt = F.lds + 128 * P272, vT = F.lds + 2 * 128 * P272, ST = F.lds + 3 * 128 * P272;
    const int tid = F.tid, lane = F.lane, wave = F.wave;
    const size_t row0 = (size_t)b * SEQ + (size_t)n * 128;
    const float lg = ret_log_gamma(h);
    const f32x4* kvp = (const f32x4*)((const float*)(F.ws + WS_RETKV) + (size_t)unit * 16384) + tid;
    f32x4 st[8]; u32x4 qw[2][2], kw[2][2], vw[4]; f32x4 tc[2][2], ts[2][2];
    const int c0q = (tid & 7) * 8, c0v = (tid & 15) * 8;
#pragma unroll
    for (int k = 0; k < 8; ++k) st[k] = kvp[512 * k];
#pragma unroll
    for (int ps = 0; ps < 2; ++ps) { const int j = (tid >> 3) + 64 * ps; const int t = n * 128 + j;
        const bf16_t* qrw = proj + (row0 + j) * NP + C_RQ + h * 128 + c0q; const bf16_t* krw = proj + (row0 + j) * NP + C_RK + h * 128 + c0q;
        qw[ps][0] = *(const u32x4*)qrw; qw[ps][1] = *(const u32x4*)(qrw + 64); kw[ps][0] = *(const u32x4*)krw; kw[ps][1] = *(const u32x4*)(krw + 64);
        tc[ps][0] = *(const f32x4*)(ropec + t * 64 + c0q); tc[ps][1] = *(const f32x4*)(ropec + t * 64 + c0q + 4); ts[ps][0] = *(const f32x4*)(ropes + t * 64 + c0q); ts[ps][1] = *(const f32x4*)(ropes + t * 64 + c0q + 4); }
#pragma unroll
    for (int ps = 0; ps < 4; ++ps) { const int j = (tid >> 4) + 32 * ps; vw[ps] = *(const u32x4*)(proj + (row0 + j) * NP + C_RV + h * 128 + c0v); }
    asm volatile("" :: "v"(st[0]), "v"(st[1]), "v"(st[2]), "v"(st[3]), "v"(st[4]), "v"(st[5]), "v"(st[6]), "v"(st[7]), "v"(qw[0][0]), "v"(qw[0][1]), "v"(qw[1][0]), "v"(qw[1][1]),
                    "v"(kw[0][0]), "v"(kw[0][1]), "v"(kw[1][0]), "v"(kw[1][1]), "v"(tc[0][0]), "v"(tc[0][1]), "v"(tc[1][0]), "v"(tc[1][1]), "v"(ts[0][0]), "v"(ts[0][1]), "v"(ts[1][0]), "v"(ts[1][1]),
                    "v"(vw[0]), "v"(vw[1]), "v"(vw[2]), "v"(vw[3]) : "memory");
    asm volatile("" : "+v"(st[0]), "+v"(st[1]), "+v"(st[2]), "+v"(st[3]), "+v"(st[4]), "+v"(st[5]), "+v"(st[6]), "+v"(st[7]));
    asm volatile("" : "+v"(qw[0][0]), "+v"(qw[0][1]), "+v"(qw[1][0]), "+v"(qw[1][1]), "+v"(kw[0][0]), "+v"(kw[0][1]), "+v"(kw[1][0]), "+v"(kw[1][1]));
    asm volatile("" : "+v"(tc[0][0]), "+v"(tc[0][1]), "+v"(tc[1][0]), "+v"(tc[1][1]), "+v"(ts[0][0]), "+v"(ts[0][1]), "+v"(ts[1][0]), "+v"(ts[1][1]));
    asm volatile("" : "+v"(vw[0]), "+v"(vw[1]), "+v"(vw[2]), "+v"(vw[3]));
#pragma unroll
    for (int k = 0; k < 8; ++k) { const int idx = (tid + 512 * k) * 4; const int e = idx >> 7, d = idx & 127;
        u32x2 w; w.x = pk2(st[k].x, st[k].y); w.y = pk2(st[k].z, st[k].w); *(LAS u32x2*)(ST + e * P272 + d * 2) = w; }
#pragma unroll
    for (int ps = 0; ps < 2; ++ps) { const int j = (tid >> 3) + 64 * ps; const int c0 = c0q;
        const float cc[8] = {tc[ps][0].x, tc[ps][0].y, tc[ps][0].z, tc[ps][0].w, tc[ps][1].x, tc[ps][1].y, tc[ps][1].z, tc[ps][1].w}, sn[8] = {ts[ps][0].x, ts[ps][0].y, ts[ps][0].z, ts[ps][0].w, ts[ps][1].x, ts[ps][1].y, ts[ps][1].z, ts[ps][1].w};
        float a[8], bb[8], r1[8], r2[8]; u32x4 w;
        unpack8(qw[ps][0], a); unpack8(qw[ps][1], bb);
#pragma unroll
        for (int x = 0; x < 8; ++x) { r1[x] = a[x] * cc[x] - bb[x] * sn[x]; r2[x] = a[x] * sn[x] + bb[x] * cc[x]; }
        w.x = pk2(r1[0], r1[1]); w.y = pk2(r1[2], r1[3]); w.z = pk2(r1[4], r1[5]); w.w = pk2(r1[6], r1[7]); *(LAS u32x4*)(Q + j * P272 + c0 * 2) = w;
        w.x = pk2(r2[0], r2[1]); w.y = pk2(r2[2], r2[3]); w.z = pk2(r2[4], r2[5]); w.w = pk2(r2[6], r2[7]); *(LAS u32x4*)(Q + j * P272 + (c0 + 64) * 2) = w;
        unpack8(kw[ps][0], a); unpack8(kw[ps][1], bb);
#pragma unroll
        for (int x = 0; x < 8; ++x) { r1[x] = a[x] * cc[x] - bb[x] * sn[x]; r2[x] = a[x] * sn[x] + bb[x] * cc[x]; }
        const float sc = 0.08838834764831845f;
        w.x = pk2(r1[0] * sc, r1[1] * sc); w.y = pk2(r1[2] * sc, r1[3] * sc); w.z = pk2(r1[4] * sc, r1[5] * sc); w.w = pk2(r1[6] * sc, r1[7] * sc); *(LAS u32x4*)(Kt + j * P272 + c0 * 2) = w;
        w.x = pk2(r2[0] * sc, r2[1] * sc); w.y = pk2(r2[2] * sc, r2[3] * sc); w.z = pk2(r2[4] * sc, r2[5] * sc); w.w = pk2(r2[6] * sc, r2[7] * sc); *(LAS u32x4*)(Kt + j * P272 + (c0 + 64) * 2) = w; }
#pragma unroll
    for (int ps = 0; ps < 4; ++ps) { const int j = (tid >> 4) + 32 * ps; const int c0 = c0v;
        const unsigned ww[4] = {vw[ps].x, vw[ps].y, vw[ps].z, vw[ps].w};
#pragma unroll
        for (int x = 0; x < 8; ++x) *(LAS unsigned short*)(vT + (c0 + x) * P272 + j * 2) = (unsigned short)((x & 1) ? (ww[x >> 1] >> 16) : (ww[x >> 1] & 0xffffu)); }
    __syncthreads();
    const int fr = lane & 15, fq = lane >> 4;
    f32x4 accC[8], accS[8];
#pragma unroll
    for (int i = 0; i < 8; ++i) { accC[i] = (f32x4){0.f, 0.f, 0.f, 0.f}; accS[i] = (f32x4){0.f, 0.f, 0.f, 0.f}; }
    strip_mma<8, 4>(accC, Q, wave * 16, P272, ST, P272, lane);
    strip_mma<8, 4>(accS, Q, wave * 16, P272, Kt, P272, lane);
    __syncthreads();
#pragma unroll
    for (int nt = 0; nt < 8; ++nt)
#pragma unroll
        for (int j = 0; j < 4; ++j) { const int i = wave * 16 + 4 * fq + j, jj = nt * 16 + fr;
            const float v = (i >= jj) ? accS[nt][j] * __expf(lg * (float)(i - jj)) : 0.0f;
            *(LAS unsigned short*)(Q + i * P272 + jj * 2) = (unsigned short)f2bf(v); }
    __syncthreads();
#pragma unroll
    for (int i = 0; i < 8; ++i) accS[i] = (f32x4){0.f, 0.f, 0.f, 0.f};
    float gvv[4][8], gn[8]; unsigned graw[4][8];
#pragma unroll
    for (int nt = 0; nt < 8; ++nt) gn[nt] = gain[nt * 16 + fr];
#pragma unroll
    for (int j = 0; j < 4; ++j) { const bf16_t* grow = proj + (row0 + wave * 16 + 4 * fq + j) * NP + C_RG + h * 128;
#pragma unroll
        for (int nt = 0; nt < 8; ++nt) graw[j][nt] = grow[nt * 16 + fr]; }
    __builtin_amdgcn_sched_barrier(0);
    strip_mma<8, 4>(accS, Q, wave * 16, P272, vT, P272, lane);
    __builtin_amdgcn_sched_barrier(0);
#pragma unroll
    for (int j = 0; j < 4; ++j) asm volatile("" : "+v"(graw[j][0]), "+v"(graw[j][1]), "+v"(graw[j][2]), "+v"(graw[j][3]), "+v"(graw[j][4]), "+v"(graw[j][5]), "+v"(graw[j][6]), "+v"(graw[j][7]));
    asm volatile("" : "+v"(gn[0]), "+v"(gn[1]), "+v"(gn[2]), "+v"(gn[3]), "+v"(gn[4]), "+v"(gn[5]), "+v"(gn[6]), "+v"(gn[7]));
#pragma unroll
    for (int j = 0; j < 4; ++j)
#pragma unroll
        for (int nt = 0; nt < 8; ++nt) gvv[j][nt] = bf2f((unsigned short)graw[j][nt]);
#pragma unroll
    for (int j = 0; j < 4; ++j) { const int i = wave * 16 + 4 * fq + j;
        const float dfs = __expf(lg * (float)(i + 1));
        float y[8]; float s = 0.f;
#pragma unroll
        for (int nt = 0; nt < 8; ++nt) { y[nt] = accS[nt][j] + dfs * accC[nt][j]; s += y[nt]; }
        s = row16_sum(s);
        const float mean = s * (1.0f / 128.0f); float q2 = 0.f;
#pragma unroll
        for (int nt = 0; nt < 8; ++nt) { y[nt] -= mean; q2 += y[nt] * y[nt]; }
        q2 = row16_sum(q2);
        const float rstd = 1.0f / sqrtf(q2 * (1.0f / 128.0f) + RMS_EPS);
        bf16_t* yrow = (bf16_t*)(F.ws + WS_Y) + (row0 + i) * DM + 0 + h * 128;
#pragma unroll
        for (int nt = 0; nt < 8; ++nt) { const int e = nt * 16 + fr; const float gv = gvv[j][nt];
            yrow[e] = (bf16_t)f2bf(gv * sigmoidf_(gv) * (y[nt] * rstd * gn[nt])); } }
    __syncthreads();
}

__device__ NOINL void lru_out_unit(ldsp lds_, int unit, int q_lo, int q_hi) {
    Frame F = mk_frame(lds_);
    const int ch = unit & 1, tc = (unit >> 1) & 31, b = unit >> 6;
    const bf16_t* proj = (const bf16_t*)(F.ws + WS_PROJ);
    LAS float* HIN = (LAS float*)F.lds;
    {   const int c = ch * 512 + F.tid;
        const float* CA = (const float*)(F.ws + SM_LRUCA) + (size_t)b * 32 * 1024 + c; const float* CH = (const float*)(F.ws + SM_LRUCH) + (size_t)b * 32 * 1024 + c;
        float H = 0.f; float ca[32], chv[32];
#pragma unroll
        for (int k = 0; k < 32; ++k) { ca[k] = CA[k * 1024]; chv[k] = CH[k * 1024]; }
#pragma unroll
        for (int k = 0; k < 32; ++k) H = (k < tc) ? ca[k] * H + chv[k] : H;
        HIN[F.tid] = H; }
    __syncthreads();
    const int cg = (F.tid & 127) * 4, tsub = F.tid >> 7; const int c0 = ch * 512 + cg;
    const f32x4 Hin = *(const LAS f32x4*)(HIN + cg);
    const size_t r0 = (size_t)b * SEQ + tc * 128 + tsub;
    const float* Hp = (const float*)(F.ws + WS_LRUH) + r0 * 1024 + c0; const float* Pp = (const float*)(F.ws + WS_LRUP) + r0 * 1024 + c0;
    const bf16_t* gp = proj + r0 * NP + C_LG + c0; bf16_t* yp = (bf16_t*)(F.ws + WS_Y) + r0 * DM + 2048 + c0;
#define LRU_LOAD(hv, pv, gv, i0_) do { _Pragma("unroll") for (int x = 0; x < 8; ++x) { const size_t t = (size_t)((i0_) + x) * 4; hv[x] = *(const f32x4*)(Hp + t * 1024); pv[x] = *(const f32x4*)(Pp + t * 1024); gv[x] = *(const u32x2*)(gp + t * NP); } } while (0)
#define LRU_EMIT(hv, pv, gv, i0_) do { _Pragma("unroll") for (int x = 0; x < 8; ++x) { const size_t t = (size_t)((i0_) + x) * 4; const f32x4 h = hv[x] + pv[x] * Hin; \
            u32x2 w; w.x = cvtpk(h.x * gelu_tanh(bflo(gv[x].x)), h.y * gelu_tanh(bfhi(gv[x].x))); w.y = cvtpk(h.z * gelu_tanh(bflo(gv[x].y)), h.w * gelu_tanh(bfhi(gv[x].y))); \
            *(u32x2*)(yp + t * DM) = w; } } while (0)
    f32x4 hA[8], pA[8], hB[8], pB[8]; u32x2 gA[8], gB[8];
    int i0 = q_lo * 8; const int i1 = q_hi * 8;
    LRU_LOAD(hA, pA, gA, i0);
#pragma unroll 1
    for (;;) {
        if (i0 + 8 >= i1) { LRU_EMIT(hA, pA, gA, i0); break; }
        LRU_LOAD(hB, pB, gB, i0 + 8);
        LRU_EMIT(hA, pA, gA, i0);
        if (i0 + 16 >= i1) { LRU_EMIT(hB, pB, gB, i0 + 8); break; }
        LRU_LOAD(hA, pA, gA, i0 + 16);
        LRU_EMIT(hB, pB, gB, i0 + 8);
        i0 += 16;
    }
#undef LRU_LOAD
#undef LRU_EMIT
    __syncthreads();
}

constexpr int SHM_T = 16384;
#define KSWZ(row, colB) ((row) * 256 + ((colB) ^ (((row) & 7) << 4)))
__device__ __forceinline__ int v_st(int k, int c) { const int kk = (k & ~0xC) | ((k & 4) << 1) | ((k & 8) >> 1); return ((kk >> 3) * 4 + (c >> 5)) * 512 + ((kk & 7) * 32 + (c & 31)) * 2; }
__device__ __forceinline__ int v_rd_base(int lane) { return ((lane & 3) << 3) | (((lane >> 2) & 3) << 6) | (((lane >> 4) & 1) << 5) | (((lane >> 5) & 1) << 8); }
constexpr int v_rd_off(int d0, int ks, int half) { return d0 * 512 + ks * 4096 + half * 2048; }
__device__ __forceinline__ int crow(int r, int hi) { return (r & 3) + 8 * (r >> 2) + 4 * hi; }
__device__ __forceinline__ float half_max(float v) { auto rr = __builtin_amdgcn_permlane32_swap(__float_as_uint(v), __float_as_uint(v), false, false); return fmaxf(__uint_as_float(rr[0]), __uint_as_float(rr[1])); }
__device__ __forceinline__ float half_sum(float v) { auto rr = __builtin_amdgcn_permlane32_swap(__float_as_uint(v), __float_as_uint(v), false, false); return __uint_as_float(rr[0]) + __uint_as_float(rr[1]); }
__device__ __forceinline__ float half_other(float v) { auto rr = __builtin_amdgcn_permlane32_swap(__float_as_uint(v), __float_as_uint(v), false, false); const float a = __uint_as_float(rr[0]), b = __uint_as_float(rr[1]); return (__lane_id() & 32) ? a : b; }

__device__ __forceinline__ void qkt(f32x16& p0, f32x16& p1, const LAS unsigned char* K_lds, int r32, int hi, const bf16x8 (&qr)[8]) {
    p0 = f32x16{}; p1 = f32x16{};
    const LAS unsigned char* kb[4];
#pragma unroll
    for (int dd = 0; dd < 4; ++dd) kb[dd] = K_lds + KSWZ(r32, (dd * 16 + hi * 8) * 2);
#pragma unroll
    for (int d0 = 0; d0 < 8; ++d0) { const LAS unsigned char* a = kb[d0 & 3] + (d0 >> 2) * 128;
        const bf16x8 b0 = *(const LAS bf16x8*)a;
        const bf16x8 b1 = *(const LAS bf16x8*)(a + 32 * 256);
        p0 = __builtin_amdgcn_mfma_f32_32x32x16_bf16(b0, qr[d0], p0, 0, 0, 0);
        p1 = __builtin_amdgcn_mfma_f32_32x32x16_bf16(b1, qr[d0], p1, 0, 0, 0);
        if (d0 & 1) __builtin_amdgcn_sched_barrier(0); }
}
__device__ __forceinline__ void pv_tile(f32x16 (&o)[4], int vb0, bf16x8 pa0, bf16x8 pa1, bf16x8 pa2, bf16x8 pa3) {
#define TRRD(dst, off) asm volatile("ds_read_b64_tr_b16 %0, %1 offset:%2" : "=&v"(dst) : "v"(vb0), "i"(off) : "memory")
#define PV_D0(d0) do { s16x4 l0, l1, l2, l3, h0, h1, h2, h3; constexpr int b_ = v_rd_off(d0, 0, 0); \
        TRRD(l0, b_); TRRD(h0, b_ + 2048); TRRD(l1, b_ + 4096); TRRD(h1, b_ + 6144); TRRD(l2, b_ + 8192); TRRD(h2, b_ + 10240); TRRD(l3, b_ + 12288); TRRD(h3, b_ + 14336); \
        asm volatile("s_waitcnt lgkmcnt(0)" ::: "memory"); __builtin_amdgcn_sched_barrier(0);   \
        o[d0] = __builtin_amdgcn_mfma_f32_32x32x16_bf16(pa0, (bf16x8){l0[0], l0[1], l0[2], l0[3], h0[0], h0[1], h0[2], h0[3]}, o[d0], 0, 0, 0);   \
        o[d0] = __builtin_amdgcn_mfma_f32_32x32x16_bf16(pa1, (bf16x8){l1[0], l1[1], l1[2], l1[3], h1[0], h1[1], h1[2], h1[3]}, o[d0], 0, 0, 0);   \
        o[d0] = __builtin_amdgcn_mfma_f32_32x32x16_bf16(pa2, (bf16x8){l2[0], l2[1], l2[2], l2[3], h2[0], h2[1], h2[2], h2[3]}, o[d0], 0, 0, 0);   \
        o[d0] = __builtin_amdgcn_mfma_f32_32x32x16_bf16(pa3, (bf16x8){l3[0], l3[1], l3[2], l3[3], h3[0], h3[1], h3[2], h3[3]}, o[d0], 0, 0, 0); } while (0)
    PV_D0(0); PV_D0(1); PV_D0(2); PV_D0(3);
#undef PV_D0
#undef TRRD
}
#define PK4(P, B_, OUT) do { unsigned a0_ = cvtpk(P[B_+0], P[B_+1]), a1_ = cvtpk(P[B_+2], P[B_+3]);                          \
        unsigned b0_ = cvtpk(P[B_+4], P[B_+5]), b1_ = cvtpk(P[B_+6], P[B_+7]);                                             \
        auto r0_ = __builtin_amdgcn_permlane32_swap(a0_, b0_, false, false); auto r1_ = __builtin_amdgcn_permlane32_swap(a1_, b1_, false, false); \
        u32x4 w_ = {r0_[0], r1_[0], r0_[1], r1_[1]}; OUT = __builtin_bit_cast(bf16x8, w_); } while (0)

__device__ __forceinline__ void glds16(const void* gsrc, unsigned lds_dst) { unsigned keep;
    asm volatile("s_mov_b32 %0, m0\n\ts_mov_b32 m0, %2\n\ts_nop 0\n\tglobal_load_lds_dwordx4 %1, off\n\ts_mov_b32 m0, %0" : "=&s"(keep) : "v"(gsrc), "s"(lds_dst) : "memory"); }
enum { AM_MOBA = 0, AM_SEL = 1, AM_WIN = 2, AM_CSTAT = 3, AM_COUT = 4 };
constexpr float ATT_C2 = 1.4426950408889634f * 0.08838834764831845f;
constexpr int ATT_BIG = 1 << 24;
constexpr float ATT_DEFER = 6.0f;

struct AttnIO {
    const bf16_t* Kg; const bf16_t* Vg; int pitch;
    int t_lo, t_hi;
    int q;
    int own;
    unsigned mlo, mhi;
};

template <int MODE, int NB>
__device__ __forceinline__ void attn_pass(ldsp lds, LAS float* wsc, const bf16x8 (&qr)[8], const AttnIO& io, f32x16 (&o)[4], float& m_reg, float& l_reg, float inv_l, LAS float* imp) {
    const int tid = otid(), lane = tid & 63, r32 = lane & 31, hi = lane >> 5;
    ldsp V_lds = lds; ldsp K_lds = lds + NB * SHM_T;
    const int vbase = (int)(unsigned)(uintptr_t)V_lds + v_rd_base(lane);
    constexpr int DEPTH = NB - 1;
    constexpr bool NEEDV = (MODE != AM_CSTAT);
    float carry = 0.f;
    const int wv = __builtin_amdgcn_readfirstlane(tid >> 6);
    size_t ksrc[2], vsrc[2];
#pragma unroll
    for (int i = 0; i < 2; ++i) { const int ch = wv * 2 + i;
        const int kr = ch * 4 + (lane >> 4), kc = (lane & 15) ^ (kr & 7);
        ksrc[i] = (size_t)kr * io.pitch + kc * 8;
        const int sub = ch * 2 + (lane >> 5), kk = (sub >> 2) * 8 + ((lane & 31) >> 2), vk = (kk & ~0xC) | ((kk & 4) << 1) | ((kk & 8) >> 1), vc = (sub & 3) * 32 + (lane & 3) * 8;
        vsrc[i] = (size_t)vk * io.pitch + vc; }
#define A_DMA(T, bf) do { const size_t t0_ = (size_t)((T) * 64) * io.pitch; \
        _Pragma("unroll") for (int i = 0; i < 2; ++i) { \
            glds16((const void*)(io.Kg + t0_ + ksrc[i]), (unsigned)(uintptr_t)(K_lds + (bf) * SHM_T + (wv * 2 + i) * 1024)); \
            if (NEEDV) glds16((const void*)(io.Vg + t0_ + vsrc[i]), (unsigned)(uintptr_t)(V_lds + (bf) * SHM_T + (wv * 2 + i) * 1024)); } } while (0)
#define A_STEP(T) do { \
        const int T_ = (T); const int bsel = (T_ - io.t_lo) & (NB - 1); const int vb0 = vbase + bsel * SHM_T; \
        if (T_ + DEPTH < io.t_hi) A_DMA(T_ + DEPTH, (T_ + DEPTH - io.t_lo) & (NB - 1)); \
        f32x16 p0, p1; qkt(p0, p1, K_lds + bsel * SHM_T, r32, hi, qr); \
        __builtin_amdgcn_sched_barrier(0); \
        int dq; unsigned W = 0x7fffffffu; \
        if (MODE == AM_MOBA) { const int blk = T_ >> 2; dq = (blk == io.own) ? (io.q - T_ * 64) : (((io.mlo >> blk) & 1u) ? ATT_BIG : -1); } \
        else if (MODE == AM_SEL) { const unsigned bit = (T_ < 32) ? ((io.mlo >> T_) & 1u) : ((io.mhi >> (T_ - 32)) & 1u); dq = (T_ == io.own) ? (io.q - T_ * 64) : (bit ? ATT_BIG : -1); } \
        else if (MODE == AM_WIN) { dq = io.q - T_ * 64; W = 512u; } \
        else { dq = io.q - T_ * 64; } \
        dq -= 4 * hi; \
        { const float NEG = -__builtin_inff(); \
          _Pragma("unroll") for (int r = 0; r < 16; ++r) { const int c = (r & 3) + 8 * (r >> 2); \
              if ((unsigned)(dq - c) >= W) p0[r] = NEG; if ((unsigned)(dq - c - 32) >= W) p1[r] = NEG; } } \
        if (MODE == AM_COUT) { \
            const float mL = -m_reg * ATT_C2; \
            _Pragma("unroll") for (int r = 0; r < 16; ++r) { p0[r] = __builtin_amdgcn_exp2f(fmaf(p0[r], ATT_C2, mL)) * inv_l; p1[r] = __builtin_amdgcn_exp2f(fmaf(p1[r], ATT_C2, mL)) * inv_l; } \
              \
            { float prev = carry; \
              _Pragma("unroll") for (int g = 0; g < 8; ++g) { \
                  const float s4 = (g < 4) ? ((p0[4 * (g & 3)] + p0[4 * (g & 3) + 1]) + (p0[4 * (g & 3) + 2] + p0[4 * (g & 3) + 3])) : ((p1[4 * (g & 3)] + p1[4 * (g & 3) + 1]) + (p1[4 * (g & 3) + 2] + p1[4 * (g & 3) + 3])); \
                  const float sp = (g < 4) ? p0[4 * (g & 3) + 3] : p1[4 * (g & 3) + 3]; \
                  const float osp = half_other(sp); \
                  imp[16 * T_ + 2 * g + hi] = s4 + (hi ? osp : prev); prev = osp; } \
              carry = prev; } \
            bf16x8 pa0, pa1, pa2, pa3; PK4(p0, 0, pa0); PK4(p0, 8, pa1); PK4(p1, 0, pa2); PK4(p1, 8, pa3); \
            pv_tile(o, vb0, pa0, pa1, pa2, pa3); \
        } else { \
            float pmax = p0[0]; \
            _Pragma("unroll") for (int r = 1; r < 16; ++r) pmax = fmaxf(pmax, p0[r]); \
            _Pragma("unroll") for (int r = 0; r < 16; ++r) pmax = fmaxf(pmax, p1[r]); \
            pmax = half_max(pmax); \
            const float mn = fmaxf(m_reg, pmax); const float alpha = __builtin_amdgcn_exp2f((m_reg - mn) * ATT_C2); m_reg = mn; \
            const float mL = -mn * ATT_C2; float ps = 0.f; \
            _Pragma("unroll") for (int r = 0; r < 16; ++r) { p0[r] = __builtin_amdgcn_exp2f(fmaf(p0[r], ATT_C2, mL)); p1[r] = __builtin_amdgcn_exp2f(fmaf(p1[r], ATT_C2, mL)); ps += p0[r] + p1[r]; } \
            ps = half_sum(ps); l_reg = l_reg * alpha + ps; \
            if (NEEDV) { \
                if (__any(alpha < 1.0f)) { if (hi == 0) wsc[r32] = alpha; LDS_WAIT(); \
                    _Pragma("unroll") for (int r = 0; r < 16; ++r) { const float al = wsc[crow(r, hi)]; o[0][r] *= al; o[1][r] *= al; o[2][r] *= al; o[3][r] *= al; } } \
                bf16x8 pa0, pa1, pa2, pa3; PK4(p0, 0, pa0); PK4(p0, 8, pa1); PK4(p1, 0, pa2); PK4(p1, 8, pa3); \
                    pv_tile(o, vb0, pa0, pa1, pa2, pa3); } \
        } \
          \
        { const int ahead = io.t_hi - 2 - T_; \
          if (DEPTH >= 3 && ahead >= 2) asm volatile("s_waitcnt vmcnt(%0)" :: "n"(2 * PER) : "memory"); \
          else if (DEPTH >= 2 && ahead >= 1) asm volatile("s_waitcnt vmcnt(%0)" :: "n"(PER) : "memory"); \
          else asm volatile("s_waitcnt vmcnt(0)" ::: "memory"); } \
        asm volatile("s_waitcnt lgkmcnt(0)" ::: "memory"); __builtin_amdgcn_s_barrier(); asm volatile("" ::: "memory"); } while (0)

    constexpr int PER = NEEDV ? 4 : 2;
#pragma unroll
    for (int d0 = 0; d0 < 8; ++d0) asm volatile("" :: "v"(qr[d0]));
    asm volatile("" :: "v"(io.mlo), "v"(io.mhi), "v"(io.q));
#pragma unroll
    for (int d = 0; d < DEPTH; ++d) if (io.t_lo + d < io.t_hi) A_DMA(io.t_lo + d, d);
    {   const int ahead = io.t_hi - 1 - io.t_lo;
        if (DEPTH >= 3 && ahead >= 2) asm volatile("s_waitcnt vmcnt(%0)" :: "n"(2 * PER) : "memory");
        else if (DEPTH >= 2 && ahead >= 1) asm volatile("s_waitcnt vmcnt(%0)" :: "n"(PER) : "memory");
        else asm volatile("s_waitcnt vmcnt(0)" ::: "memory"); }
    asm volatile("s_waitcnt lgkmcnt(0)" ::: "memory"); __builtin_amdgcn_s_barrier(); asm volatile("" ::: "memory");
#pragma unroll 1
    for (int T = io.t_lo; T < io.t_hi; ++T) A_STEP(T);
#undef A_DMA
#undef A_STEP
}

template <int MODE>
__device__ __forceinline__ void attn_pass_pipe(ldsp lds, LAS float* wsc, const bf16x8 (&qr)[8], const AttnIO& io, f32x16 (&o)[4], float& m_reg, float& l_reg) {
    constexpr int NB = 4, PER = 4;
    const int tid = otid(), lane = tid & 63, r32 = lane & 31, hi = lane >> 5;
    ldsp V_lds = lds; ldsp K_lds = lds + NB * SHM_T;
    const int vbase = (int)(unsigned)(uintptr_t)V_lds + v_rd_base(lane);
    const int wv = __builtin_amdgcn_readfirstlane(tid >> 6);
    const int q0 = __builtin_amdgcn_readfirstlane(io.q - r32);
    size_t ksrc[2], vsrc[2];
#pragma unroll
    for (int i = 0; i < 2; ++i) { const int ch = wv * 2 + i;
        const int kr = ch * 4 + (lane >> 4), kc = (lane & 15) ^ (kr & 7);
        ksrc[i] = (size_t)kr * io.pitch + kc * 8;
        const int sub = ch * 2 + (lane >> 5), kk = (sub >> 2) * 8 + ((lane & 31) >> 2), vk = (kk & ~0xC) | ((kk & 4) << 1) | ((kk & 8) >> 1), vc = (sub & 3) * 32 + (lane & 3) * 8;
        vsrc[i] = (size_t)vk * io.pitch + vc; }
#define P_DMA(T, bf) do { const size_t t0_ = (size_t)((T) * 64) * io.pitch; \
        _Pragma("unroll") for (int i = 0; i < 2; ++i) { \
            glds16((const void*)(io.Kg + t0_ + ksrc[i]), (unsigned)(uintptr_t)(K_lds + (bf) * SHM_T + (wv * 2 + i) * 1024)); \
            glds16((const void*)(io.Vg + t0_ + vsrc[i]), (unsigned)(uintptr_t)(V_lds + (bf) * SHM_T + (wv * 2 + i) * 1024)); } } while (0)
#define P_STEP(C0, C1, N0, N1, T) do { \
        const int T_ = (T); const int vb0 = vbase + ((T_ - io.t_lo) & 3) * SHM_T; \
        if (T_ + 3 < io.t_hi) P_DMA(T_ + 3, (T_ + 3 - io.t_lo) & 3); \
        if (T_ + 1 < io.t_hi) qkt(N0, N1, K_lds + ((T_ + 1 - io.t_lo) & 3) * SHM_T, r32, hi, qr); \
        __builtin_amdgcn_sched_barrier(0); \
        bool on = true, edge; int dq = io.q - T_ * 64 - 4 * hi; unsigned W = 0x7fffffffu; \
        if (MODE == AM_MOBA) { const int blk = T_ >> 2; edge = (blk == io.own); on = edge || ((io.mlo >> blk) & 1u); } \
        else if (MODE == AM_SEL) { const unsigned bit = (T_ < 32) ? ((io.mlo >> T_) & 1u) : ((io.mhi >> (T_ - 32)) & 1u); edge = (T_ == io.own); on = edge || bit; } \
        else { W = 512u; edge = !((T_ * 64 + 63 <= q0) && (q0 + 31 - T_ * 64 < 512)); } \
        if (edge) { const float NEG = -__builtin_inff(); \
          _Pragma("unroll") for (int r = 0; r < 16; ++r) { const int c = (r & 3) + 8 * (r >> 2); \
              if ((unsigned)(dq - c) >= W) C0[r] = NEG; if ((unsigned)(dq - c - 32) >= W) C1[r] = NEG; } } \
        float mx[8]; \
        _Pragma("unroll") for (int r = 0; r < 8; ++r) mx[r] = fmaxf(fmaxf(C0[2 * r], C0[2 * r + 1]), fmaxf(C1[2 * r], C1[2 * r + 1])); \
        float pmax = fmaxf(fmaxf(fmaxf(mx[0], mx[1]), fmaxf(mx[2], mx[3])), fmaxf(fmaxf(mx[4], mx[5]), fmaxf(mx[6], mx[7]))); \
        pmax = on ? pmax : -__builtin_inff(); \
        pmax = half_max(pmax); \
        const float mn = fmaxf(m_reg, pmax); const float alpha = __builtin_amdgcn_exp2f((m_reg - mn) * ATT_C2); m_reg = mn; \
        const float mL = on ? -mn * ATT_C2 : -__builtin_inff(); float ps0 = 0.f, ps1 = 0.f; \
        _Pragma("unroll") for (int r = 0; r < 16; ++r) { C0[r] = __builtin_amdgcn_exp2f(fmaf(C0[r], ATT_C2, mL)); C1[r] = __builtin_amdgcn_exp2f(fmaf(C1[r], ATT_C2, mL)); ps0 += C0[r]; ps1 += C1[r]; } \
        const float ps = half_sum(ps0 + ps1); l_reg = l_reg * alpha + ps; \
        if (__any(alpha < 1.0f)) { if (hi == 0) wsc[r32] = alpha; LDS_WAIT(); \
            _Pragma("unroll") for (int r = 0; r < 16; ++r) { const float al = wsc[crow(r, hi)]; o[0][r] *= al; o[1][r] *= al; o[2][r] *= al; o[3][r] *= al; } } \
        { bf16x8 pa0, pa1, pa2, pa3; PK4(C0, 0, pa0); PK4(C0, 8, pa1); PK4(C1, 0, pa2); PK4(C1, 8, pa3); \
          pv_tile(o, vb0, pa0, pa1, pa2, pa3); } \
          \
        if (T_ + 3 < io.t_hi) asm volatile("s_waitcnt vmcnt(%0)" :: "n"(PER) : "memory"); else asm volatile("s_waitcnt vmcnt(0)" ::: "memory"); \
        asm volatile("s_waitcnt lgkmcnt(0)" ::: "memory"); __builtin_amdgcn_s_barrier(); asm volatile("" ::: "memory"); } while (0)

#pragma unroll
    for (int d0 = 0; d0 < 8; ++d0) asm volatile("" :: "v"(qr[d0]));
    asm volatile("" :: "v"(io.mlo), "v"(io.mhi), "v"(io.q));
#pragma unroll
    for (int d = 0; d < 3; ++d) if (io.t_lo + d < io.t_hi) P_DMA(io.t_lo + d, d);
    if (io.t_lo + 2 < io.t_hi) asm volatile("s_waitcnt vmcnt(%0)" :: "n"(PER) : "memory"); else asm volatile("s_waitcnt vmcnt(0)" ::: "memory");
    asm volatile("s_waitcnt lgkmcnt(0)" ::: "memory"); __builtin_amdgcn_s_barrier(); asm volatile("" ::: "memory");
    f32x16 pA0, pA1, pB0, pB1;
    qkt(pA0, pA1, K_lds, r32, hi, qr);
#pragma unroll 1
    for (int T = io.t_lo; T < io.t_hi; T += 2) {
        P_STEP(pA0, pA1, pB0, pB1, T);
        if (T + 1 < io.t_hi) P_STEP(pB0, pB1, pA0, pA1, T + 1);
    }
#undef P_DMA
#undef P_STEP
}

template <int MODE>
__device__ __forceinline__ void attn_pass_pipe2(ldsp lds, LAS float* wsc, const bf16x8 (&qr)[8], const AttnIO& io, f32x16 (&o)[4], float& m_reg, float& l_reg) {
    constexpr int NB = 4;
    const int tid = otid(), lane = tid & 63, r32 = lane & 31, hi = lane >> 5;
    ldsp V_lds = lds; ldsp K_lds = lds + NB * SHM_T;
    const int vbase = (int)(unsigned)(uintptr_t)V_lds + v_rd_base(lane);
    const int wv = __builtin_amdgcn_readfirstlane(tid >> 6);
    const bool lead = wv < 4;
    const int q0 = __builtin_amdgcn_readfirstlane(io.q - r32);
    size_t ksrc[2], vsrc[2];
#pragma unroll
    for (int i = 0; i < 2; ++i) { const int ch = wv * 2 + i;
        const int kr = ch * 4 + (lane >> 4), kc = (lane & 15) ^ (kr & 7);
        ksrc[i] = (size_t)kr * io.pitch + kc * 8;
        const int sub = ch * 2 + (lane >> 5), kk = (sub >> 2) * 8 + ((lane & 31) >> 2), vk = (kk & ~0xC) | ((kk & 4) << 1) | ((kk & 8) >> 1), vc = (sub & 3) * 32 + (lane & 3) * 8;
        vsrc[i] = (size_t)vk * io.pitch + vc; }
#define Q_DMAK(T) do { const size_t t0_ = (size_t)((T) * 64) * io.pitch; const int bf_ = ((T) - io.t_lo) & 3; \
        _Pragma("unroll") for (int i = 0; i < 2; ++i) glds16((const void*)(io.Kg + t0_ + ksrc[i]), (unsigned)(uintptr_t)(K_lds + bf_ * SHM_T + (wv * 2 + i) * 1024)); } while (0)
#define Q_DMAV(T) do { const size_t t0_ = (size_t)((T) * 64) * io.pitch; const int bf_ = ((T) - io.t_lo) & 3; \
        _Pragma("unroll") for (int i = 0; i < 2; ++i) glds16((const void*)(io.Vg + t0_ + vsrc[i]), (unsigned)(uintptr_t)(V_lds + bf_ * SHM_T + (wv * 2 + i) * 1024)); } while (0)
#define Q_QKT(N0, N1, T_) do { if ((T_) + 1 < io.t_hi) qkt(N0, N1, K_lds + (((T_) + 1 - io.t_lo) & 3) * SHM_T, r32, hi, qr); __builtin_amdgcn_sched_barrier(0); } while (0)
#define Q_PV(TT) do { pv_tile(o, vbase + (((TT) - io.t_lo) & 3) * SHM_T, pa0, pa1, pa2, pa3); __builtin_amdgcn_sched_barrier(0); } while (0)
#define Q_SOFTMAX(C0, C1, T_) do { \
        bool on = true, edge; int dq = io.q - (T_) * 64 - 4 * hi; unsigned W = 0x7fffffffu; \
        if (MODE == AM_MOBA) { const int blk = (T_) >> 2; edge = (blk == io.own); on = edge || ((io.mlo >> blk) & 1u); } \
        else if (MODE == AM_SEL) { const unsigned bit = ((T_) < 32) ? ((io.mlo >> (T_)) & 1u) : ((io.mhi >> ((T_) - 32)) & 1u); edge = ((T_) == io.own); on = edge || bit; } \
        else { W = 512u; edge = !(((T_) * 64 + 63 <= q0) && (q0 + 31 - (T_) * 64 < 512)); } \
        if (edge) { const float NEG = -__builtin_inff(); \
          _Pragma("unroll") for (int r = 0; r < 16; ++r) { const int c = (r & 3) + 8 * (r >> 2); \
              if ((unsigned)(dq - c) >= W) C0[r] = NEG; if ((unsigned)(dq - c - 32) >= W) C1[r] = NEG; } } \
        float mx[8]; \
        _Pragma("unroll") for (int r = 0; r < 8; ++r) mx[r] = fmaxf(fmaxf(C0[2 * r], C0[2 * r + 1]), fmaxf(C1[2 * r], C1[2 * r + 1])); \
        float pmax = fmaxf(fmaxf(fmaxf(mx[0], mx[1]), fmaxf(mx[2], mx[3])), fmaxf(fmaxf(mx[4], mx[5]), fmaxf(mx[6], mx[7]))); \
        pmax = on ? pmax : -__builtin_inff(); \
        pmax = half_max(pmax); \
          \
        const bool upd = __any((pmax - m_reg) * ATT_C2 > ATT_DEFER); float alpha = 1.0f; \
        if (upd) { const float mn = fmaxf(m_reg, pmax); alpha = __builtin_amdgcn_exp2f((m_reg - mn) * ATT_C2); m_reg = mn; } \
        const float mL = on ? -m_reg * ATT_C2 : -__builtin_inff(); float ps0 = 0.f, ps1 = 0.f; \
        _Pragma("unroll") for (int r = 0; r < 16; ++r) { C0[r] = __builtin_amdgcn_exp2f(fmaf(C0[r], ATT_C2, mL)); C1[r] = __builtin_amdgcn_exp2f(fmaf(C1[r], ATT_C2, mL)); ps0 += C0[r]; ps1 += C1[r]; } \
        const float ps = half_sum(ps0 + ps1); l_reg = l_reg * alpha + ps; \
        if (upd) { if (hi == 0) wsc[r32] = alpha; LDS_WAIT(); \
            _Pragma("unroll") for (int r = 0; r < 16; ++r) { const float al = wsc[crow(r, hi)]; o[0][r] *= al; o[1][r] *= al; o[2][r] *= al; o[3][r] *= al; } } \
        PK4(C0, 0, pa0); PK4(C0, 8, pa1); PK4(C1, 0, pa2); PK4(C1, 8, pa3); __builtin_amdgcn_sched_barrier(0); } while (0)
#define Q_STEP(C0, C1, N0, N1, T) do { \
        const int T_ = (T); \
        if (T_ + 3 < io.t_hi) Q_DMAK(T_ + 3); \
        if (T_ + 2 < io.t_hi) Q_DMAV(T_ + 2); \
        if (!lead && T_ > io.t_lo) Q_PV(T_ - 1); \
        Q_QKT(N0, N1, T_); Q_SOFTMAX(C0, C1, T_); \
        if (lead) Q_PV(T_); \
          \
        { const int nk = (T_ + 3 < io.t_hi) ? 2 : 0, nv = (T_ + 2 < io.t_hi) ? 2 : 0; \
          if (nk + nv == 4) asm volatile("s_waitcnt vmcnt(4)" ::: "memory"); else if (nk + nv == 2) asm volatile("s_waitcnt vmcnt(2)" ::: "memory"); else asm volatile("s_waitcnt vmcnt(0)" ::: "memory"); } \
        asm volatile("s_waitcnt lgkmcnt(0)" ::: "memory"); __builtin_amdgcn_s_barrier(); asm volatile("" ::: "memory"); } while (0)

#pragma unroll
    for (int d0 = 0; d0 < 8; ++d0) asm volatile("" :: "v"(qr[d0]));
    asm volatile("" :: "v"(io.mlo), "v"(io.mhi), "v"(io.q));
    Q_DMAK(io.t_lo); Q_DMAV(io.t_lo);
    if (io.t_lo + 1 < io.t_hi) { Q_DMAK(io.t_lo + 1); Q_DMAV(io.t_lo + 1); }
    if (io.t_lo + 2 < io.t_hi) Q_DMAK(io.t_lo + 2);
    { const int young = ((io.t_lo + 1 < io.t_hi) ? 2 : 0) + ((io.t_lo + 2 < io.t_hi) ? 2 : 0);
      if (young == 4) asm volatile("s_waitcnt vmcnt(4)" ::: "memory"); else if (young == 2) asm volatile("s_waitcnt vmcnt(2)" ::: "memory"); else asm volatile("s_waitcnt vmcnt(0)" ::: "memory"); }
    asm volatile("s_waitcnt lgkmcnt(0)" ::: "memory"); __builtin_amdgcn_s_barrier(); asm volatile("" ::: "memory");
    f32x16 pA0, pA1, pB0, pB1; bf16x8 pa0, pa1, pa2, pa3;
    pa0 = pa1 = pa2 = pa3 = (bf16x8){0, 0, 0, 0, 0, 0, 0, 0};
    qkt(pA0, pA1, K_lds, r32, hi, qr);
#pragma unroll 1
    for (int T = io.t_lo; T < io.t_hi; T += 2) {
        Q_STEP(pA0, pA1, pB0, pB1, T);
        if (T + 1 < io.t_hi) Q_STEP(pB0, pB1, pA0, pA1, T + 1);
    }
    if (!lead) Q_PV(io.t_hi - 1);
#undef Q_DMAK
#undef Q_DMAV
#undef Q_QKT
#undef Q_PV
#undef Q_SOFTMAX
#undef Q_STEP
}

__device__ __forceinline__ void load_q(bf16x8 (&qr)[8], const bf16_t* qrow, int hi) {
#pragma unroll
    for (int d0 = 0; d0 < 8; ++d0) qr[d0] = *(const bf16x8*)(qrow + d0 * 16 + hi * 8);
}


__device__ __forceinline__ float dpp_xor1(float v) { return __int_as_float(__builtin_amdgcn_mov_dpp(__float_as_int(v), 0xB1, 0xF, 0xF, true)); }
__device__ __forceinline__ void store_o_bf16(const f32x16 (&o)[4], const LAS float* wsc, bf16_t* dst, size_t pitch, int r32, int hi) {
    float sc[16];
#pragma unroll
    for (int r = 0; r < 16; ++r) sc[r] = wsc[crow(r, hi)];
    asm volatile("" : "+v"(sc[0]), "+v"(sc[1]), "+v"(sc[2]), "+v"(sc[3]), "+v"(sc[4]), "+v"(sc[5]), "+v"(sc[6]), "+v"(sc[7]));
    asm volatile("" : "+v"(sc[8]), "+v"(sc[9]), "+v"(sc[10]), "+v"(sc[11]), "+v"(sc[12]), "+v"(sc[13]), "+v"(sc[14]), "+v"(sc[15]));
#pragma unroll
    for (int d0 = 0; d0 < 4; ++d0) { unsigned pk[16];
#pragma unroll
        for (int r = 0; r < 16; ++r) { const float v = o[d0][r] * sc[r]; pk[r] = cvtpk(v, dpp_xor1(v)); }
        if ((r32 & 1) == 0) {
#pragma unroll
            for (int r = 0; r < 16; ++r) *(unsigned*)(dst + (size_t)crow(r, hi) * pitch + d0 * 32 + r32) = pk[r]; }
        __builtin_amdgcn_sched_barrier(0); }
}

constexpr int MB_Q = 0, MB_KM = 69632, MB_GT = 77824, MB_SELM = 131072, MB_WSC = 132096;
__device__ __forceinline__ void moba_gate(ldsp lds, unsigned char* ws, int unit) {
    const int qb = unit & 15, h = (unit >> 4) & 7, b = unit >> 7;
    const bf16_t* proj = (const bf16_t*)(ws + WS_PROJ);
    const int tid = otid();
    LAS float* KM = (LAS float*)(lds + MB_KM);
    LAS float* GT = (LAS float*)(lds + MB_GT);
    LAS unsigned* SELM = (LAS unsigned*)(lds + MB_SELM);
    const size_t row0 = (size_t)b * SEQ + (size_t)qb * 256;
    const float* km = (const float*)(ws + SM_KMEAN) + (size_t)((b * 8 + h) * 16) * 128;
    {   u32x4 qw[8]; float kw[4];
#pragma unroll
        for (int i = 0; i < 8; ++i) { const int c = tid + 512 * i; qw[i] = *(const u32x4*)(proj + (row0 + (c >> 4)) * NP + C_MQ + h * 128 + (c & 15) * 8); }
#pragma unroll
        for (int i = 0; i < 4; ++i) kw[i] = km[tid + 512 * i];
#pragma unroll
        for (int i = 0; i < 8; ++i) { const int c = tid + 512 * i; *(LAS u32x4*)(lds + MB_Q + (c >> 4) * P272 + (c & 15) * 16) = qw[i]; }
#pragma unroll
        for (int i = 0; i < 4; ++i) KM[tid + 512 * i] = kw[i]; }
    __syncthreads();
    const int ql = tid >> 1, n0 = (tid & 1) * 8;
    float acc[8] = {0, 0, 0, 0, 0, 0, 0, 0};
    if (n0 < qb) {
#pragma unroll 2
        for (int i = 0; i < 16; ++i) { float qf[8]; unpack8(*(const LAS u32x4*)(lds + MB_Q + ql * P272 + i * 16), qf); const int d = 8 * i;
#pragma unroll
            for (int n = 0; n < 8; ++n) { const f32x4 k0 = *(const LAS f32x4*)(KM + (n0 + n) * 128 + d), k1 = *(const LAS f32x4*)(KM + (n0 + n) * 128 + d + 4);
                acc[n] += (qf[0] * k0.x + qf[1] * k0.y) + (qf[2] * k0.z + qf[3] * k0.w) + (qf[4] * k1.x + qf[5] * k1.y) + (qf[6] * k1.z + qf[7] * k1.w); } } }
#pragma unroll
    for (int n = 0; n < 8; ++n) GT[ql * 16 + n0 + n] = acc[n];
    __syncthreads();
    if (tid < 256) { unsigned m = 0u;
        if (qb <= 3) m = (1u << qb) - 1u;
        else { float g[16];
#pragma unroll
            for (int n = 0; n < 16; ++n) g[n] = (n < qb) ? GT[tid * 16 + n] : -__builtin_inff();
#pragma unroll
            for (int pick = 0; pick < 3; ++pick) { float best = -__builtin_inff(); int bi = 0;
#pragma unroll
                for (int n = 0; n < 16; ++n) { const bool tk = g[n] > best; best = tk ? g[n] : best; bi = tk ? n : bi; }
                m |= 1u << bi;
#pragma unroll
                for (int n = 0; n < 16; ++n) g[n] = (n == bi) ? -__builtin_inff() : g[n]; } }
        SELM[tid] = m; }
    __syncthreads();
}
__device__ NOINL void moba_unit(ldsp lds, int unit) {
    unsigned char* ws = ows();
    moba_gate(lds, ws, unit);
    f32x16 o[4] = {}; float m_reg = -1e30f, l_reg = 0.f;
    {   const int qb = unit & 15, h = (unit >> 4) & 7, b = unit >> 7;
        const bf16_t* proj = (const bf16_t*)(ws + WS_PROJ);
        const int tid = otid(), lane = tid & 63, wave = __builtin_amdgcn_readfirstlane(tid >> 6), r32 = lane & 31, hi = lane >> 5;
        const size_t row0 = (size_t)b * SEQ + (size_t)qb * 256;
        bf16x8 qr[8];
#pragma unroll
        for (int d0 = 0; d0 < 8; ++d0) qr[d0] = *(const LAS bf16x8*)(lds + MB_Q + (wave * 32 + r32) * P272 + (d0 * 16 + hi * 8) * 2);
        const unsigned mymask = ((LAS unsigned*)(lds + MB_SELM))[wave * 32 + r32];
        LDS_WAIT(); __syncthreads();
        AttnIO io; io.Kg = proj + (size_t)b * SEQ * NP + C_MK + h * 128; io.Vg = proj + (size_t)b * SEQ * NP + C_MV + h * 128; io.pitch = NP;
        io.t_lo = 0; io.t_hi = 4 * qb + 4; io.q = qb * 256 + wave * 32 + r32; io.own = qb; io.mlo = mymask; io.mhi = 0u;
        attn_pass_pipe2<AM_MOBA>(lds, (LAS float*)(lds + MB_WSC) + wave * 64, qr, io, o, m_reg, l_reg);
    }
    {   int u2 = unit; OPQ_S(u2); const int tz = otid();
        const int qb = u2 & 15, h = (u2 >> 4) & 7, b = u2 >> 7;
        const int lane = tz & 63, wave = __builtin_amdgcn_readfirstlane(tz >> 6), r32 = lane & 31, hi = lane >> 5;
        LAS float* wsc = (LAS float*)(lds + MB_WSC) + wave * 64;
        const size_t row0 = (size_t)b * SEQ + (size_t)qb * 256;
        if (hi == 0) wsc[r32] = 1.0f / l_reg;
        LDS_WAIT();
        store_o_bf16(o, wsc, (bf16_t*)(ws + WS_Y) + (row0 + wave * 32) * DM + 1024 + h * 128, DM, r32, hi);
    }
    __syncthreads();
}

constexpr int NS_IMP = 65536, NS_SELM = 131072, NS_GATE = 131584, NS_WSC = 135680;
struct NsaIdx { int qt, kvh, b, lane, wave, r32, hi, hl, qh, hh, qloc, qpos; size_t row0; };
__device__ __forceinline__ NsaIdx nsa_idx(int unit, int tid) {
    NsaIdx x; x.qt = unit & 63; x.kvh = (unit >> 6) & 1; x.b = unit >> 7; x.lane = tid & 63; x.wave = __builtin_amdgcn_readfirstlane(tid >> 6); x.r32 = x.lane & 31; x.hi = x.lane >> 5;
    x.hl = x.wave >> 1; x.qh = x.wave & 1; x.hh = x.kvh * 4 + x.hl; x.qloc = x.qh * 32 + x.r32; x.qpos = x.qt * 64 + x.qloc; x.row0 = (size_t)x.b * SEQ + (size_t)x.qt * 64; return x;
}
__device__ NOINL void nsa_cmp_branch(ldsp lds, int unit) {
    unsigned char* ws = ows();
    f32x16 o[4]; float m_reg = -1e30f, l_reg = 0.f;
#pragma unroll
    for (int d = 0; d < 4; ++d) o[d] = f32x16{};
    {   const NsaIdx x = nsa_idx(unit, otid());
        const bf16_t* proj = (const bf16_t*)(ws + WS_PROJ);
        LAS float* GATEL = (LAS float*)(lds + NS_GATE);
        if (x.hi == 0) {
#pragma unroll
            for (int br = 0; br < 3; ++br) GATEL[(x.wave * 32 + x.r32) * 4 + br] = sigmoidf_(bf2f(proj[(x.row0 + x.qloc) * NP + C_NGATE + x.hh * 3 + br])); }
        bf16x8 qr[8]; load_q(qr, proj + (x.row0 + x.qloc) * NP + C_NQ + x.hh * 128, x.hi);
        AttnIO io; io.pitch = 128; io.own = 0; io.mlo = 0u; io.mhi = 0u;
        io.Kg = (const bf16_t*)(ws + SM_KC) + (size_t)(x.b * 2 + x.kvh) * 256 * 128; io.Vg = (const bf16_t*)(ws + SM_VC) + (size_t)(x.b * 2 + x.kvh) * 256 * 128;
        io.t_lo = 0; io.t_hi = ((4 * x.qt + 2) >> 6) + 1; io.q = (x.qpos >= 31) ? ((x.qpos - 31) >> 4) : -1;
        LAS float* wsc = (LAS float*)(lds + NS_WSC) + x.wave * 64;
        attn_pass<AM_CSTAT, 2>(lds, wsc, qr, io, o, m_reg, l_reg, 0.f, nullptr);
        const float inv_l = (l_reg > 0.f) ? 1.0f / l_reg : 0.f;
        attn_pass<AM_COUT, 2>(lds, wsc, qr, io, o, m_reg, l_reg, inv_l, (LAS float*)(lds + NS_IMP) + (x.hl * 64 + x.qloc) * 64);
    }
    {   int u2 = unit; OPQ_S(u2); const int tz = otid();
        const NsaIdx x = nsa_idx(u2, tz);
        const LAS float* GATEL = (const LAS float*)(lds + NS_GATE);
        float* accp = (float*)(ws + WS_NSAACC) + (x.row0 + x.qh * 32) * 1024 + x.hh * 128;
        LDS_WAIT();
        float g0[16];
#pragma unroll
        for (int r = 0; r < 16; ++r) g0[r] = GATEL[(x.wave * 32 + crow(r, x.hi)) * 4 + 0];
        asm volatile("" : "+v"(g0[0]), "+v"(g0[1]), "+v"(g0[2]), "+v"(g0[3]), "+v"(g0[4]), "+v"(g0[5]), "+v"(g0[6]), "+v"(g0[7]));
        asm volatile("" : "+v"(g0[8]), "+v"(g0[9]), "+v"(g0[10]), "+v"(g0[11]), "+v"(g0[12]), "+v"(g0[13]), "+v"(g0[14]), "+v"(g0[15]));
#pragma unroll
        for (int r = 0; r < 16; ++r) { const int row = crow(r, x.hi);
#pragma unroll
            for (int d0 = 0; d0 < 4; ++d0) accp[(size_t)row * 1024 + d0 * 32 + x.r32] = g0[r] * o[d0][r]; }
    }
    __syncthreads();
    {   int u2 = unit; OPQ_S(u2); const int tid = otid();
        const int qt = u2 & 63;
        LAS float* IMP = (LAS float*)(lds + NS_IMP); LAS unsigned* SELM = (LAS unsigned*)(lds + NS_SELM);
        const int q = tid >> 3, jg = tid & 7;
        float v[8];
#pragma unroll
        for (int xx = 0; xx < 8; ++xx) { const int j = jg * 8 + xx; v[xx] = (IMP[(0 * 64 + q) * 64 + j] + IMP[(1 * 64 + q) * 64 + j]) + (IMP[(2 * 64 + q) * 64 + j] + IMP[(3 * 64 + q) * 64 + j]);
            if (j > qt) v[xx] = -__builtin_inff();
            if (j == 0 || j == qt || j == qt - 1) v[xx] = __builtin_inff(); }
        __syncthreads();
#pragma unroll
        for (int xx = 0; xx < 8; ++xx) IMP[q * 64 + jg * 8 + xx] = v[xx];
        __syncthreads();
        int rank[8] = {0, 0, 0, 0, 0, 0, 0, 0};
        for (int j2 = 0; j2 < 64; ++j2) { const float w = IMP[q * 64 + j2];
#pragma unroll
            for (int xx = 0; xx < 8; ++xx) { const int j = jg * 8 + xx; rank[xx] += (w > v[xx] || (w == v[xx] && j2 < j)) ? 1 : 0; } }
        unsigned bits = 0u;
#pragma unroll
        for (int xx = 0; xx < 8; ++xx) bits |= (rank[xx] < 16) ? (1u << xx) : 0u;
        unsigned lo = (jg < 4) ? (bits << (8 * jg)) : 0u, hiw = (jg >= 4) ? (bits << (8 * (jg - 4))) : 0u;
        lo |= __shfl_xor(lo, 1); lo |= __shfl_xor(lo, 2); lo |= __shfl_xor(lo, 4);
        hiw |= __shfl_xor(hiw, 1); hiw |= __shfl_xor(hiw, 2); hiw |= __shfl_xor(hiw, 4);
        if (jg == 0) { SELM[q * 2] = lo; SELM[q * 2 + 1] = hiw; }
        __syncthreads();
    }
}
template <int BR>
__device__ NOINL void nsa_attn_branch(ldsp lds, int unit) {
    unsigned char* ws = ows();
    f32x16 o[4]; float m_reg = -1e30f, l_reg = 0.f;
#pragma unroll
    for (int d = 0; d < 4; ++d) o[d] = f32x16{};
    {   const NsaIdx x = nsa_idx(unit, otid());
        const bf16_t* proj = (const bf16_t*)(ws + WS_PROJ);
        bf16x8 qr[8]; load_q(qr, proj + (x.row0 + x.qloc) * NP + C_NQ + x.hh * 128, x.hi);
        AttnIO io; io.pitch = NP; io.q = x.qpos; io.t_hi = x.qt + 1;
        const LAS unsigned* SELM = (const LAS unsigned*)(lds + NS_SELM);
        LAS float* wsc = (LAS float*)(lds + NS_WSC) + x.wave * 64;
        if (BR == 1) { io.Kg = proj + (size_t)x.b * SEQ * NP + C_NKS + x.kvh * 128; io.Vg = proj + (size_t)x.b * SEQ * NP + C_NVS + x.kvh * 128;
            io.t_lo = 0; io.own = x.qt; io.mlo = SELM[x.qloc * 2]; io.mhi = SELM[x.qloc * 2 + 1];
            attn_pass_pipe2<AM_SEL>(lds, wsc, qr, io, o, m_reg, l_reg); }
        else { io.Kg = proj + (size_t)x.b * SEQ * NP + C_NKW + x.kvh * 128; io.Vg = proj + (size_t)x.b * SEQ * NP + C_NVW + x.kvh * 128;
            io.t_lo = (x.qt >= 8) ? x.qt - 8 : 0; io.own = 0; io.mlo = 0u; io.mhi = 0u;
#ifndef PROBE_WINREP
#define PROBE_WINREP 1
#endif
            int nrep = PROBE_WINREP; OPQ_S(nrep);
#pragma unroll 1
            for (int rp = 0; rp < nrep; ++rp) {
#pragma unroll
                for (int d = 0; d < 4; ++d) o[d] = f32x16{};
                m_reg = -1e30f; l_reg = 0.f;
                attn_pass_pipe2<AM_WIN>(lds, wsc, qr, io, o, m_reg, l_reg); } }
    }
    {   int u2 = unit; OPQ_S(u2); const int tz = otid();
        const NsaIdx x = nsa_idx(u2, tz);
        const LAS float* GATEL = (const LAS float*)(lds + NS_GATE);
        LAS float* wsc = (LAS float*)(lds + NS_WSC) + x.wave * 64;
        float* accp = (float*)(ws + WS_NSAACC) + (x.row0 + x.qh * 32) * 1024 + x.hh * 128;
        if (x.hi == 0) wsc[32 + x.r32] = GATEL[(x.wave * 32 + x.r32) * 4 + BR] / l_reg;
        LDS_WAIT();
        if (BR == 1) {
            float pv[4][16];
#pragma unroll
            for (int d0 = 0; d0 < 4; ++d0)
#pragma unroll
                for (int r = 0; r < 16; ++r) pv[d0][r] = accp[(size_t)crow(r, x.hi) * 1024 + d0 * 32 + x.r32];
            asm volatile("" ::: "memory");
#pragma unroll
            for (int d0 = 0; d0 < 4; ++d0)
#pragma unroll
                for (int r = 0; r < 16; ++r) { const int row = crow(r, x.hi); accp[(size_t)row * 1024 + d0 * 32 + x.r32] = pv[d0][r] + wsc[32 + row] * o[d0][r]; } }
        else { bf16_t* yp = (bf16_t*)(ws + WS_Y) + (x.row0 + x.qh * 32) * DM + 3072 + x.hh * 128;
            float sc[16];
#pragma unroll
            for (int r = 0; r < 16; ++r) sc[r] = wsc[32 + crow(r, x.hi)];
            asm volatile("" : "+v"(sc[0]), "+v"(sc[1]), "+v"(sc[2]), "+v"(sc[3]), "+v"(sc[4]), "+v"(sc[5]), "+v"(sc[6]), "+v"(sc[7]));
            asm volatile("" : "+v"(sc[8]), "+v"(sc[9]), "+v"(sc[10]), "+v"(sc[11]), "+v"(sc[12]), "+v"(sc[13]), "+v"(sc[14]), "+v"(sc[15]));
#pragma unroll
            for (int d0 = 0; d0 < 4; ++d0)
#pragma unroll
                for (int r = 0; r < 16; ++r) o[d0][r] *= sc[r];
            float pv[4][16];
#pragma unroll
            for (int d0 = 0; d0 < 4; ++d0)
#pragma unroll
                for (int r = 0; r < 16; ++r) pv[d0][r] = accp[(size_t)crow(r, x.hi) * 1024 + d0 * 32 + x.r32];
            asm volatile("" ::: "memory");
#pragma unroll
            for (int d0 = 0; d0 < 4; ++d0) { unsigned pk[16];
#pragma unroll
                for (int r = 0; r < 16; ++r) { const float v = pv[d0][r] + o[d0][r]; pk[r] = cvtpk(v, dpp_xor1(v)); }
                if ((x.r32 & 1) == 0) {
#pragma unroll
                    for (int r = 0; r < 16; ++r) *(unsigned*)(yp + (size_t)crow(r, x.hi) * DM + d0 * 32 + x.r32) = pk[r]; }
                __builtin_amdgcn_sched_barrier(0); } }
    }
    __syncthreads();
}

__device__ __forceinline__ void s3_phase(ldsp lds, int layer) {
    int G = gridDim.x, bid = blockIdx.x; OPQ_S(G); OPQ_S(bid);
#ifndef S3_MASK
#define S3_MASK 0x3f
#endif
#ifndef S3_DUP
#define S3_DUP 0
#endif
#define S3REP(b) _Pragma("unroll 1") for (int r3_ = 0; r3_ < 1 + ((S3_DUP >> (b)) & 1); ++r3_)
    for (int u = bid; u < 256; u += G) {
        const int x = u & 7, slot = u >> 3, qbm = slot & 15;
        const int mu = (G == 256) ? ((2 * x + (slot >> 4)) * 16 + qbm) : u;
        if (S3_MASK & 1) S3REP(0) moba_unit(lds, mu); }
    for (int u = bid; u < 256; u += G) {
        int nu;
        if (G == 256) { const int x = u & 7, slot = u >> 3, qbm = slot & 15, r = 2 * (x & 1) + (slot >> 4); nu = (x >> 1) * 64 + (63 - 4 * qbm - r); }
        else { const int qbm = u & 15, bh = u >> 4; nu = (bh >> 2) * 64 + (63 - 4 * qbm - (bh & 3)); }
        if (S3_MASK & 2) S3REP(1) nsa_cmp_branch(lds, nu); if (S3_MASK & 4) S3REP(2) nsa_attn_branch<1>(lds, nu); if (S3_MASK & 8) S3REP(3) nsa_attn_branch<2>(lds, nu); }
    if (S3_MASK & 16) S3REP(4) for (int u = bid; u < 512; u += G) ret_out_unit(lds, layer, u);
    if (S3_MASK & 32) S3REP(5) { if (G == 256) lru_out_unit(lds, bid >> 1, (bid & 1) * 2, (bid & 1) * 2 + 2); else for (int u = bid; u < 128; u += G) lru_out_unit(lds, u, 0, 4); }
}

constexpr int N_PHASES = 16;
struct Args { const float* in[23]; float* out; unsigned char* ws; int ph_lo, ph_hi, li, pad; };
template <class Epi>
__device__ NOINL void gemm_call(ldsp lds, const bf16_t* A, const bf16_t* Bt, int N, int K, Epi E) {
    pg8::Gemm g{A, Bt, MTOK, N, K}; pg8::StaticOrder S; S.init(MTOK, N, (int)gridDim.x, (int)blockIdx.x);
    pg8::gemm_phase<Epi, pg8::StaticOrder, true, true>(lds, g, S, E);
}
template <class Epi>
__device__ NOINL void gemm_call_norm(ldsp lds, const bf16_t* A, const bf16_t* Bt, int N, int K, const float* ssq, Epi E, int Gg) {
    pg8::Gemm g{A, Bt, MTOK, N, K}; pg8::StaticOrder S; S.init(MTOK, N, Gg, (int)blockIdx.x);
    pg8::Unit u0; if (!S.next(0, u0)) return;
    E.fm = (u0.pm >> 3) << 3;
    pg8::epi_rstd_table(ssq, E.fm, (LAS float*)E.xl, otid());
    pg8::gemm_phase<Epi, pg8::StaticOrder, false, true>(lds, g, S, E);
}
__global__ void __launch_bounds__(NTHR, 2) trunk_fwd(Args args) {
    extern __shared__ __attribute__((aligned(16))) unsigned char lds_raw[];
    const ldsp lds = (ldsp)lds_raw;
    volatile LAS unsigned* MISC = (volatile LAS unsigned*)(lds + MISC_OFF);
    if (threadIdx.x < 64) MISC[threadIdx.x] = 0u;
    __syncthreads();
    const int lo = args.ph_lo, hi = args.ph_hi;
    unsigned char* ws = args.ws;
    XcdBarrier bar; bar.bar = (unsigned*)(ws + WS_CTL) + CW_BAR + args.li * XCD_BAR_WORDS; bar.x = 0; bar.st = nullptr;
    if (hi - lo > 1) bar = xcd_barrier_post((unsigned*)(ws + WS_CTL) + CW_BAR + args.li * XCD_BAR_WORDS, MISC + 8);
#ifndef PH_MASK
#define PH_MASK 0xfff
#endif
#define IN(k) (lo <= (k) && (k) < hi)
#define ON(b) ((PH_MASK >> (b)) & 1)
#ifndef PROBE_DUP
#define PROBE_DUP 0
#endif
#define REP(b) _Pragma("unroll 1") for (int rep_ = 0; rep_ < 1 + ((PROBE_DUP >> (b)) & 1); ++rep_)
#define SEAM(k) do { if (IN(k) && IN((k) + 1)) xcd_barrier(bar); } while (0)

    if (ON(0) && IN(0)) REP(0) p0_prologue(lds);
    SEAM(0);
    const ldsp xl = lds + 131072;
#pragma unroll
    for (int layer = 0; layer < 2; ++layer) {
        const int pb = 1 + 7 * layer;
        bf16_t* x_in = (bf16_t*)(ws + (layer == 0 ? WS_XS0 : WS_XS2)); bf16_t* x_mid = (bf16_t*)(ws + WS_XS1); bf16_t* x_out = (bf16_t*)(ws + (layer == 0 ? WS_XS2 : WS_XS0));
        float* ssqa = (float*)(ws + SM_SSQA); float* ssqb = (float*)(ws + SM_SSQB);
        if (ON(5) && IN(pb + 0)) {
            const bool split = (SPLIT_INPROJ0 && layer == 0 && gridDim.x == 256);
            if (split && (int)blockIdx.x >= GEMM0_WGS) deferred_phase(lds, GEMM0_WGS, 0, 9);
            else REP(5) gemm_call_norm(lds, x_in, (const bf16_t*)(ws + WS_WIN) + (size_t)layer * NP * DM, NP, DM, ssqa, pg8::EpiBf16N{(bf16_t*)(ws + WS_PROJ), NP, 0, xl}, split ? GEMM0_WGS : (int)gridDim.x);
        }
        SEAM(pb + 0);
        if (ON(3) && IN(pb + 1)) REP(3) s1_phase(lds, layer);
        SEAM(pb + 1);
        if (ON(3) && IN(pb + 2)) { ret_scan_phase(lds); for (int u = (int)gridDim.x - 1 - (int)blockIdx.x; u < 64; u += (int)gridDim.x) nsa_cmp2_unit(lds, layer, u); }
        SEAM(pb + 2);
        if (ON(4) && IN(pb + 3)) REP(4) s3_phase(lds, layer);
        SEAM(pb + 3);
        if (ON(6) && IN(pb + 4)) REP(6) gemm_call(lds, (const bf16_t*)(ws + WS_Y), (const bf16_t*)(ws + WS_WOUT) + (size_t)layer * DM * DM, DM, DM, pg8::EpiResidB{x_in, x_mid, DM, ssqb, xl});
        SEAM(pb + 4);
        if (ON(7) && IN(pb + 5)) {
            const bool split = (SPLIT_GU0 && layer == 0 && gridDim.x == 256);
            if (split && (int)blockIdx.x >= GU0_WGS) deferred_phase(lds, GU0_WGS, 4, 9);
            else REP(7) gemm_call_norm(lds, x_mid, (const bf16_t*)(ws + WS_WGU) + (size_t)layer * NGU * DM, NGU, DM, ssqb, pg8::EpiSwiGLUN{(bf16_t*)(ws + WS_U), DFF, 0, xl}, split ? GU0_WGS : (int)gridDim.x);
        }
        SEAM(pb + 5);
        if (ON(8) && IN(pb + 6)) REP(8) gemm_call(lds, (const bf16_t*)(ws + WS_U), (const bf16_t*)(ws + WS_WDN) + (size_t)layer * DM * DFF, DM, DFF, pg8::EpiResidB{x_mid, x_out, DM, ssqa, xl});
        SEAM(pb + 6);
    }
    if (ON(1) && IN(15)) final_norm_phase(lds, (const bf16_t*)(ws + WS_XS0), (const float*)(ws + SM_SSQA), inp(22), args.out);
#undef IN
#undef SEAM
}

extern "C" void kernel_launch(void* const* d_in, const int* in_sizes, int n_in, void* d_out, int out_size, void* d_ws, size_t ws_size, hipStream_t stream) {
    static int grid = 0;
    if (grid == 0) {
        if (n_in != 23 || in_sizes[0] != MTOK * DM || out_size != MTOK * DM || ws_size < WS_END) {
            fprintf(stderr, "kernel_launch: unexpected shapes (n_in %d, in0 %d, out %d, ws %zu < %zu); nothing launched\n", n_in, n_in > 0 ? in_sizes[0] : -1, out_size, ws_size, (size_t)WS_END); grid = -1; return; }
        int dev = 0, cus = 0, per_cu = 0;
        if (hipGetDevice(&dev) != hipSuccess || hipDeviceGetAttribute(&cus, hipDeviceAttributeMultiprocessorCount, dev) != hipSuccess) { fprintf(stderr, "kernel_launch: device query failed\n"); grid = -1; return; }
        if (hipFuncSetAttribute((const void*)trunk_fwd, hipFuncAttributeMaxDynamicSharedMemorySize, LDS_BYTES) != hipSuccess) { fprintf(stderr, "kernel_launch: hipFuncSetAttribute(%d B LDS) failed\n", LDS_BYTES); grid = -1; return; }
        if (hipOccupancyMaxActiveBlocksPerMultiprocessor(&per_cu, (const void*)trunk_fwd, NTHR, LDS_BYTES) != hipSuccess || per_cu < 1)
            fprintf(stderr, "kernel_launch: note: occupancy query reports %d workgroups per CU\n", per_cu);
        (void)hipGetLastError();
        grid = cus;
    }
    if (grid < 0) return;
    if (hipMemsetAsync((char*)d_ws + WS_CTL, 0, CTL_ZERO_BYTES, stream) != hipSuccess) { fprintf(stderr, "kernel_launch: memset failed\n"); return; }
    Args a{};
    for (int i = 0; i < 23; ++i) a.in[i] = (const float*)d_in[i];
    a.out = (float*)d_out; a.ws = (unsigned char*)d_ws; a.pad = 0;
#if MK_LAUNCHES == 1
    a.ph_lo = 0; a.ph_hi = N_PHASES; a.li = 0;
    hipLaunchKernelGGL(trunk_fwd, dim3(grid), dim3(NTHR), LDS_BYTES, stream, a);
#else
    for (int k = 0; k < N_PHASES; ++k) { a.ph_lo = k; a.ph_hi = k + 1; a.li = k;
        hipLaunchKernelGGL(trunk_fwd, dim3(grid), dim3(NTHR), LDS_BYTES, stream, a); }
#endif
    const hipError_t le = hipPeekAtLastError();
    if (le != hipSuccess) fprintf(stderr, "kernel_launch: launch failed: %s (grid %d)\n", hipGetErrorName(le), grid);
}
```
